# Optimizing an MI355X kernel written in HIP

```python
import math
import jax, jax.numpy as jnp
from jax import lax
import numpy as np

D_MODEL = 1024
BATCH = 8
SEQ = 8192
DEPTH = 4

GRID_W = 64
CTX_LEN = 256
N_MIXERS = 2
HEAD_DIM = 64
N_HEADS = D_MODEL // HEAD_DIM
N_RWKV = (DEPTH + 1) // 2
N_NA = DEPTH // 2
N_LERP = 6
N_DIRS = 2
D_DECAY_LORA = 64
D_AAA_LORA = 64
D_MV_LORA = 32
LNX_EPS = 64e-5
WIN_H = 8
WIN_W = 16
Q_BLOCK_W = 8
BAND_W = Q_BLOCK_W + WIN_W
N_CBLOCKS = GRID_W // Q_BLOCK_W
RMS_EPS = 1e-6
NEG_INF = -1e30

kernel_name = "hybrid_rwkv7_natten_dit"


def _rmsnorm(x, g):
    xf = x.astype(jnp.float32)
    y = xf * lax.rsqrt(jnp.mean(xf * xf, axis=-1, keepdims=True) + RMS_EPS)
    return (y * g.astype(jnp.float32)).astype(x.dtype)


def _heads(t):
    return t.reshape(*t.shape[:-1], N_HEADS, HEAD_DIM)


def _centred_shift(h):
    pad = jnp.pad(h, ((0, 0), (1, 1), (0, 0)))
    return 0.5 * (pad[:, :-2] + pad[:, 2:]) - h


def _rwkv_project(h, mu, w_rkvg, w0, w1, w2, a0, a1, a2, k_k, k_a, v_first, vres):
    f32 = jnp.float32
    xx = _centred_shift(h)
    xr, xw, xk, xv, xa, xg = [h + xx * mu[n] for n in range(N_LERP)]
    r = xr @ w_rkvg[0]
    k = xk @ w_rkvg[1]
    v = xv @ w_rkvg[2]
    g = jax.nn.silu(xg @ w_rkvg[3])
    if vres is not None:
        v0, v1, v2 = vres
        v = v + (v_first - v) * jax.nn.sigmoid(v0 + (xv @ v1) @ v2)
    lora_w = jnp.einsum('dbtr,drc->dbtc', jnp.tanh(jnp.einsum('btc,dcr->dbtr', xw, w1)), w2)
    w_log = -jax.nn.softplus(-(w0[:, None, None, :] + lora_w).astype(f32)) - 0.5
    decay = jnp.exp(-jnp.exp(w_log))
    lora_a = jnp.einsum('dbtr,drc->dbtc', jnp.einsum('btc,dcr->dbtr', xa, a1), a2)
    a = jax.nn.sigmoid((a0[:, None, None, :] + lora_a).astype(f32))
    kf = k.astype(f32)
    kk = _heads(kf * k_k)
    kk = kk / jnp.maximum(jnp.sqrt(jnp.sum(kk * kk, axis=-1, keepdims=True)), 1e-12)
    k_dir = kf[None] * (1.0 + (a - 1.0) * k_a)
    return (_heads(r.astype(f32)), _heads(k_dir), _heads(v.astype(f32)), kk,
            _heads(a), _heads(decay), g, v)


def _rwkv_scan(r, w, k, v, kk, a, s0, reverse):
    def step(s, inp):
        r_t, w_t, k_t, v_t, kk_t, a_t = inp
        sa = jnp.einsum('bhvk,bhk->bhv', s, -kk_t)
        s = (s * w_t[:, :, None, :]
             + sa[..., None] * (kk_t * a_t)[:, :, None, :]
             + v_t[..., None] * k_t[:, :, None, :])
        y = jnp.einsum('bhvk,bhk->bhv', s, r_t)
        return s, y
    xs = tuple(jnp.moveaxis(t, 1, 0) for t in (r, w, k, v, kk, a))
    s_final, ys = lax.scan(step, s0, xs, reverse=reverse)
    return jnp.moveaxis(ys, 0, 1), s_final


def _rwkv_output(y, r, k_dir, v, g, r_k, lnx_w, lnx_b, w_out):
    B, T = y.shape[:2]
    mu = jnp.mean(y, axis=-1, keepdims=True)
    var = jnp.mean(jnp.square(y - mu), axis=-1, keepdims=True)
    yn = ((y - mu) * lax.rsqrt(var + LNX_EPS)).reshape(B, T, D_MODEL) * lnx_w + lnx_b
    bonus = jnp.sum(jnp.sum(r[None] * k_dir * r_k, axis=-1, keepdims=True), axis=0) * v
    o = (yn + bonus.reshape(B, T, D_MODEL)).astype(g.dtype)
    return (o * g) @ w_out


def _rwkv_mixer(h_lat, h_ctx, mu, w_rkvg, w0, w1, w2, a0, a1, a2, k_k, k_a, r_k,
                lnx_w, lnx_b, w_out, v_first_lat, v_first_ctx, vres, with_ctx_out):
    B = h_lat.shape[0]
    r_l, k_l, v_l, kk_l, a_l, w_l, g_l, vraw_l = _rwkv_project(
        h_lat, mu, w_rkvg, w0, w1, w2, a0, a1, a2, k_k, k_a, v_first_lat, vres)
    r_c, k_c, v_c, kk_c, a_c, w_c, g_c, vraw_c = _rwkv_project(
        h_ctx, mu, w_rkvg, w0, w1, w2, a0, a1, a2, k_k, k_a, v_first_ctx, vres)
    s0 = jnp.zeros((B, N_HEADS, HEAD_DIM, HEAD_DIM), jnp.float32)
    y_lat = jnp.zeros_like(r_l)
    y_ctx = jnp.zeros_like(r_c)
    for d in range(N_DIRS):
        rev = d == 1
        yc, s_ctx = _rwkv_scan(r_c, w_c[d], k_c[d], v_c, kk_c, a_c[d], s0, rev)
        yl, _ = _rwkv_scan(r_l, w_l[d], k_l[d], v_l, kk_l, a_l[d], s_ctx, rev)
        y_lat = y_lat + yl
        y_ctx = y_ctx + yc
    out_lat = _rwkv_output(y_lat, r_l, k_l, v_l, g_l, r_k, lnx_w, lnx_b, w_out)
    out_ctx = _rwkv_output(y_ctx, r_c, k_c, v_c, g_c, r_k, lnx_w, lnx_b, w_out) if with_ctx_out else None
    return out_lat, out_ctx, vraw_l, vraw_c


def _na_column_tables():
    j = np.arange(GRID_W)
    win_start = np.clip(j - WIN_W // 2, 0, GRID_W - WIN_W)
    cb = np.arange(N_CBLOCKS)
    band_start = np.clip(cb * Q_BLOCK_W - WIN_W // 2, 0, GRID_W - BAND_W)
    band_cols = band_start[:, None] + np.arange(BAND_W)[None, :]
    q_cols = cb[:, None] * Q_BLOCK_W + np.arange(Q_BLOCK_W)[None, :]
    key_c = band_cols[:, None, :]
    qs = win_start[q_cols][:, :, None]
    valid = (key_c >= qs) & (key_c < qs + WIN_W)
    dc = np.clip(key_c - q_cols[:, :, None], -(WIN_W - 1), WIN_W - 1) + (WIN_W - 1)
    return band_cols, valid, dc


def _na_mixer(h_lat, h_ctx, w_in, b_in, rpb, w_out, with_ctx_out):
    B, T, D = h_lat.shape
    n_ctx = h_ctx.shape[1]
    rows = T // GRID_W
    kh = min(WIN_H, rows)
    scale = HEAD_DIM ** -0.5
    q, k, v, g = jnp.split(h_lat @ w_in + b_in, 4, axis=-1)
    q = (q * scale).reshape(B, rows, N_CBLOCKS, Q_BLOCK_W, N_HEADS, HEAD_DIM)
    k = k.reshape(B, rows, GRID_W, N_HEADS, HEAD_DIM)
    v = v.reshape(B, rows, GRID_W, N_HEADS, HEAD_DIM)
    k_c, v_c = jnp.split(h_ctx @ w_in[:, D:3 * D] + b_in[D:3 * D], 2, axis=-1)
    k_c, v_c = _heads(k_c), _heads(v_c)
    band_cols, valid_np, dc = _na_column_tables()
    valid = jnp.asarray(valid_np)[:, :, None, :]

    def row_block(args):
        r, q_r = args
        rs = jnp.clip(r - WIN_H // 2, 0, rows - kh)
        k_band = lax.dynamic_slice_in_dim(k, rs, kh, axis=1)[:, :, band_cols]
        v_band = lax.dynamic_slice_in_dim(v, rs, kh, axis=1)[:, :, band_cols]
        dr = rs - r + jnp.arange(kh) + (WIN_H - 1)
        bias = jnp.transpose(rpb[:, dr][:, :, dc], (0, 2, 3, 1, 4))
        s_win = (jnp.einsum('bcqhd,bicwhd->bhcqiw', q_r, k_band).astype(jnp.float32)
                 + bias.astype(jnp.float32)[None])
        s_win = jnp.where(valid, s_win, NEG_INF).reshape(B, N_HEADS, N_CBLOCKS, Q_BLOCK_W, kh * BAND_W)
        s_ctx = jnp.einsum('bcqhd,bshd->bhcqs', q_r, k_c).astype(jnp.float32)
        p = jax.nn.softmax(jnp.concatenate([s_win, s_ctx], axis=-1), axis=-1).astype(v.dtype)
        p_win = p[..., :kh * BAND_W].reshape(B, N_HEADS, N_CBLOCKS, Q_BLOCK_W, kh, BAND_W)
        p_ctx = p[..., kh * BAND_W:]
        o = (jnp.einsum('bhcqiw,bicwhd->bcqhd', p_win, v_band)
             + jnp.einsum('bhcqs,bshd->bcqhd', p_ctx, v_c))
        return o.reshape(B, GRID_W, D)

    o = lax.map(row_block, (jnp.arange(rows), jnp.moveaxis(q, 1, 0)))
    o = jnp.moveaxis(o, 0, 1).reshape(B, T, D)
    out_lat = (o * jax.nn.silu(g)) @ w_out
    out_ctx = None
    if with_ctx_out:
        q_cx = _heads((h_ctx @ w_in[:, :D] + b_in[:D]) * scale)
        g_cx = h_ctx @ w_in[:, 3 * D:] + b_in[3 * D:]
        s = jnp.einsum('bqhd,bshd->bhqs', q_cx, k_c).astype(jnp.float32)
        p = jax.nn.softmax(s, axis=-1).astype(v_c.dtype)
        o_c = jnp.einsum('bhqs,bshd->bqhd', p, v_c).reshape(B, n_ctx, D)
        out_ctx = (o_c * jax.nn.silu(g_cx)) @ w_out
    return out_lat, out_ctx


def setup_inputs(seed: int = 0) -> dict:
    key = jax.random.key(seed)
    ks = iter(jax.random.split(key, 40))
    D = D_MODEL
    f32 = jnp.float32

    def nrm(shape, s):
        return jax.random.normal(next(ks), shape, f32) * s

    def uni(shape, lo, hi):
        return jax.random.uniform(next(ks), shape, f32, lo, hi)

    return {
        "x": nrm((BATCH, SEQ, D), 1.0),
        "c": nrm((BATCH, D), 1.0),
        "ctx": nrm((BATCH, CTX_LEN, D), 1.0),
        "c_ctx": nrm((D,), 1.0),
        "ada_w": nrm((DEPTH, D, 3 * D), 0.5 * D ** -0.5),
        "ada_b": nrm((DEPTH, 3 * D), 0.02),
        "pre_g": 1.0 + nrm((DEPTH, D), 0.05),
        "post_g": 1.0 + nrm((DEPTH, D), 0.05),
        "rw_mu": uni((N_RWKV, N_LERP, D), 0.0, 1.0),
        "rw_w_rkvg": nrm((N_RWKV, 4, D, D), D ** -0.5),
        "rw_w0": uni((N_RWKV, N_DIRS, D), -6.0, -1.0),
        "rw_w1": nrm((N_RWKV, N_DIRS, D, D_DECAY_LORA), D ** -0.5),
        "rw_w2": nrm((N_RWKV, N_DIRS, D_DECAY_LORA, D), 0.5 * D_DECAY_LORA ** -0.5),
        "rw_a0": nrm((N_RWKV, N_DIRS, D), 0.5),
        "rw_a1": nrm((N_RWKV, N_DIRS, D, D_AAA_LORA), D ** -0.5),
        "rw_a2": nrm((N_RWKV, N_DIRS, D_AAA_LORA, D), 0.5 * D_AAA_LORA ** -0.5),
        "rw_v0": nrm((N_RWKV - 1, D), 0.5),
        "rw_v1": nrm((N_RWKV - 1, D, D_MV_LORA), D ** -0.5),
        "rw_v2": nrm((N_RWKV - 1, D_MV_LORA, D), 0.5 * D_MV_LORA ** -0.5),
        "rw_k_k": 0.85 + nrm((N_RWKV, D), 0.05),
        "rw_k_a": 1.0 + nrm((N_RWKV, D), 0.05),
        "rw_r_k": nrm((N_RWKV, N_HEADS, HEAD_DIM), 0.1),
        "rw_lnx_w": 1.0 + nrm((N_RWKV, D), 0.05),
        "rw_lnx_b": nrm((N_RWKV, D), 0.02),
        "rw_w_out": nrm((N_RWKV, D, D), D ** -0.5),
        "na_w_in": nrm((N_NA, D, 4 * D), D ** -0.5),
        "na_b_in": nrm((N_NA, 4 * D), 0.02),
        "na_rpb": nrm((N_NA, N_HEADS, 2 * WIN_H - 1, 2 * WIN_W - 1), 0.5),
        "na_w_out": nrm((N_NA, D, D), D ** -0.5),
    }


def reference(x, c, ctx, c_ctx, ada_w, ada_b, pre_g, post_g, rw_mu, rw_w_rkvg, rw_w0, rw_w1, rw_w2,
              rw_a0, rw_a1, rw_a2, rw_v0, rw_v1, rw_v2, rw_k_k, rw_k_a, rw_r_k, rw_lnx_w, rw_lnx_b,
              rw_w_out, na_w_in, na_b_in, na_rpb, na_w_out):
    silu_c = jax.nn.silu(c)
    silu_cc = jax.nn.silu(c_ctx)
    v_first_lat = None
    v_first_ctx = None
    for i in range(DEPTH):
        last = i == DEPTH - 1
        j = i // N_MIXERS
        shift, scale, gate = jnp.split(silu_c @ ada_w[i] + ada_b[i], 3, axis=-1)
        shift_c, scale_c, gate_c = jnp.split(silu_cc @ ada_w[i] + ada_b[i], 3, axis=-1)
        h = _rmsnorm(x, pre_g[i]) * (1.0 + scale[:, None]) + shift[:, None]
        hc = _rmsnorm(ctx, pre_g[i]) * (1.0 + scale_c) + shift_c
        if i % N_MIXERS == 0:
            vres = None if j == 0 else (rw_v0[j - 1], rw_v1[j - 1], rw_v2[j - 1])
            out, out_c, v_lat, v_ctx = _rwkv_mixer(
                h, hc, rw_mu[j], rw_w_rkvg[j], rw_w0[j], rw_w1[j], rw_w2[j], rw_a0[j], rw_a1[j],
                rw_a2[j], rw_k_k[j], rw_k_a[j], rw_r_k[j], rw_lnx_w[j], rw_lnx_b[j], rw_w_out[j],
                v_first_lat, v_first_ctx, vres, not last)
            if j == 0:
                v_first_lat, v_first_ctx = v_lat, v_ctx
        else:
            out, out_c = _na_mixer(h, hc, na_w_in[j], na_b_in[j], na_rpb[j], na_w_out[j], not last)
        x = x + gate[:, None] * _rmsnorm(out, post_g[i])
        if not last:
            ctx = ctx + gate_c * _rmsnorm(out_c, post_g[i])
    return x
```

```cpp
#include <hip/hip_runtime.h>
#include <hip/hip_cooperative_groups.h>
#include <cstdint>
#include <cstdio>
namespace cg = cooperative_groups;

typedef unsigned short bf;
typedef short bf16x8 __attribute__((ext_vector_type(8)));
typedef float f32x4 __attribute__((ext_vector_type(4)));
typedef unsigned u32x4 __attribute__((ext_vector_type(4)));
typedef unsigned u32x2 __attribute__((ext_vector_type(2)));

constexpr int DM = 1024, NB = 8, SEQ = 8192, NL = NB * SEQ, CTXL = 256, NC = NB * CTXL, MT = NL + NC;
constexpr int HIDW = 384;
constexpr int SMEM_BYTES = 65536;
#define NEGV (-1e30f)

struct Params {
  const float *x, *c, *ctx, *c_ctx, *ada_w, *ada_b, *pre_g, *post_g, *rw_mu, *rw_w_rkvg, *rw_w0, *rw_w1, *rw_w2,
      *rw_a0, *rw_a1, *rw_a2, *rw_v0, *rw_v1, *rw_v2, *rw_k_k, *rw_k_a, *rw_r_k, *rw_lnx_w, *rw_lnx_b, *rw_w_out,
      *na_w_in, *na_b_in, *na_rpb, *na_w_out;
  float* out;
  float *mod, *ctxbuf, *beta;
  bf *Wp, *Wo, *w2t, *a2t, *v2t;
  bf *H, *R, *K, *VF, *V2, *G, *Y1, *HID;
  Params* gp;
};

__device__ __forceinline__ float bflo(unsigned w) { return __uint_as_float(w << 16); }
__device__ __forceinline__ float bfhi(unsigned w) { return __uint_as_float(w & 0xffff0000u); }
typedef __bf16 bf16x2_t __attribute__((ext_vector_type(2)));
__device__ __forceinline__ unsigned pk2(float lo, float hi) {
  bf16x2_t v = {(__bf16)lo, (__bf16)hi};
  return __builtin_bit_cast(unsigned, v);
}
__device__ __forceinline__ float siluf(float v) { return v / (1.f + __expf(-v)); }
__device__ __forceinline__ float sigmf(float v) { return 1.f / (1.f + __expf(-v)); }
__device__ __forceinline__ float quad_sum(float v) {
  int t = __builtin_amdgcn_update_dpp(0, __float_as_int(v), 0xB1, 0xF, 0xF, true);
  v += __int_as_float(t);
  t = __builtin_amdgcn_update_dpp(0, __float_as_int(v), 0x4E, 0xF, 0xF, true);
  v += __int_as_float(t);
  return v;
}
__device__ __forceinline__ float wave_sum(float v) {
#pragma unroll
  for (int o = 32; o >= 1; o >>= 1) v += __shfl_xor(v, o);
  return v;
}
__device__ __forceinline__ int otid() { int t = threadIdx.x; asm volatile("" : "+v"(t)); return t; }
__device__ __forceinline__ int lds_off(int row, int c) { return row * 128 + ((c ^ ((row >> 1) & 7)) << 4); }
__device__ __forceinline__ unsigned lerp2(unsigned hm, unsigned h0, unsigned hp, float m0, float m1) {
  const float c0 = bflo(h0), c1 = bfhi(h0);
  const float x0 = 0.5f * (bflo(hm) + bflo(hp)) - c0;
  const float x1 = 0.5f * (bfhi(hm) + bfhi(hp)) - c1;
  return pk2(c0 + x0 * m0, c1 + x1 * m1);
}
__device__ __forceinline__ int mod_idx(int row) { return row < NL ? (row >> 13) : 8; }

__device__ void pre_phase(const Params& p, char* smem) {
  float* s = (float*)smem;
  float* red = s + 9 * 1024;
  const int tid = otid();
  for (int item = blockIdx.x; item < 4 * 48; item += gridDim.x) {
    const int i = item / 48, cb = item % 48;
    __syncthreads();
    for (int idx = tid; idx < 9 * 1024; idx += 256) {
      const int m = idx >> 10, k = idx & 1023;
      const float v = (m < 8) ? p.c[m * 1024 + k] : p.c_ctx[k];
      s[idx] = siluf(v);
    }
    __syncthreads();
    const int cc = tid & 63, kq = tid >> 6;
    float acc[9];
#pragma unroll
    for (int m = 0; m < 9; ++m) acc[m] = 0.f;
    const float* W = p.ada_w + (size_t)i * 1024 * 3072 + cb * 64 + cc;
    for (int k = kq * 256; k < kq * 256 + 256; ++k) {
      const float w = W[(size_t)k * 3072];
#pragma unroll
      for (int m = 0; m < 9; ++m) acc[m] += s[m * 1024 + k] * w;
    }
#pragma unroll
    for (int m = 0; m < 9; ++m) red[(kq * 9 + m) * 64 + cc] = acc[m];
    __syncthreads();
    for (int idx = tid; idx < 9 * 64; idx += 256) {
      const int m = idx >> 6, c2 = idx & 63;
      float v = red[(0 * 9 + m) * 64 + c2] + red[(1 * 9 + m) * 64 + c2] + red[(2 * 9 + m) * 64 + c2] + red[(3 * 9 + m) * 64 + c2];
      v += p.ada_b[i * 3072 + cb * 64 + c2];
      p.mod[(size_t)(i * 9 + m) * 3072 + cb * 64 + c2] = v;
    }
  }
}

struct TOp { const float* src; bf* dst; int K, N, Kp, Np; };
__device__ bool get_op(const Params& p, int i, int op, TOp& o) {
  const int j = i >> 1;
  if (i & 1) {
    if (op == 0) { o = {p.na_w_in + (size_t)j * 1024 * 4096, p.Wp, 1024, 4096, 1024, 4096}; return true; }
    if (op == 1) { o = {p.na_w_out + (size_t)j * 1024 * 1024, p.Wo, 1024, 1024, 1024, 1024}; return true; }
    return false;
  }
  if (op < 4) { o = {p.rw_w_rkvg + ((size_t)j * 4 + op) * 1024 * 1024, p.Wp + (size_t)op * 1024 * 1024, 1024, 1024, 1024, 1024}; return true; }
  if (op < 6) { const int d = op - 4; o = {p.rw_w1 + ((size_t)j * 2 + d) * 1024 * 64, p.Wp + (size_t)(4096 + d * 64) * 1024, 1024, 64, 1024, 64}; return true; }
  if (op < 8) { const int d = op - 6; o = {p.rw_a1 + ((size_t)j * 2 + d) * 1024 * 64, p.Wp + (size_t)(4224 + d * 64) * 1024, 1024, 64, 1024, 64}; return true; }
  if (op < 10) { const int d = op - 8; o = {p.rw_w2 + ((size_t)j * 2 + d) * 64 * 1024, p.w2t + (size_t)d * 65536, 64, 1024, 64, 1024}; return true; }
  if (op < 12) { const int d = op - 10; o = {p.rw_a2 + ((size_t)j * 2 + d) * 64 * 1024, p.a2t + (size_t)d * 65536, 64, 1024, 64, 1024}; return true; }
  if (op == 12) { o = {p.rw_w_out + (size_t)j * 1024 * 1024, p.Wo, 1024, 1024, 1024, 1024}; return true; }
  if (j == 1 && op == 13) { o = {p.rw_v1, p.Wp + (size_t)4352 * 1024, 1024, 32, 1024, 128}; return true; }
  if (j == 1 && op == 14) { o = {p.rw_v2, p.v2t, 32, 1024, 64, 1024}; return true; }
  return false;
}

__device__ void transpose_phase(const Params& p, int i, char* smem) {
  float* t = (float*)smem;
  const int tid = otid();
  int base = 0;
  for (int op = 0;; ++op) {
    TOp o;
    if (!get_op(p, i, op, o)) break;
    const int tk = o.Kp / 64, tn = o.Np / 64, nt = tk * tn;
    int first = blockIdx.x - (base % (int)gridDim.x);
    if (first < 0) first += gridDim.x;
    for (int g = first; g < nt; g += gridDim.x) {
      const int kt = g / tn, ntile = g % tn;
      __syncthreads();
#pragma unroll
      for (int ps = 0; ps < 4; ++ps) {
        const int kr = ps * 16 + (tid >> 4), c4 = (tid & 15) * 4;
        const int k = kt * 64 + kr, n = ntile * 64 + c4;
        f32x4 v = (f32x4){0.f, 0.f, 0.f, 0.f};
        if (k < o.K && n < o.N) v = *(const f32x4*)(o.src + (size_t)k * o.N + n);
        t[kr * 65 + c4 + 0] = v.x; t[kr * 65 + c4 + 1] = v.y; t[kr * 65 + c4 + 2] = v.z; t[kr * 65 + c4 + 3] = v.w;
      }
      __syncthreads();
      const int n = tid >> 2, kc = (tid & 3) * 16;
      unsigned w[8];
#pragma unroll
      for (int e = 0; e < 8; ++e) w[e] = pk2(t[(kc + 2 * e) * 65 + n], t[(kc + 2 * e + 1) * 65 + n]);
      bf* d = o.dst + (size_t)(ntile * 64 + n) * o.Kp + kt * 64 + kc;
      *(u32x4*)d = (u32x4){w[0], w[1], w[2], w[3]};
      *(u32x4*)(d + 8) = (u32x4){w[4], w[5], w[6], w[7]};
    }
    base += nt;
  }
}

__device__ void row_phase(const Params& p, int i) {
  const int tid = otid(), lane = tid & 63;
  const int gw = blockIdx.x * 4 + (tid >> 6), nw = gridDim.x * 4;
  const int nrows = (i == 4) ? NL : MT;
  for (int row = gw; row < nrows; row += nw) {
    const int m = mod_idx(row);
    const float* xs;
    if (i <= 1) xs = (row < NL) ? p.x + (size_t)row * 1024 : p.ctx + (size_t)(row - NL) * 1024;
    else xs = (row < NL) ? p.out + (size_t)row * 1024 : p.ctxbuf + (size_t)(row - NL) * 1024;
    f32x4 xv[4];
#pragma unroll
    for (int q = 0; q < 4; ++q) xv[q] = *(const f32x4*)(xs + q * 256 + lane * 4);
    if (i > 0) {
      const bf* orow = p.R + (size_t)row * 1024;
      float ov[4][4];
      float ss = 0.f;
#pragma unroll
      for (int q = 0; q < 4; ++q) {
        const u32x2 u = *(const u32x2*)(orow + q * 256 + lane * 4);
        ov[q][0] = bflo(u.x); ov[q][1] = bfhi(u.x); ov[q][2] = bflo(u.y); ov[q][3] = bfhi(u.y);
        ss += ov[q][0] * ov[q][0] + ov[q][1] * ov[q][1] + ov[q][2] * ov[q][2] + ov[q][3] * ov[q][3];
      }
      ss = wave_sum(ss);
      const float rs = rsqrtf(ss * (1.f / 1024.f) + 1e-6f);
      const float* gate = p.mod + (size_t)((i - 1) * 9 + m) * 3072 + 2048;
      const float* pg = p.post_g + (i - 1) * 1024;
      float* xd = (row < NL) ? p.out + (size_t)row * 1024 : p.ctxbuf + (size_t)(row - NL) * 1024;
#pragma unroll
      for (int q = 0; q < 4; ++q) {
        const int col = q * 256 + lane * 4;
        const f32x4 gv = *(const f32x4*)(gate + col);
        const f32x4 pv = *(const f32x4*)(pg + col);
        xv[q].x += gv.x * ov[q][0] * rs * pv.x;
        xv[q].y += gv.y * ov[q][1] * rs * pv.y;
        xv[q].z += gv.z * ov[q][2] * rs * pv.z;
        xv[q].w += gv.w * ov[q][3] * rs * pv.w;
        *(f32x4*)(xd + col) = xv[q];
      }
    }
    if (i < 4) {
      float ss = 0.f;
#pragma unroll
      for (int q = 0; q < 4; ++q) ss += xv[q].x * xv[q].x + xv[q].y * xv[q].y + xv[q].z * xv[q].z + xv[q].w * xv[q].w;
      ss = wave_sum(ss);
      const float rs = rsqrtf(ss * (1.f / 1024.f) + 1e-6f);
      const float* md = p.mod + (size_t)(i * 9 + m) * 3072;
      const float* pg = p.pre_g + i * 1024;
      bf* hd = p.H + (size_t)row * 1024;
#pragma unroll
      for (int q = 0; q < 4; ++q) {
        const int col = q * 256 + lane * 4;
        const f32x4 sh = *(const f32x4*)(md + col);
        const f32x4 sc = *(const f32x4*)(md + 1024 + col);
        const f32x4 pv = *(const f32x4*)(pg + col);
        const float h0 = xv[q].x * rs * pv.x * (1.f + sc.x) + sh.x;
        const float h1 = xv[q].y * rs * pv.y * (1.f + sc.y) + sh.y;
        const float h2 = xv[q].z * rs * pv.z * (1.f + sc.z) + sh.z;
        const float h3 = xv[q].w * rs * pv.w * (1.f + sc.w) + sh.w;
        *(u32x2*)(hd + col) = (u32x2){pk2(h0, h1), pk2(h2, h3)};
      }
    }
  }
}

struct EpiRwkvProj {
  bf *R, *K, *V, *G, *HID;
  __device__ __forceinline__ void operator()(int nt, int tok, int col, f32x4 v) const {
    bf* dst;
    if (nt < 8) dst = R + (size_t)tok * 1024 + col;
    else if (nt < 16) dst = K + (size_t)tok * 1024 + (col - 1024);
    else if (nt < 24) dst = V + (size_t)tok * 1024 + (col - 2048);
    else if (nt < 32) {
      dst = G + (size_t)tok * 1024 + (col - 3072);
#pragma unroll
      for (int e = 0; e < 4; ++e) v[e] = siluf(v[e]);
    } else {
      dst = HID + (size_t)tok * HIDW + (col - 4096);
      if (nt == 32) {
#pragma unroll
        for (int e = 0; e < 4; ++e) v[e] = tanhf(v[e]);
      }
    }
    *(u32x2*)dst = (u32x2){pk2(v[0], v[1]), pk2(v[2], v[3])};
  }
};
struct EpiNaProj {
  bf *Q, *K, *Vt, *G; const float* bias;
  __device__ __forceinline__ void operator()(int nt, int tok, int col, f32x4 v) const {
    const f32x4 b = *(const f32x4*)(bias + col);
    v[0] += b.x; v[1] += b.y; v[2] += b.z; v[3] += b.w;
    if (nt >= 16 && nt < 24) {
      const int c = col - 2048;
#pragma unroll
      for (int e = 0; e < 4; ++e) Vt[(size_t)(c + e) * MT + tok] = (bf)(pk2(v[e], 0.f) & 0xffffu);
      return;
    }
    bf* dst;
    if (nt < 8) { dst = Q + (size_t)tok * 1024 + col; v[0] *= 0.125f; v[1] *= 0.125f; v[2] *= 0.125f; v[3] *= 0.125f; }
    else if (nt < 16) dst = K + (size_t)tok * 1024 + (col - 1024);
    else dst = G + (size_t)tok * 1024 + (col - 3072);
    *(u32x2*)dst = (u32x2){pk2(v[0], v[1]), pk2(v[2], v[3])};
  }
};
struct EpiOut {
  bf* O;
  __device__ __forceinline__ void operator()(int nt, int tok, int col, f32x4 v) const {
    *(u32x2*)(O + (size_t)tok * 1024 + col) = (u32x2){pk2(v[0], v[1]), pk2(v[2], v[3])};
  }
};
struct EpiVres {
  bf* V2; const bf* VF; const float* v0;
  __device__ __forceinline__ void operator()(int nt, int tok, int col, f32x4 z) const {
    const f32x4 b = *(const f32x4*)(v0 + col);
    const u32x2 uv = *(const u32x2*)(V2 + (size_t)tok * 1024 + col);
    const u32x2 uf = *(const u32x2*)(VF + (size_t)tok * 1024 + col);
    const float v[4] = {bflo(uv.x), bfhi(uv.x), bflo(uv.y), bfhi(uv.y)};
    const float f[4] = {bflo(uf.x), bfhi(uf.x), bflo(uf.y), bfhi(uf.y)};
    const float zz[4] = {z[0] + b.x, z[1] + b.y, z[2] + b.z, z[3] + b.w};
    float r[4];
#pragma unroll
    for (int e = 0; e < 4; ++e) r[e] = v[e] + (f[e] - v[e]) * sigmf(zz[e]);
    *(u32x2*)(V2 + (size_t)tok * 1024 + col) = (u32x2){pk2(r[0], r[1]), pk2(r[2], r[3])};
  }
};

template <int AMODE, class Epi>
__device__ void gemm_phase(const bf* __restrict__ A, int lda, const bf* __restrict__ Bt, int ldb, int nkt, int mtiles, int ntiles,
                           const float* __restrict__ mu, const Epi& epi, char* smem) {
  const int tid = otid(), lane = tid & 63, wid = tid >> 6, wr = wid >> 1, wc = wid & 1, fr = lane & 15, fq = lane >> 4;
  const int rg = tid >> 3, cch = tid & 7;
  char* As = smem;
  char* Bs = smem + 32768;
  const int total = mtiles * ntiles;
  for (int tile = blockIdx.x; tile < total; tile += gridDim.x) {
    const int mt = tile / ntiles, nt = tile % ntiles;
    const int row0 = mt * 128, col0 = nt * 128;
    int lerp = 0; bool sstart = false, send = false;
    if (AMODE == 1) {
      lerp = (nt < 8) ? 0 : (nt < 16) ? 2 : (nt < 24) ? 3 : (nt < 32) ? 5 : (nt == 32) ? 1 : (nt == 33) ? 4 : 3;
      if (row0 < NL) { sstart = (row0 & (SEQ - 1)) == 0; send = ((row0 + 128) & (SEQ - 1)) == 0; }
      else { sstart = ((row0 - NL) & (CTXL - 1)) == 0; send = ((row0 + 128 - NL) & (CTXL - 1)) == 0; }
    }
    f32x4 acc[4][4];
#pragma unroll
    for (int m = 0; m < 4; ++m)
#pragma unroll
      for (int n = 0; n < 4; ++n) acc[m][n] = (f32x4){0.f, 0.f, 0.f, 0.f};
    u32x4 ra[6], rb[4];
    f32x4 muv[2];
    auto gload = [&](int kt) {
      const int kc = kt * 64 + cch * 8;
      if (AMODE == 0) {
#pragma unroll
        for (int i = 0; i < 4; ++i) ra[i] = *(const u32x4*)(A + (size_t)(row0 + rg * 4 + i) * lda + kc);
      } else {
#pragma unroll
        for (int i = 0; i < 6; ++i) {
          const int r = row0 + rg * 4 + i - 1;
          const bool zero = (i == 0 && rg == 0 && sstart) || (i == 5 && rg == 31 && send);
          ra[i] = zero ? (u32x4){0, 0, 0, 0} : *(const u32x4*)(A + (size_t)r * lda + kc);
        }
        muv[0] = *(const f32x4*)(mu + lerp * 1024 + kc);
        muv[1] = *(const f32x4*)(mu + lerp * 1024 + kc + 4);
      }
#pragma unroll
      for (int i = 0; i < 4; ++i) rb[i] = *(const u32x4*)(Bt + (size_t)(col0 + rg * 4 + i) * ldb + kc);
    };
    auto lstore = [&](int buf) {
      char* a = As + buf * 16384;
      char* b = Bs + buf * 16384;
      if (AMODE == 0) {
#pragma unroll
        for (int i = 0; i < 4; ++i) *(u32x4*)(a + lds_off(rg * 4 + i, cch)) = ra[i];
      } else {
#pragma unroll
        for (int i = 0; i < 4; ++i) {
          const u32x4 hm = ra[i], h0 = ra[i + 1], hp = ra[i + 2];
          u32x4 o;
          o.x = lerp2(hm.x, h0.x, hp.x, muv[0].x, muv[0].y);
          o.y = lerp2(hm.y, h0.y, hp.y, muv[0].z, muv[0].w);
          o.z = lerp2(hm.z, h0.z, hp.z, muv[1].x, muv[1].y);
          o.w = lerp2(hm.w, h0.w, hp.w, muv[1].z, muv[1].w);
          *(u32x4*)(a + lds_off(rg * 4 + i, cch)) = o;
        }
      }
#pragma unroll
      for (int i = 0; i < 4; ++i) *(u32x4*)(b + lds_off(rg * 4 + i, cch)) = rb[i];
    };
    __syncthreads();
    gload(0);
    lstore(0);
    __syncthreads();
    for (int kt = 0; kt < nkt; ++kt) {
      const int buf = kt & 1;
      if (kt + 1 < nkt) gload(kt + 1);
      const char* a = As + buf * 16384;
      const char* b = Bs + buf * 16384;
#pragma unroll
      for (int ks = 0; ks < 2; ++ks) {
        bf16x8 af[4], bfr[4];
#pragma unroll
        for (int m = 0; m < 4; ++m) af[m] = *(const bf16x8*)(a + lds_off(wr * 64 + m * 16 + fr, ks * 4 + fq));
#pragma unroll
        for (int n = 0; n < 4; ++n) bfr[n] = *(const bf16x8*)(b + lds_off(wc * 64 + n * 16 + fr, ks * 4 + fq));
#pragma unroll
        for (int m = 0; m < 4; ++m)
#pragma unroll
          for (int n = 0; n < 4; ++n) acc[m][n] = __builtin_amdgcn_mfma_f32_16x16x32_bf16(bfr[n], af[m], acc[m][n], 0, 0, 0);
      }
      if (kt + 1 < nkt) lstore(buf ^ 1);
      __syncthreads();
    }
#pragma unroll
    for (int m = 0; m < 4; ++m)
#pragma unroll
      for (int n = 0; n < 4; ++n) epi(nt, row0 + wr * 64 + m * 16 + fr, col0 + wc * 64 + n * 16 + fq * 4, acc[m][n]);
  }
}

__device__ void scan_phase(const Params& p, int j, char* smem) {
  if (blockIdx.x >= 256) return;
  const int item = blockIdx.x, b = item >> 5, h = (item >> 1) & 15, d = item & 1;
  const int tid = otid(), lane = tid & 63, wid = tid >> 6, fr = lane & 15, fq = lane >> 4;
  float* ops = (float*)smem;
  float* vs = ops + 32 * 320;
  float* ys = vs + 32 * 64;
  const bf* Vsrc = (j == 0) ? p.VF : p.V2;
  bf* Ydst = (d == 0) ? p.H : p.Y1;
  float* betad = p.beta + (size_t)d * MT * 16;
  bf16x8 bw[2], ba[2];
  {
    const int n = h * 64 + wid * 16 + fr;
#pragma unroll
    for (int ks = 0; ks < 2; ++ks) {
      bw[ks] = *(const bf16x8*)(p.w2t + (size_t)d * 65536 + (size_t)n * 64 + ks * 32 + fq * 8);
      ba[ks] = *(const bf16x8*)(p.a2t + (size_t)d * 65536 + (size_t)n * 64 + ks * 32 + fq * 8);
    }
  }
  float w0v[4], a0v[4];
#pragma unroll
  for (int e = 0; e < 4; ++e) {
    w0v[e] = p.rw_w0[(size_t)(j * 2 + d) * 1024 + h * 64 + wid * 16 + fq * 4 + e];
    a0v[e] = p.rw_a0[(size_t)(j * 2 + d) * 1024 + h * 64 + wid * 16 + fq * 4 + e];
  }
  const int tt = tid >> 3, c8 = tid & 7;
  float kkv[8], kav[8], rkv[8];
#pragma unroll
  for (int e = 0; e < 8; ++e) {
    kkv[e] = p.rw_k_k[j * 1024 + h * 64 + c8 * 8 + e];
    kav[e] = p.rw_k_a[j * 1024 + h * 64 + c8 * 8 + e];
    rkv[e] = p.rw_r_k[j * 1024 + h * 64 + c8 * 8 + e];
  }
  const int r16 = lane >> 2, kq = lane & 3;
  float S[16];
#pragma unroll
  for (int e = 0; e < 16; ++e) S[e] = 0.f;

  for (int ch = 0; ch < 264; ++ch) {
    int rowbase, sgn;
    if (d == 0) { sgn = 1; rowbase = (ch < 8) ? NL + b * CTXL + ch * 32 : b * SEQ + (ch - 8) * 32; }
    else { sgn = -1; rowbase = (ch < 8) ? NL + b * CTXL + 255 - ch * 32 : b * SEQ + 8191 - (ch - 8) * 32; }
#pragma unroll
    for (int m = 0; m < 2; ++m) {
      const int tok = m * 16 + fr;
      const size_t row = (size_t)(rowbase + sgn * tok);
      f32x4 aw = (f32x4){0.f, 0.f, 0.f, 0.f}, aa = aw;
#pragma unroll
      for (int ks = 0; ks < 2; ++ks) {
        const bf16x8 hw = *(const bf16x8*)(p.HID + row * HIDW + d * 64 + ks * 32 + fq * 8);
        const bf16x8 ha = *(const bf16x8*)(p.HID + row * HIDW + 128 + d * 64 + ks * 32 + fq * 8);
        aw = __builtin_amdgcn_mfma_f32_16x16x32_bf16(bw[ks], hw, aw, 0, 0, 0);
        aa = __builtin_amdgcn_mfma_f32_16x16x32_bf16(ba[ks], ha, aa, 0, 0, 0);
      }
      f32x4 wd, av;
#pragma unroll
      for (int e = 0; e < 4; ++e) {
        const float z = -(w0v[e] + aw[e]);
        const float sp = fmaxf(z, 0.f) + log1pf(__expf(-fabsf(z)));
        const float wl = -sp - 0.5f;
        wd[e] = __expf(-__expf(wl));
        av[e] = sigmf(a0v[e] + aa[e]);
      }
      *(f32x4*)(ops + (tok * 5 + 0) * 64 + wid * 16 + fq * 4) = wd;
      *(f32x4*)(ops + (tok * 5 + 2) * 64 + wid * 16 + fq * 4) = av;
    }
    __syncthreads();
    {
      const size_t row = (size_t)(rowbase + sgn * tt);
      const size_t off = row * 1024 + h * 64 + c8 * 8;
      const u32x4 uk = *(const u32x4*)(p.K + off);
      const u32x4 ur = *(const u32x4*)(p.R + off);
      const u32x4 uv = *(const u32x4*)(Vsrc + off);
      float k[8], r[8], v[8], kk[8];
#pragma unroll
      for (int e = 0; e < 4; ++e) {
        k[2 * e] = bflo(uk[e]); k[2 * e + 1] = bfhi(uk[e]);
        r[2 * e] = bflo(ur[e]); r[2 * e + 1] = bfhi(ur[e]);
        v[2 * e] = bflo(uv[e]); v[2 * e + 1] = bfhi(uv[e]);
      }
      float ss = 0.f;
#pragma unroll
      for (int e = 0; e < 8; ++e) { kk[e] = k[e] * kkv[e]; ss += kk[e] * kk[e]; }
      ss = quad_sum(ss); ss += __shfl_xor(ss, 4);
      const float inv = 1.f / fmaxf(sqrtf(ss), 1e-12f);
      float* o = ops + tt * 320 + c8 * 8;
      const f32x4 a0 = *(const f32x4*)(o + 128), a1 = *(const f32x4*)(o + 132);
      const float a[8] = {a0.x, a0.y, a0.z, a0.w, a1.x, a1.y, a1.z, a1.w};
      float nk[8], bb[8], kd[8];
      float bt = 0.f;
#pragma unroll
      for (int e = 0; e < 8; ++e) {
        kk[e] *= inv;
        nk[e] = -kk[e];
        bb[e] = kk[e] * a[e];
        kd[e] = k[e] * (1.f + (a[e] - 1.f) * kav[e]);
        bt += r[e] * kd[e] * rkv[e];
      }
      bt = quad_sum(bt); bt += __shfl_xor(bt, 4);
      if (c8 == 0) betad[row * 16 + h] = bt;
      *(f32x4*)(o + 64) = (f32x4){nk[0], nk[1], nk[2], nk[3]};   *(f32x4*)(o + 68) = (f32x4){nk[4], nk[5], nk[6], nk[7]};
      *(f32x4*)(o + 128) = (f32x4){bb[0], bb[1], bb[2], bb[3]};  *(f32x4*)(o + 132) = (f32x4){bb[4], bb[5], bb[6], bb[7]};
      *(f32x4*)(o + 192) = (f32x4){kd[0], kd[1], kd[2], kd[3]};  *(f32x4*)(o + 196) = (f32x4){kd[4], kd[5], kd[6], kd[7]};
      *(f32x4*)(o + 256) = (f32x4){r[0], r[1], r[2], r[3]};      *(f32x4*)(o + 260) = (f32x4){r[4], r[5], r[6], r[7]};
      *(f32x4*)(vs + tt * 64 + c8 * 8) = (f32x4){v[0], v[1], v[2], v[3]};
      *(f32x4*)(vs + tt * 64 + c8 * 8 + 4) = (f32x4){v[4], v[5], v[6], v[7]};
    }
    __syncthreads();
#pragma unroll 2
    for (int t = 0; t < 32; ++t) {
      const float* o = ops + t * 320 + kq * 16;
      float w[16], nk[16], bb[16], kd[16], rr[16];
#pragma unroll
      for (int q = 0; q < 4; ++q) {
        const f32x4 x0 = *(const f32x4*)(o + q * 4);
        const f32x4 x1 = *(const f32x4*)(o + 64 + q * 4);
        const f32x4 x2 = *(const f32x4*)(o + 128 + q * 4);
        const f32x4 x3 = *(const f32x4*)(o + 192 + q * 4);
        const f32x4 x4 = *(const f32x4*)(o + 256 + q * 4);
        w[q * 4] = x0.x; w[q * 4 + 1] = x0.y; w[q * 4 + 2] = x0.z; w[q * 4 + 3] = x0.w;
        nk[q * 4] = x1.x; nk[q * 4 + 1] = x1.y; nk[q * 4 + 2] = x1.z; nk[q * 4 + 3] = x1.w;
        bb[q * 4] = x2.x; bb[q * 4 + 1] = x2.y; bb[q * 4 + 2] = x2.z; bb[q * 4 + 3] = x2.w;
        kd[q * 4] = x3.x; kd[q * 4 + 1] = x3.y; kd[q * 4 + 2] = x3.z; kd[q * 4 + 3] = x3.w;
        rr[q * 4] = x4.x; rr[q * 4 + 1] = x4.y; rr[q * 4 + 2] = x4.z; rr[q * 4 + 3] = x4.w;
      }
      const float vv = vs[t * 64 + wid * 16 + r16];
      float sa0 = 0.f, sa1 = 0.f;
#pragma unroll
      for (int e = 0; e < 8; ++e) { sa0 += S[e] * nk[e]; sa1 += S[e + 8] * nk[e + 8]; }
      const float sa = quad_sum(sa0 + sa1);
      float y0 = 0.f, y1 = 0.f;
#pragma unroll
      for (int e = 0; e < 8; ++e) {
        S[e] = S[e] * w[e] + sa * bb[e] + vv * kd[e];
        S[e + 8] = S[e + 8] * w[e + 8] + sa * bb[e + 8] + vv * kd[e + 8];
        y0 += S[e] * rr[e]; y1 += S[e + 8] * rr[e + 8];
      }
      const float y = quad_sum(y0 + y1);
      if (kq == 0) ys[t * 64 + wid * 16 + r16] = y;
    }
    __syncthreads();
    {
      const size_t row = (size_t)(rowbase + sgn * tt);
      const f32x4 y0 = *(const f32x4*)(ys + tt * 64 + c8 * 8), y1 = *(const f32x4*)(ys + tt * 64 + c8 * 8 + 4);
      *(u32x4*)(Ydst + row * 1024 + h * 64 + c8 * 8) = (u32x4){pk2(y0.x, y0.y), pk2(y0.z, y0.w), pk2(y1.x, y1.y), pk2(y1.z, y1.w)};
    }
  }
}

__device__ void og_phase(const Params& p, int j) {
  const int tid = otid(), lane = tid & 63;
  const int gw = blockIdx.x * 4 + (tid >> 6), nw = gridDim.x * 4;
  const bf* Vsrc = (j == 0) ? p.VF : p.V2;
  const int col = lane * 16, hh = lane >> 2;
  float lw[16], lb[16];
#pragma unroll
  for (int e = 0; e < 16; ++e) { lw[e] = p.rw_lnx_w[j * 1024 + col + e]; lb[e] = p.rw_lnx_b[j * 1024 + col + e]; }
  for (int row = gw; row < MT; row += nw) {
    const size_t off = (size_t)row * 1024 + col;
    u32x4 u0[2], u1[2], uv[2], ug[2];
#pragma unroll
    for (int q = 0; q < 2; ++q) {
      u0[q] = *(const u32x4*)(p.H + off + q * 8);
      u1[q] = *(const u32x4*)(p.Y1 + off + q * 8);
      uv[q] = *(const u32x4*)(Vsrc + off + q * 8);
      ug[q] = *(const u32x4*)(p.G + off + q * 8);
    }
    const float bsum = p.beta[(size_t)row * 16 + hh] + p.beta[(size_t)MT * 16 + (size_t)row * 16 + hh];
    float y[16], v[16], g[16];
    float s = 0.f;
#pragma unroll
    for (int e = 0; e < 8; ++e) {
      y[2 * e] = bflo(u0[e >> 2][e & 3]) + bflo(u1[e >> 2][e & 3]); y[2 * e + 1] = bfhi(u0[e >> 2][e & 3]) + bfhi(u1[e >> 2][e & 3]);
      v[2 * e] = bflo(uv[e >> 2][e & 3]); v[2 * e + 1] = bfhi(uv[e >> 2][e & 3]);
      g[2 * e] = bflo(ug[e >> 2][e & 3]); g[2 * e + 1] = bfhi(ug[e >> 2][e & 3]);
      s += y[2 * e] + y[2 * e + 1];
    }
    s = quad_sum(s);
    const float mean = s * (1.f / 64.f);
    float q2 = 0.f;
#pragma unroll
    for (int e = 0; e < 16; ++e) { const float dd = y[e] - mean; q2 += dd * dd; }
    q2 = quad_sum(q2);
    const float rstd = rsqrtf(q2 * (1.f / 64.f) + 64e-5f);
    unsigned o[8];
#pragma unroll
    for (int e = 0; e < 8; ++e) {
      const float r0 = ((y[2 * e] - mean) * rstd * lw[2 * e] + lb[2 * e] + bsum * v[2 * e]) * g[2 * e];
      const float r1 = ((y[2 * e + 1] - mean) * rstd * lw[2 * e + 1] + lb[2 * e + 1] + bsum * v[2 * e + 1]) * g[2 * e + 1];
      o[e] = pk2(r0, r1);
    }
    *(u32x4*)(p.H + off) = (u32x4){o[0], o[1], o[2], o[3]};
    *(u32x4*)(p.H + off + 8) = (u32x4){o[4], o[5], o[6], o[7]};
  }
}

__device__ void attn_phase(const Params& p, int j, bool ctx_out, char* smem) {
  const int tid = otid(), lane = tid & 63, cgp = tid >> 6, fr = lane & 15, fq = lane >> 4;
  char* Ks = smem;
  bf* Vs = (bf*)smem;
  float* rpbs = (float*)(smem + 36864);
  const bf* Q = p.R; const bf* Kb = p.K; const bf* Vt = p.V2; const bf* Gb = p.G;
  const int nitems = 16384 + (ctx_out ? 512 : 0);
  for (int item = blockIdx.x; item < nitems; item += gridDim.x) {
    int b, h, r = 0, qrow0; bool haswin;
    if (item < 16384) { h = item & 15; r = (item >> 4) & 127; b = item >> 11; haswin = true; qrow0 = b * SEQ + r * 64; }
    else { const int it = item - 16384; h = it & 15; const int qb = (it >> 4) & 3; b = it >> 6; haswin = false; qrow0 = NL + b * CTXL + qb * 64; }
    const int qtok = qrow0 + cgp * 16 + fr;
    bf16x8 qf[2];
#pragma unroll
    for (int ks = 0; ks < 2; ++ks) qf[ks] = *(const bf16x8*)(Q + (size_t)qtok * 1024 + h * 64 + ks * 32 + fq * 8);
    const int rs = min(max(r - 4, 0), 120);
    const int qcol = cgp * 16 + fr;
    const int wsq = min(max(qcol - 8, 0), 48);
    const int bs = min(max(16 * cgp - 8, 0), 32);
    __syncthreads();
    if (haswin) for (int idx = tid; idx < 465; idx += 256) rpbs[idx] = p.na_rpb[((size_t)j * 16 + h) * 465 + idx];
    f32x4 sw[8][2], sc[4][4];
    bf16x8 pw[8];
    float m1 = NEGV, l1 = 0.f;
#pragma unroll
    for (int i = 0; i < 8; ++i) pw[i] = (bf16x8){0, 0, 0, 0, 0, 0, 0, 0};
#pragma unroll
    for (int i = 0; i < 8; ++i)
#pragma unroll
      for (int k2 = 0; k2 < 2; ++k2) sw[i][k2] = (f32x4){NEGV, NEGV, NEGV, NEGV};
#pragma unroll
    for (int st = 0; st < 3; ++st) {
      if (st < 2 && !haswin) continue;
      __syncthreads();
#pragma unroll
      for (int hf = 0; hf < 2; ++hf) {
        u32x4 u[4];
#pragma unroll
        for (int i = 0; i < 4; ++i) {
          const int q = tid + (hf * 4 + i) * 256, key = q >> 3, c = q & 7, tl = key >> 6;
          const int base = (st < 2) ? b * SEQ + (rs + st * 4 + tl) * 64 : NL + b * CTXL + tl * 64;
          u[i] = *(const u32x4*)(Kb + (size_t)(base + (key & 63)) * 1024 + h * 64 + c * 8);
        }
#pragma unroll
        for (int i = 0; i < 4; ++i) {
          const int q = tid + (hf * 4 + i) * 256, key = q >> 3, c = q & 7;
          *(u32x4*)(Ks + lds_off(key, c)) = u[i];
        }
        __builtin_amdgcn_sched_barrier(0);
      }
      __syncthreads();
      if (st < 2) {
#pragma unroll
        for (int tl = 0; tl < 4; ++tl) {
          const int i = st * 4 + tl;
          const int dr = rs + i - r + 7;
#pragma unroll
          for (int k2 = 0; k2 < 2; ++k2) {
            f32x4 acc = (f32x4){0.f, 0.f, 0.f, 0.f};
#pragma unroll
            for (int ks = 0; ks < 2; ++ks) {
              const bf16x8 kf = *(const bf16x8*)(Ks + lds_off(tl * 64 + bs + k2 * 16 + fr, ks * 4 + fq));
              acc = __builtin_amdgcn_mfma_f32_16x16x32_bf16(kf, qf[ks], acc, 0, 0, 0);
            }
#pragma unroll
            for (int e = 0; e < 4; ++e) {
              const int kc = bs + k2 * 16 + fq * 4 + e;
              const bool valid = (kc >= wsq) && (kc < wsq + 16);
              const int dc = min(max(kc - qcol, -15), 15) + 15;
              sw[i][k2][e] = valid ? acc[e] + rpbs[dr * 31 + dc] : NEGV;
            }
          }
        }
      } else {
#pragma unroll
        for (int tl = 0; tl < 4; ++tl)
#pragma unroll
          for (int k4 = 0; k4 < 4; ++k4) {
            f32x4 acc = (f32x4){0.f, 0.f, 0.f, 0.f};
#pragma unroll
            for (int ks = 0; ks < 2; ++ks) {
              const bf16x8 kf = *(const bf16x8*)(Ks + lds_off(tl * 64 + k4 * 16 + fr, ks * 4 + fq));
              acc = __builtin_amdgcn_mfma_f32_16x16x32_bf16(kf, qf[ks], acc, 0, 0, 0);
            }
            sc[tl][k4] = acc;
          }
      }
      if (st == 1) {
#pragma unroll
        for (int i = 0; i < 8; ++i)
#pragma unroll
          for (int k2 = 0; k2 < 2; ++k2)
#pragma unroll
            for (int e = 0; e < 4; ++e) m1 = fmaxf(m1, sw[i][k2][e]);
        m1 = fmaxf(m1, __shfl_xor(m1, 16));
        m1 = fmaxf(m1, __shfl_xor(m1, 32));
#pragma unroll
        for (int i = 0; i < 8; ++i) {
          float e0[4], e1[4];
#pragma unroll
          for (int e = 0; e < 4; ++e) { e0[e] = __expf(sw[i][0][e] - m1); e1[e] = __expf(sw[i][1][e] - m1); l1 += e0[e] + e1[e]; }
          u32x4 u = (u32x4){pk2(e0[0], e0[1]), pk2(e0[2], e0[3]), pk2(e1[0], e1[1]), pk2(e1[2], e1[3])};
          pw[i] = __builtin_bit_cast(bf16x8, u);
        }
        l1 += __shfl_xor(l1, 16);
        l1 += __shfl_xor(l1, 32);
      }
    }
    float m2 = NEGV;
#pragma unroll
    for (int tl = 0; tl < 4; ++tl)
#pragma unroll
      for (int k4 = 0; k4 < 4; ++k4)
#pragma unroll
        for (int e = 0; e < 4; ++e) m2 = fmaxf(m2, sc[tl][k4][e]);
    m2 = fmaxf(m2, __shfl_xor(m2, 16));
    m2 = fmaxf(m2, __shfl_xor(m2, 32));
    const float mx = fmaxf(m1, m2);
    const float alpha1 = __expf(m1 - mx);
    float l2 = 0.f;
    bf16x8 pc[4][2];
#pragma unroll
    for (int tl = 0; tl < 4; ++tl)
#pragma unroll
      for (int g2 = 0; g2 < 2; ++g2) {
        float e0[4], e1[4];
#pragma unroll
        for (int e = 0; e < 4; ++e) { e0[e] = __expf(sc[tl][2 * g2][e] - mx); e1[e] = __expf(sc[tl][2 * g2 + 1][e] - mx); l2 += e0[e] + e1[e]; }
        u32x4 u = (u32x4){pk2(e0[0], e0[1]), pk2(e0[2], e0[3]), pk2(e1[0], e1[1]), pk2(e1[2], e1[3])};
        pc[tl][g2] = __builtin_bit_cast(bf16x8, u);
      }
    l2 += __shfl_xor(l2, 16);
    l2 += __shfl_xor(l2, 32);
    const float l = alpha1 * l1 + l2;
    f32x4 o[4];
#pragma unroll
    for (int dt = 0; dt < 4; ++dt) o[dt] = (f32x4){0.f, 0.f, 0.f, 0.f};
#pragma unroll
    for (int st = 0; st < 3; ++st) {
      if (st < 2 && !haswin) continue;
      __syncthreads();
#pragma unroll
      for (int hf = 0; hf < 2; ++hf) {
        u32x4 u[4];
#pragma unroll
        for (int i = 0; i < 4; ++i) {
          const int q = tid + (hf * 4 + i) * 256, tl = q >> 9, dd = (q >> 3) & 63, c = q & 7;
          const int base = (st < 2) ? b * SEQ + (rs + st * 4 + tl) * 64 : NL + b * CTXL + tl * 64;
          u[i] = *(const u32x4*)(Vt + (size_t)(h * 64 + dd) * MT + base + c * 8);
        }
#pragma unroll
        for (int i = 0; i < 4; ++i) {
          const int q = tid + (hf * 4 + i) * 256, tl = q >> 9, dd = (q >> 3) & 63, c = q & 7;
          *(u32x4*)(Vs + tl * 4608 + dd * 72 + c * 8) = u[i];
        }
        __builtin_amdgcn_sched_barrier(0);
      }
      __syncthreads();
      if (st < 2) {
#pragma unroll
        for (int tl = 0; tl < 4; ++tl) {
          const int i = st * 4 + tl;
#pragma unroll
          for (int dt = 0; dt < 4; ++dt) {
            const bf* vp = Vs + tl * 4608 + (dt * 16 + fr) * 72 + bs + fq * 4;
            const u32x2 lo = *(const u32x2*)vp, hi = *(const u32x2*)(vp + 16);
            u32x4 u = (u32x4){lo.x, lo.y, hi.x, hi.y};
            o[dt] = __builtin_amdgcn_mfma_f32_16x16x32_bf16(__builtin_bit_cast(bf16x8, u), pw[i], o[dt], 0, 0, 0);
          }
        }
      } else {
#pragma unroll
        for (int tl = 0; tl < 4; ++tl)
#pragma unroll
          for (int g2 = 0; g2 < 2; ++g2)
#pragma unroll
            for (int dt = 0; dt < 4; ++dt) {
              const bf* vp = Vs + tl * 4608 + (dt * 16 + fr) * 72 + g2 * 32 + fq * 4;
              const u32x2 lo = *(const u32x2*)vp, hi = *(const u32x2*)(vp + 16);
              u32x4 u = (u32x4){lo.x, lo.y, hi.x, hi.y};
              o[dt] = __builtin_amdgcn_mfma_f32_16x16x32_bf16(__builtin_bit_cast(bf16x8, u), pc[tl][g2], o[dt], 0, 0, 0);
            }
      }
      if (st == 1) {
#pragma unroll
        for (int dt = 0; dt < 4; ++dt) o[dt] *= alpha1;
      }
    }
    const float inv = 1.f / l;
#pragma unroll
    for (int dt = 0; dt < 4; ++dt) {
      const size_t off = (size_t)qtok * 1024 + h * 64 + dt * 16 + fq * 4;
      const u32x2 ug = *(const u32x2*)(Gb + off);
      const float g0 = bflo(ug.x), g1 = bfhi(ug.x), g2 = bflo(ug.y), g3 = bfhi(ug.y);
      *(u32x2*)(p.H + off) = (u32x2){pk2(o[dt][0] * inv * siluf(g0), o[dt][1] * inv * siluf(g1)),
                                        pk2(o[dt][2] * inv * siluf(g2), o[dt][3] * inv * siluf(g3))};
    }
  }
}

#ifndef MULTI_LAUNCH
#define MULTI_LAUNCH 0
#endif
__device__ __forceinline__ bool step_exists(int i, int s) {
  if (s == 2) return i == 2;
  if (s == 4) return (i & 1) == 0;
  return true;
}
__device__ __forceinline__ void run_step(const Params& p, int i, int s, char* smem) {
  asm volatile("" : "+s"(i));
  const int j = i >> 1;
  if (s == 0) { transpose_phase(p, i, smem); row_phase(p, i); }
  else if (s == 1) {
    if ((i & 1) == 0) {
      EpiRwkvProj ep{p.R, p.K, (j == 0) ? p.VF : p.V2, p.G, p.HID};
      gemm_phase<1>(p.H, 1024, p.Wp, 1024, 16, MT / 128, (j == 0) ? 34 : 35, p.rw_mu + (size_t)j * 6 * 1024, ep, smem);
    } else {
      EpiNaProj ep{p.R, p.K, p.V2, p.G, p.na_b_in + (size_t)j * 4096};
      gemm_phase<0>(p.H, 1024, p.Wp, 1024, 16, MT / 128, 32, nullptr, ep, smem);
    }
  } else if (s == 2) {
    EpiVres ev{p.V2, p.VF, p.rw_v0};
    gemm_phase<0>(p.HID + 256, HIDW, p.v2t, 64, 1, MT / 128, 8, nullptr, ev, smem);
  } else if (s == 3) {
    if ((i & 1) == 0) scan_phase(p, j, smem);
    else attn_phase(p, j, i != 3, smem);
  } else if (s == 4) {
    og_phase(p, j);
  } else {
    EpiOut eo{p.R};
    gemm_phase<0>(p.H, 1024, p.Wo, 1024, 16, (i == 3) ? NL / 128 : MT / 128, 8, nullptr, eo, smem);
  }
}

__global__ void __launch_bounds__(256, 2) fwd_megakernel(Params p0) {
  __shared__ __attribute__((aligned(16))) char smem[SMEM_BYTES];
  cg::grid_group grid = cg::this_grid();
  if (blockIdx.x == 0 && threadIdx.x == 0) *p0.gp = p0;
  pre_phase(p0, smem);
  grid.sync();
  const Params& p = *(const Params*)p0.gp;
#pragma unroll 1
  for (int i = 0; i < 4; ++i) {
#pragma unroll 1
    for (int s = 0; s < 6; ++s) {
      if (!step_exists(i, s)) continue;
      run_step(p, i, s, smem);
      grid.sync();
    }
  }
  row_phase(p, 4);
}

#if MULTI_LAUNCH
template <int S> __global__ void __launch_bounds__(256, 2) step_kernel(Params p0, int i) {
  __shared__ __attribute__((aligned(16))) char smem[SMEM_BYTES];
  if (S == -1) { pre_phase(p0, smem); return; }
  if (S == 6) { row_phase(p0, 4); return; }
  run_step(p0, i, S, smem);
}
#endif

extern "C" void kernel_launch(void* const* d_in, const int* in_sizes, int n_in, void* d_out, int out_size, void* d_ws, size_t ws_size,
                              hipStream_t stream) {
  static int grid_blocks = 0;
  if (!grid_blocks) {
    int dev = 0, cus = 0, per_cu = 0;
    hipGetDevice(&dev);
    hipDeviceGetAttribute(&cus, hipDeviceAttributeMultiprocessorCount, dev);
    hipOccupancyMaxActiveBlocksPerMultiprocessor(&per_cu, fwd_megakernel, 256, 0);
    if (per_cu > 2) per_cu = 2;
    if (per_cu < 1) per_cu = 1;
    grid_blocks = cus * per_cu;
  }
  Params p{};
  const float** f = (const float**)&p;
  for (int i = 0; i < 29; ++i) f[i] = (const float*)d_in[i];
  p.out = (float*)d_out;
  char* w = (char*)d_ws;
  size_t off = 0;
  auto take = [&](size_t bytes) { char* r = w + off; off += (bytes + 255) & ~(size_t)255; return r; };
  p.gp = (Params*)take(sizeof(Params));
  p.mod = (float*)take((size_t)4 * 9 * 3072 * 4);
  p.ctxbuf = (float*)take((size_t)NC * 1024 * 4);
  p.beta = (float*)take((size_t)2 * MT * 16 * 4);
  p.Wp = (bf*)take((size_t)4480 * 1024 * 2);
  p.Wo = (bf*)take((size_t)1024 * 1024 * 2);
  p.w2t = (bf*)take((size_t)2 * 65536 * 2);
  p.a2t = (bf*)take((size_t)2 * 65536 * 2);
  p.v2t = (bf*)take((size_t)65536 * 2);
  const size_t big = (size_t)MT * 1024 * 2;
  p.H = (bf*)take(big); p.R = (bf*)take(big); p.K = (bf*)take(big); p.VF = (bf*)take(big);
  p.V2 = (bf*)take(big); p.G = (bf*)take(big); p.Y1 = (bf*)take(big);
  p.HID = (bf*)take((size_t)MT * HIDW * 2);
  if (off > ws_size) fprintf(stderr, "workspace too small: need %zu have %zu\n", off, ws_size);
#if MULTI_LAUNCH
  step_kernel<-1><<<grid_blocks, 256, 0, stream>>>(p, 0);
  for (int i = 0; i < 4; ++i) {
    step_kernel<0><<<grid_blocks, 256, 0, stream>>>(p, i);
    step_kernel<1><<<grid_blocks, 256, 0, stream>>>(p, i);
    if (i == 2) step_kernel<2><<<grid_blocks, 256, 0, stream>>>(p, i);
    step_kernel<3><<<grid_blocks, 256, 0, stream>>>(p, i);
    if ((i & 1) == 0) step_kernel<4><<<grid_blocks, 256, 0, stream>>>(p, i);
    step_kernel<5><<<grid_blocks, 256, 0, stream>>>(p, i);
  }
  step_kernel<6><<<grid_blocks, 256, 0, stream>>>(p, 0);
#else
  void* args[] = {&p};
  hipError_t e = hipLaunchCooperativeKernel((void*)fwd_megakernel, dim3(grid_blocks), dim3(256), args, 0, stream);
  if (e != hipSuccess) fprintf(stderr, "cooperative launch failed: %s (grid %d)\n", hipGetErrorString(e), grid_blocks);
#endif
}
```

```cpp
#include <hip/hip_runtime.h>
#include <hip/hip_cooperative_groups.h>
#include <cstdint>
#include <cstdio>
namespace cg = cooperative_groups;

typedef unsigned short bf;
typedef short bf16x8 __attribute__((ext_vector_type(8)));
typedef float f32x4 __attribute__((ext_vector_type(4)));
typedef unsigned u32x4 __attribute__((ext_vector_type(4)));
typedef unsigned u32x2 __attribute__((ext_vector_type(2)));

constexpr int DM = 1024, NB = 8, SEQ = 8192, NL = NB * SEQ, CTXL = 256, NC = NB * CTXL, MT = NL + NC;
constexpr int HIDW = 384;
constexpr int SMEM_BYTES = 65536;
#define NEGV (-1e30f)

struct Params {
  const float *x, *c, *ctx, *c_ctx, *ada_w, *ada_b, *pre_g, *post_g, *rw_mu, *rw_w_rkvg, *rw_w0, *rw_w1, *rw_w2,
      *rw_a0, *rw_a1, *rw_a2, *rw_v0, *rw_v1, *rw_v2, *rw_k_k, *rw_k_a, *rw_r_k, *rw_lnx_w, *rw_lnx_b, *rw_w_out,
      *na_w_in, *na_b_in, *na_rpb, *na_w_out;
  float* out;
  float *mod, *ctxbuf, *beta;
  bf *Wp, *Wo, *w2t, *a2t, *v2t;
  bf *H, *R, *K, *VF, *V2, *G, *Y1, *HID;
  Params* gp;
};

__device__ __forceinline__ float bflo(unsigned w) { return __uint_as_float(w << 16); }
__device__ __forceinline__ float bfhi(unsigned w) { return __uint_as_float(w & 0xffff0000u); }
typedef __bf16 bf16x2_t __attribute__((ext_vector_type(2)));
__device__ __forceinline__ unsigned pk2(float lo, float hi) {
  bf16x2_t v = {(__bf16)lo, (__bf16)hi};
  return __builtin_bit_cast(unsigned, v);
}
__device__ __forceinline__ float siluf(float v) { return v / (1.f + __expf(-v)); }
__device__ __forceinline__ float sigmf(float v) { return 1.f / (1.f + __expf(-v)); }
__device__ __forceinline__ float quad_sum(float v) {
  int t = __builtin_amdgcn_update_dpp(0, __float_as_int(v), 0xB1, 0xF, 0xF, true);
  v += __int_as_float(t);
  t = __builtin_amdgcn_update_dpp(0, __float_as_int(v), 0x4E, 0xF, 0xF, true);
  v += __int_as_float(t);
  return v;
}
__device__ __forceinline__ float wave_sum(float v) {
#pragma unroll
  for (int o = 32; o >= 1; o >>= 1) v += __shfl_xor(v, o);
  return v;
}
__device__ __forceinline__ int otid() { int t = threadIdx.x; asm volatile("" : "+v"(t)); return t; }
__device__ __forceinline__ int lds_off(int row, int c) { return row * 128 + ((c ^ ((row >> 1) & 7)) << 4); }
__device__ __forceinline__ unsigned lerp2(unsigned hm, unsigned h0, unsigned hp, float m0, float m1) {
  const float c0 = bflo(h0), c1 = bfhi(h0);
  const float x0 = 0.5f * (bflo(hm) + bflo(hp)) - c0;
  const float x1 = 0.5f * (bfhi(hm) + bfhi(hp)) - c1;
  return pk2(c0 + x0 * m0, c1 + x1 * m1);
}
__device__ __forceinline__ int mod_idx(int row) { return row < NL ? (row >> 13) : 8; }

__device__ void pre_phase(const Params& p, char* smem) {
  float* s = (float*)smem;
  float* red = s + 9 * 1024;
  const int tid = otid();
  for (int item = blockIdx.x; item < 4 * 48; item += gridDim.x) {
    const int i = item / 48, cb = item % 48;
    __syncthreads();
    for (int idx = tid; idx < 9 * 1024; idx += 256) {
      const int m = idx >> 10, k = idx & 1023;
      const float v = (m < 8) ? p.c[m * 1024 + k] : p.c_ctx[k];
      s[idx] = siluf(v);
    }
    __syncthreads();
    const int cc = tid & 63, kq = tid >> 6;
    float acc[9];
#pragma unroll
    for (int m = 0; m < 9; ++m) acc[m] = 0.f;
    const float* W = p.ada_w + (size_t)i * 1024 * 3072 + cb * 64 + cc;
    for (int k = kq * 256; k < kq * 256 + 256; ++k) {
      const float w = W[(size_t)k * 3072];
#pragma unroll
      for (int m = 0; m < 9; ++m) acc[m] += s[m * 1024 + k] * w;
    }
#pragma unroll
    for (int m = 0; m < 9; ++m) red[(kq * 9 + m) * 64 + cc] = acc[m];
    __syncthreads();
    for (int idx = tid; idx < 9 * 64; idx += 256) {
      const int m = idx >> 6, c2 = idx & 63;
      float v = red[(0 * 9 + m) * 64 + c2] + red[(1 * 9 + m) * 64 + c2] + red[(2 * 9 + m) * 64 + c2] + red[(3 * 9 + m) * 64 + c2];
      v += p.ada_b[i * 3072 + cb * 64 + c2];
      p.mod[(size_t)(i * 9 + m) * 3072 + cb * 64 + c2] = v;
    }
  }
}

struct TOp { const float* src; bf* dst; int K, N, Kp, Np; };
__device__ bool get_op(const Params& p, int i, int op, TOp& o) {
  const int j = i >> 1;
  if (i & 1) {
    if (op == 0) { o = {p.na_w_in + (size_t)j * 1024 * 4096, p.Wp, 1024, 4096, 1024, 4096}; return true; }
    if (op == 1) { o = {p.na_w_out + (size_t)j * 1024 * 1024, p.Wo, 1024, 1024, 1024, 1024}; return true; }
    return false;
  }
  if (op < 4) { o = {p.rw_w_rkvg + ((size_t)j * 4 + op) * 1024 * 1024, p.Wp + (size_t)op * 1024 * 1024, 1024, 1024, 1024, 1024}; return true; }
  if (op < 6) { const int d = op - 4; o = {p.rw_w1 + ((size_t)j * 2 + d) * 1024 * 64, p.Wp + (size_t)(4096 + d * 64) * 1024, 1024, 64, 1024, 64}; return true; }
  if (op < 8) { const int d = op - 6; o = {p.rw_a1 + ((size_t)j * 2 + d) * 1024 * 64, p.Wp + (size_t)(4224 + d * 64) * 1024, 1024, 64, 1024, 64}; return true; }
  if (op < 10) { const int d = op - 8; o = {p.rw_w2 + ((size_t)j * 2 + d) * 64 * 1024, p.w2t + (size_t)d * 65536, 64, 1024, 64, 1024}; return true; }
  if (op < 12) { const int d = op - 10; o = {p.rw_a2 + ((size_t)j * 2 + d) * 64 * 1024, p.a2t + (size_t)d * 65536, 64, 1024, 64, 1024}; return true; }
  if (op == 12) { o = {p.rw_w_out + (size_t)j * 1024 * 1024, p.Wo, 1024, 1024, 1024, 1024}; return true; }
  if (j == 1 && op == 13) { o = {p.rw_v1, p.Wp + (size_t)4352 * 1024, 1024, 32, 1024, 128}; return true; }
  if (j == 1 && op == 14) { o = {p.rw_v2, p.v2t, 32, 1024, 64, 1024}; return true; }
  return false;
}

__device__ void transpose_phase(const Params& p, int i, char* smem) {
  float* t = (float*)smem;
  const int tid = otid();
  int base = 0;
  for (int op = 0;; ++op) {
    TOp o;
    if (!get_op(p, i, op, o)) break;
    const int tk = o.Kp / 64, tn = o.Np / 64, nt = tk * tn;
    int first = blockIdx.x - (base % (int)gridDim.x);
    if (first < 0) first += gridDim.x;
    for (int g = first; g < nt; g += gridDim.x) {
      const int kt = g / tn, ntile = g % tn;
      __syncthreads();
#pragma unroll
      for (int ps = 0; ps < 4; ++ps) {
        const int kr = ps * 16 + (tid >> 4), c4 = (tid & 15) * 4;
        const int k = kt * 64 + kr, n = ntile * 64 + c4;
        f32x4 v = (f32x4){0.f, 0.f, 0.f, 0.f};
        if (k < o.K && n < o.N) v = *(const f32x4*)(o.src + (size_t)k * o.N + n);
        t[kr * 65 + c4 + 0] = v.x; t[kr * 65 + c4 + 1] = v.y; t[kr * 65 + c4 + 2] = v.z; t[kr * 65 + c4 + 3] = v.w;
      }
      __syncthreads();
      const int n = tid >> 2, kc = (tid & 3) * 16;
      unsigned w[8];
#pragma unroll
      for (int e = 0; e < 8; ++e) w[e] = pk2(t[(kc + 2 * e) * 65 + n], t[(kc + 2 * e + 1) * 65 + n]);
      bf* d = o.dst + (size_t)(ntile * 64 + n) * o.Kp + kt * 64 + kc;
      *(u32x4*)d = (u32x4){w[0], w[1], w[2], w[3]};
      *(u32x4*)(d + 8) = (u32x4){w[4], w[5], w[6], w[7]};
    }
    base += nt;
  }
}

__device__ void row_phase(const Params& p, int i) {
  const int tid = otid(), lane = tid & 63;
  const int gw = blockIdx.x * 4 + (tid >> 6), nw = gridDim.x * 4;
  const int nrows = (i == 4) ? NL : MT;
  for (int row = gw; row < nrows; row += nw) {
    const int m = mod_idx(row);
    const float* xs;
    if (i <= 1) xs = (row < NL) ? p.x + (size_t)row * 1024 : p.ctx + (size_t)(row - NL) * 1024;
    else xs = (row < NL) ? p.out + (size_t)row * 1024 : p.ctxbuf + (size_t)(row - NL) * 1024;
    f32x4 xv[4];
#pragma unroll
    for (int q = 0; q < 4; ++q) xv[q] = *(const f32x4*)(xs + q * 256 + lane * 4);
    if (i > 0) {
      const bf* orow = p.R + (size_t)row * 1024;
      float ov[4][4];
      float ss = 0.f;
#pragma unroll
      for (int q = 0; q < 4; ++q) {
        const u32x2 u = *(const u32x2*)(orow + q * 256 + lane * 4);
        ov[q][0] = bflo(u.x); ov[q][1] = bfhi(u.x); ov[q][2] = bflo(u.y); ov[q][3] = bfhi(u.y);
        ss += ov[q][0] * ov[q][0] + ov[q][1] * ov[q][1] + ov[q][2] * ov[q][2] + ov[q][3] * ov[q][3];
      }
      ss = wave_sum(ss);
      const float rs = rsqrtf(ss * (1.f / 1024.f) + 1e-6f);
      const float* gate = p.mod + (size_t)((i - 1) * 9 + m) * 3072 + 2048;
      const float* pg = p.post_g + (i - 1) * 1024;
      float* xd = (row < NL) ? p.out + (size_t)row * 1024 : p.ctxbuf + (size_t)(row - NL) * 1024;
#pragma unroll
      for (int q = 0; q < 4; ++q) {
        const int col = q * 256 + lane * 4;
        const f32x4 gv = *(const f32x4*)(gate + col);
        const f32x4 pv = *(const f32x4*)(pg + col);
        xv[q].x += gv.x * ov[q][0] * rs * pv.x;
        xv[q].y += gv.y * ov[q][1] * rs * pv.y;
        xv[q].z += gv.z * ov[q][2] * rs * pv.z;
        xv[q].w += gv.w * ov[q][3] * rs * pv.w;
        *(f32x4*)(xd + col) = xv[q];
      }
    }
    if (i < 4) {
      float ss = 0.f;
#pragma unroll
      for (int q = 0; q < 4; ++q) ss += xv[q].x * xv[q].x + xv[q].y * xv[q].y + xv[q].z * xv[q].z + xv[q].w * xv[q].w;
      ss = wave_sum(ss);
      const float rs = rsqrtf(ss * (1.f / 1024.f) + 1e-6f);
      const float* md = p.mod + (size_t)(i * 9 + m) * 3072;
      const float* pg = p.pre_g + i * 1024;
      bf* hd = p.H + (size_t)row * 1024;
#pragma unroll
      for (int q = 0; q < 4; ++q) {
        const int col = q * 256 + lane * 4;
        const f32x4 sh = *(const f32x4*)(md + col);
        const f32x4 sc = *(const f32x4*)(md + 1024 + col);
        const f32x4 pv = *(const f32x4*)(pg + col);
        const float h0 = xv[q].x * rs * pv.x * (1.f + sc.x) + sh.x;
        const float h1 = xv[q].y * rs * pv.y * (1.f + sc.y) + sh.y;
        const float h2 = xv[q].z * rs * pv.z * (1.f + sc.z) + sh.z;
        const float h3 = xv[q].w * rs * pv.w * (1.f + sc.w) + sh.w;
        *(u32x2*)(hd + col) = (u32x2){pk2(h0, h1), pk2(h2, h3)};
      }
    }
  }
}

struct EpiRwkvProj {
  bf *R, *K, *V, *G, *HID;
  __device__ __forceinline__ void operator()(int nt, int tok, int col, f32x4 v) const {
    bf* dst;
    if (nt < 8) dst = R + (size_t)tok * 1024 + col;
    else if (nt < 16) dst = K + (size_t)tok * 1024 + (col - 1024);
    else if (nt < 24) dst = V + (size_t)tok * 1024 + (col - 2048);
    else if (nt < 32) {
      dst = G + (size_t)tok * 1024 + (col - 3072);
#pragma unroll
      for (int e = 0; e < 4; ++e) v[e] = siluf(v[e]);
    } else {
      dst = HID + (size_t)tok * HIDW + (col - 4096);
      if (nt == 32) {
#pragma unroll
        for (int e = 0; e < 4; ++e) v[e] = tanhf(v[e]);
      }
    }
    *(u32x2*)dst = (u32x2){pk2(v[0], v[1]), pk2(v[2], v[3])};
  }
};
struct EpiNaProj {
  bf *Q, *K, *Vt, *G; const float* bias;
  __device__ __forceinline__ void operator()(int nt, int tok, int col, f32x4 v) const {
    const f32x4 b = *(const f32x4*)(bias + col);
    v[0] += b.x; v[1] += b.y; v[2] += b.z; v[3] += b.w;
    if (nt >= 16 && nt < 24) {
      const int c = col - 2048;
#pragma unroll
      for (int e = 0; e < 4; ++e) Vt[(size_t)(c + e) * MT + tok] = (bf)(pk2(v[e], 0.f) & 0xffffu);
      return;
    }
    bf* dst;
    if (nt < 8) { dst = Q + (size_t)tok * 1024 + col; v[0] *= 0.125f; v[1] *= 0.125f; v[2] *= 0.125f; v[3] *= 0.125f; }
    else if (nt < 16) dst = K + (size_t)tok * 1024 + (col - 1024);
    else dst = G + (size_t)tok * 1024 + (col - 3072);
    *(u32x2*)dst = (u32x2){pk2(v[0], v[1]), pk2(v[2], v[3])};
  }
};
struct EpiOut {
  bf* O;
  __device__ __forceinline__ void operator()(int nt, int tok, int col, f32x4 v) const {
    *(u32x2*)(O + (size_t)tok * 1024 + col) = (u32x2){pk2(v[0], v[1]), pk2(v[2], v[3])};
  }
};
struct EpiVres {
  bf* V2; const bf* VF; const float* v0;
  __device__ __forceinline__ void operator()(int nt, int tok, int col, f32x4 z) const {
    const f32x4 b = *(const f32x4*)(v0 + col);
    const u32x2 uv = *(const u32x2*)(V2 + (size_t)tok * 1024 + col);
    const u32x2 uf = *(const u32x2*)(VF + (size_t)tok * 1024 + col);
    const float v[4] = {bflo(uv.x), bfhi(uv.x), bflo(uv.y), bfhi(uv.y)};
    const float f[4] = {bflo(uf.x), bfhi(uf.x), bflo(uf.y), bfhi(uf.y)};
    const float zz[4] = {z[0] + b.x, z[1] + b.y, z[2] + b.z, z[3] + b.w};
    float r[4];
#pragma unroll
    for (int e = 0; e < 4; ++e) r[e] = v[e] + (f[e] - v[e]) * sigmf(zz[e]);
    *(u32x2*)(V2 + (size_t)tok * 1024 + col) = (u32x2){pk2(r[0], r[1]), pk2(r[2], r[3])};
  }
};

template <int AMODE, class Epi>
__device__ void gemm_phase(const bf* __restrict__ A, int lda, const bf* __restrict__ Bt, int ldb, int nkt, int mtiles, int ntiles,
                           const float* __restrict__ mu, const Epi& epi, char* smem) {
  const int tid = otid(), lane = tid & 63, wid = tid >> 6, wr = wid >> 1, wc = wid & 1, fr = lane & 15, fq = lane >> 4;
  const int rg = tid >> 3, cch = tid & 7;
  char* As = smem;
  char* Bs = smem + 32768;
  const int total = mtiles * ntiles;
  for (int tile = blockIdx.x; tile < total; tile += gridDim.x) {
    const int mt = tile / ntiles, nt = tile % ntiles;
    const int row0 = mt * 128, col0 = nt * 128;
    int lerp = 0; bool sstart = false, send = false;
    if (AMODE == 1) {
      lerp = (nt < 8) ? 0 : (nt < 16) ? 2 : (nt < 24) ? 3 : (nt < 32) ? 5 : (nt == 32) ? 1 : (nt == 33) ? 4 : 3;
      if (row0 < NL) { sstart = (row0 & (SEQ - 1)) == 0; send = ((row0 + 128) & (SEQ - 1)) == 0; }
      else { sstart = ((row0 - NL) & (CTXL - 1)) == 0; send = ((row0 + 128 - NL) & (CTXL - 1)) == 0; }
    }
    f32x4 acc[4][4];
#pragma unroll
    for (int m = 0; m < 4; ++m)
#pragma unroll
      for (int n = 0; n < 4; ++n) acc[m][n] = (f32x4){0.f, 0.f, 0.f, 0.f};
    u32x4 ra[6], rb[4];
    f32x4 muv[2];
    auto gload = [&](int kt) {
      const int kc = kt * 64 + cch * 8;
      if (AMODE == 0) {
#pragma unroll
        for (int i = 0; i < 4; ++i) ra[i] = *(const u32x4*)(A + (size_t)(row0 + rg * 4 + i) * lda + kc);
      } else {
#pragma unroll
        for (int i = 0; i < 6; ++i) {
          const int r = row0 + rg * 4 + i - 1;
          const bool zero = (i == 0 && rg == 0 && sstart) || (i == 5 && rg == 31 && send);
          ra[i] = zero ? (u32x4){0, 0, 0, 0} : *(const u32x4*)(A + (size_t)r * lda + kc);
        }
        muv[0] = *(const f32x4*)(mu + lerp * 1024 + kc);
        muv[1] = *(const f32x4*)(mu + lerp * 1024 + kc + 4);
      }
#pragma unroll
      for (int i = 0; i < 4; ++i) rb[i] = *(const u32x4*)(Bt + (size_t)(col0 + rg * 4 + i) * ldb + kc);
    };
    auto lstore = [&](int buf) {
      char* a = As + buf * 16384;
      char* b = Bs + buf * 16384;
      if (AMODE == 0) {
#pragma unroll
        for (int i = 0; i < 4; ++i) *(u32x4*)(a + lds_off(rg * 4 + i, cch)) = ra[i];
      } else {
#pragma unroll
        for (int i = 0; i < 4; ++i) {
          const u32x4 hm = ra[i], h0 = ra[i + 1], hp = ra[i + 2];
          u32x4 o;
          o.x = lerp2(hm.x, h0.x, hp.x, muv[0].x, muv[0].y);
          o.y = lerp2(hm.y, h0.y, hp.y, muv[0].z, muv[0].w);
          o.z = lerp2(hm.z, h0.z, hp.z, muv[1].x, muv[1].y);
          o.w = lerp2(hm.w, h0.w, hp.w, muv[1].z, muv[1].w);
          *(u32x4*)(a + lds_off(rg * 4 + i, cch)) = o;
        }
      }
#pragma unroll
      for (int i = 0; i < 4; ++i) *(u32x4*)(b + lds_off(rg * 4 + i, cch)) = rb[i];
    };
    __syncthreads();
    gload(0);
    lstore(0);
    __syncthreads();
    for (int kt = 0; kt < nkt; ++kt) {
      const int buf = kt & 1;
      if (kt + 1 < nkt) gload(kt + 1);
      const char* a = As + buf * 16384;
      const char* b = Bs + buf * 16384;
#pragma unroll
      for (int ks = 0; ks < 2; ++ks) {
        bf16x8 af[4], bfr[4];
#pragma unroll
        for (int m = 0; m < 4; ++m) af[m] = *(const bf16x8*)(a + lds_off(wr * 64 + m * 16 + fr, ks * 4 + fq));
#pragma unroll
        for (int n = 0; n < 4; ++n) bfr[n] = *(const bf16x8*)(b + lds_off(wc * 64 + n * 16 + fr, ks * 4 + fq));
#pragma unroll
        for (int m = 0; m < 4; ++m)
#pragma unroll
          for (int n = 0; n < 4; ++n) acc[m][n] = __builtin_amdgcn_mfma_f32_16x16x32_bf16(bfr[n], af[m], acc[m][n], 0, 0, 0);
      }
      if (kt + 1 < nkt) lstore(buf ^ 1);
      __syncthreads();
    }
#pragma unroll
    for (int m = 0; m < 4; ++m)
#pragma unroll
      for (int n = 0; n < 4; ++n) epi(nt, row0 + wr * 64 + m * 16 + fr, col0 + wc * 64 + n * 16 + fq * 4, acc[m][n]);
  }
}

typedef float f32x2 __attribute__((ext_vector_type(2)));
__device__ __forceinline__ float oct_sum(float v) {
  int t = __builtin_amdgcn_update_dpp(0, __float_as_int(v), 0xB1, 0xF, 0xF, true);
  v += __int_as_float(t);
  t = __builtin_amdgcn_update_dpp(0, __float_as_int(v), 0x4E, 0xF, 0xF, true);
  v += __int_as_float(t);
  t = __builtin_amdgcn_update_dpp(0, __float_as_int(v), 0x141, 0xF, 0xF, true);
  v += __int_as_float(t);
  return v;
}
__device__ __forceinline__ f32x2 fma2(f32x2 a, f32x2 b, f32x2 c) { return __builtin_elementwise_fma(a, b, c); }
struct ScanOps { f32x4 w[2], nk[2], bb[2], kd[2], rr[2]; f32x2 vv; };
__device__ __forceinline__ ScanOps scan_load(const float* ops, const float* vs, int t, int kq, int vrow) {
  ScanOps r;
  const float* o = ops + t * 320 + kq * 8;
  r.w[0] = *(const f32x4*)(o); r.w[1] = *(const f32x4*)(o + 4);
  r.nk[0] = *(const f32x4*)(o + 64); r.nk[1] = *(const f32x4*)(o + 68);
  r.bb[0] = *(const f32x4*)(o + 128); r.bb[1] = *(const f32x4*)(o + 132);
  r.kd[0] = *(const f32x4*)(o + 192); r.kd[1] = *(const f32x4*)(o + 196);
  r.rr[0] = *(const f32x4*)(o + 256); r.rr[1] = *(const f32x4*)(o + 260);
  r.vv = *(const f32x2*)(vs + t * 64 + vrow);
  return r;
}
#define PR(v, i) ((f32x2){(v)[(i) >> 1][((i) & 1) * 2], (v)[(i) >> 1][((i) & 1) * 2 + 1]})

__device__ void scan_phase(const Params& p, int j, char* smem) {
  if (blockIdx.x >= 256) return;
  const int item = blockIdx.x, b = item >> 5, h = (item >> 1) & 15, d = item & 1;
  const int tid = otid(), lane = tid & 63, wid = tid >> 6, fr = lane & 15, fq = lane >> 4;
  float* ops = (float*)smem;
  float* vs = ops + 32 * 320;
  float* ys = vs + 32 * 64;
  const bf* Vsrc = (j == 0) ? p.VF : p.V2;
  bf* Ydst = (d == 0) ? p.H : p.Y1;
  float* betad = p.beta + (size_t)d * MT * 16;
  bf16x8 bw[2], ba[2];
  {
    const int n = h * 64 + wid * 16 + fr;
#pragma unroll
    for (int ks = 0; ks < 2; ++ks) {
      bw[ks] = *(const bf16x8*)(p.w2t + (size_t)d * 65536 + (size_t)n * 64 + ks * 32 + fq * 8);
      ba[ks] = *(const bf16x8*)(p.a2t + (size_t)d * 65536 + (size_t)n * 64 + ks * 32 + fq * 8);
    }
  }
  float w0v[4], a0v[4];
#pragma unroll
  for (int e = 0; e < 4; ++e) {
    w0v[e] = p.rw_w0[(size_t)(j * 2 + d) * 1024 + h * 64 + wid * 16 + fq * 4 + e];
    a0v[e] = p.rw_a0[(size_t)(j * 2 + d) * 1024 + h * 64 + wid * 16 + fq * 4 + e];
  }
  const int tt = tid >> 3, c8 = tid & 7;
  float kkv[8], kav[8], rkv[8];
#pragma unroll
  for (int e = 0; e < 8; ++e) {
    kkv[e] = p.rw_k_k[j * 1024 + h * 64 + c8 * 8 + e];
    kav[e] = p.rw_k_a[j * 1024 + h * 64 + c8 * 8 + e];
    rkv[e] = p.rw_r_k[j * 1024 + h * 64 + c8 * 8 + e];
  }
  const int g = lane >> 3, kq = lane & 7, vrow = wid * 16 + g * 2;
  f32x2 S0[4], S1[4];
#pragma unroll
  for (int e = 0; e < 4; ++e) { S0[e] = (f32x2){0.f, 0.f}; S1[e] = (f32x2){0.f, 0.f}; }

  bf16x8 phw[2][2], pha[2][2];
  u32x4 puk, pur, puv;
  auto rowbase_of = [&](int ch, int& sgn) -> int {
    if (d == 0) { sgn = 1; return (ch < 8) ? NL + b * CTXL + ch * 32 : b * SEQ + (ch - 8) * 32; }
    sgn = -1; return (ch < 8) ? NL + b * CTXL + 255 - ch * 32 : b * SEQ + 8191 - (ch - 8) * 32;
  };
  auto prefetch = [&](int ch) {
    int sgn; const int rowbase = rowbase_of(ch, sgn);
#pragma unroll
    for (int m = 0; m < 2; ++m) {
      const size_t row = (size_t)(rowbase + sgn * (m * 16 + fr));
#pragma unroll
      for (int ks = 0; ks < 2; ++ks) {
        phw[m][ks] = *(const bf16x8*)(p.HID + row * HIDW + d * 64 + ks * 32 + fq * 8);
        pha[m][ks] = *(const bf16x8*)(p.HID + row * HIDW + 128 + d * 64 + ks * 32 + fq * 8);
      }
    }
    const size_t off = (size_t)(rowbase + sgn * tt) * 1024 + h * 64 + c8 * 8;
    puk = *(const u32x4*)(p.K + off);
    pur = *(const u32x4*)(p.R + off);
    puv = *(const u32x4*)(Vsrc + off);
  };
  prefetch(0);

  for (int ch = 0; ch < 264; ++ch) {
    int sgn; const int rowbase = rowbase_of(ch, sgn);
#pragma unroll
    for (int m = 0; m < 2; ++m) {
      const int tok = m * 16 + fr;
      f32x4 aw = (f32x4){0.f, 0.f, 0.f, 0.f}, aa = aw;
#pragma unroll
      for (int ks = 0; ks < 2; ++ks) {
        aw = __builtin_amdgcn_mfma_f32_16x16x32_bf16(bw[ks], phw[m][ks], aw, 0, 0, 0);
        aa = __builtin_amdgcn_mfma_f32_16x16x32_bf16(ba[ks], pha[m][ks], aa, 0, 0, 0);
      }
      f32x4 wd, av;
#pragma unroll
      for (int e = 0; e < 4; ++e) {
        const float z = -(w0v[e] + aw[e]);
        const float sp = fmaxf(z, 0.f) + log1pf(__expf(-fabsf(z)));
        const float wl = -sp - 0.5f;
        wd[e] = __expf(-__expf(wl));
        av[e] = sigmf(a0v[e] + aa[e]);
      }
      *(f32x4*)(ops + (tok * 5 + 0) * 64 + wid * 16 + fq * 4) = wd;
      *(f32x4*)(ops + (tok * 5 + 2) * 64 + wid * 16 + fq * 4) = av;
    }
    __syncthreads();
    {
      const size_t row = (size_t)(rowbase + sgn * tt);
      float k[8], r[8], v[8], kk[8];
#pragma unroll
      for (int e = 0; e < 4; ++e) {
        k[2 * e] = bflo(puk[e]); k[2 * e + 1] = bfhi(puk[e]);
        r[2 * e] = bflo(pur[e]); r[2 * e + 1] = bfhi(pur[e]);
        v[2 * e] = bflo(puv[e]); v[2 * e + 1] = bfhi(puv[e]);
      }
      float ss = 0.f;
#pragma unroll
      for (int e = 0; e < 8; ++e) { kk[e] = k[e] * kkv[e]; ss += kk[e] * kk[e]; }
      ss = oct_sum(ss);
      const float inv = 1.f / fmaxf(sqrtf(ss), 1e-12f);
      float* o = ops + tt * 320 + c8 * 8;
      const f32x4 a0 = *(const f32x4*)(o + 128), a1 = *(const f32x4*)(o + 132);
      const float a[8] = {a0.x, a0.y, a0.z, a0.w, a1.x, a1.y, a1.z, a1.w};
      float nk[8], bb[8], kd[8];
      float bt = 0.f;
#pragma unroll
      for (int e = 0; e < 8; ++e) {
        kk[e] *= inv;
        nk[e] = -kk[e];
        bb[e] = kk[e] * a[e];
        kd[e] = k[e] * (1.f + (a[e] - 1.f) * kav[e]);
        bt += r[e] * kd[e] * rkv[e];
      }
      bt = oct_sum(bt);
      if (c8 == 0) betad[row * 16 + h] = bt;
      *(f32x4*)(o + 64) = (f32x4){nk[0], nk[1], nk[2], nk[3]};   *(f32x4*)(o + 68) = (f32x4){nk[4], nk[5], nk[6], nk[7]};
      *(f32x4*)(o + 128) = (f32x4){bb[0], bb[1], bb[2], bb[3]};  *(f32x4*)(o + 132) = (f32x4){bb[4], bb[5], bb[6], bb[7]};
      *(f32x4*)(o + 192) = (f32x4){kd[0], kd[1], kd[2], kd[3]};  *(f32x4*)(o + 196) = (f32x4){kd[4], kd[5], kd[6], kd[7]};
      *(f32x4*)(o + 256) = (f32x4){r[0], r[1], r[2], r[3]};      *(f32x4*)(o + 260) = (f32x4){r[4], r[5], r[6], r[7]};
      *(f32x4*)(vs + tt * 64 + c8 * 8) = (f32x4){v[0], v[1], v[2], v[3]};
      *(f32x4*)(vs + tt * 64 + c8 * 8 + 4) = (f32x4){v[4], v[5], v[6], v[7]};
    }
    __syncthreads();
    if (ch + 1 < 264) prefetch(ch + 1);
    ScanOps cur = scan_load(ops, vs, 0, kq, vrow);
#pragma unroll 2
    for (int t = 0; t < 32; ++t) {
      const ScanOps nxt = scan_load(ops, vs, (t + 1) & 31, kq, vrow);
      f32x2 acc0 = S0[0] * PR(cur.nk, 0), acc1 = S1[0] * PR(cur.nk, 0);
#pragma unroll
      for (int e = 1; e < 4; ++e) { acc0 = fma2(S0[e], PR(cur.nk, e), acc0); acc1 = fma2(S1[e], PR(cur.nk, e), acc1); }
      const float sa0 = oct_sum(acc0.x + acc0.y), sa1 = oct_sum(acc1.x + acc1.y);
      const f32x2 sa0v = (f32x2){sa0, sa0}, sa1v = (f32x2){sa1, sa1};
      const f32x2 v0v = (f32x2){cur.vv.x, cur.vv.x}, v1v = (f32x2){cur.vv.y, cur.vv.y};
      f32x2 y0 = (f32x2){0.f, 0.f}, y1 = y0;
#pragma unroll
      for (int e = 0; e < 4; ++e) {
        const f32x2 we = PR(cur.w, e), be = PR(cur.bb, e), ke = PR(cur.kd, e), re = PR(cur.rr, e);
        S0[e] = fma2(v0v, ke, fma2(sa0v, be, S0[e] * we));
        S1[e] = fma2(v1v, ke, fma2(sa1v, be, S1[e] * we));
        y0 = fma2(S0[e], re, y0);
        y1 = fma2(S1[e], re, y1);
      }
      const float yy0 = oct_sum(y0.x + y0.y), yy1 = oct_sum(y1.x + y1.y);
      if (kq == 0) *(f32x2*)(ys + t * 64 + vrow) = (f32x2){yy0, yy1};
      cur = nxt;
    }
    __syncthreads();
    {
      const size_t row = (size_t)(rowbase + sgn * tt);
      const f32x4 y0 = *(const f32x4*)(ys + tt * 64 + c8 * 8), y1 = *(const f32x4*)(ys + tt * 64 + c8 * 8 + 4);
      *(u32x4*)(Ydst + row * 1024 + h * 64 + c8 * 8) = (u32x4){pk2(y0.x, y0.y), pk2(y0.z, y0.w), pk2(y1.x, y1.y), pk2(y1.z, y1.w)};
    }
  }
}

__device__ void og_phase(const Params& p, int j) {
  const int tid = otid(), lane = tid & 63;
  const int gw = blockIdx.x * 4 + (tid >> 6), nw = gridDim.x * 4;
  const bf* Vsrc = (j == 0) ? p.VF : p.V2;
  const int col = lane * 16, hh = lane >> 2;
  float lw[16], lb[16];
#pragma unroll
  for (int e = 0; e < 16; ++e) { lw[e] = p.rw_lnx_w[j * 1024 + col + e]; lb[e] = p.rw_lnx_b[j * 1024 + col + e]; }
  for (int row = gw; row < MT; row += nw) {
    const size_t off = (size_t)row * 1024 + col;
    u32x4 u0[2], u1[2], uv[2], ug[2];
#pragma unroll
    for (int q = 0; q < 2; ++q) {
      u0[q] = *(const u32x4*)(p.H + off + q * 8);
      u1[q] = *(const u32x4*)(p.Y1 + off + q * 8);
      uv[q] = *(const u32x4*)(Vsrc + off + q * 8);
      ug[q] = *(const u32x4*)(p.G + off + q * 8);
    }
    const float bsum = p.beta[(size_t)row * 16 + hh] + p.beta[(size_t)MT * 16 + (size_t)row * 16 + hh];
    float y[16], v[16], g[16];
    float s = 0.f;
#pragma unroll
    for (int e = 0; e < 8; ++e) {
      y[2 * e] = bflo(u0[e >> 2][e & 3]) + bflo(u1[e >> 2][e & 3]); y[2 * e + 1] = bfhi(u0[e >> 2][e & 3]) + bfhi(u1[e >> 2][e & 3]);
      v[2 * e] = bflo(uv[e >> 2][e & 3]); v[2 * e + 1] = bfhi(uv[e >> 2][e & 3]);
      g[2 * e] = bflo(ug[e >> 2][e & 3]); g[2 * e + 1] = bfhi(ug[e >> 2][e & 3]);
      s += y[2 * e] + y[2 * e + 1];
    }
    s = quad_sum(s);
    const float mean = s * (1.f / 64.f);
    float q2 = 0.f;
#pragma unroll
    for (int e = 0; e < 16; ++e) { const float dd = y[e] - mean; q2 += dd * dd; }
    q2 = quad_sum(q2);
    const float rstd = rsqrtf(q2 * (1.f / 64.f) + 64e-5f);
    unsigned o[8];
#pragma unroll
    for (int e = 0; e < 8; ++e) {
      const float r0 = ((y[2 * e] - mean) * rstd * lw[2 * e] + lb[2 * e] + bsum * v[2 * e]) * g[2 * e];
      const float r1 = ((y[2 * e + 1] - mean) * rstd * lw[2 * e + 1] + lb[2 * e + 1] + bsum * v[2 * e + 1]) * g[2 * e + 1];
      o[e] = pk2(r0, r1);
    }
    *(u32x4*)(p.H + off) = (u32x4){o[0], o[1], o[2], o[3]};
    *(u32x4*)(p.H + off + 8) = (u32x4){o[4], o[5], o[6], o[7]};
  }
}

__device__ void attn_phase(const Params& p, int j, bool ctx_out, char* smem) {
  const int tid = otid(), lane = tid & 63, cgp = tid >> 6, fr = lane & 15, fq = lane >> 4;
  char* Ks = smem;
  bf* Vs = (bf*)smem;
  float* rpbs = (float*)(smem + 36864);
  const bf* Q = p.R; const bf* Kb = p.K; const bf* Vt = p.V2; const bf* Gb = p.G;
  const int nitems = 16384 + (ctx_out ? 512 : 0);
  for (int item = blockIdx.x; item < nitems; item += gridDim.x) {
    int b, h, r = 0, qrow0; bool haswin;
    if (item < 16384) { h = item & 15; r = (item >> 4) & 127; b = item >> 11; haswin = true; qrow0 = b * SEQ + r * 64; }
    else { const int it = item - 16384; h = it & 15; const int qb = (it >> 4) & 3; b = it >> 6; haswin = false; qrow0 = NL + b * CTXL + qb * 64; }
    const int qtok = qrow0 + cgp * 16 + fr;
    bf16x8 qf[2];
#pragma unroll
    for (int ks = 0; ks < 2; ++ks) qf[ks] = *(const bf16x8*)(Q + (size_t)qtok * 1024 + h * 64 + ks * 32 + fq * 8);
    const int rs = min(max(r - 4, 0), 120);
    const int qcol = cgp * 16 + fr;
    const int wsq = min(max(qcol - 8, 0), 48);
    const int bs = min(max(16 * cgp - 8, 0), 32);
    __syncthreads();
    if (haswin) for (int idx = tid; idx < 465; idx += 256) rpbs[idx] = p.na_rpb[((size_t)j * 16 + h) * 465 + idx];
    f32x4 sw[8][2], sc[4][4];
    bf16x8 pw[8];
    float m1 = NEGV, l1 = 0.f;
#pragma unroll
    for (int i = 0; i < 8; ++i) pw[i] = (bf16x8){0, 0, 0, 0, 0, 0, 0, 0};
#pragma unroll
    for (int i = 0; i < 8; ++i)
#pragma unroll
      for (int k2 = 0; k2 < 2; ++k2) sw[i][k2] = (f32x4){NEGV, NEGV, NEGV, NEGV};
#pragma unroll
    for (int st = 0; st < 3; ++st) {
      if (st < 2 && !haswin) continue;
      __syncthreads();
#pragma unroll
      for (int hf = 0; hf < 2; ++hf) {
        u32x4 u[4];
#pragma unroll
        for (int i = 0; i < 4; ++i) {
          const int q = tid + (hf * 4 + i) * 256, key = q >> 3, c = q & 7, tl = key >> 6;
          const int base = (st < 2) ? b * SEQ + (rs + st * 4 + tl) * 64 : NL + b * CTXL + tl * 64;
          u[i] = *(const u32x4*)(Kb + (size_t)(base + (key & 63)) * 1024 + h * 64 + c * 8);
        }
#pragma unroll
        for (int i = 0; i < 4; ++i) {
          const int q = tid + (hf * 4 + i) * 256, key = q >> 3, c = q & 7;
          *(u32x4*)(Ks + lds_off(key, c)) = u[i];
        }
        __builtin_amdgcn_sched_barrier(0);
      }
      __syncthreads();
      if (st < 2) {
#pragma unroll
        for (int tl = 0; tl < 4; ++tl) {
          const int i = st * 4 + tl;
          const int dr = rs + i - r + 7;
#pragma unroll
          for (int k2 = 0; k2 < 2; ++k2) {
            f32x4 acc = (f32x4){0.f, 0.f, 0.f, 0.f};
#pragma unroll
            for (int ks = 0; ks < 2; ++ks) {
              const bf16x8 kf = *(const bf16x8*)(Ks + lds_off(tl * 64 + bs + k2 * 16 + fr, ks * 4 + fq));
              acc = __builtin_amdgcn_mfma_f32_16x16x32_bf16(kf, qf[ks], acc, 0, 0, 0);
            }
#pragma unroll
            for (int e = 0; e < 4; ++e) {
              const int kc = bs + k2 * 16 + fq * 4 + e;
              const bool valid = (kc >= wsq) && (kc < wsq + 16);
              const int dc = min(max(kc - qcol, -15), 15) + 15;
              sw[i][k2][e] = valid ? acc[e] + rpbs[dr * 31 + dc] : NEGV;
            }
          }
          __builtin_amdgcn_sched_barrier(0);
        }
      } else {
#pragma unroll
        for (int tl = 0; tl < 4; ++tl)
#pragma unroll
          for (int k4 = 0; k4 < 4; ++k4) {
            f32x4 acc = (f32x4){0.f, 0.f, 0.f, 0.f};
#pragma unroll
            for (int ks = 0; ks < 2; ++ks) {
              const bf16x8 kf = *(const bf16x8*)(Ks + lds_off(tl * 64 + k4 * 16 + fr, ks * 4 + fq));
              acc = __builtin_amdgcn_mfma_f32_16x16x32_bf16(kf, qf[ks], acc, 0, 0, 0);
            }
            sc[tl][k4] = acc;
            if (k4 & 1) __builtin_amdgcn_sched_barrier(0);
          }
      }
      if (st == 1) {
#pragma unroll
        for (int i = 0; i < 8; ++i)
#pragma unroll
          for (int k2 = 0; k2 < 2; ++k2)
#pragma unroll
            for (int e = 0; e < 4; ++e) m1 = fmaxf(m1, sw[i][k2][e]);
        m1 = fmaxf(m1, __shfl_xor(m1, 16));
        m1 = fmaxf(m1, __shfl_xor(m1, 32));
#pragma unroll
        for (int i = 0; i < 8; ++i) {
          float e0[4], e1[4];
#pragma unroll
          for (int e = 0; e < 4; ++e) { e0[e] = __expf(sw[i][0][e] - m1); e1[e] = __expf(sw[i][1][e] - m1); l1 += e0[e] + e1[e]; }
          u32x4 u = (u32x4){pk2(e0[0], e0[1]), pk2(e0[2], e0[3]), pk2(e1[0], e1[1]), pk2(e1[2], e1[3])};
          pw[i] = __builtin_bit_cast(bf16x8, u);
        }
        l1 += __shfl_xor(l1, 16);
        l1 += __shfl_xor(l1, 32);
      }
    }
    float m2 = NEGV;
#pragma unroll
    for (int tl = 0; tl < 4; ++tl)
#pragma unroll
      for (int k4 = 0; k4 < 4; ++k4)
#pragma unroll
        for (int e = 0; e < 4; ++e) m2 = fmaxf(m2, sc[tl][k4][e]);
    m2 = fmaxf(m2, __shfl_xor(m2, 16));
    m2 = fmaxf(m2, __shfl_xor(m2, 32));
    const float mx = fmaxf(m1, m2);
    const float alpha1 = __expf(m1 - mx);
    float l2 = 0.f;
    bf16x8 pc[4][2];
#pragma unroll
    for (int tl = 0; tl < 4; ++tl)
#pragma unroll
      for (int g2 = 0; g2 < 2; ++g2) {
        float e0[4], e1[4];
#pragma unroll
        for (int e = 0; e < 4; ++e) { e0[e] = __expf(sc[tl][2 * g2][e] - mx); e1[e] = __expf(sc[tl][2 * g2 + 1][e] - mx); l2 += e0[e] + e1[e]; }
        u32x4 u = (u32x4){pk2(e0[0], e0[1]), pk2(e0[2], e0[3]), pk2(e1[0], e1[1]), pk2(e1[2], e1[3])};
        pc[tl][g2] = __builtin_bit_cast(bf16x8, u);
      }
    l2 += __shfl_xor(l2, 16);
    l2 += __shfl_xor(l2, 32);
    const float l = alpha1 * l1 + l2;
    f32x4 o[4];
#pragma unroll
    for (int dt = 0; dt < 4; ++dt) o[dt] = (f32x4){0.f, 0.f, 0.f, 0.f};
#pragma unroll
    for (int st = 0; st < 3; ++st) {
      if (st < 2 && !haswin) continue;
      __syncthreads();
#pragma unroll
      for (int hf = 0; hf < 2; ++hf) {
        u32x4 u[4];
#pragma unroll
        for (int i = 0; i < 4; ++i) {
          const int q = tid + (hf * 4 + i) * 256, tl = q >> 9, dd = (q >> 3) & 63, c = q & 7;
          const int base = (st < 2) ? b * SEQ + (rs + st * 4 + tl) * 64 : NL + b * CTXL + tl * 64;
          u[i] = *(const u32x4*)(Vt + (size_t)(h * 64 + dd) * MT + base + c * 8);
        }
#pragma unroll
        for (int i = 0; i < 4; ++i) {
          const int q = tid + (hf * 4 + i) * 256, tl = q >> 9, dd = (q >> 3) & 63, c = q & 7;
          *(u32x4*)(Vs + tl * 4608 + dd * 72 + c * 8) = u[i];
        }
        __builtin_amdgcn_sched_barrier(0);
      }
      __syncthreads();
      if (st < 2) {
#pragma unroll
        for (int tl = 0; tl < 4; ++tl) {
          const int i = st * 4 + tl;
#pragma unroll
          for (int dt = 0; dt < 4; ++dt) {
            const bf* vp = Vs + tl * 4608 + (dt * 16 + fr) * 72 + bs + fq * 4;
            const u32x2 lo = *(const u32x2*)vp, hi = *(const u32x2*)(vp + 16);
            u32x4 u = (u32x4){lo.x, lo.y, hi.x, hi.y};
            o[dt] = __builtin_amdgcn_mfma_f32_16x16x32_bf16(__builtin_bit_cast(bf16x8, u), pw[i], o[dt], 0, 0, 0);
          }
          __builtin_amdgcn_sched_barrier(0);
        }
      } else {
#pragma unroll
        for (int tl = 0; tl < 4; ++tl)
#pragma unroll
          for (int g2 = 0; g2 < 2; ++g2)
#pragma unroll
            for (int dt = 0; dt < 4; ++dt) {
              const bf* vp = Vs + tl * 4608 + (dt * 16 + fr) * 72 + g2 * 32 + fq * 4;
              const u32x2 lo = *(const u32x2*)vp, hi = *(const u32x2*)(vp + 16);
              u32x4 u = (u32x4){lo.x, lo.y, hi.x, hi.y};
              o[dt] = __builtin_amdgcn_mfma_f32_16x16x32_bf16(__builtin_bit_cast(bf16x8, u), pc[tl][g2], o[dt], 0, 0, 0);
              if (dt == 3) __builtin_amdgcn_sched_barrier(0);
            }
      }
      if (st == 1) {
#pragma unroll
        for (int dt = 0; dt < 4; ++dt) o[dt] *= alpha1;
      }
    }
    const float inv = 1.f / l;
#pragma unroll
    for (int dt = 0; dt < 4; ++dt) {
      const size_t off = (size_t)qtok * 1024 + h * 64 + dt * 16 + fq * 4;
      const u32x2 ug = *(const u32x2*)(Gb + off);
      const float g0 = bflo(ug.x), g1 = bfhi(ug.x), g2 = bflo(ug.y), g3 = bfhi(ug.y);
      *(u32x2*)(p.H + off) = (u32x2){pk2(o[dt][0] * inv * siluf(g0), o[dt][1] * inv * siluf(g1)),
                                        pk2(o[dt][2] * inv * siluf(g2), o[dt][3] * inv * siluf(g3))};
    }
  }
}

#ifndef DUP_SCAN
#define DUP_SCAN 0
#endif
#ifndef DUP_ATTN
#define DUP_ATTN 0
#endif
#ifndef DUP_GEMM
#define DUP_GEMM 0
#endif
#ifndef MULTI_LAUNCH
#define MULTI_LAUNCH 0
#endif
__device__ __forceinline__ bool step_exists(int i, int s) {
  if (s == 2) return i == 2;
  if (s == 4) return (i & 1) == 0;
  return true;
}
__device__ __forceinline__ void run_step(const Params& p, int i, int s, char* smem) {
  asm volatile("" : "+s"(i));
  const int j = i >> 1;
  if (s == 0) { transpose_phase(p, i, smem); row_phase(p, i); }
  else if (s == 1) {
    if ((i & 1) == 0) {
      EpiRwkvProj ep{p.R, p.K, (j == 0) ? p.VF : p.V2, p.G, p.HID};
      gemm_phase<1>(p.H, 1024, p.Wp, 1024, 16, MT / 128, (j == 0) ? 34 : 35, p.rw_mu + (size_t)j * 6 * 1024, ep, smem);
    } else {
      EpiNaProj ep{p.R, p.K, p.V2, p.G, p.na_b_in + (size_t)j * 4096};
      gemm_phase<0>(p.H, 1024, p.Wp, 1024, 16, MT / 128, 32, nullptr, ep, smem);
    }
  } else if (s == 2) {
    EpiVres ev{p.V2, p.VF, p.rw_v0};
    gemm_phase<0>(p.HID + 256, HIDW, p.v2t, 64, 1, MT / 128, 8, nullptr, ev, smem);
  } else if (s == 3) {
    if ((i & 1) == 0) scan_phase(p, j, smem);
    else attn_phase(p, j, i != 3, smem);
  } else if (s == 4) {
    og_phase(p, j);
  } else {
    EpiOut eo{p.R};
    gemm_phase<0>(p.H, 1024, p.Wo, 1024, 16, (i == 3) ? NL / 128 : MT / 128, 8, nullptr, eo, smem);
  }
}

__global__ void __launch_bounds__(256, 2) fwd_megakernel(Params p0) {
  __shared__ __attribute__((aligned(16))) char smem[SMEM_BYTES];
  cg::grid_group grid = cg::this_grid();
  if (blockIdx.x == 0 && threadIdx.x == 0) *p0.gp = p0;
  pre_phase(p0, smem);
  grid.sync();
  const Params& p = *(const Params*)p0.gp;
#pragma unroll 1
  for (int i = 0; i < 4; ++i) {
#pragma unroll 1
    for (int s = 0; s < 6; ++s) {
      if (!step_exists(i, s)) continue;
      run_step(p, i, s, smem);
      grid.sync();
#if DUP_SCAN
      if (s == 3 && (i & 1) == 0) { run_step(p, i, s, smem); grid.sync(); }
#endif
#if DUP_ATTN
      if (s == 3 && (i & 1) == 1) { run_step(p, i, s, smem); grid.sync(); }
#endif
#if DUP_GEMM
      if (s == 1 || s == 5) { run_step(p, i, s, smem); grid.sync(); }
#endif
    }
  }
  row_phase(p, 4);
}

#if MULTI_LAUNCH
template <int S> __global__ void __launch_bounds__(256, 2) step_kernel(Params p0, int i) {
  __shared__ __attribute__((aligned(16))) char smem[SMEM_BYTES];
  if (S == -1) { pre_phase(p0, smem); return; }
  if (S == 6) { row_phase(p0, 4); return; }
  run_step(p0, i, S, smem);
}
#endif

extern "C" void kernel_launch(void* const* d_in, const int* in_sizes, int n_in, void* d_out, int out_size, void* d_ws, size_t ws_size,
                              hipStream_t stream) {
  static int grid_blocks = 0;
  if (!grid_blocks) {
    int dev = 0, cus = 0, per_cu = 0;
    hipGetDevice(&dev);
    hipDeviceGetAttribute(&cus, hipDeviceAttributeMultiprocessorCount, dev);
    hipOccupancyMaxActiveBlocksPerMultiprocessor(&per_cu, fwd_megakernel, 256, 0);
    if (per_cu > 2) per_cu = 2;
    if (per_cu < 1) per_cu = 1;
    grid_blocks = cus * per_cu;
  }
  Params p{};
  const float** f = (const float**)&p;
  for (int i = 0; i < 29; ++i) f[i] = (const float*)d_in[i];
  p.out = (float*)d_out;
  char* w = (char*)d_ws;
  size_t off = 0;
  auto take = [&](size_t bytes) { char* r = w + off; off += (bytes + 255) & ~(size_t)255; return r; };
  p.gp = (Params*)take(sizeof(Params));
  p.mod = (float*)take((size_t)4 * 9 * 3072 * 4);
  p.ctxbuf = (float*)take((size_t)NC * 1024 * 4);
  p.beta = (float*)take((size_t)2 * MT * 16 * 4);
  p.Wp = (bf*)take((size_t)4480 * 1024 * 2);
  p.Wo = (bf*)take((size_t)1024 * 1024 * 2);
  p.w2t = (bf*)take((size_t)2 * 65536 * 2);
  p.a2t = (bf*)take((size_t)2 * 65536 * 2);
  p.v2t = (bf*)take((size_t)65536 * 2);
  const size_t big = (size_t)MT * 1024 * 2;
  p.H = (bf*)take(big); p.R = (bf*)take(big); p.K = (bf*)take(big); p.VF = (bf*)take(big);
  p.V2 = (bf*)take(big); p.G = (bf*)take(big); p.Y1 = (bf*)take(big);
  p.HID = (bf*)take((size_t)MT * HIDW * 2);
  if (off > ws_size) fprintf(stderr, "workspace too small: need %zu have %zu\n", off, ws_size);
#if MULTI_LAUNCH
  step_kernel<-1><<<grid_blocks, 256, 0, stream>>>(p, 0);
  for (int i = 0; i < 4; ++i) {
    step_kernel<0><<<grid_blocks, 256, 0, stream>>>(p, i);
    step_kernel<1><<<grid_blocks, 256, 0, stream>>>(p, i);
    if (i == 2) step_kernel<2><<<grid_blocks, 256, 0, stream>>>(p, i);
    step_kernel<3><<<grid_blocks, 256, 0, stream>>>(p, i);
    if ((i & 1) == 0) step_kernel<4><<<grid_blocks, 256, 0, stream>>>(p, i);
    step_kernel<5><<<grid_blocks, 256, 0, stream>>>(p, i);
  }
  step_kernel<6><<<grid_blocks, 256, 0, stream>>>(p, 0);
#else
  void* args[] = {&p};
  hipError_t e = hipLaunchCooperativeKernel((void*)fwd_megakernel, dim3(grid_blocks), dim3(256), args, 0, stream);
  if (e != hipSuccess) fprintf(stderr, "cooperative launch failed: %s (grid %d)\n", hipGetErrorString(e), grid_blocks);
#endif
}
```

```cpp
#include <hip/hip_runtime.h>
#include <hip/hip_cooperative_groups.h>
#include <cstdint>
#include <cstdio>
namespace cg = cooperative_groups;

typedef unsigned short bf;
typedef short bf16x8 __attribute__((ext_vector_type(8)));
typedef float f32x4 __attribute__((ext_vector_type(4)));
typedef unsigned u32x4 __attribute__((ext_vector_type(4)));
typedef unsigned u32x2 __attribute__((ext_vector_type(2)));

constexpr int DM = 1024, NB = 8, SEQ = 8192, NL = NB * SEQ, CTXL = 256, NC = NB * CTXL, MT = NL + NC;
constexpr int HIDW = 384;
constexpr int SMEM_BYTES = 65536;
#define NEGV (-1e30f)

struct Params {
  const float *x, *c, *ctx, *c_ctx, *ada_w, *ada_b, *pre_g, *post_g, *rw_mu, *rw_w_rkvg, *rw_w0, *rw_w1, *rw_w2,
      *rw_a0, *rw_a1, *rw_a2, *rw_v0, *rw_v1, *rw_v2, *rw_k_k, *rw_k_a, *rw_r_k, *rw_lnx_w, *rw_lnx_b, *rw_w_out,
      *na_w_in, *na_b_in, *na_rpb, *na_w_out;
  float* out;
  float *mod, *ctxbuf, *beta;
  bf *Wp, *Wo, *w2t, *a2t, *v2t;
  bf *H, *R, *K, *VF, *V2, *G, *Y1, *HID;
  Params* gp;
};

__device__ __forceinline__ float bflo(unsigned w) { return __uint_as_float(w << 16); }
__device__ __forceinline__ float bfhi(unsigned w) { return __uint_as_float(w & 0xffff0000u); }
typedef __bf16 bf16x2_t __attribute__((ext_vector_type(2)));
__device__ __forceinline__ unsigned pk2(float lo, float hi) {
  bf16x2_t v = {(__bf16)lo, (__bf16)hi};
  return __builtin_bit_cast(unsigned, v);
}
__device__ __forceinline__ float siluf(float v) { return v / (1.f + __expf(-v)); }
__device__ __forceinline__ float sigmf(float v) { return 1.f / (1.f + __expf(-v)); }
__device__ __forceinline__ float quad_sum(float v) {
  int t = __builtin_amdgcn_update_dpp(0, __float_as_int(v), 0xB1, 0xF, 0xF, true);
  v += __int_as_float(t);
  t = __builtin_amdgcn_update_dpp(0, __float_as_int(v), 0x4E, 0xF, 0xF, true);
  v += __int_as_float(t);
  return v;
}
__device__ __forceinline__ float wave_sum(float v) {
#pragma unroll
  for (int o = 32; o >= 1; o >>= 1) v += __shfl_xor(v, o);
  return v;
}
__device__ __forceinline__ int otid() { int t = threadIdx.x; asm volatile("" : "+v"(t)); return t; }
__device__ __forceinline__ void lds_barrier() { asm volatile("s_waitcnt lgkmcnt(0)\n\ts_barrier" ::: "memory"); }
__device__ __forceinline__ int lds_off(int row, int c) { return row * 128 + ((c ^ ((row >> 1) & 7)) << 4); }
__device__ __forceinline__ unsigned lerp2(unsigned hm, unsigned h0, unsigned hp, float m0, float m1) {
  const float c0 = bflo(h0), c1 = bfhi(h0);
  const float x0 = 0.5f * (bflo(hm) + bflo(hp)) - c0;
  const float x1 = 0.5f * (bfhi(hm) + bfhi(hp)) - c1;
  return pk2(c0 + x0 * m0, c1 + x1 * m1);
}
__device__ __forceinline__ int mod_idx(int row) { return row < NL ? (row >> 13) : 8; }

__device__ void pre_phase(const Params& p, char* smem) {
  float* s = (float*)smem;
  float* red = s + 9 * 1024;
  const int tid = otid();
  for (int item = blockIdx.x; item < 4 * 48; item += gridDim.x) {
    const int i = item / 48, cb = item % 48;
    __syncthreads();
    for (int idx = tid; idx < 9 * 1024; idx += 256) {
      const int m = idx >> 10, k = idx & 1023;
      const float v = (m < 8) ? p.c[m * 1024 + k] : p.c_ctx[k];
      s[idx] = siluf(v);
    }
    __syncthreads();
    const int cc = tid & 63, kq = tid >> 6;
    float acc[9];
#pragma unroll
    for (int m = 0; m < 9; ++m) acc[m] = 0.f;
    const float* W = p.ada_w + (size_t)i * 1024 * 3072 + cb * 64 + cc;
    for (int k = kq * 256; k < kq * 256 + 256; ++k) {
      const float w = W[(size_t)k * 3072];
#pragma unroll
      for (int m = 0; m < 9; ++m) acc[m] += s[m * 1024 + k] * w;
    }
#pragma unroll
    for (int m = 0; m < 9; ++m) red[(kq * 9 + m) * 64 + cc] = acc[m];
    __syncthreads();
    for (int idx = tid; idx < 9 * 64; idx += 256) {
      const int m = idx >> 6, c2 = idx & 63;
      float v = red[(0 * 9 + m) * 64 + c2] + red[(1 * 9 + m) * 64 + c2] + red[(2 * 9 + m) * 64 + c2] + red[(3 * 9 + m) * 64 + c2];
      v += p.ada_b[i * 3072 + cb * 64 + c2];
      p.mod[(size_t)(i * 9 + m) * 3072 + cb * 64 + c2] = v;
    }
  }
}

struct TOp { const float* src; bf* dst; int K, N, Kp, Np; };
__device__ bool get_op(const Params& p, int i, int op, TOp& o) {
  const int j = i >> 1;
  if (i & 1) {
    if (op == 0) { o = {p.na_w_in + (size_t)j * 1024 * 4096, p.Wp, 1024, 4096, 1024, 4096}; return true; }
    if (op == 1) { o = {p.na_w_out + (size_t)j * 1024 * 1024, p.Wo, 1024, 1024, 1024, 1024}; return true; }
    return false;
  }
  if (op < 4) { o = {p.rw_w_rkvg + ((size_t)j * 4 + op) * 1024 * 1024, p.Wp + (size_t)op * 1024 * 1024, 1024, 1024, 1024, 1024}; return true; }
  if (op < 6) { const int d = op - 4; o = {p.rw_w1 + ((size_t)j * 2 + d) * 1024 * 64, p.Wp + (size_t)(4096 + d * 64) * 1024, 1024, 64, 1024, 64}; return true; }
  if (op < 8) { const int d = op - 6; o = {p.rw_a1 + ((size_t)j * 2 + d) * 1024 * 64, p.Wp + (size_t)(4224 + d * 64) * 1024, 1024, 64, 1024, 64}; return true; }
  if (op < 10) { const int d = op - 8; o = {p.rw_w2 + ((size_t)j * 2 + d) * 64 * 1024, p.w2t + (size_t)d * 65536, 64, 1024, 64, 1024}; return true; }
  if (op < 12) { const int d = op - 10; o = {p.rw_a2 + ((size_t)j * 2 + d) * 64 * 1024, p.a2t + (size_t)d * 65536, 64, 1024, 64, 1024}; return true; }
  if (op == 12) { o = {p.rw_w_out + (size_t)j * 1024 * 1024, p.Wo, 1024, 1024, 1024, 1024}; return true; }
  if (j == 1 && op == 13) { o = {p.rw_v1, p.Wp + (size_t)4352 * 1024, 1024, 32, 1024, 128}; return true; }
  if (j == 1 && op == 14) { o = {p.rw_v2, p.v2t, 32, 1024, 64, 1024}; return true; }
  return false;
}

__device__ void transpose_phase(const Params& p, int i, char* smem) {
  float* t = (float*)smem;
  const int tid = otid();
  int base = 0;
  for (int op = 0;; ++op) {
    TOp o;
    if (!get_op(p, i, op, o)) break;
    const int tk = o.Kp / 64, tn = o.Np / 64, nt = tk * tn;
    int first = blockIdx.x - (base % (int)gridDim.x);
    if (first < 0) first += gridDim.x;
    for (int g = first; g < nt; g += gridDim.x) {
      const int kt = g / tn, ntile = g % tn;
      __syncthreads();
#pragma unroll
      for (int ps = 0; ps < 4; ++ps) {
        const int kr = ps * 16 + (tid >> 4), c4 = (tid & 15) * 4;
        const int k = kt * 64 + kr, n = ntile * 64 + c4;
        f32x4 v = (f32x4){0.f, 0.f, 0.f, 0.f};
        if (k < o.K && n < o.N) v = *(const f32x4*)(o.src + (size_t)k * o.N + n);
        t[kr * 65 + c4 + 0] = v.x; t[kr * 65 + c4 + 1] = v.y; t[kr * 65 + c4 + 2] = v.z; t[kr * 65 + c4 + 3] = v.w;
      }
      __syncthreads();
      const int n = tid >> 2, kc = (tid & 3) * 16;
      unsigned w[8];
#pragma unroll
      for (int e = 0; e < 8; ++e) w[e] = pk2(t[(kc + 2 * e) * 65 + n], t[(kc + 2 * e + 1) * 65 + n]);
      bf* d = o.dst + (size_t)(ntile * 64 + n) * o.Kp + kt * 64 + kc;
      *(u32x4*)d = (u32x4){w[0], w[1], w[2], w[3]};
      *(u32x4*)(d + 8) = (u32x4){w[4], w[5], w[6], w[7]};
    }
    base += nt;
  }
}

__device__ void row_phase(const Params& p, int i) {
  const int tid = otid(), lane = tid & 63;
  const int gw = blockIdx.x * 4 + (tid >> 6), nw = gridDim.x * 4;
  const int nrows = (i == 4) ? NL : MT;
  for (int row = gw; row < nrows; row += nw) {
    const int m = mod_idx(row);
    const float* xs;
    if (i <= 1) xs = (row < NL) ? p.x + (size_t)row * 1024 : p.ctx + (size_t)(row - NL) * 1024;
    else xs = (row < NL) ? p.out + (size_t)row * 1024 : p.ctxbuf + (size_t)(row - NL) * 1024;
    f32x4 xv[4];
#pragma unroll
    for (int q = 0; q < 4; ++q) xv[q] = *(const f32x4*)(xs + q * 256 + lane * 4);
    if (i > 0) {
      const bf* orow = p.R + (size_t)row * 1024;
      float ov[4][4];
      float ss = 0.f;
#pragma unroll
      for (int q = 0; q < 4; ++q) {
        const u32x2 u = *(const u32x2*)(orow + q * 256 + lane * 4);
        ov[q][0] = bflo(u.x); ov[q][1] = bfhi(u.x); ov[q][2] = bflo(u.y); ov[q][3] = bfhi(u.y);
        ss += ov[q][0] * ov[q][0] + ov[q][1] * ov[q][1] + ov[q][2] * ov[q][2] + ov[q][3] * ov[q][3];
      }
      ss = wave_sum(ss);
      const float rs = rsqrtf(ss * (1.f / 1024.f) + 1e-6f);
      const float* gate = p.mod + (size_t)((i - 1) * 9 + m) * 3072 + 2048;
      const float* pg = p.post_g + (i - 1) * 1024;
      float* xd = (row < NL) ? p.out + (size_t)row * 1024 : p.ctxbuf + (size_t)(row - NL) * 1024;
#pragma unroll
      for (int q = 0; q < 4; ++q) {
        const int col = q * 256 + lane * 4;
        const f32x4 gv = *(const f32x4*)(gate + col);
        const f32x4 pv = *(const f32x4*)(pg + col);
        xv[q].x += gv.x * ov[q][0] * rs * pv.x;
        xv[q].y += gv.y * ov[q][1] * rs * pv.y;
        xv[q].z += gv.z * ov[q][2] * rs * pv.z;
        xv[q].w += gv.w * ov[q][3] * rs * pv.w;
        *(f32x4*)(xd + col) = xv[q];
      }
    }
    if (i < 4) {
      float ss = 0.f;
#pragma unroll
      for (int q = 0; q < 4; ++q) ss += xv[q].x * xv[q].x + xv[q].y * xv[q].y + xv[q].z * xv[q].z + xv[q].w * xv[q].w;
      ss = wave_sum(ss);
      const float rs = rsqrtf(ss * (1.f / 1024.f) + 1e-6f);
      const float* md = p.mod + (size_t)(i * 9 + m) * 3072;
      const float* pg = p.pre_g + i * 1024;
      bf* hd = p.H + (size_t)row * 1024;
#pragma unroll
      for (int q = 0; q < 4; ++q) {
        const int col = q * 256 + lane * 4;
        const f32x4 sh = *(const f32x4*)(md + col);
        const f32x4 sc = *(const f32x4*)(md + 1024 + col);
        const f32x4 pv = *(const f32x4*)(pg + col);
        const float h0 = xv[q].x * rs * pv.x * (1.f + sc.x) + sh.x;
        const float h1 = xv[q].y * rs * pv.y * (1.f + sc.y) + sh.y;
        const float h2 = xv[q].z * rs * pv.z * (1.f + sc.z) + sh.z;
        const float h3 = xv[q].w * rs * pv.w * (1.f + sc.w) + sh.w;
        *(u32x2*)(hd + col) = (u32x2){pk2(h0, h1), pk2(h2, h3)};
      }
    }
  }
}

struct EpiRwkvProj {
  bf *R, *K, *V, *G, *HID;
  __device__ __forceinline__ void operator()(int nt, int tok, int col, f32x4 v) const {
    bf* dst;
    if (nt < 8) dst = R + (size_t)tok * 1024 + col;
    else if (nt < 16) dst = K + (size_t)tok * 1024 + (col - 1024);
    else if (nt < 24) dst = V + (size_t)tok * 1024 + (col - 2048);
    else if (nt < 32) {
      dst = G + (size_t)tok * 1024 + (col - 3072);
#pragma unroll
      for (int e = 0; e < 4; ++e) v[e] = siluf(v[e]);
    } else {
      dst = HID + (size_t)tok * HIDW + (col - 4096);
      if (nt == 32) {
#pragma unroll
        for (int e = 0; e < 4; ++e) v[e] = tanhf(v[e]);
      }
    }
    *(u32x2*)dst = (u32x2){pk2(v[0], v[1]), pk2(v[2], v[3])};
  }
};
struct EpiNaProj {
  bf *Q, *K, *Vt, *G; const float* bias;
  __device__ __forceinline__ void operator()(int nt, int tok, int col, f32x4 v) const {
    const f32x4 b = *(const f32x4*)(bias + col);
    v[0] += b.x; v[1] += b.y; v[2] += b.z; v[3] += b.w;
    if (nt >= 16 && nt < 24) {
      const int c = col - 2048;
#pragma unroll
      for (int e = 0; e < 4; ++e) Vt[(size_t)(c + e) * MT + tok] = (bf)(pk2(v[e], 0.f) & 0xffffu);
      return;
    }
    bf* dst;
    if (nt < 8) { dst = Q + (size_t)tok * 1024 + col; v[0] *= 0.125f; v[1] *= 0.125f; v[2] *= 0.125f; v[3] *= 0.125f; }
    else if (nt < 16) dst = K + (size_t)tok * 1024 + (col - 1024);
    else dst = G + (size_t)tok * 1024 + (col - 3072);
    *(u32x2*)dst = (u32x2){pk2(v[0], v[1]), pk2(v[2], v[3])};
  }
};
struct EpiOut {
  bf* O;
  __device__ __forceinline__ void operator()(int nt, int tok, int col, f32x4 v) const {
    *(u32x2*)(O + (size_t)tok * 1024 + col) = (u32x2){pk2(v[0], v[1]), pk2(v[2], v[3])};
  }
};
struct EpiVres {
  bf* V2; const bf* VF; const float* v0;
  __device__ __forceinline__ void operator()(int nt, int tok, int col, f32x4 z) const {
    const f32x4 b = *(const f32x4*)(v0 + col);
    const u32x2 uv = *(const u32x2*)(V2 + (size_t)tok * 1024 + col);
    const u32x2 uf = *(const u32x2*)(VF + (size_t)tok * 1024 + col);
    const float v[4] = {bflo(uv.x), bfhi(uv.x), bflo(uv.y), bfhi(uv.y)};
    const float f[4] = {bflo(uf.x), bfhi(uf.x), bflo(uf.y), bfhi(uf.y)};
    const float zz[4] = {z[0] + b.x, z[1] + b.y, z[2] + b.z, z[3] + b.w};
    float r[4];
#pragma unroll
    for (int e = 0; e < 4; ++e) r[e] = v[e] + (f[e] - v[e]) * sigmf(zz[e]);
    *(u32x2*)(V2 + (size_t)tok * 1024 + col) = (u32x2){pk2(r[0], r[1]), pk2(r[2], r[3])};
  }
};

template <int AMODE, class Epi>
__device__ void gemm_phase(const bf* __restrict__ A, int lda, const bf* __restrict__ Bt, int ldb, int nkt, int mtiles, int ntiles,
                           const float* __restrict__ mu, const Epi& epi, char* smem) {
  const int tid = otid(), lane = tid & 63, wid = tid >> 6, wr = wid >> 1, wc = wid & 1, fr = lane & 15, fq = lane >> 4;
  const int rg = tid >> 3, cch = tid & 7;
  char* As = smem;
  char* Bs = smem + 32768;
  constexpr int GM = 6;
  const int xcd = blockIdx.x & 7, slot = blockIdx.x >> 3, nslots = gridDim.x >> 3;
  const int per_group = GM * ntiles;
  const int ngroups = (mtiles + GM - 1) / GM;
  const int my_groups = (ngroups - xcd + 7) >> 3;
  const int my_total = my_groups * per_group;
  for (int q = slot; q < my_total; q += nslots) {
    const int gi = q / per_group, e = q - gi * per_group;
    const int nt = e / GM, mt = (xcd + 8 * gi) * GM + (e - nt * GM);
    if (mt >= mtiles) continue;
    const int row0 = mt * 128, col0 = nt * 128;
    int lerp = 0; bool sstart = false, send = false;
    if (AMODE == 1) {
      lerp = (nt < 8) ? 0 : (nt < 16) ? 2 : (nt < 24) ? 3 : (nt < 32) ? 5 : (nt == 32) ? 1 : (nt == 33) ? 4 : 3;
      if (row0 < NL) { sstart = (row0 & (SEQ - 1)) == 0; send = ((row0 + 128) & (SEQ - 1)) == 0; }
      else { sstart = ((row0 - NL) & (CTXL - 1)) == 0; send = ((row0 + 128 - NL) & (CTXL - 1)) == 0; }
    }
    f32x4 acc[4][4];
#pragma unroll
    for (int m = 0; m < 4; ++m)
#pragma unroll
      for (int n = 0; n < 4; ++n) acc[m][n] = (f32x4){0.f, 0.f, 0.f, 0.f};
    u32x4 ra[6], rb[4];
    f32x4 muv[2];
    auto gload = [&](int kt) {
      const int kc = kt * 64 + cch * 8;
      if (AMODE == 0) {
#pragma unroll
        for (int i = 0; i < 4; ++i) ra[i] = *(const u32x4*)(A + (size_t)(row0 + rg * 4 + i) * lda + kc);
      } else {
#pragma unroll
        for (int i = 0; i < 6; ++i) {
          const int r = row0 + rg * 4 + i - 1;
          const bool zero = (i == 0 && rg == 0 && sstart) || (i == 5 && rg == 31 && send);
          ra[i] = zero ? (u32x4){0, 0, 0, 0} : *(const u32x4*)(A + (size_t)r * lda + kc);
        }
        muv[0] = *(const f32x4*)(mu + lerp * 1024 + kc);
        muv[1] = *(const f32x4*)(mu + lerp * 1024 + kc + 4);
      }
#pragma unroll
      for (int i = 0; i < 4; ++i) rb[i] = *(const u32x4*)(Bt + (size_t)(col0 + rg * 4 + i) * ldb + kc);
    };
    auto lstore = [&](int buf) {
      char* a = As + buf * 16384;
      char* b = Bs + buf * 16384;
      if (AMODE == 0) {
#pragma unroll
        for (int i = 0; i < 4; ++i) *(u32x4*)(a + lds_off(rg * 4 + i, cch)) = ra[i];
      } else {
#pragma unroll
        for (int i = 0; i < 4; ++i) {
          const u32x4 hm = ra[i], h0 = ra[i + 1], hp = ra[i + 2];
          u32x4 o;
          o.x = lerp2(hm.x, h0.x, hp.x, muv[0].x, muv[0].y);
          o.y = lerp2(hm.y, h0.y, hp.y, muv[0].z, muv[0].w);
          o.z = lerp2(hm.z, h0.z, hp.z, muv[1].x, muv[1].y);
          o.w = lerp2(hm.w, h0.w, hp.w, muv[1].z, muv[1].w);
          *(u32x4*)(a + lds_off(rg * 4 + i, cch)) = o;
        }
      }
#pragma unroll
      for (int i = 0; i < 4; ++i) *(u32x4*)(b + lds_off(rg * 4 + i, cch)) = rb[i];
    };
    lds_barrier();
    gload(0);
    lstore(0);
    lds_barrier();
    for (int kt = 0; kt < nkt; ++kt) {
      const int buf = kt & 1;
      if (kt + 1 < nkt) gload(kt + 1);
      const char* a = As + buf * 16384;
      const char* b = Bs + buf * 16384;
#pragma unroll
      for (int ks = 0; ks < 2; ++ks) {
        bf16x8 af[4], bfr[4];
#pragma unroll
        for (int m = 0; m < 4; ++m) af[m] = *(const bf16x8*)(a + lds_off(wr * 64 + m * 16 + fr, ks * 4 + fq));
#pragma unroll
        for (int n = 0; n < 4; ++n) bfr[n] = *(const bf16x8*)(b + lds_off(wc * 64 + n * 16 + fr, ks * 4 + fq));
#pragma unroll
        for (int m = 0; m < 4; ++m)
#pragma unroll
          for (int n = 0; n < 4; ++n) acc[m][n] = __builtin_amdgcn_mfma_f32_16x16x32_bf16(bfr[n], af[m], acc[m][n], 0, 0, 0);
      }
      if (kt + 1 < nkt) lstore(buf ^ 1);
      lds_barrier();
    }
#pragma unroll
    for (int m = 0; m < 4; ++m)
#pragma unroll
      for (int n = 0; n < 4; ++n) epi(nt, row0 + wr * 64 + m * 16 + fr, col0 + wc * 64 + n * 16 + fq * 4, acc[m][n]);
  }
}

typedef float f32x2 __attribute__((ext_vector_type(2)));
__device__ __forceinline__ float oct_sum(float v) {
  int t = __builtin_amdgcn_update_dpp(0, __float_as_int(v), 0xB1, 0xF, 0xF, true);
  v += __int_as_float(t);
  t = __builtin_amdgcn_update_dpp(0, __float_as_int(v), 0x4E, 0xF, 0xF, true);
  v += __int_as_float(t);
  t = __builtin_amdgcn_update_dpp(0, __float_as_int(v), 0x141, 0xF, 0xF, true);
  v += __int_as_float(t);
  return v;
}
__device__ __forceinline__ f32x2 fma2(f32x2 a, f32x2 b, f32x2 c) { return __builtin_elementwise_fma(a, b, c); }
__device__ __forceinline__ float fma_s(float a, float b, float c) { float d; asm("v_fma_f32 %0, %1, %2, %3" : "=v"(d) : "v"(a), "v"(b), "v"(c)); return d; }
__device__ __forceinline__ float mul_s(float a, float b) { float d; asm("v_mul_f32 %0, %1, %2" : "=v"(d) : "v"(a), "v"(b)); return d; }
struct ScanOps { f32x4 w[2], nk[2], bb[2], kd[2], rr[2]; f32x2 vv; };
__device__ __forceinline__ ScanOps scan_load(const float* ops, const float* vs, int t, int kq, int vrow) {
  ScanOps r;
  const float* o = ops + t * 320 + kq * 8;
  r.w[0] = *(const f32x4*)(o); r.w[1] = *(const f32x4*)(o + 4);
  r.nk[0] = *(const f32x4*)(o + 64); r.nk[1] = *(const f32x4*)(o + 68);
  r.bb[0] = *(const f32x4*)(o + 128); r.bb[1] = *(const f32x4*)(o + 132);
  r.kd[0] = *(const f32x4*)(o + 192); r.kd[1] = *(const f32x4*)(o + 196);
  r.rr[0] = *(const f32x4*)(o + 256); r.rr[1] = *(const f32x4*)(o + 260);
  r.vv = *(const f32x2*)(vs + t * 64 + vrow);
  return r;
}
#define PR(v, i) ((f32x2){(v)[(i) >> 1][((i) & 1) * 2], (v)[(i) >> 1][((i) & 1) * 2 + 1]})

constexpr int SC_P = 0, SC_YA = 8192, SC_V = 16384, SC_AT = 24576, SC_RT = SC_AT + 4352, SC_BT = SC_RT + 4352, SC_KT = SC_BT + 4352;
constexpr int SC_BTT = 41984, SC_KTT = SC_BTT + 4608, SC_MABT = 51200, SC_SM = 53248;
__device__ __forceinline__ bf16x8 mk8(u32x2 lo, u32x2 hi) { u32x4 u = (u32x4){lo.x, lo.y, hi.x, hi.y}; return __builtin_bit_cast(bf16x8, u); }
__device__ __forceinline__ bf16x8 mk4(u32x2 lo) { u32x4 u = (u32x4){lo.x, lo.y, 0u, 0u}; return __builtin_bit_cast(bf16x8, u); }
__device__ __forceinline__ float bfround(float x) { return bflo(pk2(x, 0.f) & 0xffffu); }
__device__ __forceinline__ void split4(f32x4 x, u32x2& hi, u32x2& lo) {
  hi = (u32x2){pk2(x[0], x[1]), pk2(x[2], x[3])};
  const float r0 = x[0] - bflo(hi.x), r1 = x[1] - bfhi(hi.x), r2 = x[2] - bflo(hi.y), r3 = x[3] - bfhi(hi.y);
  lo = (u32x2){pk2(r0, r1), pk2(r2, r3)};
}

__device__ void scan_phase(const Params& p, int j, char* smem) {
  const int tid = otid(), lane = tid & 63, wid = tid >> 6, fr = lane & 15, fq = lane >> 4;
  float* Pbuf = (float*)(smem + SC_P);
  float* abuf = (float*)(smem + SC_YA);
  float* ys = (float*)(smem + SC_YA);
  float* vs = (float*)(smem + SC_V);
  for (int item = blockIdx.x; item < 256; item += gridDim.x) {
  const int b = item >> 5, h = (item >> 1) & 15, d = item & 1;
  lds_barrier();
  const bf* Vsrc = (j == 0) ? p.VF : p.V2;
  bf* Ydst = (d == 0) ? p.H : p.Y1;
  float* betad = p.beta + (size_t)d * MT * 16;
  bf16x8 bw[2], ba[2];
  {
    const int n = h * 64 + wid * 16 + fr;
#pragma unroll
    for (int ks = 0; ks < 2; ++ks) {
      bw[ks] = *(const bf16x8*)(p.w2t + (size_t)d * 65536 + (size_t)n * 64 + ks * 32 + fq * 8);
      ba[ks] = *(const bf16x8*)(p.a2t + (size_t)d * 65536 + (size_t)n * 64 + ks * 32 + fq * 8);
    }
  }
  float w0v[4], a0v[4];
#pragma unroll
  for (int e = 0; e < 4; ++e) {
    w0v[e] = p.rw_w0[(size_t)(j * 2 + d) * 1024 + h * 64 + wid * 16 + fq * 4 + e];
    a0v[e] = p.rw_a0[(size_t)(j * 2 + d) * 1024 + h * 64 + wid * 16 + fq * 4 + e];
  }
  const int tt = tid >> 3, c8 = tid & 7;
  float kkv[8], kav[8], rkv[8];
#pragma unroll
  for (int e = 0; e < 8; ++e) {
    kkv[e] = p.rw_k_k[j * 1024 + h * 64 + c8 * 8 + e];
    kav[e] = p.rw_k_a[j * 1024 + h * 64 + c8 * 8 + e];
    rkv[e] = p.rw_r_k[j * 1024 + h * 64 + c8 * 8 + e];
  }
  f32x4 ST[4];
#pragma unroll
  for (int kt = 0; kt < 4; ++kt) ST[kt] = (f32x4){0.f, 0.f, 0.f, 0.f};

  bf16x8 phw[2][2], pha[2][2];
  u32x4 puk, pur, puv;
  auto rowbase_of = [&](int ch, int& sgn) -> int {
    if (d == 0) { sgn = 1; return (ch < 8) ? NL + b * CTXL + ch * 32 : b * SEQ + (ch - 8) * 32; }
    sgn = -1; return (ch < 8) ? NL + b * CTXL + 255 - ch * 32 : b * SEQ + 8191 - (ch - 8) * 32;
  };
  auto prefetch = [&](int ch) {
    int sgn; const int rowbase = rowbase_of(ch, sgn);
#pragma unroll
    for (int m = 0; m < 2; ++m) {
      const size_t row = (size_t)(rowbase + sgn * (m * 16 + fr));
#pragma unroll
      for (int ks = 0; ks < 2; ++ks) {
        phw[m][ks] = *(const bf16x8*)(p.HID + row * HIDW + d * 64 + ks * 32 + fq * 8);
        pha[m][ks] = *(const bf16x8*)(p.HID + row * HIDW + 128 + d * 64 + ks * 32 + fq * 8);
      }
    }
    const size_t off = (size_t)(rowbase + sgn * tt) * 1024 + h * 64 + c8 * 8;
    puk = *(const u32x4*)(p.K + off);
    pur = *(const u32x4*)(p.R + off);
    puv = *(const u32x4*)(Vsrc + off);
  };
  prefetch(0);

  for (int ch = 0; ch < 264; ++ch) {
    int sgn; const int rowbase = rowbase_of(ch, sgn);
#pragma unroll
    for (int m = 0; m < 2; ++m) {
      const int tok = m * 16 + fr;
      f32x4 aw = (f32x4){0.f, 0.f, 0.f, 0.f}, aa = aw;
#pragma unroll
      for (int ks = 0; ks < 2; ++ks) {
        aw = __builtin_amdgcn_mfma_f32_16x16x32_bf16(bw[ks], phw[m][ks], aw, 0, 0, 0);
        aa = __builtin_amdgcn_mfma_f32_16x16x32_bf16(ba[ks], pha[m][ks], aa, 0, 0, 0);
      }
      f32x4 wd, av;
#pragma unroll
      for (int e = 0; e < 4; ++e) {
        const float z = -(w0v[e] + aw[e]);
        const float sp = fmaxf(z, 0.f) + __logf(1.f + __expf(-fabsf(z)));
        const float wl = -sp - 0.5f;
        wd[e] = __expf(-__expf(wl));
        av[e] = sigmf(a0v[e] + aa[e]);
      }
      *(f32x4*)(Pbuf + tok * 64 + wid * 16 + fq * 4) = wd;
      *(f32x4*)(abuf + tok * 64 + wid * 16 + fq * 4) = av;
    }
    lds_barrier();
    if (tid < 128) {
      const int k = tid & 63, sc = tid >> 6;
      float P = 1.f;
#pragma unroll
      for (int t = 0; t < 16; ++t) { float* q = Pbuf + (sc * 16 + t) * 64 + k; P *= *q; *q = P; }
    }
    lds_barrier();
    {
      const size_t row = (size_t)(rowbase + sgn * tt);
      float k[8], r[8], kk[8];
#pragma unroll
      for (int e = 0; e < 4; ++e) {
        k[2 * e] = bflo(puk[e]); k[2 * e + 1] = bfhi(puk[e]);
        r[2 * e] = bflo(pur[e]); r[2 * e + 1] = bfhi(pur[e]);
      }
      float ss = 0.f;
#pragma unroll
      for (int e = 0; e < 8; ++e) { kk[e] = k[e] * kkv[e]; ss += kk[e] * kk[e]; }
      ss = oct_sum(ss);
      const float inv = 1.f / fmaxf(sqrtf(ss), 1e-12f);
      const f32x4 a0 = *(const f32x4*)(abuf + tt * 64 + c8 * 8), a1 = *(const f32x4*)(abuf + tt * 64 + c8 * 8 + 4);
      const f32x4 p0 = *(const f32x4*)(Pbuf + tt * 64 + c8 * 8), p1 = *(const f32x4*)(Pbuf + tt * 64 + c8 * 8 + 4);
      f32x4 q0 = (f32x4){1.f, 1.f, 1.f, 1.f}, q1 = q0;
      if (tt & 15) { q0 = *(const f32x4*)(Pbuf + (tt - 1) * 64 + c8 * 8); q1 = *(const f32x4*)(Pbuf + (tt - 1) * 64 + c8 * 8 + 4); }
      const float a[8] = {a0.x, a0.y, a0.z, a0.w, a1.x, a1.y, a1.z, a1.w};
      const float Pt[8] = {p0.x, p0.y, p0.z, p0.w, p1.x, p1.y, p1.z, p1.w};
      const float Pm[8] = {q0.x, q0.y, q0.z, q0.w, q1.x, q1.y, q1.z, q1.w};
      float at[8], bt_[8], kt_[8], rt[8];
      float bsum = 0.f;
#pragma unroll
      for (int e = 0; e < 8; ++e) {
        const float kkn = kk[e] * inv;
        const float kd = k[e] * (1.f + (a[e] - 1.f) * kav[e]);
        bsum += r[e] * kd * rkv[e];
        const float ip = 1.f / Pt[e];
        at[e] = -kkn * Pm[e];
        bt_[e] = kkn * a[e] * ip;
        kt_[e] = kd * ip;
        rt[e] = r[e] * Pt[e];
      }
      bsum = oct_sum(bsum);
      if (c8 == 0) betad[row * 16 + h] = bsum;
      char* ro = smem + tt * 136 + c8 * 16;
      *(u32x2*)(ro + SC_AT) = (u32x2){pk2(at[0], at[1]), pk2(at[2], at[3])};   *(u32x2*)(ro + SC_AT + 8) = (u32x2){pk2(at[4], at[5]), pk2(at[6], at[7])};
      *(u32x2*)(ro + SC_RT) = (u32x2){pk2(rt[0], rt[1]), pk2(rt[2], rt[3])};   *(u32x2*)(ro + SC_RT + 8) = (u32x2){pk2(rt[4], rt[5]), pk2(rt[6], rt[7])};
      *(u32x2*)(ro + SC_BT) = (u32x2){pk2(bt_[0], bt_[1]), pk2(bt_[2], bt_[3])}; *(u32x2*)(ro + SC_BT + 8) = (u32x2){pk2(bt_[4], bt_[5]), pk2(bt_[6], bt_[7])};
      *(u32x2*)(ro + SC_KT) = (u32x2){pk2(kt_[0], kt_[1]), pk2(kt_[2], kt_[3])}; *(u32x2*)(ro + SC_KT + 8) = (u32x2){pk2(kt_[4], kt_[5]), pk2(kt_[6], kt_[7])};
#pragma unroll
      for (int e = 0; e < 8; ++e) {
        *(bf*)(smem + SC_BTT + (c8 * 8 + e) * 72 + tt * 2) = (bf)(pk2(bt_[e], 0.f) & 0xffffu);
        *(bf*)(smem + SC_KTT + (c8 * 8 + e) * 72 + tt * 2) = (bf)(pk2(kt_[e], 0.f) & 0xffffu);
      }
      *(f32x4*)(vs + tt * 64 + c8 * 8) = (f32x4){bflo(puv[0]), bfhi(puv[0]), bflo(puv[1]), bfhi(puv[1])};
      *(f32x4*)(vs + tt * 64 + c8 * 8 + 4) = (f32x4){bflo(puv[2]), bfhi(puv[2]), bflo(puv[3]), bfhi(puv[3])};
    }
    lds_barrier();
    if (ch + 1 < 264) prefetch(ch + 1);
    {
      auto gram = [&](int xbase, int ybase, int sc) -> f32x4 {
        f32x4 acc = (f32x4){0.f, 0.f, 0.f, 0.f};
#pragma unroll
        for (int ks = 0; ks < 2; ++ks) {
          const char* xp = smem + xbase + (sc * 16 + fr) * 136 + ks * 64 + fq * 16;
          const char* yp = smem + ybase + (sc * 16 + fr) * 136 + ks * 64 + fq * 16;
          const bf16x8 xf = mk8(*(const u32x2*)xp, *(const u32x2*)(xp + 8));
          const bf16x8 yf = mk8(*(const u32x2*)yp, *(const u32x2*)(yp + 8));
          acc = __builtin_amdgcn_mfma_f32_16x16x32_bf16(xf, yf, acc, 0, 0, 0);
        }
        return acc;
      };
      auto store_small = [&](f32x4 g, int sc, int kind, bool strict) {
#pragma unroll
        for (int e = 0; e < 4; ++e) { const int sidx = fq * 4 + e; const bool keep = strict ? (sidx < fr) : (sidx <= fr); g[e] = keep ? g[e] : 0.f; }
        *(u32x2*)(smem + SC_SM + (sc * 5 + kind) * 640 + fr * 40 + fq * 8) = (u32x2){pk2(g[0], g[1]), pk2(g[2], g[3])};
      };
      if (wid < 2) {
        const int sc = wid;
        f32x4 g = gram(SC_BT, SC_AT, sc);
#pragma unroll
        for (int e = 0; e < 4; ++e) g[e] = (fq * 4 + e < fr) ? g[e] : 0.f;
        *(f32x4*)(smem + SC_MABT + sc * 1024 + fr * 64 + fq * 16) = g;
        asm volatile("s_waitcnt lgkmcnt(0)" ::: "memory");
        if (lane < 16) {
          float n[16];
#pragma unroll
          for (int t = 0; t < 16; ++t) {
            const float* mc = (const float*)(smem + SC_MABT + sc * 1024 + t * 64);
            float acc = (t == lane) ? 1.f : 0.f;
#pragma unroll
            for (int sp = 0; sp < t; ++sp) acc = fmaf(n[sp], mc[sp], acc);
            n[t] = acc;
          }
#pragma unroll
          for (int t = 0; t < 16; ++t) {
            const unsigned hi = pk2(n[t], 0.f) & 0xffffu;
            const unsigned lo = pk2(n[t] - bflo(hi), 0.f) & 0xffffu;
            *(bf*)(smem + SC_SM + (sc * 5 + 0) * 640 + t * 40 + lane * 2) = (bf)hi;
            *(bf*)(smem + SC_SM + (sc * 5 + 1) * 640 + t * 40 + lane * 2) = (bf)lo;
          }
        }
      } else {
        const int sc = wid - 2;
        store_small(gram(SC_KT, SC_AT, sc), sc, 2, true);
        store_small(gram(SC_BT, SC_RT, sc), sc, 3, false);
        store_small(gram(SC_KT, SC_RT, sc), sc, 4, false);
      }
    }
    lds_barrier();
#pragma unroll
    for (int sc = 0; sc < 2; ++sc) {
      bf16x8 shi[2], slo[2];
#pragma unroll
      for (int g = 0; g < 2; ++g) {
        u32x2 h0, l0, h1, l1;
        split4(ST[2 * g], h0, l0); split4(ST[2 * g + 1], h1, l1);
        shi[g] = mk8(h0, h1); slo[g] = mk8(l0, l1);
      }
      const char* arow = smem + SC_AT + (sc * 16 + fr) * 136 + fq * 8;
      const char* rrow = smem + SC_RT + (sc * 16 + fr) * 136 + fq * 8;
      f32x4 wt = (f32x4){0.f, 0.f, 0.f, 0.f}, yt = wt;
#pragma unroll
      for (int g = 0; g < 2; ++g) {
        const bf16x8 xa = mk8(*(const u32x2*)(arow + g * 64), *(const u32x2*)(arow + g * 64 + 32));
        const bf16x8 xr = mk8(*(const u32x2*)(rrow + g * 64), *(const u32x2*)(rrow + g * 64 + 32));
        wt = __builtin_amdgcn_mfma_f32_16x16x32_bf16(xa, shi[g], wt, 0, 0, 0);
        wt = __builtin_amdgcn_mfma_f32_16x16x32_bf16(xa, slo[g], wt, 0, 0, 0);
        yt = __builtin_amdgcn_mfma_f32_16x16x32_bf16(xr, shi[g], yt, 0, 0, 0);
        yt = __builtin_amdgcn_mfma_f32_16x16x32_bf16(xr, slo[g], yt, 0, 0, 0);
      }
      const int vcol = wid * 16 + fr;
      const float* vp = vs + (sc * 16 + fq * 4) * 64 + vcol;
      const bf16x8 vmf = mk4((u32x2){pk2(vp[0], vp[64]), pk2(vp[128], vp[192])});
      const char* smb = smem + SC_SM + sc * 5 * 640 + fr * 40 + fq * 8;
      const bf16x8 xnh = mk4(*(const u32x2*)(smb)), xnl = mk4(*(const u32x2*)(smb + 640));
      const bf16x8 xmak = mk4(*(const u32x2*)(smb + 2 * 640)), xmrb = mk4(*(const u32x2*)(smb + 3 * 640)), xmrk = mk4(*(const u32x2*)(smb + 4 * 640));
      wt = __builtin_amdgcn_mfma_f32_16x16x32_bf16(xmak, vmf, wt, 0, 0, 0);
      u32x2 whi, wlo;
      split4(wt, whi, wlo);
      f32x4 ut = (f32x4){0.f, 0.f, 0.f, 0.f};
      ut = __builtin_amdgcn_mfma_f32_16x16x32_bf16(xnh, mk4(whi), ut, 0, 0, 0);
      ut = __builtin_amdgcn_mfma_f32_16x16x32_bf16(xnh, mk4(wlo), ut, 0, 0, 0);
      ut = __builtin_amdgcn_mfma_f32_16x16x32_bf16(xnl, mk4(whi), ut, 0, 0, 0);
      u32x2 uhi, ulo;
      split4(ut, uhi, ulo);
      const bf16x8 uhf = mk4(uhi), ulf = mk4(ulo);
      yt = __builtin_amdgcn_mfma_f32_16x16x32_bf16(xmrb, uhf, yt, 0, 0, 0);
      yt = __builtin_amdgcn_mfma_f32_16x16x32_bf16(xmrb, ulf, yt, 0, 0, 0);
      yt = __builtin_amdgcn_mfma_f32_16x16x32_bf16(xmrk, vmf, yt, 0, 0, 0);
#pragma unroll
      for (int e = 0; e < 4; ++e) ys[(sc * 16 + fq * 4 + e) * 64 + vcol] = yt[e];
#pragma unroll
      for (int kt = 0; kt < 4; ++kt) {
        const bf16x8 xb = mk4(*(const u32x2*)(smem + SC_BTT + (kt * 16 + fr) * 72 + (sc * 16 + fq * 4) * 2));
        const bf16x8 xk = mk4(*(const u32x2*)(smem + SC_KTT + (kt * 16 + fr) * 72 + (sc * 16 + fq * 4) * 2));
        ST[kt] = __builtin_amdgcn_mfma_f32_16x16x32_bf16(xb, uhf, ST[kt], 0, 0, 0);
        ST[kt] = __builtin_amdgcn_mfma_f32_16x16x32_bf16(xb, ulf, ST[kt], 0, 0, 0);
        ST[kt] = __builtin_amdgcn_mfma_f32_16x16x32_bf16(xk, vmf, ST[kt], 0, 0, 0);
        const f32x4 pc = *(const f32x4*)(Pbuf + (sc * 16 + 15) * 64 + kt * 16 + fq * 4);
        ST[kt] = ST[kt] * pc;
      }
    }
    lds_barrier();
    {
      const size_t row = (size_t)(rowbase + sgn * tt);
      const f32x4 y0 = *(const f32x4*)(ys + tt * 64 + c8 * 8), y1 = *(const f32x4*)(ys + tt * 64 + c8 * 8 + 4);
      *(u32x4*)(Ydst + row * 1024 + h * 64 + c8 * 8) = (u32x4){pk2(y0.x, y0.y), pk2(y0.z, y0.w), pk2(y1.x, y1.y), pk2(y1.z, y1.w)};
    }
    lds_barrier();
  }
  }
}

__device__ void og_phase(const Params& p, int j) {
  const int tid = otid(), lane = tid & 63;
  const int gw = blockIdx.x * 4 + (tid >> 6), nw = gridDim.x * 4;
  const bf* Vsrc = (j == 0) ? p.VF : p.V2;
  const int col = lane * 16, hh = lane >> 2;
  float lw[16], lb[16];
#pragma unroll
  for (int e = 0; e < 16; ++e) { lw[e] = p.rw_lnx_w[j * 1024 + col + e]; lb[e] = p.rw_lnx_b[j * 1024 + col + e]; }
  for (int row = gw; row < MT; row += nw) {
    const size_t off = (size_t)row * 1024 + col;
    u32x4 u0[2], u1[2], uv[2], ug[2];
#pragma unroll
    for (int q = 0; q < 2; ++q) {
      u0[q] = *(const u32x4*)(p.H + off + q * 8);
      u1[q] = *(const u32x4*)(p.Y1 + off + q * 8);
      uv[q] = *(const u32x4*)(Vsrc + off + q * 8);
      ug[q] = *(const u32x4*)(p.G + off + q * 8);
    }
    const float bsum = p.beta[(size_t)row * 16 + hh] + p.beta[(size_t)MT * 16 + (size_t)row * 16 + hh];
    float y[16], v[16], g[16];
    float s = 0.f;
#pragma unroll
    for (int e = 0; e < 8; ++e) {
      y[2 * e] = bflo(u0[e >> 2][e & 3]) + bflo(u1[e >> 2][e & 3]); y[2 * e + 1] = bfhi(u0[e >> 2][e & 3]) + bfhi(u1[e >> 2][e & 3]);
      v[2 * e] = bflo(uv[e >> 2][e & 3]); v[2 * e + 1] = bfhi(uv[e >> 2][e & 3]);
      g[2 * e] = bflo(ug[e >> 2][e & 3]); g[2 * e + 1] = bfhi(ug[e >> 2][e & 3]);
      s += y[2 * e] + y[2 * e + 1];
    }
    s = quad_sum(s);
    const float mean = s * (1.f / 64.f);
    float q2 = 0.f;
#pragma unroll
    for (int e = 0; e < 16; ++e) { const float dd = y[e] - mean; q2 += dd * dd; }
    q2 = quad_sum(q2);
    const float rstd = rsqrtf(q2 * (1.f / 64.f) + 64e-5f);
    unsigned o[8];
#pragma unroll
    for (int e = 0; e < 8; ++e) {
      const float r0 = ((y[2 * e] - mean) * rstd * lw[2 * e] + lb[2 * e] + bsum * v[2 * e]) * g[2 * e];
      const float r1 = ((y[2 * e + 1] - mean) * rstd * lw[2 * e + 1] + lb[2 * e + 1] + bsum * v[2 * e + 1]) * g[2 * e + 1];
      o[e] = pk2(r0, r1);
    }
    *(u32x4*)(p.H + off) = (u32x4){o[0], o[1], o[2], o[3]};
    *(u32x4*)(p.H + off + 8) = (u32x4){o[4], o[5], o[6], o[7]};
  }
}

__device__ void attn_phase(const Params& p, int j, bool ctx_out, char* smem) {
  const int tid = otid(), lane = tid & 63, cgp = tid >> 6, fr = lane & 15, fq = lane >> 4;
  char* Ks = smem;
  bf* Vs = (bf*)smem;
  float* rpbs = (float*)(smem + 36864);
  const bf* Q = p.R; const bf* Kb = p.K; const bf* Vt = p.V2; const bf* Gb = p.G;
  const int nitems = 16384 + (ctx_out ? 512 : 0);
  for (int item = blockIdx.x; item < nitems; item += gridDim.x) {
    int b, h, r = 0, qrow0; bool haswin;
    if (item < 16384) { h = item & 15; r = (item >> 4) & 127; b = item >> 11; haswin = true; qrow0 = b * SEQ + r * 64; }
    else { const int it = item - 16384; h = it & 15; const int qb = (it >> 4) & 3; b = it >> 6; haswin = false; qrow0 = NL + b * CTXL + qb * 64; }
    const int qtok = qrow0 + cgp * 16 + fr;
    bf16x8 qf[2];
#pragma unroll
    for (int ks = 0; ks < 2; ++ks) qf[ks] = *(const bf16x8*)(Q + (size_t)qtok * 1024 + h * 64 + ks * 32 + fq * 8);
    const int rs = min(max(r - 4, 0), 120);
    const int qcol = cgp * 16 + fr;
    const int wsq = min(max(qcol - 8, 0), 48);
    const int bs = min(max(16 * cgp - 8, 0), 32);
    lds_barrier();
    if (haswin) for (int idx = tid; idx < 465; idx += 256) rpbs[idx] = p.na_rpb[((size_t)j * 16 + h) * 465 + idx];
    f32x4 sw[8][2], sc[4][4];
    bf16x8 pw[8];
    float m1 = NEGV, l1 = 0.f;
#pragma unroll
    for (int i = 0; i < 8; ++i) pw[i] = (bf16x8){0, 0, 0, 0, 0, 0, 0, 0};
#pragma unroll
    for (int i = 0; i < 8; ++i)
#pragma unroll
      for (int k2 = 0; k2 < 2; ++k2) sw[i][k2] = (f32x4){NEGV, NEGV, NEGV, NEGV};
#pragma unroll
    for (int st = 0; st < 3; ++st) {
      if (st < 2 && !haswin) continue;
      lds_barrier();
      int tq = tid; asm volatile("" : "+v"(tq));
#pragma unroll
      for (int hf = 0; hf < 2; ++hf) {
        u32x4 u[4];
#pragma unroll
        for (int i = 0; i < 4; ++i) {
          const int q = tq + (hf * 4 + i) * 256, key = q >> 3, c = q & 7, tl = key >> 6;
          const int base = (st < 2) ? b * SEQ + (rs + st * 4 + tl) * 64 : NL + b * CTXL + tl * 64;
          u[i] = *(const u32x4*)(Kb + (size_t)(base + (key & 63)) * 1024 + h * 64 + c * 8);
        }
#pragma unroll
        for (int i = 0; i < 4; ++i) {
          const int q = tq + (hf * 4 + i) * 256, key = q >> 3, c = q & 7;
          *(u32x4*)(Ks + lds_off(key, c)) = u[i];
        }
        __builtin_amdgcn_sched_barrier(0);
      }
      lds_barrier();
      if (st < 2) {
#pragma unroll
        for (int tl = 0; tl < 4; ++tl) {
          const int i = st * 4 + tl;
          const int dr = rs + i - r + 7;
#pragma unroll
          for (int k2 = 0; k2 < 2; ++k2) {
            f32x4 acc = (f32x4){0.f, 0.f, 0.f, 0.f};
#pragma unroll
            for (int ks = 0; ks < 2; ++ks) {
              const bf16x8 kf = *(const bf16x8*)(Ks + lds_off(tl * 64 + bs + k2 * 16 + fr, ks * 4 + fq));
              acc = __builtin_amdgcn_mfma_f32_16x16x32_bf16(kf, qf[ks], acc, 0, 0, 0);
            }
#pragma unroll
            for (int e = 0; e < 4; ++e) {
              const int kc = bs + k2 * 16 + fq * 4 + e;
              const bool valid = (kc >= wsq) && (kc < wsq + 16);
              const int dc = min(max(kc - qcol, -15), 15) + 15;
              sw[i][k2][e] = valid ? acc[e] + rpbs[dr * 31 + dc] : NEGV;
            }
          }
          __builtin_amdgcn_sched_barrier(0);
        }
      } else {
#pragma unroll
        for (int tl = 0; tl < 4; ++tl)
#pragma unroll
          for (int k4 = 0; k4 < 4; ++k4) {
            f32x4 acc = (f32x4){0.f, 0.f, 0.f, 0.f};
#pragma unroll
            for (int ks = 0; ks < 2; ++ks) {
              const bf16x8 kf = *(const bf16x8*)(Ks + lds_off(tl * 64 + k4 * 16 + fr, ks * 4 + fq));
              acc = __builtin_amdgcn_mfma_f32_16x16x32_bf16(kf, qf[ks], acc, 0, 0, 0);
            }
            sc[tl][k4] = acc;
            if (k4 & 1) __builtin_amdgcn_sched_barrier(0);
          }
      }
      if (st == 1) {
#pragma unroll
        for (int i = 0; i < 8; ++i)
#pragma unroll
          for (int k2 = 0; k2 < 2; ++k2)
#pragma unroll
            for (int e = 0; e < 4; ++e) m1 = fmaxf(m1, sw[i][k2][e]);
        m1 = fmaxf(m1, __shfl_xor(m1, 16));
        m1 = fmaxf(m1, __shfl_xor(m1, 32));
#pragma unroll
        for (int i = 0; i < 8; ++i) {
          float e0[4], e1[4];
#pragma unroll
          for (int e = 0; e < 4; ++e) { e0[e] = __expf(sw[i][0][e] - m1); e1[e] = __expf(sw[i][1][e] - m1); l1 += e0[e] + e1[e]; }
          u32x4 u = (u32x4){pk2(e0[0], e0[1]), pk2(e0[2], e0[3]), pk2(e1[0], e1[1]), pk2(e1[2], e1[3])};
          pw[i] = __builtin_bit_cast(bf16x8, u);
        }
        l1 += __shfl_xor(l1, 16);
        l1 += __shfl_xor(l1, 32);
      }
    }
    float m2 = NEGV;
#pragma unroll
    for (int tl = 0; tl < 4; ++tl)
#pragma unroll
      for (int k4 = 0; k4 < 4; ++k4)
#pragma unroll
        for (int e = 0; e < 4; ++e) m2 = fmaxf(m2, sc[tl][k4][e]);
    m2 = fmaxf(m2, __shfl_xor(m2, 16));
    m2 = fmaxf(m2, __shfl_xor(m2, 32));
    const float mx = fmaxf(m1, m2);
    const float alpha1 = __expf(m1 - mx);
    float l2 = 0.f;
    bf16x8 pc[4][2];
#pragma unroll
    for (int tl = 0; tl < 4; ++tl)
#pragma unroll
      for (int g2 = 0; g2 < 2; ++g2) {
        float e0[4], e1[4];
#pragma unroll
        for (int e = 0; e < 4; ++e) { e0[e] = __expf(sc[tl][2 * g2][e] - mx); e1[e] = __expf(sc[tl][2 * g2 + 1][e] - mx); l2 += e0[e] + e1[e]; }
        u32x4 u = (u32x4){pk2(e0[0], e0[1]), pk2(e0[2], e0[3]), pk2(e1[0], e1[1]), pk2(e1[2], e1[3])};
        pc[tl][g2] = __builtin_bit_cast(bf16x8, u);
      }
    l2 += __shfl_xor(l2, 16);
    l2 += __shfl_xor(l2, 32);
    const float l = alpha1 * l1 + l2;
    f32x4 o[4];
#pragma unroll
    for (int dt = 0; dt < 4; ++dt) o[dt] = (f32x4){0.f, 0.f, 0.f, 0.f};
#pragma unroll
    for (int st = 0; st < 3; ++st) {
      if (st < 2 && !haswin) continue;
      lds_barrier();
      int tq = tid; asm volatile("" : "+v"(tq));
#pragma unroll
      for (int hf = 0; hf < 2; ++hf) {
        u32x4 u[4];
#pragma unroll
        for (int i = 0; i < 4; ++i) {
          const int q = tq + (hf * 4 + i) * 256, tl = q >> 9, dd = (q >> 3) & 63, c = q & 7;
          const int base = (st < 2) ? b * SEQ + (rs + st * 4 + tl) * 64 : NL + b * CTXL + tl * 64;
          u[i] = *(const u32x4*)(Vt + (size_t)(h * 64 + dd) * MT + base + c * 8);
        }
#pragma unroll
        for (int i = 0; i < 4; ++i) {
          const int q = tq + (hf * 4 + i) * 256, tl = q >> 9, dd = (q >> 3) & 63, c = q & 7;
          *(u32x4*)(Vs + tl * 4608 + dd * 72 + c * 8) = u[i];
        }
        __builtin_amdgcn_sched_barrier(0);
      }
      lds_barrier();
      if (st < 2) {
#pragma unroll
        for (int tl = 0; tl < 4; ++tl) {
          const int i = st * 4 + tl;
#pragma unroll
          for (int dt = 0; dt < 4; ++dt) {
            const bf* vp = Vs + tl * 4608 + (dt * 16 + fr) * 72 + bs + fq * 4;
            const u32x2 lo = *(const u32x2*)vp, hi = *(const u32x2*)(vp + 16);
            u32x4 u = (u32x4){lo.x, lo.y, hi.x, hi.y};
            o[dt] = __builtin_amdgcn_mfma_f32_16x16x32_bf16(__builtin_bit_cast(bf16x8, u), pw[i], o[dt], 0, 0, 0);
          }
          __builtin_amdgcn_sched_barrier(0);
        }
      } else {
#pragma unroll
        for (int tl = 0; tl < 4; ++tl)
#pragma unroll
          for (int g2 = 0; g2 < 2; ++g2)
#pragma unroll
            for (int dt = 0; dt < 4; ++dt) {
              const bf* vp = Vs + tl * 4608 + (dt * 16 + fr) * 72 + g2 * 32 + fq * 4;
              const u32x2 lo = *(const u32x2*)vp, hi = *(const u32x2*)(vp + 16);
              u32x4 u = (u32x4){lo.x, lo.y, hi.x, hi.y};
              o[dt] = __builtin_amdgcn_mfma_f32_16x16x32_bf16(__builtin_bit_cast(bf16x8, u), pc[tl][g2], o[dt], 0, 0, 0);
              if (dt == 3) __builtin_amdgcn_sched_barrier(0);
            }
      }
      if (st == 1) {
#pragma unroll
        for (int dt = 0; dt < 4; ++dt) o[dt] *= alpha1;
      }
    }
    const float inv = 1.f / l;
#pragma unroll
    for (int dt = 0; dt < 4; ++dt) {
      const size_t off = (size_t)qtok * 1024 + h * 64 + dt * 16 + fq * 4;
      const u32x2 ug = *(const u32x2*)(Gb + off);
      const float g0 = bflo(ug.x), g1 = bfhi(ug.x), g2 = bflo(ug.y), g3 = bfhi(ug.y);
      *(u32x2*)(p.H + off) = (u32x2){pk2(o[dt][0] * inv * siluf(g0), o[dt][1] * inv * siluf(g1)),
                                        pk2(o[dt][2] * inv * siluf(g2), o[dt][3] * inv * siluf(g3))};
    }
  }
}

#ifndef DUP_SCAN
#define DUP_SCAN 0
#endif
#ifndef DUP_ATTN
#define DUP_ATTN 0
#endif
#ifndef DUP_GEMM
#define DUP_GEMM 0
#endif
#ifndef MULTI_LAUNCH
#define MULTI_LAUNCH 0
#endif
__device__ __forceinline__ bool step_exists(int i, int s) {
  if (s == 2) return i == 2;
  if (s == 4) return (i & 1) == 0;
  return true;
}
__device__ __forceinline__ void run_step(const Params& p, int i, int s, char* smem) {
  asm volatile("" : "+s"(i));
  const int j = i >> 1;
  if (s == 0) { transpose_phase(p, i, smem); row_phase(p, i); }
  else if (s == 1) {
    if ((i & 1) == 0) {
      EpiRwkvProj ep{p.R, p.K, (j == 0) ? p.VF : p.V2, p.G, p.HID};
      gemm_phase<1>(p.H, 1024, p.Wp, 1024, 16, MT / 128, (j == 0) ? 34 : 35, p.rw_mu + (size_t)j * 6 * 1024, ep, smem);
    } else {
      EpiNaProj ep{p.R, p.K, p.V2, p.G, p.na_b_in + (size_t)j * 4096};
      gemm_phase<0>(p.H, 1024, p.Wp, 1024, 16, MT / 128, 32, nullptr, ep, smem);
    }
  } else if (s == 2) {
    EpiVres ev{p.V2, p.VF, p.rw_v0};
    gemm_phase<0>(p.HID + 256, HIDW, p.v2t, 64, 1, MT / 128, 8, nullptr, ev, smem);
  } else if (s == 3) {
    if ((i & 1) == 0) scan_phase(p, j, smem);
    else attn_phase(p, j, i != 3, smem);
  } else if (s == 4) {
    og_phase(p, j);
  } else {
    EpiOut eo{p.R};
    gemm_phase<0>(p.H, 1024, p.Wo, 1024, 16, (i == 3) ? NL / 128 : MT / 128, 8, nullptr, eo, smem);
  }
}

__global__ void __launch_bounds__(256, 2) fwd_megakernel(Params p0) {
  __shared__ __attribute__((aligned(16))) char smem[SMEM_BYTES];
  cg::grid_group grid = cg::this_grid();
  if (blockIdx.x == 0 && threadIdx.x == 0) *p0.gp = p0;
  pre_phase(p0, smem);
  grid.sync();
  const Params& p = *(const Params*)p0.gp;
#pragma unroll 1
  for (int i = 0; i < 4; ++i) {
#pragma unroll 1
    for (int s = 0; s < 6; ++s) {
      if (!step_exists(i, s)) continue;
      int reps = 1;
      if (DUP_SCAN && s == 3 && (i & 1) == 0) reps = 2;
      if (DUP_ATTN && s == 3 && (i & 1) == 1) reps = 2;
      if (DUP_GEMM && (s == 1 || s == 5)) reps = 2;
#pragma unroll 1
      for (int rep = 0; rep < reps; ++rep) {
        run_step(p, i, s, smem);
        grid.sync();
      }
    }
  }
  row_phase(p, 4);
}

#if MULTI_LAUNCH
template <int S> __global__ void __launch_bounds__(256, 2) step_kernel(Params p0, int i) {
  __shared__ __attribute__((aligned(16))) char smem[SMEM_BYTES];
  if (S == -1) { pre_phase(p0, smem); return; }
  if (S == 6) { row_phase(p0, 4); return; }
  run_step(p0, i, S, smem);
}
#endif

extern "C" void kernel_launch(void* const* d_in, const int* in_sizes, int n_in, void* d_out, int out_size, void* d_ws, size_t ws_size,
                              hipStream_t stream) {
  static int grid_blocks = 0;
  if (!grid_blocks) {
    int dev = 0, cus = 0, per_cu = 0;
    hipGetDevice(&dev);
    hipDeviceGetAttribute(&cus, hipDeviceAttributeMultiprocessorCount, dev);
    hipOccupancyMaxActiveBlocksPerMultiprocessor(&per_cu, fwd_megakernel, 256, 0);
    if (per_cu > 2) per_cu = 2;
    if (per_cu < 1) per_cu = 1;
    grid_blocks = cus * per_cu;
  }
  Params p{};
  const float** f = (const float**)&p;
  for (int i = 0; i < 29; ++i) f[i] = (const float*)d_in[i];
  p.out = (float*)d_out;
  char* w = (char*)d_ws;
  size_t off = 0;
  auto take = [&](size_t bytes) { char* r = w + off; off += (bytes + 255) & ~(size_t)255; return r; };
  p.gp = (Params*)take(sizeof(Params));
  p.mod = (float*)take((size_t)4 * 9 * 3072 * 4);
  p.ctxbuf = (float*)take((size_t)NC * 1024 * 4);
  p.beta = (float*)take((size_t)2 * MT * 16 * 4);
  p.Wp = (bf*)take((size_t)4480 * 1024 * 2);
  p.Wo = (bf*)take((size_t)1024 * 1024 * 2);
  p.w2t = (bf*)take((size_t)2 * 65536 * 2);
  p.a2t = (bf*)take((size_t)2 * 65536 * 2);
  p.v2t = (bf*)take((size_t)65536 * 2);
  const size_t big = (size_t)MT * 1024 * 2;
  p.H = (bf*)take(big); p.R = (bf*)take(big); p.K = (bf*)take(big); p.VF = (bf*)take(big);
  p.V2 = (bf*)take(big); p.G = (bf*)take(big); p.Y1 = (bf*)take(big);
  p.HID = (bf*)take((size_t)MT * HIDW * 2);
  if (off > ws_size) fprintf(stderr, "workspace too small: need %zu have %zu\n", off, ws_size);
#if MULTI_LAUNCH
  step_kernel<-1><<<grid_blocks, 256, 0, stream>>>(p, 0);
  for (int i = 0; i < 4; ++i) {
    step_kernel<0><<<grid_blocks, 256, 0, stream>>>(p, i);
    step_kernel<1><<<grid_blocks, 256, 0, stream>>>(p, i);
    if (i == 2) step_kernel<2><<<grid_blocks, 256, 0, stream>>>(p, i);
    step_kernel<3><<<grid_blocks, 256, 0, stream>>>(p, i);
    if ((i & 1) == 0) step_kernel<4><<<grid_blocks, 256, 0, stream>>>(p, i);
    step_kernel<5><<<grid_blocks, 256, 0, stream>>>(p, i);
  }
  step_kernel<6><<<grid_blocks, 256, 0, stream>>>(p, 0);
#else
  void* args[] = {&p};
  hipError_t e = hipLaunchCooperativeKernel((void*)fwd_megakernel, dim3(grid_blocks), dim3(256), args, 0, stream);
  if (e != hipSuccess) fprintf(stderr, "cooperative launch failed: %s (grid %d)\n", hipGetErrorString(e), grid_blocks);
#endif
}
```

```cpp
#include <hip/hip_runtime.h>
#include <hip/hip_cooperative_groups.h>
#include <cstdint>
#include <cstdio>
namespace cg = cooperative_groups;

typedef unsigned short bf;
typedef short bf16x8 __attribute__((ext_vector_type(8)));
typedef float f32x4 __attribute__((ext_vector_type(4)));
typedef unsigned u32x4 __attribute__((ext_vector_type(4)));
typedef unsigned u32x2 __attribute__((ext_vector_type(2)));

constexpr int DM = 1024, NB = 8, SEQ = 8192, NL = NB * SEQ, CTXL = 256, NC = NB * CTXL, MT = NL + NC;
constexpr int HIDW = 384;
constexpr int LDH = 1088, LDW = 1088;
constexpr int SMEM_BYTES = 65536;
#define NEGV (-1e30f)
#ifndef PROBE_GEMM
#define PROBE_GEMM 0
#endif

struct Params {
  const float *x, *c, *ctx, *c_ctx, *ada_w, *ada_b, *pre_g, *post_g, *rw_mu, *rw_w_rkvg, *rw_w0, *rw_w1, *rw_w2,
      *rw_a0, *rw_a1, *rw_a2, *rw_v0, *rw_v1, *rw_v2, *rw_k_k, *rw_k_a, *rw_r_k, *rw_lnx_w, *rw_lnx_b, *rw_w_out,
      *na_w_in, *na_b_in, *na_rpb, *na_w_out;
  float* out;
  float *mod, *ctxbuf, *beta;
  bf *Wp, *Wo, *w2t, *a2t, *v2t;
  bf *H, *R, *K, *VF, *V2, *G, *Y1, *HID;
  Params* gp;
  unsigned* bar;
};

__device__ __forceinline__ float bflo(unsigned w) { return __uint_as_float(w << 16); }
__device__ __forceinline__ float bfhi(unsigned w) { return __uint_as_float(w & 0xffff0000u); }
typedef __bf16 bf16x2_t __attribute__((ext_vector_type(2)));
__device__ __forceinline__ unsigned pk2(float lo, float hi) {
  bf16x2_t v = {(__bf16)lo, (__bf16)hi};
  return __builtin_bit_cast(unsigned, v);
}
__device__ __forceinline__ float siluf(float v) { return v / (1.f + __expf(-v)); }
__device__ __forceinline__ float sigmf(float v) { return 1.f / (1.f + __expf(-v)); }
__device__ __forceinline__ float quad_sum(float v) {
  int t = __builtin_amdgcn_update_dpp(0, __float_as_int(v), 0xB1, 0xF, 0xF, true);
  v += __int_as_float(t);
  t = __builtin_amdgcn_update_dpp(0, __float_as_int(v), 0x4E, 0xF, 0xF, true);
  v += __int_as_float(t);
  return v;
}
__device__ __forceinline__ float wave_sum(float v) {
#pragma unroll
  for (int o = 32; o >= 1; o >>= 1) v += __shfl_xor(v, o);
  return v;
}
__device__ __forceinline__ int otid() { int t = threadIdx.x; asm volatile("" : "+v"(t)); return t; }
__device__ __forceinline__ void lds_barrier() { asm volatile("s_waitcnt lgkmcnt(0)\n\ts_barrier" ::: "memory"); }
__device__ __forceinline__ int lds_off(int row, int c) { return row * 128 + ((c ^ ((row >> 1) & 7)) << 4); }
__device__ __forceinline__ unsigned lerp2(unsigned hm, unsigned h0, unsigned hp, float m0, float m1) {
  const float c0 = bflo(h0), c1 = bfhi(h0);
  const float x0 = 0.5f * (bflo(hm) + bflo(hp)) - c0;
  const float x1 = 0.5f * (bfhi(hm) + bfhi(hp)) - c1;
  return pk2(c0 + x0 * m0, c1 + x1 * m1);
}
__device__ __forceinline__ int mod_idx(int row) { return row < NL ? (row >> 13) : 8; }

__device__ void pre_phase(const Params& p, char* smem) {
  float* s = (float*)smem;
  float* red = s + 9 * 1024;
  const int tid = otid();
  for (int item = blockIdx.x; item < 4 * 48; item += gridDim.x) {
    const int i = item / 48, cb = item % 48;
    __syncthreads();
    for (int idx = tid; idx < 9 * 1024; idx += 256) {
      const int m = idx >> 10, k = idx & 1023;
      const float v = (m < 8) ? p.c[m * 1024 + k] : p.c_ctx[k];
      s[idx] = siluf(v);
    }
    __syncthreads();
    const int cc = tid & 63, kq = tid >> 6;
    float acc[9];
#pragma unroll
    for (int m = 0; m < 9; ++m) acc[m] = 0.f;
    const float* W = p.ada_w + (size_t)i * 1024 * 3072 + cb * 64 + cc;
    for (int k = kq * 256; k < kq * 256 + 256; ++k) {
      const float w = W[(size_t)k * 3072];
#pragma unroll
      for (int m = 0; m < 9; ++m) acc[m] += s[m * 1024 + k] * w;
    }
#pragma unroll
    for (int m = 0; m < 9; ++m) red[(kq * 9 + m) * 64 + cc] = acc[m];
    __syncthreads();
    for (int idx = tid; idx < 9 * 64; idx += 256) {
      const int m = idx >> 6, c2 = idx & 63;
      float v = red[(0 * 9 + m) * 64 + c2] + red[(1 * 9 + m) * 64 + c2] + red[(2 * 9 + m) * 64 + c2] + red[(3 * 9 + m) * 64 + c2];
      v += p.ada_b[i * 3072 + cb * 64 + c2];
      p.mod[(size_t)(i * 9 + m) * 3072 + cb * 64 + c2] = v;
    }
  }
}

struct TOp { const float* src; bf* dst; int K, N, Kp, Np, ldd; };
__device__ bool get_op(const Params& p, int i, int op, TOp& o) {
  const int j = i >> 1;
  if (i & 1) {
    if (op == 0) { o = {p.na_w_in + (size_t)j * 1024 * 4096, p.Wp, 1024, 4096, 1024, 4096, LDW}; return true; }
    if (op == 1) { o = {p.na_w_out + (size_t)j * 1024 * 1024, p.Wo, 1024, 1024, 1024, 1024, LDW}; return true; }
    return false;
  }
  if (op < 4) { o = {p.rw_w_rkvg + ((size_t)j * 4 + op) * 1024 * 1024, p.Wp + (size_t)op * 1024 * LDW, 1024, 1024, 1024, 1024, LDW}; return true; }
  if (op < 6) { const int d = op - 4; o = {p.rw_w1 + ((size_t)j * 2 + d) * 1024 * 64, p.Wp + (size_t)(4096 + d * 64) * LDW, 1024, 64, 1024, 64, LDW}; return true; }
  if (op < 8) { const int d = op - 6; o = {p.rw_a1 + ((size_t)j * 2 + d) * 1024 * 64, p.Wp + (size_t)(4224 + d * 64) * LDW, 1024, 64, 1024, 64, LDW}; return true; }
  if (op < 10) { const int d = op - 8; o = {p.rw_w2 + ((size_t)j * 2 + d) * 64 * 1024, p.w2t + (size_t)d * 65536, 64, 1024, 64, 1024, 64}; return true; }
  if (op < 12) { const int d = op - 10; o = {p.rw_a2 + ((size_t)j * 2 + d) * 64 * 1024, p.a2t + (size_t)d * 65536, 64, 1024, 64, 1024, 64}; return true; }
  if (op == 12) { o = {p.rw_w_out + (size_t)j * 1024 * 1024, p.Wo, 1024, 1024, 1024, 1024, LDW}; return true; }
  if (j == 1 && op == 13) { o = {p.rw_v1, p.Wp + (size_t)4352 * LDW, 1024, 32, 1024, 128, LDW}; return true; }
  if (j == 1 && op == 14) { o = {p.rw_v2, p.v2t, 32, 1024, 64, 1024, 64}; return true; }
  return false;
}

__device__ void transpose_phase(const Params& p, int i, char* smem) {
  float* t = (float*)smem;
  const int tid = otid();
  int base = 0;
  for (int op = 0;; ++op) {
    TOp o;
    if (!get_op(p, i, op, o)) break;
    const int tk = o.Kp / 64, tn = o.Np / 64, nt = tk * tn;
    int first = blockIdx.x - (base % (int)gridDim.x);
    if (first < 0) first += gridDim.x;
    for (int g = first; g < nt; g += gridDim.x) {
      const int kt = g / tn, ntile = g % tn;
      __syncthreads();
#pragma unroll
      for (int ps = 0; ps < 4; ++ps) {
        const int kr = ps * 16 + (tid >> 4), c4 = (tid & 15) * 4;
        const int k = kt * 64 + kr, n = ntile * 64 + c4;
        f32x4 v = (f32x4){0.f, 0.f, 0.f, 0.f};
        if (k < o.K && n < o.N) v = *(const f32x4*)(o.src + (size_t)k * o.N + n);
        t[kr * 65 + c4 + 0] = v.x; t[kr * 65 + c4 + 1] = v.y; t[kr * 65 + c4 + 2] = v.z; t[kr * 65 + c4 + 3] = v.w;
      }
      __syncthreads();
      const int n = tid >> 2, kc = (tid & 3) * 16;
      unsigned w[8];
#pragma unroll
      for (int e = 0; e < 8; ++e) w[e] = pk2(t[(kc + 2 * e) * 65 + n], t[(kc + 2 * e + 1) * 65 + n]);
      bf* d = o.dst + (size_t)(ntile * 64 + n) * o.ldd + kt * 64 + kc;
      *(u32x4*)d = (u32x4){w[0], w[1], w[2], w[3]};
      *(u32x4*)(d + 8) = (u32x4){w[4], w[5], w[6], w[7]};
    }
    base += nt;
  }
}

__device__ void row_phase(const Params& p, int i) {
  const int tid = otid(), lane = tid & 63;
  const int gw = blockIdx.x * 4 + (tid >> 6), nw = gridDim.x * 4;
  const int nrows = (i == 4) ? NL : MT;
  for (int row = gw; row < nrows; row += nw) {
    const int m = mod_idx(row);
    const float* xs;
    if (i <= 1) xs = (row < NL) ? p.x + (size_t)row * 1024 : p.ctx + (size_t)(row - NL) * 1024;
    else xs = (row < NL) ? p.out + (size_t)row * 1024 : p.ctxbuf + (size_t)(row - NL) * 1024;
    f32x4 xv[4];
#pragma unroll
    for (int q = 0; q < 4; ++q) xv[q] = *(const f32x4*)(xs + q * 256 + lane * 4);
    if (i > 0) {
      const bf* orow = p.R + (size_t)row * 1024;
      float ov[4][4];
      float ss = 0.f;
#pragma unroll
      for (int q = 0; q < 4; ++q) {
        const u32x2 u = *(const u32x2*)(orow + q * 256 + lane * 4);
        ov[q][0] = bflo(u.x); ov[q][1] = bfhi(u.x); ov[q][2] = bflo(u.y); ov[q][3] = bfhi(u.y);
        ss += ov[q][0] * ov[q][0] + ov[q][1] * ov[q][1] + ov[q][2] * ov[q][2] + ov[q][3] * ov[q][3];
      }
      ss = wave_sum(ss);
      const float rs = rsqrtf(ss * (1.f / 1024.f) + 1e-6f);
      const float* gate = p.mod + (size_t)((i - 1) * 9 + m) * 3072 + 2048;
      const float* pg = p.post_g + (i - 1) * 1024;
      float* xd = (row < NL) ? p.out + (size_t)row * 1024 : p.ctxbuf + (size_t)(row - NL) * 1024;
#pragma unroll
      for (int q = 0; q < 4; ++q) {
        const int col = q * 256 + lane * 4;
        const f32x4 gv = *(const f32x4*)(gate + col);
        const f32x4 pv = *(const f32x4*)(pg + col);
        xv[q].x += gv.x * ov[q][0] * rs * pv.x;
        xv[q].y += gv.y * ov[q][1] * rs * pv.y;
        xv[q].z += gv.z * ov[q][2] * rs * pv.z;
        xv[q].w += gv.w * ov[q][3] * rs * pv.w;
        *(f32x4*)(xd + col) = xv[q];
      }
    }
    if (i < 4) {
      float ss = 0.f;
#pragma unroll
      for (int q = 0; q < 4; ++q) ss += xv[q].x * xv[q].x + xv[q].y * xv[q].y + xv[q].z * xv[q].z + xv[q].w * xv[q].w;
      ss = wave_sum(ss);
      const float rs = rsqrtf(ss * (1.f / 1024.f) + 1e-6f);
      const float* md = p.mod + (size_t)(i * 9 + m) * 3072;
      const float* pg = p.pre_g + i * 1024;
      bf* hd = p.H + (size_t)row * LDH;
#pragma unroll
      for (int q = 0; q < 4; ++q) {
        const int col = q * 256 + lane * 4;
        const f32x4 sh = *(const f32x4*)(md + col);
        const f32x4 sc = *(const f32x4*)(md + 1024 + col);
        const f32x4 pv = *(const f32x4*)(pg + col);
        const float h0 = xv[q].x * rs * pv.x * (1.f + sc.x) + sh.x;
        const float h1 = xv[q].y * rs * pv.y * (1.f + sc.y) + sh.y;
        const float h2 = xv[q].z * rs * pv.z * (1.f + sc.z) + sh.z;
        const float h3 = xv[q].w * rs * pv.w * (1.f + sc.w) + sh.w;
        *(u32x2*)(hd + col) = (u32x2){pk2(h0, h1), pk2(h2, h3)};
      }
    }
  }
}

struct EpiRwkvProj {
  bf *R, *K, *V, *G, *HID;
  __device__ __forceinline__ void operator()(int nt, int tok, int col, f32x4 v) const {
    bf* dst;
    if (nt < 8) dst = R + (size_t)tok * 1024 + col;
    else if (nt < 16) dst = K + (size_t)tok * 1024 + (col - 1024);
    else if (nt < 24) dst = V + (size_t)tok * 1024 + (col - 2048);
    else if (nt < 32) {
      dst = G + (size_t)tok * 1024 + (col - 3072);
#pragma unroll
      for (int e = 0; e < 4; ++e) v[e] = siluf(v[e]);
    } else {
      dst = HID + (size_t)tok * HIDW + (col - 4096);
      if (nt == 32) {
#pragma unroll
        for (int e = 0; e < 4; ++e) v[e] = tanhf(v[e]);
      }
    }
    *(u32x2*)dst = (u32x2){pk2(v[0], v[1]), pk2(v[2], v[3])};
  }
};
struct EpiNaProj {
  bf *Q, *K, *Vt, *G; const float* bias;
  __device__ __forceinline__ void operator()(int nt, int tok, int col, f32x4 v) const {
    const f32x4 b = *(const f32x4*)(bias + col);
    v[0] += b.x; v[1] += b.y; v[2] += b.z; v[3] += b.w;
    if (nt >= 16 && nt < 24) {
      const int c = col - 2048;
#pragma unroll
      for (int e = 0; e < 4; ++e) Vt[(size_t)(c + e) * MT + tok] = (bf)(pk2(v[e], 0.f) & 0xffffu);
      return;
    }
    bf* dst;
    if (nt < 8) { dst = Q + (size_t)tok * 1024 + col; v[0] *= 0.125f; v[1] *= 0.125f; v[2] *= 0.125f; v[3] *= 0.125f; }
    else if (nt < 16) dst = K + (size_t)tok * 1024 + (col - 1024);
    else dst = G + (size_t)tok * 1024 + (col - 3072);
    *(u32x2*)dst = (u32x2){pk2(v[0], v[1]), pk2(v[2], v[3])};
  }
};
struct EpiOut {
  bf* O;
  __device__ __forceinline__ void operator()(int nt, int tok, int col, f32x4 v) const {
    *(u32x2*)(O + (size_t)tok * 1024 + col) = (u32x2){pk2(v[0], v[1]), pk2(v[2], v[3])};
  }
};
struct EpiVres {
  bf* V2; const bf* VF; const float* v0;
  __device__ __forceinline__ void operator()(int nt, int tok, int col, f32x4 z) const {
    const f32x4 b = *(const f32x4*)(v0 + col);
    const u32x2 uv = *(const u32x2*)(V2 + (size_t)tok * 1024 + col);
    const u32x2 uf = *(const u32x2*)(VF + (size_t)tok * 1024 + col);
    const float v[4] = {bflo(uv.x), bfhi(uv.x), bflo(uv.y), bfhi(uv.y)};
    const float f[4] = {bflo(uf.x), bfhi(uf.x), bflo(uf.y), bfhi(uf.y)};
    const float zz[4] = {z[0] + b.x, z[1] + b.y, z[2] + b.z, z[3] + b.w};
    float r[4];
#pragma unroll
    for (int e = 0; e < 4; ++e) r[e] = v[e] + (f[e] - v[e]) * sigmf(zz[e]);
    *(u32x2*)(V2 + (size_t)tok * 1024 + col) = (u32x2){pk2(r[0], r[1]), pk2(r[2], r[3])};
  }
};

template <int AMODE, class Epi>
__device__ void gemm_phase(const bf* __restrict__ A, int lda, const bf* __restrict__ Bt, int ldb, int nkt, int mtiles, int ntiles,
                           const float* __restrict__ mu, const Epi& epi, char* smem, bool fake = false) {
  const int tid = otid(), lane = tid & 63, wid = tid >> 6, wr = wid >> 1, wc = wid & 1, fr = lane & 15, fq = lane >> 4;
  const int rg = tid >> 3, cch = tid & 7;
  char* As = smem;
  char* Bs = smem + 32768;
  constexpr int GM = 6;
  const int xcd = blockIdx.x & 7, slot = blockIdx.x >> 3, nslots = gridDim.x >> 3;
  const int per_group = GM * ntiles;
  const int ngroups = (mtiles + GM - 1) / GM;
  const int my_groups = (ngroups - xcd + 7) >> 3;
  const int my_total = my_groups * per_group;
  for (int q = slot; q < my_total; q += nslots) {
    const int gi = q / per_group, e = q - gi * per_group;
    const int nt = e / GM, mt = (xcd + 8 * gi) * GM + (e - nt * GM);
    if (mt >= mtiles) continue;
    const int row0 = mt * 128, col0 = nt * 128;
    int lerp = 0; bool sstart = false, send = false;
    if (AMODE == 1) {
      lerp = (nt < 8) ? 0 : (nt < 16) ? 2 : (nt < 24) ? 3 : (nt < 32) ? 5 : (nt == 32) ? 1 : (nt == 33) ? 4 : 3;
      if (row0 < NL) { sstart = (row0 & (SEQ - 1)) == 0; send = ((row0 + 128) & (SEQ - 1)) == 0; }
      else { sstart = ((row0 - NL) & (CTXL - 1)) == 0; send = ((row0 + 128 - NL) & (CTXL - 1)) == 0; }
    }
    f32x4 acc[4][4];
#pragma unroll
    for (int m = 0; m < 4; ++m)
#pragma unroll
      for (int n = 0; n < 4; ++n) acc[m][n] = (f32x4){0.f, 0.f, 0.f, 0.f};
    u32x4 ra[6], rb[4];
    f32x4 muv[2];
    auto gload = [&](int kt) {
      const int kc = kt * 64 + cch * 8;
      if (AMODE == 0) {
#pragma unroll
        for (int i = 0; i < 4; ++i) ra[i] = *(const u32x4*)(A + (size_t)(row0 + rg * 4 + i) * lda + kc);
      } else {
#pragma unroll
        for (int i = 0; i < 6; ++i) {
          const int r = row0 + rg * 4 + i - 1;
          const bool zero = (i == 0 && rg == 0 && sstart) || (i == 5 && rg == 31 && send);
          ra[i] = zero ? (u32x4){0, 0, 0, 0} : *(const u32x4*)(A + (size_t)r * lda + kc);
        }
        muv[0] = *(const f32x4*)(mu + lerp * 1024 + kc);
        muv[1] = *(const f32x4*)(mu + lerp * 1024 + kc + 4);
      }
#pragma unroll
      for (int i = 0; i < 4; ++i) rb[i] = *(const u32x4*)(Bt + (size_t)(col0 + rg * 4 + i) * ldb + kc);
    };
    auto lstore = [&](int buf) {
      char* a = As + buf * 16384;
      char* b = Bs + buf * 16384;
      if (AMODE == 0) {
#pragma unroll
        for (int i = 0; i < 4; ++i) *(u32x4*)(a + lds_off(rg * 4 + i, cch)) = ra[i];
      } else {
#pragma unroll
        for (int i = 0; i < 4; ++i) {
          const u32x4 hm = ra[i], h0 = ra[i + 1], hp = ra[i + 2];
          u32x4 o;
          o.x = lerp2(hm.x, h0.x, hp.x, muv[0].x, muv[0].y);
          o.y = lerp2(hm.y, h0.y, hp.y, muv[0].z, muv[0].w);
          o.z = lerp2(hm.z, h0.z, hp.z, muv[1].x, muv[1].y);
          o.w = lerp2(hm.w, h0.w, hp.w, muv[1].z, muv[1].w);
          *(u32x4*)(a + lds_off(rg * 4 + i, cch)) = o;
        }
      }
#pragma unroll
      for (int i = 0; i < 4; ++i) *(u32x4*)(b + lds_off(rg * 4 + i, cch)) = rb[i];
    };
    lds_barrier();
    gload(0);
    lstore(0);
    lds_barrier();
    for (int kt = 0; kt < nkt; ++kt) {
      const int buf = kt & 1;
      if (!fake && kt + 1 < nkt) gload(kt + 1);
      const char* a = As + buf * 16384;
      const char* b = Bs + buf * 16384;
#pragma unroll
      for (int ks = 0; ks < 2; ++ks) {
        bf16x8 af[4], bfr[4];
#pragma unroll
        for (int m = 0; m < 4; ++m) af[m] = *(const bf16x8*)(a + lds_off(wr * 64 + m * 16 + fr, ks * 4 + fq));
#pragma unroll
        for (int n = 0; n < 4; ++n) bfr[n] = *(const bf16x8*)(b + lds_off(wc * 64 + n * 16 + fr, ks * 4 + fq));
#pragma unroll
        for (int m = 0; m < 4; ++m)
#pragma unroll
          for (int n = 0; n < 4; ++n) acc[m][n] = __builtin_amdgcn_mfma_f32_16x16x32_bf16(bfr[n], af[m], acc[m][n], 0, 0, 0);
      }
      if (kt + 1 < nkt) lstore(buf ^ 1);
      lds_barrier();
    }
#pragma unroll
    for (int m = 0; m < 4; ++m)
#pragma unroll
      for (int n = 0; n < 4; ++n) epi(nt, row0 + wr * 64 + m * 16 + fr, col0 + wc * 64 + n * 16 + fq * 4, acc[m][n]);
  }
}

typedef float f32x2 __attribute__((ext_vector_type(2)));
__device__ __forceinline__ float oct_sum(float v) {
  int t = __builtin_amdgcn_update_dpp(0, __float_as_int(v), 0xB1, 0xF, 0xF, true);
  v += __int_as_float(t);
  t = __builtin_amdgcn_update_dpp(0, __float_as_int(v), 0x4E, 0xF, 0xF, true);
  v += __int_as_float(t);
  t = __builtin_amdgcn_update_dpp(0, __float_as_int(v), 0x141, 0xF, 0xF, true);
  v += __int_as_float(t);
  return v;
}
__device__ __forceinline__ f32x2 fma2(f32x2 a, f32x2 b, f32x2 c) { return __builtin_elementwise_fma(a, b, c); }
__device__ __forceinline__ float fma_s(float a, float b, float c) { float d; asm("v_fma_f32 %0, %1, %2, %3" : "=v"(d) : "v"(a), "v"(b), "v"(c)); return d; }
__device__ __forceinline__ float mul_s(float a, float b) { float d; asm("v_mul_f32 %0, %1, %2" : "=v"(d) : "v"(a), "v"(b)); return d; }
struct ScanOps { f32x4 w[2], nk[2], bb[2], kd[2], rr[2]; f32x2 vv; };
__device__ __forceinline__ ScanOps scan_load(const float* ops, const float* vs, int t, int kq, int vrow) {
  ScanOps r;
  const float* o = ops + t * 320 + kq * 8;
  r.w[0] = *(const f32x4*)(o); r.w[1] = *(const f32x4*)(o + 4);
  r.nk[0] = *(const f32x4*)(o + 64); r.nk[1] = *(const f32x4*)(o + 68);
  r.bb[0] = *(const f32x4*)(o + 128); r.bb[1] = *(const f32x4*)(o + 132);
  r.kd[0] = *(const f32x4*)(o + 192); r.kd[1] = *(const f32x4*)(o + 196);
  r.rr[0] = *(const f32x4*)(o + 256); r.rr[1] = *(const f32x4*)(o + 260);
  r.vv = *(const f32x2*)(vs + t * 64 + vrow);
  return r;
}
#define PR(v, i) ((f32x2){(v)[(i) >> 1][((i) & 1) * 2], (v)[(i) >> 1][((i) & 1) * 2 + 1]})

constexpr int SC_P = 0, SC_YA = 8192, SC_V = 16384, SC_AT = 24576, SC_RT = SC_AT + 4352, SC_BT = SC_RT + 4352, SC_KT = SC_BT + 4352;
constexpr int SC_BTT = 41984, SC_KTT = SC_BTT + 4608, SC_MABT = 51200, SC_SM = 53248;
__device__ __forceinline__ bf16x8 mk8(u32x2 lo, u32x2 hi) { u32x4 u = (u32x4){lo.x, lo.y, hi.x, hi.y}; return __builtin_bit_cast(bf16x8, u); }
__device__ __forceinline__ bf16x8 mk4(u32x2 lo) { u32x4 u = (u32x4){lo.x, lo.y, 0u, 0u}; return __builtin_bit_cast(bf16x8, u); }
__device__ __forceinline__ float bfround(float x) { return bflo(pk2(x, 0.f) & 0xffffu); }
__device__ __forceinline__ void split4(f32x4 x, u32x2& hi, u32x2& lo) {
  hi = (u32x2){pk2(x[0], x[1]), pk2(x[2], x[3])};
  const float r0 = x[0] - bflo(hi.x), r1 = x[1] - bfhi(hi.x), r2 = x[2] - bflo(hi.y), r3 = x[3] - bfhi(hi.y);
  lo = (u32x2){pk2(r0, r1), pk2(r2, r3)};
}

__device__ void scan_phase(const Params& p, int j, char* smem) {
  const int tid = otid(), lane = tid & 63, wid = tid >> 6, fr = lane & 15, fq = lane >> 4;
  float* Pbuf = (float*)(smem + SC_P);
  float* abuf = (float*)(smem + SC_YA);
  float* ys = (float*)(smem + SC_YA);
  float* vs = (float*)(smem + SC_V);
  for (int item = blockIdx.x; item < 256; item += gridDim.x) {
  const int b = item >> 5, h = (item >> 1) & 15, d = item & 1;
  lds_barrier();
  const bf* Vsrc = (j == 0) ? p.VF : p.V2;
  bf* Ydst = (d == 0) ? p.H : p.Y1;
  const int ldy = (d == 0) ? LDH : 1024;
  float* betad = p.beta + (size_t)d * MT * 16;
  bf16x8 bw[2], ba[2];
  {
    const int n = h * 64 + wid * 16 + fr;
#pragma unroll
    for (int ks = 0; ks < 2; ++ks) {
      bw[ks] = *(const bf16x8*)(p.w2t + (size_t)d * 65536 + (size_t)n * 64 + ks * 32 + fq * 8);
      ba[ks] = *(const bf16x8*)(p.a2t + (size_t)d * 65536 + (size_t)n * 64 + ks * 32 + fq * 8);
    }
  }
  float w0v[4], a0v[4];
#pragma unroll
  for (int e = 0; e < 4; ++e) {
    w0v[e] = p.rw_w0[(size_t)(j * 2 + d) * 1024 + h * 64 + wid * 16 + fq * 4 + e];
    a0v[e] = p.rw_a0[(size_t)(j * 2 + d) * 1024 + h * 64 + wid * 16 + fq * 4 + e];
  }
  const int tt = tid >> 3, c8 = tid & 7;
  float kkv[8], kav[8], rkv[8];
#pragma unroll
  for (int e = 0; e < 8; ++e) {
    kkv[e] = p.rw_k_k[j * 1024 + h * 64 + c8 * 8 + e];
    kav[e] = p.rw_k_a[j * 1024 + h * 64 + c8 * 8 + e];
    rkv[e] = p.rw_r_k[j * 1024 + h * 64 + c8 * 8 + e];
  }
  f32x4 ST[4];
#pragma unroll
  for (int kt = 0; kt < 4; ++kt) ST[kt] = (f32x4){0.f, 0.f, 0.f, 0.f};

  bf16x8 phw[2][2], pha[2][2];
  u32x4 puk, pur, puv;
  auto rowbase_of = [&](int ch, int& sgn) -> int {
    if (d == 0) { sgn = 1; return (ch < 8) ? NL + b * CTXL + ch * 32 : b * SEQ + (ch - 8) * 32; }
    sgn = -1; return (ch < 8) ? NL + b * CTXL + 255 - ch * 32 : b * SEQ + 8191 - (ch - 8) * 32;
  };
  auto prefetch = [&](int ch) {
    int sgn; const int rowbase = rowbase_of(ch, sgn);
#pragma unroll
    for (int m = 0; m < 2; ++m) {
      const size_t row = (size_t)(rowbase + sgn * (m * 16 + fr));
#pragma unroll
      for (int ks = 0; ks < 2; ++ks) {
        phw[m][ks] = *(const bf16x8*)(p.HID + row * HIDW + d * 64 + ks * 32 + fq * 8);
        pha[m][ks] = *(const bf16x8*)(p.HID + row * HIDW + 128 + d * 64 + ks * 32 + fq * 8);
      }
    }
    const size_t off = (size_t)(rowbase + sgn * tt) * 1024 + h * 64 + c8 * 8;
    puk = *(const u32x4*)(p.K + off);
    pur = *(const u32x4*)(p.R + off);
    puv = *(const u32x4*)(Vsrc + off);
  };
  prefetch(0);

  for (int ch = 0; ch < 264; ++ch) {
    int sgn; const int rowbase = rowbase_of(ch, sgn);
#pragma unroll
    for (int m = 0; m < 2; ++m) {
      const int tok = m * 16 + fr;
      f32x4 aw = (f32x4){0.f, 0.f, 0.f, 0.f}, aa = aw;
#pragma unroll
      for (int ks = 0; ks < 2; ++ks) {
        aw = __builtin_amdgcn_mfma_f32_16x16x32_bf16(bw[ks], phw[m][ks], aw, 0, 0, 0);
        aa = __builtin_amdgcn_mfma_f32_16x16x32_bf16(ba[ks], pha[m][ks], aa, 0, 0, 0);
      }
      f32x4 wd, av;
#pragma unroll
      for (int e = 0; e < 4; ++e) {
        const float z = -(w0v[e] + aw[e]);
        const float sp = fmaxf(z, 0.f) + __logf(1.f + __expf(-fabsf(z)));
        const float wl = -sp - 0.5f;
        wd[e] = __expf(-__expf(wl));
        av[e] = sigmf(a0v[e] + aa[e]);
      }
      *(f32x4*)(Pbuf + tok * 64 + wid * 16 + fq * 4) = wd;
      *(f32x4*)(abuf + tok * 64 + wid * 16 + fq * 4) = av;
    }
    lds_barrier();
    if (tid < 128) {
      const int k = tid & 63, sc = tid >> 6;
      float P = 1.f;
#pragma unroll
      for (int t = 0; t < 16; ++t) { float* q = Pbuf + (sc * 16 + t) * 64 + k; P *= *q; *q = P; }
    }
    lds_barrier();
    {
      const size_t row = (size_t)(rowbase + sgn * tt);
      float k[8], r[8], kk[8];
#pragma unroll
      for (int e = 0; e < 4; ++e) {
        k[2 * e] = bflo(puk[e]); k[2 * e + 1] = bfhi(puk[e]);
        r[2 * e] = bflo(pur[e]); r[2 * e + 1] = bfhi(pur[e]);
      }
      float ss = 0.f;
#pragma unroll
      for (int e = 0; e < 8; ++e) { kk[e] = k[e] * kkv[e]; ss += kk[e] * kk[e]; }
      ss = oct_sum(ss);
      const float inv = 1.f / fmaxf(sqrtf(ss), 1e-12f);
      const f32x4 a0 = *(const f32x4*)(abuf + tt * 64 + c8 * 8), a1 = *(const f32x4*)(abuf + tt * 64 + c8 * 8 + 4);
      const f32x4 p0 = *(const f32x4*)(Pbuf + tt * 64 + c8 * 8), p1 = *(const f32x4*)(Pbuf + tt * 64 + c8 * 8 + 4);
      f32x4 q0 = (f32x4){1.f, 1.f, 1.f, 1.f}, q1 = q0;
      if (tt & 15) { q0 = *(const f32x4*)(Pbuf + (tt - 1) * 64 + c8 * 8); q1 = *(const f32x4*)(Pbuf + (tt - 1) * 64 + c8 * 8 + 4); }
      const float a[8] = {a0.x, a0.y, a0.z, a0.w, a1.x, a1.y, a1.z, a1.w};
      const float Pt[8] = {p0.x, p0.y, p0.z, p0.w, p1.x, p1.y, p1.z, p1.w};
      const float Pm[8] = {q0.x, q0.y, q0.z, q0.w, q1.x, q1.y, q1.z, q1.w};
      float at[8], bt_[8], kt_[8], rt[8];
      float bsum = 0.f;
#pragma unroll
      for (int e = 0; e < 8; ++e) {
        const float kkn = kk[e] * inv;
        const float kd = k[e] * (1.f + (a[e] - 1.f) * kav[e]);
        bsum += r[e] * kd * rkv[e];
        const float ip = 1.f / Pt[e];
        at[e] = -kkn * Pm[e];
        bt_[e] = kkn * a[e] * ip;
        kt_[e] = kd * ip;
        rt[e] = r[e] * Pt[e];
      }
      bsum = oct_sum(bsum);
      if (c8 == 0) betad[row * 16 + h] = bsum;
      char* ro = smem + tt * 136 + c8 * 16;
      *(u32x2*)(ro + SC_AT) = (u32x2){pk2(at[0], at[1]), pk2(at[2], at[3])};   *(u32x2*)(ro + SC_AT + 8) = (u32x2){pk2(at[4], at[5]), pk2(at[6], at[7])};
      *(u32x2*)(ro + SC_RT) = (u32x2){pk2(rt[0], rt[1]), pk2(rt[2], rt[3])};   *(u32x2*)(ro + SC_RT + 8) = (u32x2){pk2(rt[4], rt[5]), pk2(rt[6], rt[7])};
      *(u32x2*)(ro + SC_BT) = (u32x2){pk2(bt_[0], bt_[1]), pk2(bt_[2], bt_[3])}; *(u32x2*)(ro + SC_BT + 8) = (u32x2){pk2(bt_[4], bt_[5]), pk2(bt_[6], bt_[7])};
      *(u32x2*)(ro + SC_KT) = (u32x2){pk2(kt_[0], kt_[1]), pk2(kt_[2], kt_[3])}; *(u32x2*)(ro + SC_KT + 8) = (u32x2){pk2(kt_[4], kt_[5]), pk2(kt_[6], kt_[7])};
#pragma unroll
      for (int e = 0; e < 8; ++e) {
        *(bf*)(smem + SC_BTT + (c8 * 8 + e) * 72 + tt * 2) = (bf)(pk2(bt_[e], 0.f) & 0xffffu);
        *(bf*)(smem + SC_KTT + (c8 * 8 + e) * 72 + tt * 2) = (bf)(pk2(kt_[e], 0.f) & 0xffffu);
      }
      *(f32x4*)(vs + tt * 64 + c8 * 8) = (f32x4){bflo(puv[0]), bfhi(puv[0]), bflo(puv[1]), bfhi(puv[1])};
      *(f32x4*)(vs + tt * 64 + c8 * 8 + 4) = (f32x4){bflo(puv[2]), bfhi(puv[2]), bflo(puv[3]), bfhi(puv[3])};
    }
    lds_barrier();
    if (ch + 1 < 264) prefetch(ch + 1);
    {
      auto gram = [&](int xbase, int ybase, int sc) -> f32x4 {
        f32x4 acc = (f32x4){0.f, 0.f, 0.f, 0.f};
#pragma unroll
        for (int ks = 0; ks < 2; ++ks) {
          const char* xp = smem + xbase + (sc * 16 + fr) * 136 + ks * 64 + fq * 16;
          const char* yp = smem + ybase + (sc * 16 + fr) * 136 + ks * 64 + fq * 16;
          const bf16x8 xf = mk8(*(const u32x2*)xp, *(const u32x2*)(xp + 8));
          const bf16x8 yf = mk8(*(const u32x2*)yp, *(const u32x2*)(yp + 8));
          acc = __builtin_amdgcn_mfma_f32_16x16x32_bf16(xf, yf, acc, 0, 0, 0);
        }
        return acc;
      };
      auto store_small = [&](f32x4 g, int sc, int kind, bool strict) {
#pragma unroll
        for (int e = 0; e < 4; ++e) { const int sidx = fq * 4 + e; const bool keep = strict ? (sidx < fr) : (sidx <= fr); g[e] = keep ? g[e] : 0.f; }
        *(u32x2*)(smem + SC_SM + (sc * 5 + kind) * 640 + fr * 40 + fq * 8) = (u32x2){pk2(g[0], g[1]), pk2(g[2], g[3])};
      };
      if (wid < 2) {
        const int sc = wid;
        f32x4 g = gram(SC_BT, SC_AT, sc);
#pragma unroll
        for (int e = 0; e < 4; ++e) g[e] = (fq * 4 + e < fr) ? g[e] : 0.f;
        *(f32x4*)(smem + SC_MABT + sc * 1024 + fr * 64 + fq * 16) = g;
        asm volatile("s_waitcnt lgkmcnt(0)" ::: "memory");
        if (lane < 16) {
          float n[16];
#pragma unroll
          for (int t = 0; t < 16; ++t) {
            const float* mc = (const float*)(smem + SC_MABT + sc * 1024 + t * 64);
            float acc = (t == lane) ? 1.f : 0.f;
#pragma unroll
            for (int sp = 0; sp < t; ++sp) acc = fmaf(n[sp], mc[sp], acc);
            n[t] = acc;
          }
#pragma unroll
          for (int t = 0; t < 16; ++t) {
            const unsigned hi = pk2(n[t], 0.f) & 0xffffu;
            const unsigned lo = pk2(n[t] - bflo(hi), 0.f) & 0xffffu;
            *(bf*)(smem + SC_SM + (sc * 5 + 0) * 640 + t * 40 + lane * 2) = (bf)hi;
            *(bf*)(smem + SC_SM + (sc * 5 + 1) * 640 + t * 40 + lane * 2) = (bf)lo;
          }
        }
      } else {
        const int sc = wid - 2;
        store_small(gram(SC_KT, SC_AT, sc), sc, 2, true);
        store_small(gram(SC_BT, SC_RT, sc), sc, 3, false);
        store_small(gram(SC_KT, SC_RT, sc), sc, 4, false);
      }
    }
    lds_barrier();
#pragma unroll
    for (int sc = 0; sc < 2; ++sc) {
      bf16x8 shi[2], slo[2];
#pragma unroll
      for (int g = 0; g < 2; ++g) {
        u32x2 h0, l0, h1, l1;
        split4(ST[2 * g], h0, l0); split4(ST[2 * g + 1], h1, l1);
        shi[g] = mk8(h0, h1); slo[g] = mk8(l0, l1);
      }
      const char* arow = smem + SC_AT + (sc * 16 + fr) * 136 + fq * 8;
      const char* rrow = smem + SC_RT + (sc * 16 + fr) * 136 + fq * 8;
      f32x4 wt = (f32x4){0.f, 0.f, 0.f, 0.f}, yt = wt;
#pragma unroll
      for (int g = 0; g < 2; ++g) {
        const bf16x8 xa = mk8(*(const u32x2*)(arow + g * 64), *(const u32x2*)(arow + g * 64 + 32));
        const bf16x8 xr = mk8(*(const u32x2*)(rrow + g * 64), *(const u32x2*)(rrow + g * 64 + 32));
        wt = __builtin_amdgcn_mfma_f32_16x16x32_bf16(xa, shi[g], wt, 0, 0, 0);
        wt = __builtin_amdgcn_mfma_f32_16x16x32_bf16(xa, slo[g], wt, 0, 0, 0);
        yt = __builtin_amdgcn_mfma_f32_16x16x32_bf16(xr, shi[g], yt, 0, 0, 0);
        yt = __builtin_amdgcn_mfma_f32_16x16x32_bf16(xr, slo[g], yt, 0, 0, 0);
      }
      const int vcol = wid * 16 + fr;
      const float* vp = vs + (sc * 16 + fq * 4) * 64 + vcol;
      const bf16x8 vmf = mk4((u32x2){pk2(vp[0], vp[64]), pk2(vp[128], vp[192])});
      const char* smb = smem + SC_SM + sc * 5 * 640 + fr * 40 + fq * 8;
      const bf16x8 xnh = mk4(*(const u32x2*)(smb)), xnl = mk4(*(const u32x2*)(smb + 640));
      const bf16x8 xmak = mk4(*(const u32x2*)(smb + 2 * 640)), xmrb = mk4(*(const u32x2*)(smb + 3 * 640)), xmrk = mk4(*(const u32x2*)(smb + 4 * 640));
      wt = __builtin_amdgcn_mfma_f32_16x16x32_bf16(xmak, vmf, wt, 0, 0, 0);
      u32x2 whi, wlo;
      split4(wt, whi, wlo);
      f32x4 ut = (f32x4){0.f, 0.f, 0.f, 0.f};
      ut = __builtin_amdgcn_mfma_f32_16x16x32_bf16(xnh, mk4(whi), ut, 0, 0, 0);
      ut = __builtin_amdgcn_mfma_f32_16x16x32_bf16(xnh, mk4(wlo), ut, 0, 0, 0);
      ut = __builtin_amdgcn_mfma_f32_16x16x32_bf16(xnl, mk4(whi), ut, 0, 0, 0);
      u32x2 uhi, ulo;
      split4(ut, uhi, ulo);
      const bf16x8 uhf = mk4(uhi), ulf = mk4(ulo);
      yt = __builtin_amdgcn_mfma_f32_16x16x32_bf16(xmrb, uhf, yt, 0, 0, 0);
      yt = __builtin_amdgcn_mfma_f32_16x16x32_bf16(xmrb, ulf, yt, 0, 0, 0);
      yt = __builtin_amdgcn_mfma_f32_16x16x32_bf16(xmrk, vmf, yt, 0, 0, 0);
#pragma unroll
      for (int e = 0; e < 4; ++e) ys[(sc * 16 + fq * 4 + e) * 64 + vcol] = yt[e];
#pragma unroll
      for (int kt = 0; kt < 4; ++kt) {
        const bf16x8 xb = mk4(*(const u32x2*)(smem + SC_BTT + (kt * 16 + fr) * 72 + (sc * 16 + fq * 4) * 2));
        const bf16x8 xk = mk4(*(const u32x2*)(smem + SC_KTT + (kt * 16 + fr) * 72 + (sc * 16 + fq * 4) * 2));
        ST[kt] = __builtin_amdgcn_mfma_f32_16x16x32_bf16(xb, uhf, ST[kt], 0, 0, 0);
        ST[kt] = __builtin_amdgcn_mfma_f32_16x16x32_bf16(xb, ulf, ST[kt], 0, 0, 0);
        ST[kt] = __builtin_amdgcn_mfma_f32_16x16x32_bf16(xk, vmf, ST[kt], 0, 0, 0);
        const f32x4 pc = *(const f32x4*)(Pbuf + (sc * 16 + 15) * 64 + kt * 16 + fq * 4);
        ST[kt] = ST[kt] * pc;
      }
    }
    lds_barrier();
    {
      const size_t row = (size_t)(rowbase + sgn * tt);
      const f32x4 y0 = *(const f32x4*)(ys + tt * 64 + c8 * 8), y1 = *(const f32x4*)(ys + tt * 64 + c8 * 8 + 4);
      *(u32x4*)(Ydst + row * ldy + h * 64 + c8 * 8) = (u32x4){pk2(y0.x, y0.y), pk2(y0.z, y0.w), pk2(y1.x, y1.y), pk2(y1.z, y1.w)};
    }
    lds_barrier();
  }
  }
}

__device__ void og_phase(const Params& p, int j) {
  const int tid = otid(), lane = tid & 63;
  const int gw = blockIdx.x * 4 + (tid >> 6), nw = gridDim.x * 4;
  const bf* Vsrc = (j == 0) ? p.VF : p.V2;
  const int col = lane * 16, hh = lane >> 2;
  float lw[16], lb[16];
#pragma unroll
  for (int e = 0; e < 16; ++e) { lw[e] = p.rw_lnx_w[j * 1024 + col + e]; lb[e] = p.rw_lnx_b[j * 1024 + col + e]; }
  for (int row = gw; row < MT; row += nw) {
    const size_t off = (size_t)row * 1024 + col, offh = (size_t)row * LDH + col;
    u32x4 u0[2], u1[2], uv[2], ug[2];
#pragma unroll
    for (int q = 0; q < 2; ++q) {
      u0[q] = *(const u32x4*)(p.H + offh + q * 8);
      u1[q] = *(const u32x4*)(p.Y1 + off + q * 8);
      uv[q] = *(const u32x4*)(Vsrc + off + q * 8);
      ug[q] = *(const u32x4*)(p.G + off + q * 8);
    }
    const float bsum = p.beta[(size_t)row * 16 + hh] + p.beta[(size_t)MT * 16 + (size_t)row * 16 + hh];
    float y[16], v[16], g[16];
    float s = 0.f;
#pragma unroll
    for (int e = 0; e < 8; ++e) {
      y[2 * e] = bflo(u0[e >> 2][e & 3]) + bflo(u1[e >> 2][e & 3]); y[2 * e + 1] = bfhi(u0[e >> 2][e & 3]) + bfhi(u1[e >> 2][e & 3]);
      v[2 * e] = bflo(uv[e >> 2][e & 3]); v[2 * e + 1] = bfhi(uv[e >> 2][e & 3]);
      g[2 * e] = bflo(ug[e >> 2][e & 3]); g[2 * e + 1] = bfhi(ug[e >> 2][e & 3]);
      s += y[2 * e] + y[2 * e + 1];
    }
    s = quad_sum(s);
    const float mean = s * (1.f / 64.f);
    float q2 = 0.f;
#pragma unroll
    for (int e = 0; e < 16; ++e) { const float dd = y[e] - mean; q2 += dd * dd; }
    q2 = quad_sum(q2);
    const float rstd = rsqrtf(q2 * (1.f / 64.f) + 64e-5f);
    unsigned o[8];
#pragma unroll
    for (int e = 0; e < 8; ++e) {
      const float r0 = ((y[2 * e] - mean) * rstd * lw[2 * e] + lb[2 * e] + bsum * v[2 * e]) * g[2 * e];
      const float r1 = ((y[2 * e + 1] - mean) * rstd * lw[2 * e + 1] + lb[2 * e + 1] + bsum * v[2 * e + 1]) * g[2 * e + 1];
      o[e] = pk2(r0, r1);
    }
    *(u32x4*)(p.H + offh) = (u32x4){o[0], o[1], o[2], o[3]};
    *(u32x4*)(p.H + offh + 8) = (u32x4){o[4], o[5], o[6], o[7]};
  }
}

__device__ void attn_phase(const Params& p, int j, bool ctx_out, char* smem) {
  const int tid = otid(), lane = tid & 63, cgp = tid >> 6, fr = lane & 15, fq = lane >> 4;
  char* Ks = smem;
  bf* Vs = (bf*)smem;
  float* rpbs = (float*)(smem + 36864);
  const bf* Q = p.R; const bf* Kb = p.K; const bf* Vt = p.V2; const bf* Gb = p.G;
  const int nitems = 16384 + (ctx_out ? 512 : 0);
  for (int item = blockIdx.x; item < nitems; item += gridDim.x) {
    int b, h, r = 0, qrow0; bool haswin;
    if (item < 16384) { h = item & 15; r = (item >> 4) & 127; b = item >> 11; haswin = true; qrow0 = b * SEQ + r * 64; }
    else { const int it = item - 16384; h = it & 15; const int qb = (it >> 4) & 3; b = it >> 6; haswin = false; qrow0 = NL + b * CTXL + qb * 64; }
    const int qtok = qrow0 + cgp * 16 + fr;
    bf16x8 qf[2];
#pragma unroll
    for (int ks = 0; ks < 2; ++ks) qf[ks] = *(const bf16x8*)(Q + (size_t)qtok * 1024 + h * 64 + ks * 32 + fq * 8);
    const int rs = min(max(r - 4, 0), 120);
    const int qcol = cgp * 16 + fr;
    const int wsq = min(max(qcol - 8, 0), 48);
    const int bs = min(max(16 * cgp - 8, 0), 32);
    lds_barrier();
    if (haswin) for (int idx = tid; idx < 465; idx += 256) rpbs[idx] = p.na_rpb[((size_t)j * 16 + h) * 465 + idx];
    f32x4 sw[8][2], sc[4][4];
    bf16x8 pw[8];
    float m1 = NEGV, l1 = 0.f;
#pragma unroll
    for (int i = 0; i < 8; ++i) pw[i] = (bf16x8){0, 0, 0, 0, 0, 0, 0, 0};
#pragma unroll
    for (int i = 0; i < 8; ++i)
#pragma unroll
      for (int k2 = 0; k2 < 2; ++k2) sw[i][k2] = (f32x4){NEGV, NEGV, NEGV, NEGV};
#pragma unroll
    for (int st = 0; st < 3; ++st) {
      if (st < 2 && !haswin) continue;
      lds_barrier();
      int tq = tid; asm volatile("" : "+v"(tq));
#pragma unroll
      for (int hf = 0; hf < 2; ++hf) {
        u32x4 u[4];
#pragma unroll
        for (int i = 0; i < 4; ++i) {
          const int q = tq + (hf * 4 + i) * 256, key = q >> 3, c = q & 7, tl = key >> 6;
          const int base = (st < 2) ? b * SEQ + (rs + st * 4 + tl) * 64 : NL + b * CTXL + tl * 64;
          u[i] = *(const u32x4*)(Kb + (size_t)(base + (key & 63)) * 1024 + h * 64 + c * 8);
        }
#pragma unroll
        for (int i = 0; i < 4; ++i) {
          const int q = tq + (hf * 4 + i) * 256, key = q >> 3, c = q & 7;
          *(u32x4*)(Ks + lds_off(key, c)) = u[i];
        }
        __builtin_amdgcn_sched_barrier(0);
      }
      lds_barrier();
      if (st < 2) {
#pragma unroll
        for (int tl = 0; tl < 4; ++tl) {
          const int i = st * 4 + tl;
          const int dr = rs + i - r + 7;
#pragma unroll
          for (int k2 = 0; k2 < 2; ++k2) {
            f32x4 acc = (f32x4){0.f, 0.f, 0.f, 0.f};
#pragma unroll
            for (int ks = 0; ks < 2; ++ks) {
              const bf16x8 kf = *(const bf16x8*)(Ks + lds_off(tl * 64 + bs + k2 * 16 + fr, ks * 4 + fq));
              acc = __builtin_amdgcn_mfma_f32_16x16x32_bf16(kf, qf[ks], acc, 0, 0, 0);
            }
#pragma unroll
            for (int e = 0; e < 4; ++e) {
              const int kc = bs + k2 * 16 + fq * 4 + e;
              const bool valid = (kc >= wsq) && (kc < wsq + 16);
              const int dc = min(max(kc - qcol, -15), 15) + 15;
              sw[i][k2][e] = valid ? acc[e] + rpbs[dr * 31 + dc] : NEGV;
            }
          }
          __builtin_amdgcn_sched_barrier(0);
        }
      } else {
#pragma unroll
        for (int tl = 0; tl < 4; ++tl)
#pragma unroll
          for (int k4 = 0; k4 < 4; ++k4) {
            f32x4 acc = (f32x4){0.f, 0.f, 0.f, 0.f};
#pragma unroll
            for (int ks = 0; ks < 2; ++ks) {
              const bf16x8 kf = *(const bf16x8*)(Ks + lds_off(tl * 64 + k4 * 16 + fr, ks * 4 + fq));
              acc = __builtin_amdgcn_mfma_f32_16x16x32_bf16(kf, qf[ks], acc, 0, 0, 0);
            }
            sc[tl][k4] = acc;
            if (k4 & 1) __builtin_amdgcn_sched_barrier(0);
          }
      }
      if (st == 1) {
#pragma unroll
        for (int i = 0; i < 8; ++i)
#pragma unroll
          for (int k2 = 0; k2 < 2; ++k2)
#pragma unroll
            for (int e = 0; e < 4; ++e) m1 = fmaxf(m1, sw[i][k2][e]);
        m1 = fmaxf(m1, __shfl_xor(m1, 16));
        m1 = fmaxf(m1, __shfl_xor(m1, 32));
#pragma unroll
        for (int i = 0; i < 8; ++i) {
          float e0[4], e1[4];
#pragma unroll
          for (int e = 0; e < 4; ++e) { e0[e] = __expf(sw[i][0][e] - m1); e1[e] = __expf(sw[i][1][e] - m1); l1 += e0[e] + e1[e]; }
          u32x4 u = (u32x4){pk2(e0[0], e0[1]), pk2(e0[2], e0[3]), pk2(e1[0], e1[1]), pk2(e1[2], e1[3])};
          pw[i] = __builtin_bit_cast(bf16x8, u);
        }
        l1 += __shfl_xor(l1, 16);
        l1 += __shfl_xor(l1, 32);
      }
    }
    float m2 = NEGV;
#pragma unroll
    for (int tl = 0; tl < 4; ++tl)
#pragma unroll
      for (int k4 = 0; k4 < 4; ++k4)
#pragma unroll
        for (int e = 0; e < 4; ++e) m2 = fmaxf(m2, sc[tl][k4][e]);
    m2 = fmaxf(m2, __shfl_xor(m2, 16));
    m2 = fmaxf(m2, __shfl_xor(m2, 32));
    const float mx = fmaxf(m1, m2);
    const float alpha1 = __expf(m1 - mx);
    float l2 = 0.f;
    bf16x8 pc[4][2];
#pragma unroll
    for (int tl = 0; tl < 4; ++tl)
#pragma unroll
      for (int g2 = 0; g2 < 2; ++g2) {
        float e0[4], e1[4];
#pragma unroll
        for (int e = 0; e < 4; ++e) { e0[e] = __expf(sc[tl][2 * g2][e] - mx); e1[e] = __expf(sc[tl][2 * g2 + 1][e] - mx); l2 += e0[e] + e1[e]; }
        u32x4 u = (u32x4){pk2(e0[0], e0[1]), pk2(e0[2], e0[3]), pk2(e1[0], e1[1]), pk2(e1[2], e1[3])};
        pc[tl][g2] = __builtin_bit_cast(bf16x8, u);
      }
    l2 += __shfl_xor(l2, 16);
    l2 += __shfl_xor(l2, 32);
    const float l = alpha1 * l1 + l2;
    f32x4 o[4];
#pragma unroll
    for (int dt = 0; dt < 4; ++dt) o[dt] = (f32x4){0.f, 0.f, 0.f, 0.f};
#pragma unroll
    for (int st = 0; st < 3; ++st) {
      if (st < 2 && !haswin) continue;
      lds_barrier();
      int tq = tid; asm volatile("" : "+v"(tq));
#pragma unroll
      for (int hf = 0; hf < 2; ++hf) {
        u32x4 u[4];
#pragma unroll
        for (int i = 0; i < 4; ++i) {
          const int q = tq + (hf * 4 + i) * 256, tl = q >> 9, dd = (q >> 3) & 63, c = q & 7;
          const int base = (st < 2) ? b * SEQ + (rs + st * 4 + tl) * 64 : NL + b * CTXL + tl * 64;
          u[i] = *(const u32x4*)(Vt + (size_t)(h * 64 + dd) * MT + base + c * 8);
        }
#pragma unroll
        for (int i = 0; i < 4; ++i) {
          const int q = tq + (hf * 4 + i) * 256, tl = q >> 9, dd = (q >> 3) & 63, c = q & 7;
          *(u32x4*)(Vs + tl * 4608 + dd * 72 + c * 8) = u[i];
        }
        __builtin_amdgcn_sched_barrier(0);
      }
      lds_barrier();
      if (st < 2) {
#pragma unroll
        for (int tl = 0; tl < 4; ++tl) {
          const int i = st * 4 + tl;
#pragma unroll
          for (int dt = 0; dt < 4; ++dt) {
            const bf* vp = Vs + tl * 4608 + (dt * 16 + fr) * 72 + bs + fq * 4;
            const u32x2 lo = *(const u32x2*)vp, hi = *(const u32x2*)(vp + 16);
            u32x4 u = (u32x4){lo.x, lo.y, hi.x, hi.y};
            o[dt] = __builtin_amdgcn_mfma_f32_16x16x32_bf16(__builtin_bit_cast(bf16x8, u), pw[i], o[dt], 0, 0, 0);
          }
          __builtin_amdgcn_sched_barrier(0);
        }
      } else {
#pragma unroll
        for (int tl = 0; tl < 4; ++tl)
#pragma unroll
          for (int g2 = 0; g2 < 2; ++g2)
#pragma unroll
            for (int dt = 0; dt < 4; ++dt) {
              const bf* vp = Vs + tl * 4608 + (dt * 16 + fr) * 72 + g2 * 32 + fq * 4;
              const u32x2 lo = *(const u32x2*)vp, hi = *(const u32x2*)(vp + 16);
              u32x4 u = (u32x4){lo.x, lo.y, hi.x, hi.y};
              o[dt] = __builtin_amdgcn_mfma_f32_16x16x32_bf16(__builtin_bit_cast(bf16x8, u), pc[tl][g2], o[dt], 0, 0, 0);
              if (dt == 3) __builtin_amdgcn_sched_barrier(0);
            }
      }
      if (st == 1) {
#pragma unroll
        for (int dt = 0; dt < 4; ++dt) o[dt] *= alpha1;
      }
    }
    const float inv = 1.f / l;
#pragma unroll
    for (int dt = 0; dt < 4; ++dt) {
      const size_t off = (size_t)qtok * 1024 + h * 64 + dt * 16 + fq * 4;
      const u32x2 ug = *(const u32x2*)(Gb + off);
      const float g0 = bflo(ug.x), g1 = bfhi(ug.x), g2 = bflo(ug.y), g3 = bfhi(ug.y);
      *(u32x2*)(p.H + (size_t)qtok * LDH + h * 64 + dt * 16 + fq * 4) = (u32x2){pk2(o[dt][0] * inv * siluf(g0), o[dt][1] * inv * siluf(g1)),
                                        pk2(o[dt][2] * inv * siluf(g2), o[dt][3] * inv * siluf(g3))};
    }
  }
}


#define XB_TMO      128
#define XB_XCNT(j)  (256  + 64 * (j))
#define XB_XSUB(j)  (1280 + 64 * (j))
#define XB_XGEN(j)  (2304 + 64 * (j))
#define XB_TOP      3328
#define XB_TOPGEN   3392
#define XCD_BAR_WORDS 3456
#define XB_SPIN_CAP (1u << 18)
__device__ __forceinline__ unsigned xb_ld(unsigned* q) { return __hip_atomic_load(q, __ATOMIC_RELAXED, __HIP_MEMORY_SCOPE_AGENT); }
__device__ __forceinline__ unsigned xb_add(unsigned* q, unsigned v) { return __hip_atomic_fetch_add(q, v, __ATOMIC_RELAXED, __HIP_MEMORY_SCOPE_AGENT); }
__device__ __forceinline__ unsigned xb_xcc_id() { return (unsigned)__builtin_amdgcn_s_getreg((3 << 11) | 20) & 0xFu; }
#define XB_SPIN(cond, bar) do { unsigned _sp = 0; while (cond) { __builtin_amdgcn_s_sleep(1); \
    if ((++_sp & 255u) == 0u) { if (xb_ld(&(bar)[XB_TMO])) break; if (_sp > XB_SPIN_CAP) { atomicAdd(&(bar)[XB_TMO], 1u); break; } } } } while (0)
struct XcdBarrier { unsigned* bar; unsigned x, nloc, nx; };
__device__ __forceinline__ void xcd_barrier(const XcdBarrier& b) {
  asm volatile("s_waitcnt vmcnt(0)" ::: "memory");
  __syncthreads();
  if (threadIdx.x == 0) {
    unsigned* bar = b.bar;
    __builtin_amdgcn_s_waitcnt(0);
    const unsigned nloc = b.nloc, nx = b.nx;
    const unsigned old = xb_add(&bar[XB_XSUB(b.x)], 1u);
    const unsigned gen = old / nloc;
    if (old + 1u == (gen + 1u) * nloc) {
      __builtin_amdgcn_fence(__ATOMIC_RELEASE, "agent");
      asm volatile("s_waitcnt vmcnt(0)" ::: "memory");
      const unsigned og = xb_add(&bar[XB_TOP], 1u);
      const unsigned tg = og / nx;
      if (og + 1u == (tg + 1u) * nx) xb_add(&bar[XB_TOPGEN], 1u);
      else XB_SPIN(xb_ld(&bar[XB_TOPGEN]) == tg, bar);
      __builtin_amdgcn_fence(__ATOMIC_ACQUIRE, "agent");
      xb_add(&bar[XB_XGEN(b.x)], 1u);
      asm volatile("s_waitcnt vmcnt(0)" ::: "memory");
    } else {
      XB_SPIN(xb_ld(&bar[XB_XGEN(b.x)]) == gen, bar);
      __builtin_amdgcn_fence(__ATOMIC_ACQUIRE, "agent");
      asm volatile("s_waitcnt vmcnt(0)" ::: "memory");
    }
  }
  __syncthreads();
}

#ifndef DUP_SCAN
#define DUP_SCAN 0
#endif
#ifndef DUP_ATTN
#define DUP_ATTN 0
#endif
#ifndef DUP_GEMM
#define DUP_GEMM 0
#endif
#ifndef MULTI_LAUNCH
#define MULTI_LAUNCH 0
#endif
__device__ __forceinline__ bool step_exists(int i, int s) {
  if (s == 2) return i == 2;
  if (s == 4) return (i & 1) == 0;
  return true;
}
__device__ __forceinline__ void run_step(const Params& p, int i, int s, char* smem) {
  asm volatile("" : "+s"(i));
  const int j = i >> 1;
  if (s == 0) { transpose_phase(p, i, smem); row_phase(p, i); }
  else if (s == 1) {
    if ((i & 1) == 0) {
      EpiRwkvProj ep{p.R, p.K, (j == 0) ? p.VF : p.V2, p.G, p.HID};
#pragma unroll 1
      for (int rep = PROBE_GEMM ? 0 : 1; rep < 2; ++rep)
      gemm_phase<1>(p.H, LDH, p.Wp, LDW, 16, MT / 128, (j == 0) ? 34 : 35, p.rw_mu + (size_t)j * 6 * 1024, ep, smem, rep == 0);
    } else {
      EpiNaProj ep{p.R, p.K, p.V2, p.G, p.na_b_in + (size_t)j * 4096};
#pragma unroll 1
      for (int rep = PROBE_GEMM ? 0 : 1; rep < 2; ++rep)
      gemm_phase<0>(p.H, LDH, p.Wp, LDW, 16, MT / 128, 32, nullptr, ep, smem, rep == 0);
    }
  } else if (s == 2) {
    EpiVres ev{p.V2, p.VF, p.rw_v0};
    gemm_phase<0>(p.HID + 256, HIDW, p.v2t, 64, 1, MT / 128, 8, nullptr, ev, smem);
  } else if (s == 3) {
    if ((i & 1) == 0) scan_phase(p, j, smem);
    else attn_phase(p, j, i != 3, smem);
  } else if (s == 4) {
    og_phase(p, j);
  } else {
    EpiOut eo{p.R};
#pragma unroll 1
    for (int rep = PROBE_GEMM ? 0 : 1; rep < 2; ++rep)
    gemm_phase<0>(p.H, LDH, p.Wo, LDW, 16, (i == 3) ? NL / 128 : MT / 128, 8, nullptr, eo, smem, rep == 0);
  }
}

__global__ void __launch_bounds__(256, 2) fwd_megakernel(Params p0) {
  __shared__ __attribute__((aligned(16))) char smem[SMEM_BYTES];
  cg::grid_group grid = cg::this_grid();
  XcdBarrier xb;
  xb.bar = p0.bar; xb.x = xb_xcc_id(); xb.nloc = 0u; xb.nx = 0u;
  if (threadIdx.x == 0) (void)xb_add(&xb.bar[XB_XCNT(xb.x)], 1u);
  pre_phase(p0, smem);
  grid.sync();
  {
    unsigned cnt = 0u, mine = 0u;
#pragma unroll 1
    for (unsigned jj = 0; jj < 16; ++jj) { const unsigned c = xb_ld(&xb.bar[XB_XCNT(jj)]); cnt += (c > 0u) ? 1u : 0u; mine = (jj == xb.x) ? c : mine; }
    xb.nloc = mine > 0u ? mine : 1u; xb.nx = cnt > 0u ? cnt : 1u;
  }
  const Params& p = p0;
#pragma unroll 1
  for (int i = 0; i < 4; ++i) {
#pragma unroll 1
    for (int s = 0; s < 6; ++s) {
      if (!step_exists(i, s)) continue;
      int reps = 1;
      if (DUP_SCAN && s == 3 && (i & 1) == 0) reps = 2;
      if (DUP_ATTN && s == 3 && (i & 1) == 1) reps = 2;
      if (DUP_GEMM && (s == 1 || s == 5)) reps = 2;
#pragma unroll 1
      for (int rep = 0; rep < reps; ++rep) {
        run_step(p, i, s, smem);
        xcd_barrier(xb);
      }
    }
  }
  row_phase(p, 4);
}

#if MULTI_LAUNCH
template <int S> __global__ void __launch_bounds__(256, 2) step_kernel(Params p0, int i) {
  __shared__ __attribute__((aligned(16))) char smem[SMEM_BYTES];
  if (S == -1) { pre_phase(p0, smem); return; }
  if (S == 6) { row_phase(p0, 4); return; }
  run_step(p0, i, S, smem);
}
#endif

extern "C" void kernel_launch(void* const* d_in, const int* in_sizes, int n_in, void* d_out, int out_size, void* d_ws, size_t ws_size,
                              hipStream_t stream) {
  static int grid_blocks = 0;
  if (!grid_blocks) {
    int dev = 0, cus = 0, per_cu = 0;
    hipGetDevice(&dev);
    hipDeviceGetAttribute(&cus, hipDeviceAttributeMultiprocessorCount, dev);
    hipOccupancyMaxActiveBlocksPerMultiprocessor(&per_cu, fwd_megakernel, 256, 0);
    if (per_cu > 2) per_cu = 2;
    if (per_cu < 1) per_cu = 1;
    grid_blocks = cus * per_cu;
  }
  Params p{};
  const float** f = (const float**)&p;
  for (int i = 0; i < 29; ++i) f[i] = (const float*)d_in[i];
  p.out = (float*)d_out;
  char* w = (char*)d_ws;
  size_t off = 0;
  auto take = [&](size_t bytes) { char* r = w + off; off += (bytes + 255) & ~(size_t)255; return r; };
  p.gp = (Params*)take(sizeof(Params));
  p.bar = (unsigned*)take((size_t)XCD_BAR_WORDS * 4);
  p.mod = (float*)take((size_t)4 * 9 * 3072 * 4);
  p.ctxbuf = (float*)take((size_t)NC * 1024 * 4);
  p.beta = (float*)take((size_t)2 * MT * 16 * 4);
  p.Wp = (bf*)take((size_t)4480 * LDW * 2);
  p.Wo = (bf*)take((size_t)1024 * LDW * 2);
  p.w2t = (bf*)take((size_t)2 * 65536 * 2);
  p.a2t = (bf*)take((size_t)2 * 65536 * 2);
  p.v2t = (bf*)take((size_t)65536 * 2);
  const size_t big = (size_t)MT * 1024 * 2;
  p.H = (bf*)take((size_t)MT * LDH * 2); p.R = (bf*)take(big); p.K = (bf*)take(big); p.VF = (bf*)take(big);
  p.V2 = (bf*)take(big); p.G = (bf*)take(big); p.Y1 = (bf*)take(big);
  p.HID = (bf*)take((size_t)MT * HIDW * 2);
  if (off > ws_size) fprintf(stderr, "workspace too small: need %zu have %zu\n", off, ws_size);
#if MULTI_LAUNCH
  step_kernel<-1><<<grid_blocks, 256, 0, stream>>>(p, 0);
  for (int i = 0; i < 4; ++i) {
    step_kernel<0><<<grid_blocks, 256, 0, stream>>>(p, i);
    step_kernel<1><<<grid_blocks, 256, 0, stream>>>(p, i);
    if (i == 2) step_kernel<2><<<grid_blocks, 256, 0, stream>>>(p, i);
    step_kernel<3><<<grid_blocks, 256, 0, stream>>>(p, i);
    if ((i & 1) == 0) step_kernel<4><<<grid_blocks, 256, 0, stream>>>(p, i);
    step_kernel<5><<<grid_blocks, 256, 0, stream>>>(p, i);
  }
  step_kernel<6><<<grid_blocks, 256, 0, stream>>>(p, 0);
#else
  (void)hipMemsetAsync(p.bar, 0, (size_t)XCD_BAR_WORDS * 4, stream);
  void* args[] = {&p};
  hipError_t e = hipLaunchCooperativeKernel((void*)fwd_megakernel, dim3(grid_blocks), dim3(256), args, 0, stream);
  if (e != hipSuccess) fprintf(stderr, "cooperative launch failed: %s (grid %d)\n", hipGetErrorString(e), grid_blocks);
#endif
}
```

```cpp
#include <hip/hip_runtime.h>
#include <hip/hip_cooperative_groups.h>
#include <cstdint>
#include <cstdio>
namespace cg = cooperative_groups;

typedef unsigned short bf;
typedef short bf16x8 __attribute__((ext_vector_type(8)));
typedef float f32x4 __attribute__((ext_vector_type(4)));
typedef unsigned u32x4 __attribute__((ext_vector_type(4)));
typedef unsigned u32x2 __attribute__((ext_vector_type(2)));

constexpr int DM = 1024, NB = 8, SEQ = 8192, NL = NB * SEQ, CTXL = 256, NC = NB * CTXL, MT = NL + NC;
constexpr int HIDW = 384;
constexpr int LDH = 1088, LDW = 1088;
constexpr int SMEM_BYTES = 65536;
#define NEGV (-1e30f)
#ifndef PROBE_GEMM
#define PROBE_GEMM 0
#endif

struct Params {
  const float *x, *c, *ctx, *c_ctx, *ada_w, *ada_b, *pre_g, *post_g, *rw_mu, *rw_w_rkvg, *rw_w0, *rw_w1, *rw_w2,
      *rw_a0, *rw_a1, *rw_a2, *rw_v0, *rw_v1, *rw_v2, *rw_k_k, *rw_k_a, *rw_r_k, *rw_lnx_w, *rw_lnx_b, *rw_w_out,
      *na_w_in, *na_b_in, *na_rpb, *na_w_out;
  float* out;
  float *mod, *ctxbuf, *beta;
  bf *Wp, *Wo, *w2t, *a2t, *v2t;
  bf *H, *R, *K, *VF, *V2, *G, *Y1, *HID;
  Params* gp;
  unsigned* bar;
};

__device__ __forceinline__ float bflo(unsigned w) { return __uint_as_float(w << 16); }
__device__ __forceinline__ float bfhi(unsigned w) { return __uint_as_float(w & 0xffff0000u); }
typedef __bf16 bf16x2_t __attribute__((ext_vector_type(2)));
__device__ __forceinline__ unsigned pk2(float lo, float hi) {
  bf16x2_t v = {(__bf16)lo, (__bf16)hi};
  return __builtin_bit_cast(unsigned, v);
}
__device__ __forceinline__ float siluf(float v) { return v / (1.f + __expf(-v)); }
__device__ __forceinline__ float sigmf(float v) { return 1.f / (1.f + __expf(-v)); }
__device__ __forceinline__ float quad_sum(float v) {
  int t = __builtin_amdgcn_update_dpp(0, __float_as_int(v), 0xB1, 0xF, 0xF, true);
  v += __int_as_float(t);
  t = __builtin_amdgcn_update_dpp(0, __float_as_int(v), 0x4E, 0xF, 0xF, true);
  v += __int_as_float(t);
  return v;
}
__device__ __forceinline__ float wave_sum(float v) {
#pragma unroll
  for (int o = 32; o >= 1; o >>= 1) v += __shfl_xor(v, o);
  return v;
}
__device__ __forceinline__ int otid() { int t = threadIdx.x; asm volatile("" : "+v"(t)); return t; }
__device__ __forceinline__ void lds_barrier() { asm volatile("s_waitcnt lgkmcnt(0)\n\ts_barrier" ::: "memory"); }
__device__ __forceinline__ int lds_off(int row, int c) { return row * 128 + ((c ^ ((row >> 1) & 7)) << 4); }
__device__ __forceinline__ unsigned lerp2(unsigned hm, unsigned h0, unsigned hp, float m0, float m1) {
  const float c0 = bflo(h0), c1 = bfhi(h0);
  const float x0 = 0.5f * (bflo(hm) + bflo(hp)) - c0;
  const float x1 = 0.5f * (bfhi(hm) + bfhi(hp)) - c1;
  return pk2(c0 + x0 * m0, c1 + x1 * m1);
}
__device__ __forceinline__ int mod_idx(int row) { return row < NL ? (row >> 13) : 8; }

__device__ void pre_phase(const Params& p, char* smem) {
  float* s = (float*)smem;
  float* red = s + 9 * 1024;
  const int tid = otid();
  for (int item = blockIdx.x; item < 4 * 48; item += gridDim.x) {
    const int i = item / 48, cb = item % 48;
    __syncthreads();
    for (int idx = tid; idx < 9 * 1024; idx += 256) {
      const int m = idx >> 10, k = idx & 1023;
      const float v = (m < 8) ? p.c[m * 1024 + k] : p.c_ctx[k];
      s[idx] = siluf(v);
    }
    __syncthreads();
    const int cc = tid & 63, kq = tid >> 6;
    float acc[9];
#pragma unroll
    for (int m = 0; m < 9; ++m) acc[m] = 0.f;
    const float* W = p.ada_w + (size_t)i * 1024 * 3072 + cb * 64 + cc;
    for (int k = kq * 256; k < kq * 256 + 256; ++k) {
      const float w = W[(size_t)k * 3072];
#pragma unroll
      for (int m = 0; m < 9; ++m) acc[m] += s[m * 1024 + k] * w;
    }
#pragma unroll
    for (int m = 0; m < 9; ++m) red[(kq * 9 + m) * 64 + cc] = acc[m];
    __syncthreads();
    for (int idx = tid; idx < 9 * 64; idx += 256) {
      const int m = idx >> 6, c2 = idx & 63;
      float v = red[(0 * 9 + m) * 64 + c2] + red[(1 * 9 + m) * 64 + c2] + red[(2 * 9 + m) * 64 + c2] + red[(3 * 9 + m) * 64 + c2];
      v += p.ada_b[i * 3072 + cb * 64 + c2];
      p.mod[(size_t)(i * 9 + m) * 3072 + cb * 64 + c2] = v;
    }
  }
}

struct TOp { const float* src; bf* dst; int K, N, Kp, Np, ldd; };
__device__ bool get_op(const Params& p, int i, int op, TOp& o) {
  const int j = i >> 1;
  if (i & 1) {
    if (op == 0) { o = {p.na_w_in + (size_t)j * 1024 * 4096, p.Wp, 1024, 4096, 1024, 4096, LDW}; return true; }
    if (op == 1) { o = {p.na_w_out + (size_t)j * 1024 * 1024, p.Wo, 1024, 1024, 1024, 1024, LDW}; return true; }
    return false;
  }
  if (op < 4) { o = {p.rw_w_rkvg + ((size_t)j * 4 + op) * 1024 * 1024, p.Wp + (size_t)op * 1024 * LDW, 1024, 1024, 1024, 1024, LDW}; return true; }
  if (op < 6) { const int d = op - 4; o = {p.rw_w1 + ((size_t)j * 2 + d) * 1024 * 64, p.Wp + (size_t)(4096 + d * 64) * LDW, 1024, 64, 1024, 64, LDW}; return true; }
  if (op < 8) { const int d = op - 6; o = {p.rw_a1 + ((size_t)j * 2 + d) * 1024 * 64, p.Wp + (size_t)(4224 + d * 64) * LDW, 1024, 64, 1024, 64, LDW}; return true; }
  if (op < 10) { const int d = op - 8; o = {p.rw_w2 + ((size_t)j * 2 + d) * 64 * 1024, p.w2t + (size_t)d * 65536, 64, 1024, 64, 1024, 64}; return true; }
  if (op < 12) { const int d = op - 10; o = {p.rw_a2 + ((size_t)j * 2 + d) * 64 * 1024, p.a2t + (size_t)d * 65536, 64, 1024, 64, 1024, 64}; return true; }
  if (op == 12) { o = {p.rw_w_out + (size_t)j * 1024 * 1024, p.Wo, 1024, 1024, 1024, 1024, LDW}; return true; }
  if (j == 1 && op == 13) { o = {p.rw_v1, p.Wp + (size_t)4352 * LDW, 1024, 32, 1024, 128, LDW}; return true; }
  if (j == 1 && op == 14) { o = {p.rw_v2, p.v2t, 32, 1024, 64, 1024, 64}; return true; }
  return false;
}

__device__ void transpose_phase(const Params& p, int i, char* smem) {
  float* t = (float*)smem;
  const int tid = otid();
  int base = 0;
  for (int op = 0;; ++op) {
    TOp o;
    if (!get_op(p, i, op, o)) break;
    const int tk = o.Kp / 64, tn = o.Np / 64, nt = tk * tn;
    int first = blockIdx.x - (base % (int)gridDim.x);
    if (first < 0) first += gridDim.x;
    for (int g = first; g < nt; g += gridDim.x) {
      const int kt = g / tn, ntile = g % tn;
      __syncthreads();
#pragma unroll
      for (int ps = 0; ps < 4; ++ps) {
        const int kr = ps * 16 + (tid >> 4), c4 = (tid & 15) * 4;
        const int k = kt * 64 + kr, n = ntile * 64 + c4;
        f32x4 v = (f32x4){0.f, 0.f, 0.f, 0.f};
        if (k < o.K && n < o.N) v = *(const f32x4*)(o.src + (size_t)k * o.N + n);
        t[kr * 65 + c4 + 0] = v.x; t[kr * 65 + c4 + 1] = v.y; t[kr * 65 + c4 + 2] = v.z; t[kr * 65 + c4 + 3] = v.w;
      }
      __syncthreads();
      const int n = tid >> 2, kc = (tid & 3) * 16;
      unsigned w[8];
#pragma unroll
      for (int e = 0; e < 8; ++e) w[e] = pk2(t[(kc + 2 * e) * 65 + n], t[(kc + 2 * e + 1) * 65 + n]);
      bf* d = o.dst + (size_t)(ntile * 64 + n) * o.ldd + kt * 64 + kc;
      *(u32x4*)d = (u32x4){w[0], w[1], w[2], w[3]};
      *(u32x4*)(d + 8) = (u32x4){w[4], w[5], w[6], w[7]};
    }
    base += nt;
  }
}

template <bool UPD, bool MKH>
__device__ __forceinline__ void row_phase_t(const Params& p, int i) {
  const int tid = otid(), lane = tid & 63;
  const int gw = blockIdx.x * 4 + (tid >> 6), nw = gridDim.x * 4;
  const int nrows = MKH ? MT : NL;
  for (int row0 = gw; row0 < nrows; row0 += 2 * nw) {
    const bool valid1 = (row0 + nw) < nrows;
    const int rws[2] = {row0, valid1 ? row0 + nw : row0};
    f32x4 xv[2][4];
    u32x2 ou[2][4];
#pragma unroll
    for (int u = 0; u < 2; ++u) {
      const int row = rws[u];
      const float* xs;
      if (i <= 1) xs = (row < NL) ? p.x + (size_t)row * 1024 : p.ctx + (size_t)(row - NL) * 1024;
      else xs = (row < NL) ? p.out + (size_t)row * 1024 : p.ctxbuf + (size_t)(row - NL) * 1024;
#pragma unroll
      for (int q = 0; q < 4; ++q) xv[u][q] = *(const f32x4*)(xs + q * 256 + lane * 4);
      if (UPD) {
        const bf* orow = p.R + (size_t)row * 1024;
#pragma unroll
        for (int q = 0; q < 4; ++q) ou[u][q] = *(const u32x2*)(orow + q * 256 + lane * 4);
      }
    }
#pragma unroll
    for (int u = 0; u < 2; ++u) {
      const int row = rws[u];
      const bool st = (u == 0) || valid1;
      const int m = mod_idx(row);
      if (UPD) {
        float ov[4][4];
        float ss = 0.f;
#pragma unroll
        for (int q = 0; q < 4; ++q) {
          ov[q][0] = bflo(ou[u][q].x); ov[q][1] = bfhi(ou[u][q].x); ov[q][2] = bflo(ou[u][q].y); ov[q][3] = bfhi(ou[u][q].y);
          ss += ov[q][0] * ov[q][0] + ov[q][1] * ov[q][1] + ov[q][2] * ov[q][2] + ov[q][3] * ov[q][3];
        }
        ss = wave_sum(ss);
        const float rs = rsqrtf(ss * (1.f / 1024.f) + 1e-6f);
        const float* gate = p.mod + (size_t)((i - 1) * 9 + m) * 3072 + 2048;
        const float* pg = p.post_g + (i - 1) * 1024;
        float* xd = (row < NL) ? p.out + (size_t)row * 1024 : p.ctxbuf + (size_t)(row - NL) * 1024;
#pragma unroll
        for (int q = 0; q < 4; ++q) {
          const int col = q * 256 + lane * 4;
          const f32x4 gv = *(const f32x4*)(gate + col);
          const f32x4 pv = *(const f32x4*)(pg + col);
          xv[u][q].x += gv.x * ov[q][0] * rs * pv.x;
          xv[u][q].y += gv.y * ov[q][1] * rs * pv.y;
          xv[u][q].z += gv.z * ov[q][2] * rs * pv.z;
          xv[u][q].w += gv.w * ov[q][3] * rs * pv.w;
          if (st) *(f32x4*)(xd + col) = xv[u][q];
        }
      }
      if (MKH) {
        float ss = 0.f;
#pragma unroll
        for (int q = 0; q < 4; ++q) ss += xv[u][q].x * xv[u][q].x + xv[u][q].y * xv[u][q].y + xv[u][q].z * xv[u][q].z + xv[u][q].w * xv[u][q].w;
        ss = wave_sum(ss);
        const float rs = rsqrtf(ss * (1.f / 1024.f) + 1e-6f);
        const float* md = p.mod + (size_t)(i * 9 + m) * 3072;
        const float* pg = p.pre_g + i * 1024;
        bf* hd = p.H + (size_t)row * LDH;
#pragma unroll
        for (int q = 0; q < 4; ++q) {
          const int col = q * 256 + lane * 4;
          const f32x4 sh = *(const f32x4*)(md + col);
          const f32x4 sc = *(const f32x4*)(md + 1024 + col);
          const f32x4 pv = *(const f32x4*)(pg + col);
          const float h0 = xv[u][q].x * rs * pv.x * (1.f + sc.x) + sh.x;
          const float h1 = xv[u][q].y * rs * pv.y * (1.f + sc.y) + sh.y;
          const float h2 = xv[u][q].z * rs * pv.z * (1.f + sc.z) + sh.z;
          const float h3 = xv[u][q].w * rs * pv.w * (1.f + sc.w) + sh.w;
          if (st) *(u32x2*)(hd + col) = (u32x2){pk2(h0, h1), pk2(h2, h3)};
        }
      }
    }
  }
}
__device__ __forceinline__ void row_phase(const Params& p, int i) {
  if (i == 0) row_phase_t<false, true>(p, i);
  else if (i < 4) row_phase_t<true, true>(p, i);
  else row_phase_t<true, false>(p, i);
}

struct EpiRwkvProj {
  bf *R, *K, *V, *G, *HID;
  __device__ __forceinline__ void operator()(int nt, int tok, int col, f32x4 v) const {
    bf* dst;
    if (nt < 8) dst = R + (size_t)tok * 1024 + col;
    else if (nt < 16) dst = K + (size_t)tok * 1024 + (col - 1024);
    else if (nt < 24) dst = V + (size_t)tok * 1024 + (col - 2048);
    else if (nt < 32) {
      dst = G + (size_t)tok * 1024 + (col - 3072);
#pragma unroll
      for (int e = 0; e < 4; ++e) v[e] = siluf(v[e]);
    } else {
      dst = HID + (size_t)tok * HIDW + (col - 4096);
      if (nt == 32) {
#pragma unroll
        for (int e = 0; e < 4; ++e) v[e] = tanhf(v[e]);
      }
    }
    *(u32x2*)dst = (u32x2){pk2(v[0], v[1]), pk2(v[2], v[3])};
  }
};
struct EpiNaProj {
  bf *Q, *K, *Vt, *G; const float* bias;
  __device__ __forceinline__ void operator()(int nt, int tok, int col, f32x4 v) const {
    const f32x4 b = *(const f32x4*)(bias + col);
    v[0] += b.x; v[1] += b.y; v[2] += b.z; v[3] += b.w;
    if (nt >= 16 && nt < 24) {
      const int c = col - 2048;
#pragma unroll
      for (int e = 0; e < 4; ++e) Vt[(size_t)(c + e) * MT + tok] = (bf)(pk2(v[e], 0.f) & 0xffffu);
      return;
    }
    bf* dst;
    if (nt < 8) { dst = Q + (size_t)tok * 1024 + col; v[0] *= 0.125f; v[1] *= 0.125f; v[2] *= 0.125f; v[3] *= 0.125f; }
    else if (nt < 16) dst = K + (size_t)tok * 1024 + (col - 1024);
    else dst = G + (size_t)tok * 1024 + (col - 3072);
    *(u32x2*)dst = (u32x2){pk2(v[0], v[1]), pk2(v[2], v[3])};
  }
};
struct EpiOut {
  bf* O;
  __device__ __forceinline__ void operator()(int nt, int tok, int col, f32x4 v) const {
    *(u32x2*)(O + (size_t)tok * 1024 + col) = (u32x2){pk2(v[0], v[1]), pk2(v[2], v[3])};
  }
};
struct EpiVres {
  bf* V2; const bf* VF; const float* v0;
  __device__ __forceinline__ void operator()(int nt, int tok, int col, f32x4 z) const {
    const f32x4 b = *(const f32x4*)(v0 + col);
    const u32x2 uv = *(const u32x2*)(V2 + (size_t)tok * 1024 + col);
    const u32x2 uf = *(const u32x2*)(VF + (size_t)tok * 1024 + col);
    const float v[4] = {bflo(uv.x), bfhi(uv.x), bflo(uv.y), bfhi(uv.y)};
    const float f[4] = {bflo(uf.x), bfhi(uf.x), bflo(uf.y), bfhi(uf.y)};
    const float zz[4] = {z[0] + b.x, z[1] + b.y, z[2] + b.z, z[3] + b.w};
    float r[4];
#pragma unroll
    for (int e = 0; e < 4; ++e) r[e] = v[e] + (f[e] - v[e]) * sigmf(zz[e]);
    *(u32x2*)(V2 + (size_t)tok * 1024 + col) = (u32x2){pk2(r[0], r[1]), pk2(r[2], r[3])};
  }
};

template <int AMODE, class Epi>
__device__ void gemm_phase(const bf* __restrict__ A, int lda, const bf* __restrict__ Bt, int ldb, int nkt, int mtiles, int ntiles,
                           const float* __restrict__ mu, const Epi& epi, char* smem, bool fake = false) {
  const int tid = otid(), lane = tid & 63, wid = tid >> 6, wr = wid >> 1, wc = wid & 1, fr = lane & 15, fq = lane >> 4;
  const int rg = tid >> 3, cch = tid & 7;
  char* As = smem;
  char* Bs = smem + 32768;
  constexpr int GM = 6;
  const int xcd = blockIdx.x & 7, slot = blockIdx.x >> 3, nslots = gridDim.x >> 3;
  const int per_group = GM * ntiles;
  const int ngroups = (mtiles + GM - 1) / GM;
  const int my_groups = (ngroups - xcd + 7) >> 3;
  const int my_total = my_groups * per_group;
  for (int q = slot; q < my_total; q += nslots) {
    const int gi = q / per_group, e = q - gi * per_group;
    const int nt = e / GM, mt = (xcd + 8 * gi) * GM + (e - nt * GM);
    if (mt >= mtiles) continue;
    const int row0 = mt * 128, col0 = nt * 128;
    int lerp = 0; bool sstart = false, send = false;
    if (AMODE == 1) {
      lerp = (nt < 8) ? 0 : (nt < 16) ? 2 : (nt < 24) ? 3 : (nt < 32) ? 5 : (nt == 32) ? 1 : (nt == 33) ? 4 : 3;
      if (row0 < NL) { sstart = (row0 & (SEQ - 1)) == 0; send = ((row0 + 128) & (SEQ - 1)) == 0; }
      else { sstart = ((row0 - NL) & (CTXL - 1)) == 0; send = ((row0 + 128 - NL) & (CTXL - 1)) == 0; }
    }
    f32x4 acc[4][4];
#pragma unroll
    for (int m = 0; m < 4; ++m)
#pragma unroll
      for (int n = 0; n < 4; ++n) acc[m][n] = (f32x4){0.f, 0.f, 0.f, 0.f};
    u32x4 ra[6], rb[4];
    f32x4 muv[2];
    auto gload = [&](int kt) {
      const int kc = kt * 64 + cch * 8;
      if (AMODE == 0) {
#pragma unroll
        for (int i = 0; i < 4; ++i) ra[i] = *(const u32x4*)(A + (size_t)(row0 + rg * 4 + i) * lda + kc);
      } else {
#pragma unroll
        for (int i = 0; i < 6; ++i) {
          const int r = row0 + rg * 4 + i - 1;
          const bool zero = (i == 0 && rg == 0 && sstart) || (i == 5 && rg == 31 && send);
          ra[i] = zero ? (u32x4){0, 0, 0, 0} : *(const u32x4*)(A + (size_t)r * lda + kc);
        }
        muv[0] = *(const f32x4*)(mu + lerp * 1024 + kc);
        muv[1] = *(const f32x4*)(mu + lerp * 1024 + kc + 4);
      }
#pragma unroll
      for (int i = 0; i < 4; ++i) rb[i] = *(const u32x4*)(Bt + (size_t)(col0 + rg * 4 + i) * ldb + kc);
    };
    auto lstore = [&](int buf) {
      char* a = As + buf * 16384;
      char* b = Bs + buf * 16384;
      if (AMODE == 0) {
#pragma unroll
        for (int i = 0; i < 4; ++i) *(u32x4*)(a + lds_off(rg * 4 + i, cch)) = ra[i];
      } else {
#pragma unroll
        for (int i = 0; i < 4; ++i) {
          const u32x4 hm = ra[i], h0 = ra[i + 1], hp = ra[i + 2];
          u32x4 o;
          o.x = lerp2(hm.x, h0.x, hp.x, muv[0].x, muv[0].y);
          o.y = lerp2(hm.y, h0.y, hp.y, muv[0].z, muv[0].w);
          o.z = lerp2(hm.z, h0.z, hp.z, muv[1].x, muv[1].y);
          o.w = lerp2(hm.w, h0.w, hp.w, muv[1].z, muv[1].w);
          *(u32x4*)(a + lds_off(rg * 4 + i, cch)) = o;
        }
      }
#pragma unroll
      for (int i = 0; i < 4; ++i) *(u32x4*)(b + lds_off(rg * 4 + i, cch)) = rb[i];
    };
    lds_barrier();
    gload(0);
    lstore(0);
    lds_barrier();
    for (int kt = 0; kt < nkt; ++kt) {
      const int buf = kt & 1;
      if (!fake && kt + 1 < nkt) gload(kt + 1);
      const char* a = As + buf * 16384;
      const char* b = Bs + buf * 16384;
#pragma unroll
      for (int ks = 0; ks < 2; ++ks) {
        bf16x8 af[4], bfr[4];
#pragma unroll
        for (int m = 0; m < 4; ++m) af[m] = *(const bf16x8*)(a + lds_off(wr * 64 + m * 16 + fr, ks * 4 + fq));
#pragma unroll
        for (int n = 0; n < 4; ++n) bfr[n] = *(const bf16x8*)(b + lds_off(wc * 64 + n * 16 + fr, ks * 4 + fq));
        __builtin_amdgcn_s_setprio(1);
#pragma unroll
        for (int m = 0; m < 4; ++m)
#pragma unroll
          for (int n = 0; n < 4; ++n) acc[m][n] = __builtin_amdgcn_mfma_f32_16x16x32_bf16(bfr[n], af[m], acc[m][n], 0, 0, 0);
        __builtin_amdgcn_s_setprio(0);
      }
      if (kt + 1 < nkt) lstore(buf ^ 1);
      lds_barrier();
    }
#pragma unroll
    for (int m = 0; m < 4; ++m)
#pragma unroll
      for (int n = 0; n < 4; ++n) epi(nt, row0 + wr * 64 + m * 16 + fr, col0 + wc * 64 + n * 16 + fq * 4, acc[m][n]);
  }
}

typedef float f32x2 __attribute__((ext_vector_type(2)));
__device__ __forceinline__ float oct_sum(float v) {
  int t = __builtin_amdgcn_update_dpp(0, __float_as_int(v), 0xB1, 0xF, 0xF, true);
  v += __int_as_float(t);
  t = __builtin_amdgcn_update_dpp(0, __float_as_int(v), 0x4E, 0xF, 0xF, true);
  v += __int_as_float(t);
  t = __builtin_amdgcn_update_dpp(0, __float_as_int(v), 0x141, 0xF, 0xF, true);
  v += __int_as_float(t);
  return v;
}
__device__ __forceinline__ f32x2 fma2(f32x2 a, f32x2 b, f32x2 c) { return __builtin_elementwise_fma(a, b, c); }
__device__ __forceinline__ float fma_s(float a, float b, float c) { float d; asm("v_fma_f32 %0, %1, %2, %3" : "=v"(d) : "v"(a), "v"(b), "v"(c)); return d; }
__device__ __forceinline__ float mul_s(float a, float b) { float d; asm("v_mul_f32 %0, %1, %2" : "=v"(d) : "v"(a), "v"(b)); return d; }
struct ScanOps { f32x4 w[2], nk[2], bb[2], kd[2], rr[2]; f32x2 vv; };
__device__ __forceinline__ ScanOps scan_load(const float* ops, const float* vs, int t, int kq, int vrow) {
  ScanOps r;
  const float* o = ops + t * 320 + kq * 8;
  r.w[0] = *(const f32x4*)(o); r.w[1] = *(const f32x4*)(o + 4);
  r.nk[0] = *(const f32x4*)(o + 64); r.nk[1] = *(const f32x4*)(o + 68);
  r.bb[0] = *(const f32x4*)(o + 128); r.bb[1] = *(const f32x4*)(o + 132);
  r.kd[0] = *(const f32x4*)(o + 192); r.kd[1] = *(const f32x4*)(o + 196);
  r.rr[0] = *(const f32x4*)(o + 256); r.rr[1] = *(const f32x4*)(o + 260);
  r.vv = *(const f32x2*)(vs + t * 64 + vrow);
  return r;
}
#define PR(v, i) ((f32x2){(v)[(i) >> 1][((i) & 1) * 2], (v)[(i) >> 1][((i) & 1) * 2 + 1]})

constexpr int SC_P = 0, SC_YA = 8192, SC_V = 16384, SC_AT = 24576, SC_RT = SC_AT + 4352, SC_BT = SC_RT + 4352, SC_KT = SC_BT + 4352;
constexpr int SC_BTT = 41984, SC_KTT = SC_BTT + 4608, SC_MABT = 51200, SC_SM = 53248;
__device__ __forceinline__ bf16x8 mk8(u32x2 lo, u32x2 hi) { u32x4 u = (u32x4){lo.x, lo.y, hi.x, hi.y}; return __builtin_bit_cast(bf16x8, u); }
__device__ __forceinline__ bf16x8 mk4(u32x2 lo) { u32x4 u = (u32x4){lo.x, lo.y, 0u, 0u}; return __builtin_bit_cast(bf16x8, u); }
__device__ __forceinline__ float bfround(float x) { return bflo(pk2(x, 0.f) & 0xffffu); }
__device__ __forceinline__ void split4(f32x4 x, u32x2& hi, u32x2& lo) {
  hi = (u32x2){pk2(x[0], x[1]), pk2(x[2], x[3])};
  const float r0 = x[0] - bflo(hi.x), r1 = x[1] - bfhi(hi.x), r2 = x[2] - bflo(hi.y), r3 = x[3] - bfhi(hi.y);
  lo = (u32x2){pk2(r0, r1), pk2(r2, r3)};
}

__device__ void scan_phase(const Params& p, int j, char* smem) {
  const int tid = otid(), lane = tid & 63, wid = tid >> 6, fr = lane & 15, fq = lane >> 4;
  float* Pbuf = (float*)(smem + SC_P);
  float* abuf = (float*)(smem + SC_YA);
  float* ys = (float*)(smem + SC_YA);
  float* vs = (float*)(smem + SC_V);
  for (int item = blockIdx.x; item < 256; item += gridDim.x) {
  const int b = item >> 5, h = (item >> 1) & 15, d = item & 1;
  lds_barrier();
  const bf* Vsrc = (j == 0) ? p.VF : p.V2;
  bf* Ydst = (d == 0) ? p.H : p.Y1;
  const int ldy = (d == 0) ? LDH : 1024;
  float* betad = p.beta + (size_t)d * MT * 16;
  bf16x8 bw[2], ba[2];
  {
    const int n = h * 64 + wid * 16 + fr;
#pragma unroll
    for (int ks = 0; ks < 2; ++ks) {
      bw[ks] = *(const bf16x8*)(p.w2t + (size_t)d * 65536 + (size_t)n * 64 + ks * 32 + fq * 8);
      ba[ks] = *(const bf16x8*)(p.a2t + (size_t)d * 65536 + (size_t)n * 64 + ks * 32 + fq * 8);
    }
  }
  float w0v[4], a0v[4];
#pragma unroll
  for (int e = 0; e < 4; ++e) {
    w0v[e] = p.rw_w0[(size_t)(j * 2 + d) * 1024 + h * 64 + wid * 16 + fq * 4 + e];
    a0v[e] = p.rw_a0[(size_t)(j * 2 + d) * 1024 + h * 64 + wid * 16 + fq * 4 + e];
  }
  const int tt = tid >> 3, c8 = tid & 7;
  float kkv[8], kav[8], rkv[8];
#pragma unroll
  for (int e = 0; e < 8; ++e) {
    kkv[e] = p.rw_k_k[j * 1024 + h * 64 + c8 * 8 + e];
    kav[e] = p.rw_k_a[j * 1024 + h * 64 + c8 * 8 + e];
    rkv[e] = p.rw_r_k[j * 1024 + h * 64 + c8 * 8 + e];
  }
  f32x4 ST[4];
#pragma unroll
  for (int kt = 0; kt < 4; ++kt) ST[kt] = (f32x4){0.f, 0.f, 0.f, 0.f};

  bf16x8 phw[2][2], pha[2][2];
  u32x4 puk, pur, puv;
  auto rowbase_of = [&](int ch, int& sgn) -> int {
    if (d == 0) { sgn = 1; return (ch < 8) ? NL + b * CTXL + ch * 32 : b * SEQ + (ch - 8) * 32; }
    sgn = -1; return (ch < 8) ? NL + b * CTXL + 255 - ch * 32 : b * SEQ + 8191 - (ch - 8) * 32;
  };
  auto prefetch = [&](int ch) {
    int sgn; const int rowbase = rowbase_of(ch, sgn);
#pragma unroll
    for (int m = 0; m < 2; ++m) {
      const size_t row = (size_t)(rowbase + sgn * (m * 16 + fr));
#pragma unroll
      for (int ks = 0; ks < 2; ++ks) {
        phw[m][ks] = *(const bf16x8*)(p.HID + row * HIDW + d * 64 + ks * 32 + fq * 8);
        pha[m][ks] = *(const bf16x8*)(p.HID + row * HIDW + 128 + d * 64 + ks * 32 + fq * 8);
      }
    }
    const size_t off = (size_t)(rowbase + sgn * tt) * 1024 + h * 64 + c8 * 8;
    puk = *(const u32x4*)(p.K + off);
    pur = *(const u32x4*)(p.R + off);
    puv = *(const u32x4*)(Vsrc + off);
  };
  prefetch(0);

  for (int ch = 0; ch < 264; ++ch) {
    int sgn; const int rowbase = rowbase_of(ch, sgn);
#pragma unroll
    for (int m = 0; m < 2; ++m) {
      const int tok = m * 16 + fr;
      f32x4 aw = (f32x4){0.f, 0.f, 0.f, 0.f}, aa = aw;
#pragma unroll
      for (int ks = 0; ks < 2; ++ks) {
        aw = __builtin_amdgcn_mfma_f32_16x16x32_bf16(bw[ks], phw[m][ks], aw, 0, 0, 0);
        aa = __builtin_amdgcn_mfma_f32_16x16x32_bf16(ba[ks], pha[m][ks], aa, 0, 0, 0);
      }
      f32x4 wd, av;
#pragma unroll
      for (int e = 0; e < 4; ++e) {
        const float z = -(w0v[e] + aw[e]);
        const float sp = fmaxf(z, 0.f) + __logf(1.f + __expf(-fabsf(z)));
        const float wl = -sp - 0.5f;
        wd[e] = __expf(-__expf(wl));
        av[e] = sigmf(a0v[e] + aa[e]);
      }
      *(f32x4*)(Pbuf + tok * 64 + wid * 16 + fq * 4) = wd;
      *(f32x4*)(abuf + tok * 64 + wid * 16 + fq * 4) = av;
    }
    lds_barrier();
    if (tid < 128) {
      const int k = tid & 63, sc = tid >> 6;
      float P = 1.f;
#pragma unroll
      for (int t = 0; t < 16; ++t) { float* q = Pbuf + (sc * 16 + t) * 64 + k; P *= *q; *q = P; }
    }
    lds_barrier();
    {
      const size_t row = (size_t)(rowbase + sgn * tt);
      float k[8], r[8], kk[8];
#pragma unroll
      for (int e = 0; e < 4; ++e) {
        k[2 * e] = bflo(puk[e]); k[2 * e + 1] = bfhi(puk[e]);
        r[2 * e] = bflo(pur[e]); r[2 * e + 1] = bfhi(pur[e]);
      }
      float ss = 0.f;
#pragma unroll
      for (int e = 0; e < 8; ++e) { kk[e] = k[e] * kkv[e]; ss += kk[e] * kk[e]; }
      ss = oct_sum(ss);
      const float inv = 1.f / fmaxf(sqrtf(ss), 1e-12f);
      const f32x4 a0 = *(const f32x4*)(abuf + tt * 64 + c8 * 8), a1 = *(const f32x4*)(abuf + tt * 64 + c8 * 8 + 4);
      const f32x4 p0 = *(const f32x4*)(Pbuf + tt * 64 + c8 * 8), p1 = *(const f32x4*)(Pbuf + tt * 64 + c8 * 8 + 4);
      f32x4 q0 = (f32x4){1.f, 1.f, 1.f, 1.f}, q1 = q0;
      if (tt & 15) { q0 = *(const f32x4*)(Pbuf + (tt - 1) * 64 + c8 * 8); q1 = *(const f32x4*)(Pbuf + (tt - 1) * 64 + c8 * 8 + 4); }
      const float a[8] = {a0.x, a0.y, a0.z, a0.w, a1.x, a1.y, a1.z, a1.w};
      const float Pt[8] = {p0.x, p0.y, p0.z, p0.w, p1.x, p1.y, p1.z, p1.w};
      const float Pm[8] = {q0.x, q0.y, q0.z, q0.w, q1.x, q1.y, q1.z, q1.w};
      float at[8], bt_[8], kt_[8], rt[8];
      float bsum = 0.f;
#pragma unroll
      for (int e = 0; e < 8; ++e) {
        const float kkn = kk[e] * inv;
        const float kd = k[e] * (1.f + (a[e] - 1.f) * kav[e]);
        bsum += r[e] * kd * rkv[e];
        const float ip = 1.f / Pt[e];
        at[e] = -kkn * Pm[e];
        bt_[e] = kkn * a[e] * ip;
        kt_[e] = kd * ip;
        rt[e] = r[e] * Pt[e];
      }
      bsum = oct_sum(bsum);
      if (c8 == 0) betad[row * 16 + h] = bsum;
      char* ro = smem + tt * 136 + c8 * 16;
      *(u32x2*)(ro + SC_AT) = (u32x2){pk2(at[0], at[1]), pk2(at[2], at[3])};   *(u32x2*)(ro + SC_AT + 8) = (u32x2){pk2(at[4], at[5]), pk2(at[6], at[7])};
      *(u32x2*)(ro + SC_RT) = (u32x2){pk2(rt[0], rt[1]), pk2(rt[2], rt[3])};   *(u32x2*)(ro + SC_RT + 8) = (u32x2){pk2(rt[4], rt[5]), pk2(rt[6], rt[7])};
      *(u32x2*)(ro + SC_BT) = (u32x2){pk2(bt_[0], bt_[1]), pk2(bt_[2], bt_[3])}; *(u32x2*)(ro + SC_BT + 8) = (u32x2){pk2(bt_[4], bt_[5]), pk2(bt_[6], bt_[7])};
      *(u32x2*)(ro + SC_KT) = (u32x2){pk2(kt_[0], kt_[1]), pk2(kt_[2], kt_[3])}; *(u32x2*)(ro + SC_KT + 8) = (u32x2){pk2(kt_[4], kt_[5]), pk2(kt_[6], kt_[7])};
#pragma unroll
      for (int e = 0; e < 8; ++e) {
        *(bf*)(smem + SC_BTT + (c8 * 8 + e) * 72 + tt * 2) = (bf)(pk2(bt_[e], 0.f) & 0xffffu);
        *(bf*)(smem + SC_KTT + (c8 * 8 + e) * 72 + tt * 2) = (bf)(pk2(kt_[e], 0.f) & 0xffffu);
      }
      *(f32x4*)(vs + tt * 64 + c8 * 8) = (f32x4){bflo(puv[0]), bfhi(puv[0]), bflo(puv[1]), bfhi(puv[1])};
      *(f32x4*)(vs + tt * 64 + c8 * 8 + 4) = (f32x4){bflo(puv[2]), bfhi(puv[2]), bflo(puv[3]), bfhi(puv[3])};
    }
    lds_barrier();
    if (ch + 1 < 264) prefetch(ch + 1);
    {
      auto gram = [&](int xbase, int ybase, int sc) -> f32x4 {
        f32x4 acc = (f32x4){0.f, 0.f, 0.f, 0.f};
#pragma unroll
        for (int ks = 0; ks < 2; ++ks) {
          const char* xp = smem + xbase + (sc * 16 + fr) * 136 + ks * 64 + fq * 16;
          const char* yp = smem + ybase + (sc * 16 + fr) * 136 + ks * 64 + fq * 16;
          const bf16x8 xf = mk8(*(const u32x2*)xp, *(const u32x2*)(xp + 8));
          const bf16x8 yf = mk8(*(const u32x2*)yp, *(const u32x2*)(yp + 8));
          acc = __builtin_amdgcn_mfma_f32_16x16x32_bf16(xf, yf, acc, 0, 0, 0);
        }
        return acc;
      };
      auto store_small = [&](f32x4 g, int sc, int kind, bool strict) {
#pragma unroll
        for (int e = 0; e < 4; ++e) { const int sidx = fq * 4 + e; const bool keep = strict ? (sidx < fr) : (sidx <= fr); g[e] = keep ? g[e] : 0.f; }
        *(u32x2*)(smem + SC_SM + (sc * 5 + kind) * 640 + fr * 40 + fq * 8) = (u32x2){pk2(g[0], g[1]), pk2(g[2], g[3])};
      };
      if (wid < 2) {
        const int sc = wid;
        f32x4 g = gram(SC_BT, SC_AT, sc);
#pragma unroll
        for (int e = 0; e < 4; ++e) g[e] = (fq * 4 + e < fr) ? g[e] : 0.f;
        *(f32x4*)(smem + SC_MABT + sc * 1024 + fr * 64 + fq * 16) = g;
        asm volatile("s_waitcnt lgkmcnt(0)" ::: "memory");
        if (lane < 16) {
          float n[16];
#pragma unroll
          for (int t = 0; t < 16; ++t) {
            const float* mc = (const float*)(smem + SC_MABT + sc * 1024 + t * 64);
            float acc = (t == lane) ? 1.f : 0.f;
#pragma unroll
            for (int sp = 0; sp < t; ++sp) acc = fmaf(n[sp], mc[sp], acc);
            n[t] = acc;
          }
#pragma unroll
          for (int t = 0; t < 16; ++t) {
            const unsigned hi = pk2(n[t], 0.f) & 0xffffu;
            const unsigned lo = pk2(n[t] - bflo(hi), 0.f) & 0xffffu;
            *(bf*)(smem + SC_SM + (sc * 5 + 0) * 640 + t * 40 + lane * 2) = (bf)hi;
            *(bf*)(smem + SC_SM + (sc * 5 + 1) * 640 + t * 40 + lane * 2) = (bf)lo;
          }
        }
      } else {
        const int sc = wid - 2;
        store_small(gram(SC_KT, SC_AT, sc), sc, 2, true);
        store_small(gram(SC_BT, SC_RT, sc), sc, 3, false);
        store_small(gram(SC_KT, SC_RT, sc), sc, 4, false);
      }
    }
    lds_barrier();
#pragma unroll
    for (int sc = 0; sc < 2; ++sc) {
      bf16x8 shi[2], slo[2];
#pragma unroll
      for (int g = 0; g < 2; ++g) {
        u32x2 h0, l0, h1, l1;
        split4(ST[2 * g], h0, l0); split4(ST[2 * g + 1], h1, l1);
        shi[g] = mk8(h0, h1); slo[g] = mk8(l0, l1);
      }
      const char* arow = smem + SC_AT + (sc * 16 + fr) * 136 + fq * 8;
      const char* rrow = smem + SC_RT + (sc * 16 + fr) * 136 + fq * 8;
      f32x4 wt = (f32x4){0.f, 0.f, 0.f, 0.f}, yt = wt;
#pragma unroll
      for (int g = 0; g < 2; ++g) {
        const bf16x8 xa = mk8(*(const u32x2*)(arow + g * 64), *(const u32x2*)(arow + g * 64 + 32));
        const bf16x8 xr = mk8(*(const u32x2*)(rrow + g * 64), *(const u32x2*)(rrow + g * 64 + 32));
        wt = __builtin_amdgcn_mfma_f32_16x16x32_bf16(xa, shi[g], wt, 0, 0, 0);
        wt = __builtin_amdgcn_mfma_f32_16x16x32_bf16(xa, slo[g], wt, 0, 0, 0);
        yt = __builtin_amdgcn_mfma_f32_16x16x32_bf16(xr, shi[g], yt, 0, 0, 0);
        yt = __builtin_amdgcn_mfma_f32_16x16x32_bf16(xr, slo[g], yt, 0, 0, 0);
      }
      const int vcol = wid * 16 + fr;
      const float* vp = vs + (sc * 16 + fq * 4) * 64 + vcol;
      const bf16x8 vmf = mk4((u32x2){pk2(vp[0], vp[64]), pk2(vp[128], vp[192])});
      const char* smb = smem + SC_SM + sc * 5 * 640 + fr * 40 + fq * 8;
      const bf16x8 xnh = mk4(*(const u32x2*)(smb)), xnl = mk4(*(const u32x2*)(smb + 640));
      const bf16x8 xmak = mk4(*(const u32x2*)(smb + 2 * 640)), xmrb = mk4(*(const u32x2*)(smb + 3 * 640)), xmrk = mk4(*(const u32x2*)(smb + 4 * 640));
      wt = __builtin_amdgcn_mfma_f32_16x16x32_bf16(xmak, vmf, wt, 0, 0, 0);
      u32x2 whi, wlo;
      split4(wt, whi, wlo);
      f32x4 ut = (f32x4){0.f, 0.f, 0.f, 0.f};
      ut = __builtin_amdgcn_mfma_f32_16x16x32_bf16(xnh, mk4(whi), ut, 0, 0, 0);
      ut = __builtin_amdgcn_mfma_f32_16x16x32_bf16(xnh, mk4(wlo), ut, 0, 0, 0);
      ut = __builtin_amdgcn_mfma_f32_16x16x32_bf16(xnl, mk4(whi), ut, 0, 0, 0);
      u32x2 uhi, ulo;
      split4(ut, uhi, ulo);
      const bf16x8 uhf = mk4(uhi), ulf = mk4(ulo);
      yt = __builtin_amdgcn_mfma_f32_16x16x32_bf16(xmrb, uhf, yt, 0, 0, 0);
      yt = __builtin_amdgcn_mfma_f32_16x16x32_bf16(xmrb, ulf, yt, 0, 0, 0);
      yt = __builtin_amdgcn_mfma_f32_16x16x32_bf16(xmrk, vmf, yt, 0, 0, 0);
#pragma unroll
      for (int e = 0; e < 4; ++e) ys[(sc * 16 + fq * 4 + e) * 64 + vcol] = yt[e];
#pragma unroll
      for (int kt = 0; kt < 4; ++kt) {
        const bf16x8 xb = mk4(*(const u32x2*)(smem + SC_BTT + (kt * 16 + fr) * 72 + (sc * 16 + fq * 4) * 2));
        const bf16x8 xk = mk4(*(const u32x2*)(smem + SC_KTT + (kt * 16 + fr) * 72 + (sc * 16 + fq * 4) * 2));
        ST[kt] = __builtin_amdgcn_mfma_f32_16x16x32_bf16(xb, uhf, ST[kt], 0, 0, 0);
        ST[kt] = __builtin_amdgcn_mfma_f32_16x16x32_bf16(xb, ulf, ST[kt], 0, 0, 0);
        ST[kt] = __builtin_amdgcn_mfma_f32_16x16x32_bf16(xk, vmf, ST[kt], 0, 0, 0);
        const f32x4 pc = *(const f32x4*)(Pbuf + (sc * 16 + 15) * 64 + kt * 16 + fq * 4);
        ST[kt] = ST[kt] * pc;
      }
    }
    lds_barrier();
    {
      const size_t row = (size_t)(rowbase + sgn * tt);
      const f32x4 y0 = *(const f32x4*)(ys + tt * 64 + c8 * 8), y1 = *(const f32x4*)(ys + tt * 64 + c8 * 8 + 4);
      *(u32x4*)(Ydst + row * ldy + h * 64 + c8 * 8) = (u32x4){pk2(y0.x, y0.y), pk2(y0.z, y0.w), pk2(y1.x, y1.y), pk2(y1.z, y1.w)};
    }
    lds_barrier();
  }
  }
}

__device__ void og_phase(const Params& p, int j) {
  const int tid = otid(), lane = tid & 63;
  const int gw = blockIdx.x * 4 + (tid >> 6), nw = gridDim.x * 4;
  const bf* Vsrc = (j == 0) ? p.VF : p.V2;
  const int col = lane * 16, hh = lane >> 2;
  float lw[16], lb[16];
#pragma unroll
  for (int e = 0; e < 16; ++e) { lw[e] = p.rw_lnx_w[j * 1024 + col + e]; lb[e] = p.rw_lnx_b[j * 1024 + col + e]; }
  for (int row = gw; row < MT; row += nw) {
    const size_t off = (size_t)row * 1024 + col, offh = (size_t)row * LDH + col;
    u32x4 u0[2], u1[2], uv[2], ug[2];
#pragma unroll
    for (int q = 0; q < 2; ++q) {
      u0[q] = *(const u32x4*)(p.H + offh + q * 8);
      u1[q] = *(const u32x4*)(p.Y1 + off + q * 8);
      uv[q] = *(const u32x4*)(Vsrc + off + q * 8);
      ug[q] = *(const u32x4*)(p.G + off + q * 8);
    }
    const float bsum = p.beta[(size_t)row * 16 + hh] + p.beta[(size_t)MT * 16 + (size_t)row * 16 + hh];
    float y[16], v[16], g[16];
    float s = 0.f;
#pragma unroll
    for (int e = 0; e < 8; ++e) {
      y[2 * e] = bflo(u0[e >> 2][e & 3]) + bflo(u1[e >> 2][e & 3]); y[2 * e + 1] = bfhi(u0[e >> 2][e & 3]) + bfhi(u1[e >> 2][e & 3]);
      v[2 * e] = bflo(uv[e >> 2][e & 3]); v[2 * e + 1] = bfhi(uv[e >> 2][e & 3]);
      g[2 * e] = bflo(ug[e >> 2][e & 3]); g[2 * e + 1] = bfhi(ug[e >> 2][e & 3]);
      s += y[2 * e] + y[2 * e + 1];
    }
    s = quad_sum(s);
    const float mean = s * (1.f / 64.f);
    float q2 = 0.f;
#pragma unroll
    for (int e = 0; e < 16; ++e) { const float dd = y[e] - mean; q2 += dd * dd; }
    q2 = quad_sum(q2);
    const float rstd = rsqrtf(q2 * (1.f / 64.f) + 64e-5f);
    unsigned o[8];
#pragma unroll
    for (int e = 0; e < 8; ++e) {
      const float r0 = ((y[2 * e] - mean) * rstd * lw[2 * e] + lb[2 * e] + bsum * v[2 * e]) * g[2 * e];
      const float r1 = ((y[2 * e + 1] - mean) * rstd * lw[2 * e + 1] + lb[2 * e + 1] + bsum * v[2 * e + 1]) * g[2 * e + 1];
      o[e] = pk2(r0, r1);
    }
    *(u32x4*)(p.H + offh) = (u32x4){o[0], o[1], o[2], o[3]};
    *(u32x4*)(p.H + offh + 8) = (u32x4){o[4], o[5], o[6], o[7]};
  }
}

__device__ void attn_phase(const Params& p, int j, bool ctx_out, char* smem) {
  const int tid = otid(), lane = tid & 63, cgp = tid >> 6, fr = lane & 15, fq = lane >> 4;
  char* Ks = smem;
  bf* Vs = (bf*)smem;
  float* rpbs = (float*)(smem + 36864);
  const bf* Q = p.R; const bf* Kb = p.K; const bf* Vt = p.V2; const bf* Gb = p.G;
  const int nitems = 16384 + (ctx_out ? 512 : 0);
  for (int item = blockIdx.x; item < nitems; item += gridDim.x) {
    int b, h, r = 0, qrow0; bool haswin;
    if (item < 16384) { h = item & 15; r = (item >> 4) & 127; b = item >> 11; haswin = true; qrow0 = b * SEQ + r * 64; }
    else { const int it = item - 16384; h = it & 15; const int qb = (it >> 4) & 3; b = it >> 6; haswin = false; qrow0 = NL + b * CTXL + qb * 64; }
    const int qtok = qrow0 + cgp * 16 + fr;
    bf16x8 qf[2];
#pragma unroll
    for (int ks = 0; ks < 2; ++ks) qf[ks] = *(const bf16x8*)(Q + (size_t)qtok * 1024 + h * 64 + ks * 32 + fq * 8);
    const int rs = min(max(r - 4, 0), 120);
    const int qcol = cgp * 16 + fr;
    const int wsq = min(max(qcol - 8, 0), 48);
    const int bs = min(max(16 * cgp - 8, 0), 32);
    lds_barrier();
    if (haswin) for (int idx = tid; idx < 465; idx += 256) rpbs[idx] = p.na_rpb[((size_t)j * 16 + h) * 465 + idx];
    f32x4 sw[8][2], sc[4][4];
    bf16x8 pw[8];
    float m1 = NEGV, l1 = 0.f;
#pragma unroll
    for (int i = 0; i < 8; ++i) pw[i] = (bf16x8){0, 0, 0, 0, 0, 0, 0, 0};
#pragma unroll
    for (int i = 0; i < 8; ++i)
#pragma unroll
      for (int k2 = 0; k2 < 2; ++k2) sw[i][k2] = (f32x4){NEGV, NEGV, NEGV, NEGV};
#pragma unroll
    for (int st = 0; st < 3; ++st) {
      if (st < 2 && !haswin) continue;
      lds_barrier();
      int tq = tid; asm volatile("" : "+v"(tq));
#pragma unroll
      for (int hf = 0; hf < 2; ++hf) {
        u32x4 u[4];
#pragma unroll
        for (int i = 0; i < 4; ++i) {
          const int q = tq + (hf * 4 + i) * 256, key = q >> 3, c = q & 7, tl = key >> 6;
          const int base = (st < 2) ? b * SEQ + (rs + st * 4 + tl) * 64 : NL + b * CTXL + tl * 64;
          u[i] = *(const u32x4*)(Kb + (size_t)(base + (key & 63)) * 1024 + h * 64 + c * 8);
        }
#pragma unroll
        for (int i = 0; i < 4; ++i) {
          const int q = tq + (hf * 4 + i) * 256, key = q >> 3, c = q & 7;
          *(u32x4*)(Ks + lds_off(key, c)) = u[i];
        }
        __builtin_amdgcn_sched_barrier(0);
      }
      lds_barrier();
      if (st < 2) {
#pragma unroll
        for (int tl = 0; tl < 4; ++tl) {
          const int i = st * 4 + tl;
          const int dr = rs + i - r + 7;
#pragma unroll
          for (int k2 = 0; k2 < 2; ++k2) {
            f32x4 acc = (f32x4){0.f, 0.f, 0.f, 0.f};
#pragma unroll
            for (int ks = 0; ks < 2; ++ks) {
              const bf16x8 kf = *(const bf16x8*)(Ks + lds_off(tl * 64 + bs + k2 * 16 + fr, ks * 4 + fq));
              acc = __builtin_amdgcn_mfma_f32_16x16x32_bf16(kf, qf[ks], acc, 0, 0, 0);
            }
#pragma unroll
            for (int e = 0; e < 4; ++e) {
              const int kc = bs + k2 * 16 + fq * 4 + e;
              const bool valid = (kc >= wsq) && (kc < wsq + 16);
              const int dc = min(max(kc - qcol, -15), 15) + 15;
              sw[i][k2][e] = valid ? acc[e] + rpbs[dr * 31 + dc] : NEGV;
            }
          }
          __builtin_amdgcn_sched_barrier(0);
        }
      } else {
#pragma unroll
        for (int tl = 0; tl < 4; ++tl)
#pragma unroll
          for (int k4 = 0; k4 < 4; ++k4) {
            f32x4 acc = (f32x4){0.f, 0.f, 0.f, 0.f};
#pragma unroll
            for (int ks = 0; ks < 2; ++ks) {
              const bf16x8 kf = *(const bf16x8*)(Ks + lds_off(tl * 64 + k4 * 16 + fr, ks * 4 + fq));
              acc = __builtin_amdgcn_mfma_f32_16x16x32_bf16(kf, qf[ks], acc, 0, 0, 0);
            }
            sc[tl][k4] = acc;
            if (k4 & 1) __builtin_amdgcn_sched_barrier(0);
          }
      }
      if (st == 1) {
#pragma unroll
        for (int i = 0; i < 8; ++i)
#pragma unroll
          for (int k2 = 0; k2 < 2; ++k2)
#pragma unroll
            for (int e = 0; e < 4; ++e) m1 = fmaxf(m1, sw[i][k2][e]);
        m1 = fmaxf(m1, __shfl_xor(m1, 16));
        m1 = fmaxf(m1, __shfl_xor(m1, 32));
#pragma unroll
        for (int i = 0; i < 8; ++i) {
          float e0[4], e1[4];
#pragma unroll
          for (int e = 0; e < 4; ++e) { e0[e] = __expf(sw[i][0][e] - m1); e1[e] = __expf(sw[i][1][e] - m1); l1 += e0[e] + e1[e]; }
          u32x4 u = (u32x4){pk2(e0[0], e0[1]), pk2(e0[2], e0[3]), pk2(e1[0], e1[1]), pk2(e1[2], e1[3])};
          pw[i] = __builtin_bit_cast(bf16x8, u);
        }
        l1 += __shfl_xor(l1, 16);
        l1 += __shfl_xor(l1, 32);
      }
    }
    float m2 = NEGV;
#pragma unroll
    for (int tl = 0; tl < 4; ++tl)
#pragma unroll
      for (int k4 = 0; k4 < 4; ++k4)
#pragma unroll
        for (int e = 0; e < 4; ++e) m2 = fmaxf(m2, sc[tl][k4][e]);
    m2 = fmaxf(m2, __shfl_xor(m2, 16));
    m2 = fmaxf(m2, __shfl_xor(m2, 32));
    const float mx = fmaxf(m1, m2);
    const float alpha1 = __expf(m1 - mx);
    float l2 = 0.f;
    bf16x8 pc[4][2];
#pragma unroll
    for (int tl = 0; tl < 4; ++tl)
#pragma unroll
      for (int g2 = 0; g2 < 2; ++g2) {
        float e0[4], e1[4];
#pragma unroll
        for (int e = 0; e < 4; ++e) { e0[e] = __expf(sc[tl][2 * g2][e] - mx); e1[e] = __expf(sc[tl][2 * g2 + 1][e] - mx); l2 += e0[e] + e1[e]; }
        u32x4 u = (u32x4){pk2(e0[0], e0[1]), pk2(e0[2], e0[3]), pk2(e1[0], e1[1]), pk2(e1[2], e1[3])};
        pc[tl][g2] = __builtin_bit_cast(bf16x8, u);
      }
    l2 += __shfl_xor(l2, 16);
    l2 += __shfl_xor(l2, 32);
    const float l = alpha1 * l1 + l2;
    f32x4 o[4];
#pragma unroll
    for (int dt = 0; dt < 4; ++dt) o[dt] = (f32x4){0.f, 0.f, 0.f, 0.f};
#pragma unroll
    for (int st = 0; st < 3; ++st) {
      if (st < 2 && !haswin) continue;
      lds_barrier();
      int tq = tid; asm volatile("" : "+v"(tq));
#pragma unroll
      for (int hf = 0; hf < 2; ++hf) {
        u32x4 u[4];
#pragma unroll
        for (int i = 0; i < 4; ++i) {
          const int q = tq + (hf * 4 + i) * 256, tl = q >> 9, dd = (q >> 3) & 63, c = q & 7;
          const int base = (st < 2) ? b * SEQ + (rs + st * 4 + tl) * 64 : NL + b * CTXL + tl * 64;
          u[i] = *(const u32x4*)(Vt + (size_t)(h * 64 + dd) * MT + base + c * 8);
        }
#pragma unroll
        for (int i = 0; i < 4; ++i) {
          const int q = tq + (hf * 4 + i) * 256, tl = q >> 9, dd = (q >> 3) & 63, c = q & 7;
          *(u32x4*)(Vs + tl * 4608 + dd * 72 + c * 8) = u[i];
        }
        __builtin_amdgcn_sched_barrier(0);
      }
      lds_barrier();
      if (st < 2) {
#pragma unroll
        for (int tl = 0; tl < 4; ++tl) {
          const int i = st * 4 + tl;
#pragma unroll
          for (int dt = 0; dt < 4; ++dt) {
            const bf* vp = Vs + tl * 4608 + (dt * 16 + fr) * 72 + bs + fq * 4;
            const u32x2 lo = *(const u32x2*)vp, hi = *(const u32x2*)(vp + 16);
            u32x4 u = (u32x4){lo.x, lo.y, hi.x, hi.y};
            o[dt] = __builtin_amdgcn_mfma_f32_16x16x32_bf16(__builtin_bit_cast(bf16x8, u), pw[i], o[dt], 0, 0, 0);
          }
          __builtin_amdgcn_sched_barrier(0);
        }
      } else {
#pragma unroll
        for (int tl = 0; tl < 4; ++tl)
#pragma unroll
          for (int g2 = 0; g2 < 2; ++g2)
#pragma unroll
            for (int dt = 0; dt < 4; ++dt) {
              const bf* vp = Vs + tl * 4608 + (dt * 16 + fr) * 72 + g2 * 32 + fq * 4;
              const u32x2 lo = *(const u32x2*)vp, hi = *(const u32x2*)(vp + 16);
              u32x4 u = (u32x4){lo.x, lo.y, hi.x, hi.y};
              o[dt] = __builtin_amdgcn_mfma_f32_16x16x32_bf16(__builtin_bit_cast(bf16x8, u), pc[tl][g2], o[dt], 0, 0, 0);
              if (dt == 3) __builtin_amdgcn_sched_barrier(0);
            }
      }
      if (st == 1) {
#pragma unroll
        for (int dt = 0; dt < 4; ++dt) o[dt] *= alpha1;
      }
    }
    const float inv = 1.f / l;
#pragma unroll
    for (int dt = 0; dt < 4; ++dt) {
      const size_t off = (size_t)qtok * 1024 + h * 64 + dt * 16 + fq * 4;
      const u32x2 ug = *(const u32x2*)(Gb + off);
      const float g0 = bflo(ug.x), g1 = bfhi(ug.x), g2 = bflo(ug.y), g3 = bfhi(ug.y);
      *(u32x2*)(p.H + (size_t)qtok * LDH + h * 64 + dt * 16 + fq * 4) = (u32x2){pk2(o[dt][0] * inv * siluf(g0), o[dt][1] * inv * siluf(g1)),
                                        pk2(o[dt][2] * inv * siluf(g2), o[dt][3] * inv * siluf(g3))};
    }
  }
}


#define XB_TMO      128
#define XB_XCNT(j)  (256  + 64 * (j))
#define XB_XSUB(j)  (1280 + 64 * (j))
#define XB_XGEN(j)  (2304 + 64 * (j))
#define XB_TOP      3328
#define XB_TOPGEN   3392
#define XCD_BAR_WORDS 3456
#define XB_SPIN_CAP (1u << 18)
__device__ __forceinline__ unsigned xb_ld(unsigned* q) { return __hip_atomic_load(q, __ATOMIC_RELAXED, __HIP_MEMORY_SCOPE_AGENT); }
__device__ __forceinline__ unsigned xb_add(unsigned* q, unsigned v) { return __hip_atomic_fetch_add(q, v, __ATOMIC_RELAXED, __HIP_MEMORY_SCOPE_AGENT); }
__device__ __forceinline__ unsigned xb_xcc_id() { return (unsigned)__builtin_amdgcn_s_getreg((3 << 11) | 20) & 0xFu; }
#define XB_SPIN(cond, bar) do { unsigned _sp = 0; while (cond) { __builtin_amdgcn_s_sleep(1); \
    if ((++_sp & 255u) == 0u) { if (xb_ld(&(bar)[XB_TMO])) break; if (_sp > XB_SPIN_CAP) { atomicAdd(&(bar)[XB_TMO], 1u); break; } } } } while (0)
struct XcdBarrier { unsigned* bar; unsigned x, nloc, nx; };
__device__ __forceinline__ void xcd_barrier(const XcdBarrier& b) {
  asm volatile("s_waitcnt vmcnt(0)" ::: "memory");
  __syncthreads();
  if (threadIdx.x == 0) {
    unsigned* bar = b.bar;
    __builtin_amdgcn_s_waitcnt(0);
    const unsigned nloc = b.nloc, nx = b.nx;
    const unsigned old = xb_add(&bar[XB_XSUB(b.x)], 1u);
    const unsigned gen = old / nloc;
    if (old + 1u == (gen + 1u) * nloc) {
      __builtin_amdgcn_fence(__ATOMIC_RELEASE, "agent");
      asm volatile("s_waitcnt vmcnt(0)" ::: "memory");
      const unsigned og = xb_add(&bar[XB_TOP], 1u);
      const unsigned tg = og / nx;
      if (og + 1u == (tg + 1u) * nx) xb_add(&bar[XB_TOPGEN], 1u);
      else XB_SPIN(xb_ld(&bar[XB_TOPGEN]) == tg, bar);
      __builtin_amdgcn_fence(__ATOMIC_ACQUIRE, "agent");
      xb_add(&bar[XB_XGEN(b.x)], 1u);
      asm volatile("s_waitcnt vmcnt(0)" ::: "memory");
    } else {
      XB_SPIN(xb_ld(&bar[XB_XGEN(b.x)]) == gen, bar);
      __builtin_amdgcn_fence(__ATOMIC_ACQUIRE, "agent");
      asm volatile("s_waitcnt vmcnt(0)" ::: "memory");
    }
  }
  __syncthreads();
}

#ifndef DUP_SCAN
#define DUP_SCAN 0
#endif
#ifndef DUP_ATTN
#define DUP_ATTN 0
#endif
#ifndef DUP_GEMM
#define DUP_GEMM 0
#endif
#ifndef MULTI_LAUNCH
#define MULTI_LAUNCH 0
#endif
__device__ __forceinline__ bool step_exists(int i, int s) {
  if (s == 2) return i == 2;
  if (s == 4) return (i & 1) == 0;
  return true;
}
__device__ __forceinline__ void run_step(const Params& p, int i, int s, char* smem) {
  asm volatile("" : "+s"(i));
  const int j = i >> 1;
  if (s == 0) { transpose_phase(p, i, smem); row_phase(p, i); }
  else if (s == 1) {
    if ((i & 1) == 0) {
      EpiRwkvProj ep{p.R, p.K, (j == 0) ? p.VF : p.V2, p.G, p.HID};
#pragma unroll 1
      for (int rep = PROBE_GEMM ? 0 : 1; rep < 2; ++rep)
      gemm_phase<1>(p.H, LDH, p.Wp, LDW, 16, MT / 128, (j == 0) ? 34 : 35, p.rw_mu + (size_t)j * 6 * 1024, ep, smem, rep == 0);
    } else {
      EpiNaProj ep{p.R, p.K, p.V2, p.G, p.na_b_in + (size_t)j * 4096};
#pragma unroll 1
      for (int rep = PROBE_GEMM ? 0 : 1; rep < 2; ++rep)
      gemm_phase<0>(p.H, LDH, p.Wp, LDW, 16, MT / 128, 32, nullptr, ep, smem, rep == 0);
    }
  } else if (s == 2) {
    EpiVres ev{p.V2, p.VF, p.rw_v0};
    gemm_phase<0>(p.HID + 256, HIDW, p.v2t, 64, 1, MT / 128, 8, nullptr, ev, smem);
  } else if (s == 3) {
    if ((i & 1) == 0) scan_phase(p, j, smem);
    else attn_phase(p, j, i != 3, smem);
  } else if (s == 4) {
    og_phase(p, j);
  } else {
    EpiOut eo{p.R};
#pragma unroll 1
    for (int rep = PROBE_GEMM ? 0 : 1; rep < 2; ++rep)
    gemm_phase<0>(p.H, LDH, p.Wo, LDW, 16, (i == 3) ? NL / 128 : MT / 128, 8, nullptr, eo, smem, rep == 0);
  }
}

__global__ void __launch_bounds__(256, 2) fwd_megakernel(Params p0) {
  __shared__ __attribute__((aligned(16))) char smem[SMEM_BYTES];
  cg::grid_group grid = cg::this_grid();
  XcdBarrier xb;
  xb.bar = p0.bar; xb.x = xb_xcc_id(); xb.nloc = 0u; xb.nx = 0u;
  if (threadIdx.x == 0) (void)xb_add(&xb.bar[XB_XCNT(xb.x)], 1u);
  pre_phase(p0, smem);
  grid.sync();
  {
    unsigned cnt = 0u, mine = 0u;
#pragma unroll 1
    for (unsigned jj = 0; jj < 16; ++jj) { const unsigned c = xb_ld(&xb.bar[XB_XCNT(jj)]); cnt += (c > 0u) ? 1u : 0u; mine = (jj == xb.x) ? c : mine; }
    xb.nloc = mine > 0u ? mine : 1u; xb.nx = cnt > 0u ? cnt : 1u;
  }
  const Params& p = p0;
#pragma unroll 1
  for (int i = 0; i < 4; ++i) {
#pragma unroll 1
    for (int s = 0; s < 6; ++s) {
      if (!step_exists(i, s)) continue;
      int reps = 1;
      if (DUP_SCAN && s == 3 && (i & 1) == 0) reps = 2;
      if (DUP_ATTN && s == 3 && (i & 1) == 1) reps = 2;
      if (DUP_GEMM && (s == 1 || s == 5)) reps = 2;
#pragma unroll 1
      for (int rep = 0; rep < reps; ++rep) {
        run_step(p, i, s, smem);
        xcd_barrier(xb);
      }
    }
  }
  row_phase(p, 4);
}

#if MULTI_LAUNCH
template <int S> __global__ void __launch_bounds__(256, 2) step_kernel(Params p0, int i) {
  __shared__ __attribute__((aligned(16))) char smem[SMEM_BYTES];
  if (S == -1) { pre_phase(p0, smem); return; }
  if (S == 6) { row_phase(p0, 4); return; }
  run_step(p0, i, S, smem);
}
#endif

extern "C" void kernel_launch(void* const* d_in, const int* in_sizes, int n_in, void* d_out, int out_size, void* d_ws, size_t ws_size,
                              hipStream_t stream) {
  static int grid_blocks = 0;
  if (!grid_blocks) {
    int dev = 0, cus = 0, per_cu = 0;
    hipGetDevice(&dev);
    hipDeviceGetAttribute(&cus, hipDeviceAttributeMultiprocessorCount, dev);
    hipOccupancyMaxActiveBlocksPerMultiprocessor(&per_cu, fwd_megakernel, 256, 0);
    if (per_cu > 2) per_cu = 2;
    if (per_cu < 1) per_cu = 1;
    grid_blocks = cus * per_cu;
  }
  Params p{};
  const float** f = (const float**)&p;
  for (int i = 0; i < 29; ++i) f[i] = (const float*)d_in[i];
  p.out = (float*)d_out;
  char* w = (char*)d_ws;
  size_t off = 0;
  auto take = [&](size_t bytes) { char* r = w + off; off += (bytes + 255) & ~(size_t)255; return r; };
  p.gp = (Params*)take(sizeof(Params));
  p.bar = (unsigned*)take((size_t)XCD_BAR_WORDS * 4);
  p.mod = (float*)take((size_t)4 * 9 * 3072 * 4);
  p.ctxbuf = (float*)take((size_t)NC * 1024 * 4);
  p.beta = (float*)take((size_t)2 * MT * 16 * 4);
  p.Wp = (bf*)take((size_t)4480 * LDW * 2);
  p.Wo = (bf*)take((size_t)1024 * LDW * 2);
  p.w2t = (bf*)take((size_t)2 * 65536 * 2);
  p.a2t = (bf*)take((size_t)2 * 65536 * 2);
  p.v2t = (bf*)take((size_t)65536 * 2);
  const size_t big = (size_t)MT * 1024 * 2;
  p.H = (bf*)take((size_t)MT * LDH * 2); p.R = (bf*)take(big); p.K = (bf*)take(big); p.VF = (bf*)take(big);
  p.V2 = (bf*)take(big); p.G = (bf*)take(big); p.Y1 = (bf*)take(big);
  p.HID = (bf*)take((size_t)MT * HIDW * 2);
  if (off > ws_size) fprintf(stderr, "workspace too small: need %zu have %zu\n", off, ws_size);
#if MULTI_LAUNCH
  step_kernel<-1><<<grid_blocks, 256, 0, stream>>>(p, 0);
  for (int i = 0; i < 4; ++i) {
    step_kernel<0><<<grid_blocks, 256, 0, stream>>>(p, i);
    step_kernel<1><<<grid_blocks, 256, 0, stream>>>(p, i);
    if (i == 2) step_kernel<2><<<grid_blocks, 256, 0, stream>>>(p, i);
    step_kernel<3><<<grid_blocks, 256, 0, stream>>>(p, i);
    if ((i & 1) == 0) step_kernel<4><<<grid_blocks, 256, 0, stream>>>(p, i);
    step_kernel<5><<<grid_blocks, 256, 0, stream>>>(p, i);
  }
  step_kernel<6><<<grid_blocks, 256, 0, stream>>>(p, 0);
#else
  (void)hipMemsetAsync(p.bar, 0, (size_t)XCD_BAR_WORDS * 4, stream);
  void* args[] = {&p};
  hipError_t e = hipLaunchCooperativeKernel((void*)fwd_megakernel, dim3(grid_blocks), dim3(256), args, 0, stream);
  if (e != hipSuccess) fprintf(stderr, "cooperative launch failed: %s (grid %d)\n", hipGetErrorString(e), grid_blocks);
#endif
}
```

```cpp
#include <hip/hip_runtime.h>
#include <hip/hip_cooperative_groups.h>
#include <cstdint>
#include <cstdio>
namespace cg = cooperative_groups;

typedef unsigned short bf;
typedef short bf16x8 __attribute__((ext_vector_type(8)));
typedef float f32x4 __attribute__((ext_vector_type(4)));
typedef unsigned u32x4 __attribute__((ext_vector_type(4)));
typedef unsigned u32x2 __attribute__((ext_vector_type(2)));

constexpr int DM = 1024, NB = 8, SEQ = 8192, NL = NB * SEQ, CTXL = 256, NC = NB * CTXL, MT = NL + NC;
constexpr int HIDW = 384;
constexpr int LDH = 1088, LDW = 1088;
constexpr int SMEM_BYTES = 65536;
#define NEGV (-1e30f)
#ifndef PROBE_GEMM
#define PROBE_GEMM 0
#endif

struct Params {
  const float *x, *c, *ctx, *c_ctx, *ada_w, *ada_b, *pre_g, *post_g, *rw_mu, *rw_w_rkvg, *rw_w0, *rw_w1, *rw_w2,
      *rw_a0, *rw_a1, *rw_a2, *rw_v0, *rw_v1, *rw_v2, *rw_k_k, *rw_k_a, *rw_r_k, *rw_lnx_w, *rw_lnx_b, *rw_w_out,
      *na_w_in, *na_b_in, *na_rpb, *na_w_out;
  float* out;
  float *mod, *ctxbuf, *beta;
  bf *Wp, *Wo, *w2t, *a2t, *v2t;
  bf *H, *R, *K, *VF, *V2, *G, *Y1, *HID;
  Params* gp;
  unsigned* bar;
};

__device__ __forceinline__ float bflo(unsigned w) { return __uint_as_float(w << 16); }
__device__ __forceinline__ float bfhi(unsigned w) { return __uint_as_float(w & 0xffff0000u); }
typedef __bf16 bf16x2_t __attribute__((ext_vector_type(2)));
__device__ __forceinline__ unsigned pk2(float lo, float hi) {
  bf16x2_t v = {(__bf16)lo, (__bf16)hi};
  return __builtin_bit_cast(unsigned, v);
}
__device__ __forceinline__ float siluf(float v) { return v / (1.f + __expf(-v)); }
__device__ __forceinline__ float sigmf(float v) { return 1.f / (1.f + __expf(-v)); }
__device__ __forceinline__ float quad_sum(float v) {
  int t = __builtin_amdgcn_update_dpp(0, __float_as_int(v), 0xB1, 0xF, 0xF, true);
  v += __int_as_float(t);
  t = __builtin_amdgcn_update_dpp(0, __float_as_int(v), 0x4E, 0xF, 0xF, true);
  v += __int_as_float(t);
  return v;
}
__device__ __forceinline__ float wave_sum(float v) {
#pragma unroll
  for (int o = 32; o >= 1; o >>= 1) v += __shfl_xor(v, o);
  return v;
}
__device__ __forceinline__ int otid() { int t = threadIdx.x; asm volatile("" : "+v"(t)); return t; }
__device__ __forceinline__ void lds_barrier() { asm volatile("s_waitcnt lgkmcnt(0)\n\ts_barrier" ::: "memory"); }
__device__ __forceinline__ int lds_off(int row, int c) { return row * 128 + ((c ^ ((row >> 1) & 7)) << 4); }
__device__ __forceinline__ unsigned lerp2(unsigned hm, unsigned h0, unsigned hp, float m0, float m1) {
  const float c0 = bflo(h0), c1 = bfhi(h0);
  const float x0 = 0.5f * (bflo(hm) + bflo(hp)) - c0;
  const float x1 = 0.5f * (bfhi(hm) + bfhi(hp)) - c1;
  return pk2(c0 + x0 * m0, c1 + x1 * m1);
}
__device__ __forceinline__ int mod_idx(int row) { return row < NL ? (row >> 13) : 8; }

__device__ void pre_phase(const Params& p, char* smem) {
  float* s = (float*)smem;
  float* red = s + 9 * 1024;
  const int tid = otid();
  for (int item = blockIdx.x; item < 4 * 48; item += gridDim.x) {
    const int i = item / 48, cb = item % 48;
    __syncthreads();
    for (int idx = tid; idx < 9 * 1024; idx += 256) {
      const int m = idx >> 10, k = idx & 1023;
      const float v = (m < 8) ? p.c[m * 1024 + k] : p.c_ctx[k];
      s[idx] = siluf(v);
    }
    __syncthreads();
    const int cc = tid & 63, kq = tid >> 6;
    float acc[9];
#pragma unroll
    for (int m = 0; m < 9; ++m) acc[m] = 0.f;
    const float* W = p.ada_w + (size_t)i * 1024 * 3072 + cb * 64 + cc;
    for (int k = kq * 256; k < kq * 256 + 256; ++k) {
      const float w = W[(size_t)k * 3072];
#pragma unroll
      for (int m = 0; m < 9; ++m) acc[m] += s[m * 1024 + k] * w;
    }
#pragma unroll
    for (int m = 0; m < 9; ++m) red[(kq * 9 + m) * 64 + cc] = acc[m];
    __syncthreads();
    for (int idx = tid; idx < 9 * 64; idx += 256) {
      const int m = idx >> 6, c2 = idx & 63;
      float v = red[(0 * 9 + m) * 64 + c2] + red[(1 * 9 + m) * 64 + c2] + red[(2 * 9 + m) * 64 + c2] + red[(3 * 9 + m) * 64 + c2];
      v += p.ada_b[i * 3072 + cb * 64 + c2];
      p.mod[(size_t)(i * 9 + m) * 3072 + cb * 64 + c2] = v;
    }
  }
}

struct TOp { const float* src; bf* dst; int K, N, Kp, Np, ldd; };
__device__ bool get_op(const Params& p, int i, int op, TOp& o) {
  const int j = i >> 1;
  if (i & 1) {
    if (op == 0) { o = {p.na_w_in + (size_t)j * 1024 * 4096, p.Wp, 1024, 4096, 1024, 4096, LDW}; return true; }
    if (op == 1) { o = {p.na_w_out + (size_t)j * 1024 * 1024, p.Wo, 1024, 1024, 1024, 1024, LDW}; return true; }
    return false;
  }
  if (op < 4) { o = {p.rw_w_rkvg + ((size_t)j * 4 + op) * 1024 * 1024, p.Wp + (size_t)op * 1024 * LDW, 1024, 1024, 1024, 1024, LDW}; return true; }
  if (op < 6) { const int d = op - 4; o = {p.rw_w1 + ((size_t)j * 2 + d) * 1024 * 64, p.Wp + (size_t)(4096 + d * 64) * LDW, 1024, 64, 1024, 64, LDW}; return true; }
  if (op < 8) { const int d = op - 6; o = {p.rw_a1 + ((size_t)j * 2 + d) * 1024 * 64, p.Wp + (size_t)(4224 + d * 64) * LDW, 1024, 64, 1024, 64, LDW}; return true; }
  if (op < 10) { const int d = op - 8; o = {p.rw_w2 + ((size_t)j * 2 + d) * 64 * 1024, p.w2t + (size_t)d * 65536, 64, 1024, 64, 1024, 64}; return true; }
  if (op < 12) { const int d = op - 10; o = {p.rw_a2 + ((size_t)j * 2 + d) * 64 * 1024, p.a2t + (size_t)d * 65536, 64, 1024, 64, 1024, 64}; return true; }
  if (op == 12) { o = {p.rw_w_out + (size_t)j * 1024 * 1024, p.Wo, 1024, 1024, 1024, 1024, LDW}; return true; }
  if (j == 1 && op == 13) { o = {p.rw_v1, p.Wp + (size_t)4352 * LDW, 1024, 32, 1024, 128, LDW}; return true; }
  if (j == 1 && op == 14) { o = {p.rw_v2, p.v2t, 32, 1024, 64, 1024, 64}; return true; }
  return false;
}

__device__ void transpose_phase(const Params& p, int i, char* smem) {
  float* t = (float*)smem;
  const int tid = otid();
  int base = 0;
  for (int op = 0;; ++op) {
    TOp o;
    if (!get_op(p, i, op, o)) break;
    const int tk = o.Kp / 64, tn = o.Np / 64, nt = tk * tn;
    int first = blockIdx.x - (base % (int)gridDim.x);
    if (first < 0) first += gridDim.x;
    for (int g = first; g < nt; g += gridDim.x) {
      const int kt = g / tn, ntile = g % tn;
      __syncthreads();
#pragma unroll
      for (int ps = 0; ps < 4; ++ps) {
        const int kr = ps * 16 + (tid >> 4), c4 = (tid & 15) * 4;
        const int k = kt * 64 + kr, n = ntile * 64 + c4;
        f32x4 v = (f32x4){0.f, 0.f, 0.f, 0.f};
        if (k < o.K && n < o.N) v = *(const f32x4*)(o.src + (size_t)k * o.N + n);
        t[kr * 65 + c4 + 0] = v.x; t[kr * 65 + c4 + 1] = v.y; t[kr * 65 + c4 + 2] = v.z; t[kr * 65 + c4 + 3] = v.w;
      }
      __syncthreads();
      const int n = tid >> 2, kc = (tid & 3) * 16;
      unsigned w[8];
#pragma unroll
      for (int e = 0; e < 8; ++e) w[e] = pk2(t[(kc + 2 * e) * 65 + n], t[(kc + 2 * e + 1) * 65 + n]);
      bf* d = o.dst + (size_t)(ntile * 64 + n) * o.ldd + kt * 64 + kc;
      *(u32x4*)d = (u32x4){w[0], w[1], w[2], w[3]};
      *(u32x4*)(d + 8) = (u32x4){w[4], w[5], w[6], w[7]};
    }
    base += nt;
  }
}

template <bool UPD, bool MKH>
__device__ __forceinline__ void row_phase_t(const Params& p, int i) {
  const int tid = otid(), lane = tid & 63;
  const int gw = blockIdx.x * 4 + (tid >> 6), nw = gridDim.x * 4;
  const int nrows = MKH ? MT : NL;
  for (int row0 = gw; row0 < nrows; row0 += 2 * nw) {
    const bool valid1 = (row0 + nw) < nrows;
    const int rws[2] = {row0, valid1 ? row0 + nw : row0};
    f32x4 xv[2][4];
    u32x2 ou[2][4];
#pragma unroll
    for (int u = 0; u < 2; ++u) {
      const int row = rws[u];
      const float* xs;
      if (i <= 1) xs = (row < NL) ? p.x + (size_t)row * 1024 : p.ctx + (size_t)(row - NL) * 1024;
      else xs = (row < NL) ? p.out + (size_t)row * 1024 : p.ctxbuf + (size_t)(row - NL) * 1024;
#pragma unroll
      for (int q = 0; q < 4; ++q) xv[u][q] = *(const f32x4*)(xs + q * 256 + lane * 4);
      if (UPD) {
        const bf* orow = p.R + (size_t)row * 1024;
#pragma unroll
        for (int q = 0; q < 4; ++q) ou[u][q] = *(const u32x2*)(orow + q * 256 + lane * 4);
      }
    }
#pragma unroll
    for (int u = 0; u < 2; ++u) {
      const int row = rws[u];
      const bool st = (u == 0) || valid1;
      const int m = mod_idx(row);
      if (UPD) {
        float ov[4][4];
        float ss = 0.f;
#pragma unroll
        for (int q = 0; q < 4; ++q) {
          ov[q][0] = bflo(ou[u][q].x); ov[q][1] = bfhi(ou[u][q].x); ov[q][2] = bflo(ou[u][q].y); ov[q][3] = bfhi(ou[u][q].y);
          ss += ov[q][0] * ov[q][0] + ov[q][1] * ov[q][1] + ov[q][2] * ov[q][2] + ov[q][3] * ov[q][3];
        }
        ss = wave_sum(ss);
        const float rs = rsqrtf(ss * (1.f / 1024.f) + 1e-6f);
        const float* gate = p.mod + (size_t)((i - 1) * 9 + m) * 3072 + 2048;
        const float* pg = p.post_g + (i - 1) * 1024;
        float* xd = (row < NL) ? p.out + (size_t)row * 1024 : p.ctxbuf + (size_t)(row - NL) * 1024;
#pragma unroll
        for (int q = 0; q < 4; ++q) {
          const int col = q * 256 + lane * 4;
          const f32x4 gv = *(const f32x4*)(gate + col);
          const f32x4 pv = *(const f32x4*)(pg + col);
          xv[u][q].x += gv.x * ov[q][0] * rs * pv.x;
          xv[u][q].y += gv.y * ov[q][1] * rs * pv.y;
          xv[u][q].z += gv.z * ov[q][2] * rs * pv.z;
          xv[u][q].w += gv.w * ov[q][3] * rs * pv.w;
          if (st) *(f32x4*)(xd + col) = xv[u][q];
        }
      }
      if (MKH) {
        float ss = 0.f;
#pragma unroll
        for (int q = 0; q < 4; ++q) ss += xv[u][q].x * xv[u][q].x + xv[u][q].y * xv[u][q].y + xv[u][q].z * xv[u][q].z + xv[u][q].w * xv[u][q].w;
        ss = wave_sum(ss);
        const float rs = rsqrtf(ss * (1.f / 1024.f) + 1e-6f);
        const float* md = p.mod + (size_t)(i * 9 + m) * 3072;
        const float* pg = p.pre_g + i * 1024;
        bf* hd = p.H + (size_t)row * LDH;
#pragma unroll
        for (int q = 0; q < 4; ++q) {
          const int col = q * 256 + lane * 4;
          const f32x4 sh = *(const f32x4*)(md + col);
          const f32x4 sc = *(const f32x4*)(md + 1024 + col);
          const f32x4 pv = *(const f32x4*)(pg + col);
          const float h0 = xv[u][q].x * rs * pv.x * (1.f + sc.x) + sh.x;
          const float h1 = xv[u][q].y * rs * pv.y * (1.f + sc.y) + sh.y;
          const float h2 = xv[u][q].z * rs * pv.z * (1.f + sc.z) + sh.z;
          const float h3 = xv[u][q].w * rs * pv.w * (1.f + sc.w) + sh.w;
          if (st) *(u32x2*)(hd + col) = (u32x2){pk2(h0, h1), pk2(h2, h3)};
        }
      }
    }
  }
}
__device__ __forceinline__ void row_phase(const Params& p, int i) {
  if (i == 0) row_phase_t<false, true>(p, i);
  else if (i < 4) row_phase_t<true, true>(p, i);
  else row_phase_t<true, false>(p, i);
}

struct EpiRwkvProj {
  bf *R, *K, *V, *G, *HID;
  __device__ __forceinline__ void operator()(int nt, int tok, int col, f32x4 v) const {
    bf* dst;
    if (nt < 8) dst = R + (size_t)tok * 1024 + col;
    else if (nt < 16) dst = K + (size_t)tok * 1024 + (col - 1024);
    else if (nt < 24) dst = V + (size_t)tok * 1024 + (col - 2048);
    else if (nt < 32) {
      dst = G + (size_t)tok * 1024 + (col - 3072);
#pragma unroll
      for (int e = 0; e < 4; ++e) v[e] = siluf(v[e]);
    } else {
      dst = HID + (size_t)tok * HIDW + (col - 4096);
      if (nt == 32) {
#pragma unroll
        for (int e = 0; e < 4; ++e) v[e] = tanhf(v[e]);
      }
    }
    *(u32x2*)dst = (u32x2){pk2(v[0], v[1]), pk2(v[2], v[3])};
  }
};
struct EpiNaProj {
  bf *Q, *K, *Vt, *G; const float* bias;
  __device__ __forceinline__ void operator()(int nt, int tok, int col, f32x4 v) const {
    const f32x4 b = *(const f32x4*)(bias + col);
    v[0] += b.x; v[1] += b.y; v[2] += b.z; v[3] += b.w;
    if (nt >= 16 && nt < 24) {
      const int c = col - 2048;
#pragma unroll
      for (int e = 0; e < 4; ++e) Vt[(size_t)(c + e) * MT + tok] = (bf)(pk2(v[e], 0.f) & 0xffffu);
      return;
    }
    bf* dst;
    if (nt < 8) { dst = Q + (size_t)tok * 1024 + col; v[0] *= 0.125f; v[1] *= 0.125f; v[2] *= 0.125f; v[3] *= 0.125f; }
    else if (nt < 16) dst = K + (size_t)tok * 1024 + (col - 1024);
    else dst = G + (size_t)tok * 1024 + (col - 3072);
    *(u32x2*)dst = (u32x2){pk2(v[0], v[1]), pk2(v[2], v[3])};
  }
};
struct EpiOut {
  bf* O;
  __device__ __forceinline__ void operator()(int nt, int tok, int col, f32x4 v) const {
    *(u32x2*)(O + (size_t)tok * 1024 + col) = (u32x2){pk2(v[0], v[1]), pk2(v[2], v[3])};
  }
};
struct EpiVres {
  bf* V2; const bf* VF; const float* v0;
  __device__ __forceinline__ void operator()(int nt, int tok, int col, f32x4 z) const {
    const f32x4 b = *(const f32x4*)(v0 + col);
    const u32x2 uv = *(const u32x2*)(V2 + (size_t)tok * 1024 + col);
    const u32x2 uf = *(const u32x2*)(VF + (size_t)tok * 1024 + col);
    const float v[4] = {bflo(uv.x), bfhi(uv.x), bflo(uv.y), bfhi(uv.y)};
    const float f[4] = {bflo(uf.x), bfhi(uf.x), bflo(uf.y), bfhi(uf.y)};
    const float zz[4] = {z[0] + b.x, z[1] + b.y, z[2] + b.z, z[3] + b.w};
    float r[4];
#pragma unroll
    for (int e = 0; e < 4; ++e) r[e] = v[e] + (f[e] - v[e]) * sigmf(zz[e]);
    *(u32x2*)(V2 + (size_t)tok * 1024 + col) = (u32x2){pk2(r[0], r[1]), pk2(r[2], r[3])};
  }
};

template <int AMODE, class Epi>
__device__ void gemm_phase(const bf* __restrict__ A, int lda, const bf* __restrict__ Bt, int ldb, int nkt, int mtiles, int ntiles,
                           const float* __restrict__ mu, const Epi& epi, char* smem, bool fake = false) {
  const int tid = otid(), lane = tid & 63, wid = tid >> 6, wr = wid >> 1, wc = wid & 1, fr = lane & 15, fq = lane >> 4;
  const int rg = tid >> 3, cch = tid & 7;
  char* As = smem;
  char* Bs = smem + 32768;
  constexpr int GM = 6;
  const int xcd = blockIdx.x & 7, slot = blockIdx.x >> 3, nslots = gridDim.x >> 3;
  const int per_group = GM * ntiles;
  const int ngroups = (mtiles + GM - 1) / GM;
  const int my_groups = (ngroups - xcd + 7) >> 3;
  const int my_total = my_groups * per_group;
  for (int q = slot; q < my_total; q += nslots) {
    const int gi = q / per_group, e = q - gi * per_group;
    const int nt = e / GM, mt = (xcd + 8 * gi) * GM + (e - nt * GM);
    if (mt >= mtiles) continue;
    const int row0 = mt * 128, col0 = nt * 128;
    int lerp = 0; bool sstart = false, send = false;
    if (AMODE == 1) {
      lerp = (nt < 8) ? 0 : (nt < 16) ? 2 : (nt < 24) ? 3 : (nt < 32) ? 5 : (nt == 32) ? 1 : (nt == 33) ? 4 : 3;
      if (row0 < NL) { sstart = (row0 & (SEQ - 1)) == 0; send = ((row0 + 128) & (SEQ - 1)) == 0; }
      else { sstart = ((row0 - NL) & (CTXL - 1)) == 0; send = ((row0 + 128 - NL) & (CTXL - 1)) == 0; }
    }
    f32x4 acc[4][4];
#pragma unroll
    for (int m = 0; m < 4; ++m)
#pragma unroll
      for (int n = 0; n < 4; ++n) acc[m][n] = (f32x4){0.f, 0.f, 0.f, 0.f};
    u32x4 ra[6];
    f32x4 muv[2];
    auto glds_tile = [&](const bf* G, int ld, int grow0, int kt, char* ldsbase) {
#pragma unroll
      for (int pc = 0; pc < 4; ++pc) {
        const int row = wid * 32 + pc * 8 + (lane >> 3), cp = lane & 7, c = cp ^ ((row >> 1) & 7);
        const bf* src = G + (size_t)(grow0 + row) * ld + kt * 64 + c * 8;
        __builtin_amdgcn_global_load_lds((const __attribute__((address_space(1))) void*)src,
                                         (__attribute__((address_space(3))) void*)(ldsbase + row * 128 + cp * 16), 16, 0, 0);
      }
    };
    auto gloadA = [&](int kt) {
      const int kc = kt * 64 + cch * 8;
#pragma unroll
      for (int i = 0; i < 6; ++i) {
        const int r = row0 + rg * 4 + i - 1;
        const bool zero = (i == 0 && rg == 0 && sstart) || (i == 5 && rg == 31 && send);
        ra[i] = zero ? (u32x4){0, 0, 0, 0} : *(const u32x4*)(A + (size_t)r * lda + kc);
      }
      muv[0] = *(const f32x4*)(mu + lerp * 1024 + kc);
      muv[1] = *(const f32x4*)(mu + lerp * 1024 + kc + 4);
    };
    auto lstoreA = [&](int buf) {
      char* a = As + buf * 16384;
#pragma unroll
      for (int i = 0; i < 4; ++i) {
        const u32x4 hm = ra[i], h0 = ra[i + 1], hp = ra[i + 2];
        u32x4 o;
        o.x = lerp2(hm.x, h0.x, hp.x, muv[0].x, muv[0].y);
        o.y = lerp2(hm.y, h0.y, hp.y, muv[0].z, muv[0].w);
        o.z = lerp2(hm.z, h0.z, hp.z, muv[1].x, muv[1].y);
        o.w = lerp2(hm.w, h0.w, hp.w, muv[1].z, muv[1].w);
        *(u32x4*)(a + lds_off(rg * 4 + i, cch)) = o;
      }
    };
    lds_barrier();
    glds_tile(Bt, ldb, col0, 0, Bs);
    if (AMODE == 0) glds_tile(A, lda, row0, 0, As);
    else { gloadA(0); lstoreA(0); }
    asm volatile("s_waitcnt vmcnt(0)" ::: "memory");
    lds_barrier();
    for (int kt = 0; kt < nkt; ++kt) {
      const int buf = kt & 1;
      if (!fake && kt + 1 < nkt) {
        glds_tile(Bt, ldb, col0, kt + 1, Bs + (buf ^ 1) * 16384);
        if (AMODE == 0) glds_tile(A, lda, row0, kt + 1, As + (buf ^ 1) * 16384);
        else gloadA(kt + 1);
      }
      const char* a = As + buf * 16384;
      const char* b = Bs + buf * 16384;
#pragma unroll
      for (int ks = 0; ks < 2; ++ks) {
        bf16x8 af[4], bfr[4];
#pragma unroll
        for (int m = 0; m < 4; ++m) af[m] = *(const bf16x8*)(a + lds_off(wr * 64 + m * 16 + fr, ks * 4 + fq));
#pragma unroll
        for (int n = 0; n < 4; ++n) bfr[n] = *(const bf16x8*)(b + lds_off(wc * 64 + n * 16 + fr, ks * 4 + fq));
        __builtin_amdgcn_s_setprio(1);
#pragma unroll
        for (int m = 0; m < 4; ++m)
#pragma unroll
          for (int n = 0; n < 4; ++n) acc[m][n] = __builtin_amdgcn_mfma_f32_16x16x32_bf16(bfr[n], af[m], acc[m][n], 0, 0, 0);
        __builtin_amdgcn_s_setprio(0);
      }
      if (AMODE == 1 && kt + 1 < nkt) lstoreA(buf ^ 1);
      asm volatile("s_waitcnt vmcnt(0)" ::: "memory");
      lds_barrier();
    }
#pragma unroll
    for (int m = 0; m < 4; ++m)
#pragma unroll
      for (int n = 0; n < 4; ++n) epi(nt, row0 + wr * 64 + m * 16 + fr, col0 + wc * 64 + n * 16 + fq * 4, acc[m][n]);
  }
}

typedef float f32x2 __attribute__((ext_vector_type(2)));
__device__ __forceinline__ float oct_sum(float v) {
  int t = __builtin_amdgcn_update_dpp(0, __float_as_int(v), 0xB1, 0xF, 0xF, true);
  v += __int_as_float(t);
  t = __builtin_amdgcn_update_dpp(0, __float_as_int(v), 0x4E, 0xF, 0xF, true);
  v += __int_as_float(t);
  t = __builtin_amdgcn_update_dpp(0, __float_as_int(v), 0x141, 0xF, 0xF, true);
  v += __int_as_float(t);
  return v;
}
__device__ __forceinline__ f32x2 fma2(f32x2 a, f32x2 b, f32x2 c) { return __builtin_elementwise_fma(a, b, c); }
__device__ __forceinline__ float fma_s(float a, float b, float c) { float d; asm("v_fma_f32 %0, %1, %2, %3" : "=v"(d) : "v"(a), "v"(b), "v"(c)); return d; }
__device__ __forceinline__ float mul_s(float a, float b) { float d; asm("v_mul_f32 %0, %1, %2" : "=v"(d) : "v"(a), "v"(b)); return d; }
struct ScanOps { f32x4 w[2], nk[2], bb[2], kd[2], rr[2]; f32x2 vv; };
__device__ __forceinline__ ScanOps scan_load(const float* ops, const float* vs, int t, int kq, int vrow) {
  ScanOps r;
  const float* o = ops + t * 320 + kq * 8;
  r.w[0] = *(const f32x4*)(o); r.w[1] = *(const f32x4*)(o + 4);
  r.nk[0] = *(const f32x4*)(o + 64); r.nk[1] = *(const f32x4*)(o + 68);
  r.bb[0] = *(const f32x4*)(o + 128); r.bb[1] = *(const f32x4*)(o + 132);
  r.kd[0] = *(const f32x4*)(o + 192); r.kd[1] = *(const f32x4*)(o + 196);
  r.rr[0] = *(const f32x4*)(o + 256); r.rr[1] = *(const f32x4*)(o + 260);
  r.vv = *(const f32x2*)(vs + t * 64 + vrow);
  return r;
}
#define PR(v, i) ((f32x2){(v)[(i) >> 1][((i) & 1) * 2], (v)[(i) >> 1][((i) & 1) * 2 + 1]})

constexpr int SC_P = 0, SC_YA = 8192, SC_V = 16384, SC_AT = 24576, SC_RT = SC_AT + 4352, SC_BT = SC_RT + 4352, SC_KT = SC_BT + 4352;
constexpr int SC_BTT = 41984, SC_KTT = SC_BTT + 4608, SC_MABT = 51200, SC_SM = 53248;
__device__ __forceinline__ bf16x8 mk8(u32x2 lo, u32x2 hi) { u32x4 u = (u32x4){lo.x, lo.y, hi.x, hi.y}; return __builtin_bit_cast(bf16x8, u); }
__device__ __forceinline__ bf16x8 mk4(u32x2 lo) { u32x4 u = (u32x4){lo.x, lo.y, 0u, 0u}; return __builtin_bit_cast(bf16x8, u); }
__device__ __forceinline__ float bfround(float x) { return bflo(pk2(x, 0.f) & 0xffffu); }
__device__ __forceinline__ void split4(f32x4 x, u32x2& hi, u32x2& lo) {
  hi = (u32x2){pk2(x[0], x[1]), pk2(x[2], x[3])};
  const float r0 = x[0] - bflo(hi.x), r1 = x[1] - bfhi(hi.x), r2 = x[2] - bflo(hi.y), r3 = x[3] - bfhi(hi.y);
  lo = (u32x2){pk2(r0, r1), pk2(r2, r3)};
}

__device__ void scan_phase(const Params& p, int j, char* smem) {
  const int tid = otid(), lane = tid & 63, wid = tid >> 6, fr = lane & 15, fq = lane >> 4;
  float* Pbuf = (float*)(smem + SC_P);
  float* abuf = (float*)(smem + SC_YA);
  float* ys = (float*)(smem + SC_YA);
  float* vs = (float*)(smem + SC_V);
  for (int item = blockIdx.x; item < 256; item += gridDim.x) {
  const int b = item >> 5, h = (item >> 1) & 15, d = item & 1;
  lds_barrier();
  const bf* Vsrc = (j == 0) ? p.VF : p.V2;
  bf* Ydst = (d == 0) ? p.H : p.Y1;
  const int ldy = (d == 0) ? LDH : 1024;
  float* betad = p.beta + (size_t)d * MT * 16;
  bf16x8 bw[2], ba[2];
  {
    const int n = h * 64 + wid * 16 + fr;
#pragma unroll
    for (int ks = 0; ks < 2; ++ks) {
      bw[ks] = *(const bf16x8*)(p.w2t + (size_t)d * 65536 + (size_t)n * 64 + ks * 32 + fq * 8);
      ba[ks] = *(const bf16x8*)(p.a2t + (size_t)d * 65536 + (size_t)n * 64 + ks * 32 + fq * 8);
    }
  }
  float w0v[4], a0v[4];
#pragma unroll
  for (int e = 0; e < 4; ++e) {
    w0v[e] = p.rw_w0[(size_t)(j * 2 + d) * 1024 + h * 64 + wid * 16 + fq * 4 + e];
    a0v[e] = p.rw_a0[(size_t)(j * 2 + d) * 1024 + h * 64 + wid * 16 + fq * 4 + e];
  }
  const int tt = tid >> 3, c8 = tid & 7;
  float kkv[8], kav[8], rkv[8];
#pragma unroll
  for (int e = 0; e < 8; ++e) {
    kkv[e] = p.rw_k_k[j * 1024 + h * 64 + c8 * 8 + e];
    kav[e] = p.rw_k_a[j * 1024 + h * 64 + c8 * 8 + e];
    rkv[e] = p.rw_r_k[j * 1024 + h * 64 + c8 * 8 + e];
  }
  f32x4 ST[4];
#pragma unroll
  for (int kt = 0; kt < 4; ++kt) ST[kt] = (f32x4){0.f, 0.f, 0.f, 0.f};

  bf16x8 phw[2][2], pha[2][2];
  u32x4 puk, pur, puv;
  auto rowbase_of = [&](int ch, int& sgn) -> int {
    if (d == 0) { sgn = 1; return (ch < 8) ? NL + b * CTXL + ch * 32 : b * SEQ + (ch - 8) * 32; }
    sgn = -1; return (ch < 8) ? NL + b * CTXL + 255 - ch * 32 : b * SEQ + 8191 - (ch - 8) * 32;
  };
  auto prefetch = [&](int ch) {
    int sgn; const int rowbase = rowbase_of(ch, sgn);
#pragma unroll
    for (int m = 0; m < 2; ++m) {
      const size_t row = (size_t)(rowbase + sgn * (m * 16 + fr));
#pragma unroll
      for (int ks = 0; ks < 2; ++ks) {
        phw[m][ks] = *(const bf16x8*)(p.HID + row * HIDW + d * 64 + ks * 32 + fq * 8);
        pha[m][ks] = *(const bf16x8*)(p.HID + row * HIDW + 128 + d * 64 + ks * 32 + fq * 8);
      }
    }
    const size_t off = (size_t)(rowbase + sgn * tt) * 1024 + h * 64 + c8 * 8;
    puk = *(const u32x4*)(p.K + off);
    pur = *(const u32x4*)(p.R + off);
    puv = *(const u32x4*)(Vsrc + off);
  };
  prefetch(0);

  for (int ch = 0; ch < 264; ++ch) {
    int sgn; const int rowbase = rowbase_of(ch, sgn);
#pragma unroll
    for (int m = 0; m < 2; ++m) {
      const int tok = m * 16 + fr;
      f32x4 aw = (f32x4){0.f, 0.f, 0.f, 0.f}, aa = aw;
#pragma unroll
      for (int ks = 0; ks < 2; ++ks) {
        aw = __builtin_amdgcn_mfma_f32_16x16x32_bf16(bw[ks], phw[m][ks], aw, 0, 0, 0);
        aa = __builtin_amdgcn_mfma_f32_16x16x32_bf16(ba[ks], pha[m][ks], aa, 0, 0, 0);
      }
      f32x4 wd, av;
#pragma unroll
      for (int e = 0; e < 4; ++e) {
        const float z = -(w0v[e] + aw[e]);
        const float sp = fmaxf(z, 0.f) + __logf(1.f + __expf(-fabsf(z)));
        const float wl = -sp - 0.5f;
        wd[e] = __expf(-__expf(wl));
        av[e] = sigmf(a0v[e] + aa[e]);
      }
      *(f32x4*)(Pbuf + tok * 64 + wid * 16 + fq * 4) = wd;
      *(f32x4*)(abuf + tok * 64 + wid * 16 + fq * 4) = av;
    }
    lds_barrier();
    if (tid < 128) {
      const int k = tid & 63, sc = tid >> 6;
      float P = 1.f;
#pragma unroll
      for (int t = 0; t < 16; ++t) { float* q = Pbuf + (sc * 16 + t) * 64 + k; P *= *q; *q = P; }
    }
    lds_barrier();
    {
      const size_t row = (size_t)(rowbase + sgn * tt);
      float k[8], r[8], kk[8];
#pragma unroll
      for (int e = 0; e < 4; ++e) {
        k[2 * e] = bflo(puk[e]); k[2 * e + 1] = bfhi(puk[e]);
        r[2 * e] = bflo(pur[e]); r[2 * e + 1] = bfhi(pur[e]);
      }
      float ss = 0.f;
#pragma unroll
      for (int e = 0; e < 8; ++e) { kk[e] = k[e] * kkv[e]; ss += kk[e] * kk[e]; }
      ss = oct_sum(ss);
      const float inv = 1.f / fmaxf(sqrtf(ss), 1e-12f);
      const f32x4 a0 = *(const f32x4*)(abuf + tt * 64 + c8 * 8), a1 = *(const f32x4*)(abuf + tt * 64 + c8 * 8 + 4);
      const f32x4 p0 = *(const f32x4*)(Pbuf + tt * 64 + c8 * 8), p1 = *(const f32x4*)(Pbuf + tt * 64 + c8 * 8 + 4);
      f32x4 q0 = (f32x4){1.f, 1.f, 1.f, 1.f}, q1 = q0;
      if (tt & 15) { q0 = *(const f32x4*)(Pbuf + (tt - 1) * 64 + c8 * 8); q1 = *(const f32x4*)(Pbuf + (tt - 1) * 64 + c8 * 8 + 4); }
      const float a[8] = {a0.x, a0.y, a0.z, a0.w, a1.x, a1.y, a1.z, a1.w};
      const float Pt[8] = {p0.x, p0.y, p0.z, p0.w, p1.x, p1.y, p1.z, p1.w};
      const float Pm[8] = {q0.x, q0.y, q0.z, q0.w, q1.x, q1.y, q1.z, q1.w};
      float at[8], bt_[8], kt_[8], rt[8];
      float bsum = 0.f;
#pragma unroll
      for (int e = 0; e < 8; ++e) {
        const float kkn = kk[e] * inv;
        const float kd = k[e] * (1.f + (a[e] - 1.f) * kav[e]);
        bsum += r[e] * kd * rkv[e];
        const float ip = 1.f / Pt[e];
        at[e] = -kkn * Pm[e];
        bt_[e] = kkn * a[e] * ip;
        kt_[e] = kd * ip;
        rt[e] = r[e] * Pt[e];
      }
      bsum = oct_sum(bsum);
      if (c8 == 0) betad[row * 16 + h] = bsum;
      char* ro = smem + tt * 136 + c8 * 16;
      *(u32x2*)(ro + SC_AT) = (u32x2){pk2(at[0], at[1]), pk2(at[2], at[3])};   *(u32x2*)(ro + SC_AT + 8) = (u32x2){pk2(at[4], at[5]), pk2(at[6], at[7])};
      *(u32x2*)(ro + SC_RT) = (u32x2){pk2(rt[0], rt[1]), pk2(rt[2], rt[3])};   *(u32x2*)(ro + SC_RT + 8) = (u32x2){pk2(rt[4], rt[5]), pk2(rt[6], rt[7])};
      *(u32x2*)(ro + SC_BT) = (u32x2){pk2(bt_[0], bt_[1]), pk2(bt_[2], bt_[3])}; *(u32x2*)(ro + SC_BT + 8) = (u32x2){pk2(bt_[4], bt_[5]), pk2(bt_[6], bt_[7])};
      *(u32x2*)(ro + SC_KT) = (u32x2){pk2(kt_[0], kt_[1]), pk2(kt_[2], kt_[3])}; *(u32x2*)(ro + SC_KT + 8) = (u32x2){pk2(kt_[4], kt_[5]), pk2(kt_[6], kt_[7])};
#pragma unroll
      for (int e = 0; e < 8; ++e) {
        *(bf*)(smem + SC_BTT + (c8 * 8 + e) * 72 + tt * 2) = (bf)(pk2(bt_[e], 0.f) & 0xffffu);
        *(bf*)(smem + SC_KTT + (c8 * 8 + e) * 72 + tt * 2) = (bf)(pk2(kt_[e], 0.f) & 0xffffu);
      }
      *(f32x4*)(vs + tt * 64 + c8 * 8) = (f32x4){bflo(puv[0]), bfhi(puv[0]), bflo(puv[1]), bfhi(puv[1])};
      *(f32x4*)(vs + tt * 64 + c8 * 8 + 4) = (f32x4){bflo(puv[2]), bfhi(puv[2]), bflo(puv[3]), bfhi(puv[3])};
    }
    lds_barrier();
    if (ch + 1 < 264) prefetch(ch + 1);
    {
      auto gram = [&](int xbase, int ybase, int sc) -> f32x4 {
        f32x4 acc = (f32x4){0.f, 0.f, 0.f, 0.f};
#pragma unroll
        for (int ks = 0; ks < 2; ++ks) {
          const char* xp = smem + xbase + (sc * 16 + fr) * 136 + ks * 64 + fq * 16;
          const char* yp = smem + ybase + (sc * 16 + fr) * 136 + ks * 64 + fq * 16;
          const bf16x8 xf = mk8(*(const u32x2*)xp, *(const u32x2*)(xp + 8));
          const bf16x8 yf = mk8(*(const u32x2*)yp, *(const u32x2*)(yp + 8));
          acc = __builtin_amdgcn_mfma_f32_16x16x32_bf16(xf, yf, acc, 0, 0, 0);
        }
        return acc;
      };
      auto store_small = [&](f32x4 g, int sc, int kind, bool strict) {
#pragma unroll
        for (int e = 0; e < 4; ++e) { const int sidx = fq * 4 + e; const bool keep = strict ? (sidx < fr) : (sidx <= fr); g[e] = keep ? g[e] : 0.f; }
        *(u32x2*)(smem + SC_SM + (sc * 5 + kind) * 640 + fr * 40 + fq * 8) = (u32x2){pk2(g[0], g[1]), pk2(g[2], g[3])};
      };
      if (wid < 2) {
        const int sc = wid;
        f32x4 g = gram(SC_BT, SC_AT, sc);
#pragma unroll
        for (int e = 0; e < 4; ++e) g[e] = (fq * 4 + e < fr) ? g[e] : 0.f;
        *(f32x4*)(smem + SC_MABT + sc * 1024 + fr * 64 + fq * 16) = g;
        asm volatile("s_waitcnt lgkmcnt(0)" ::: "memory");
        if (lane < 16) {
          float n[16];
#pragma unroll
          for (int t = 0; t < 16; ++t) {
            const float* mc = (const float*)(smem + SC_MABT + sc * 1024 + t * 64);
            float acc = (t == lane) ? 1.f : 0.f;
#pragma unroll
            for (int sp = 0; sp < t; ++sp) acc = fmaf(n[sp], mc[sp], acc);
            n[t] = acc;
          }
#pragma unroll
          for (int t = 0; t < 16; ++t) {
            const unsigned hi = pk2(n[t], 0.f) & 0xffffu;
            const unsigned lo = pk2(n[t] - bflo(hi), 0.f) & 0xffffu;
            *(bf*)(smem + SC_SM + (sc * 5 + 0) * 640 + t * 40 + lane * 2) = (bf)hi;
            *(bf*)(smem + SC_SM + (sc * 5 + 1) * 640 + t * 40 + lane * 2) = (bf)lo;
          }
        }
      } else {
        const int sc = wid - 2;
        store_small(gram(SC_KT, SC_AT, sc), sc, 2, true);
        store_small(gram(SC_BT, SC_RT, sc), sc, 3, false);
        store_small(gram(SC_KT, SC_RT, sc), sc, 4, false);
      }
    }
    lds_barrier();
#pragma unroll
    for (int sc = 0; sc < 2; ++sc) {
      bf16x8 shi[2], slo[2];
#pragma unroll
      for (int g = 0; g < 2; ++g) {
        u32x2 h0, l0, h1, l1;
        split4(ST[2 * g], h0, l0); split4(ST[2 * g + 1], h1, l1);
        shi[g] = mk8(h0, h1); slo[g] = mk8(l0, l1);
      }
      const char* arow = smem + SC_AT + (sc * 16 + fr) * 136 + fq * 8;
      const char* rrow = smem + SC_RT + (sc * 16 + fr) * 136 + fq * 8;
      f32x4 wt = (f32x4){0.f, 0.f, 0.f, 0.f}, yt = wt;
#pragma unroll
      for (int g = 0; g < 2; ++g) {
        const bf16x8 xa = mk8(*(const u32x2*)(arow + g * 64), *(const u32x2*)(arow + g * 64 + 32));
        const bf16x8 xr = mk8(*(const u32x2*)(rrow + g * 64), *(const u32x2*)(rrow + g * 64 + 32));
        wt = __builtin_amdgcn_mfma_f32_16x16x32_bf16(xa, shi[g], wt, 0, 0, 0);
        wt = __builtin_amdgcn_mfma_f32_16x16x32_bf16(xa, slo[g], wt, 0, 0, 0);
        yt = __builtin_amdgcn_mfma_f32_16x16x32_bf16(xr, shi[g], yt, 0, 0, 0);
        yt = __builtin_amdgcn_mfma_f32_16x16x32_bf16(xr, slo[g], yt, 0, 0, 0);
      }
      const int vcol = wid * 16 + fr;
      const float* vp = vs + (sc * 16 + fq * 4) * 64 + vcol;
      const bf16x8 vmf = mk4((u32x2){pk2(vp[0], vp[64]), pk2(vp[128], vp[192])});
      const char* smb = smem + SC_SM + sc * 5 * 640 + fr * 40 + fq * 8;
      const bf16x8 xnh = mk4(*(const u32x2*)(smb)), xnl = mk4(*(const u32x2*)(smb + 640));
      const bf16x8 xmak = mk4(*(const u32x2*)(smb + 2 * 640)), xmrb = mk4(*(const u32x2*)(smb + 3 * 640)), xmrk = mk4(*(const u32x2*)(smb + 4 * 640));
      wt = __builtin_amdgcn_mfma_f32_16x16x32_bf16(xmak, vmf, wt, 0, 0, 0);
      u32x2 whi, wlo;
      split4(wt, whi, wlo);
      f32x4 ut = (f32x4){0.f, 0.f, 0.f, 0.f};
      ut = __builtin_amdgcn_mfma_f32_16x16x32_bf16(xnh, mk4(whi), ut, 0, 0, 0);
      ut = __builtin_amdgcn_mfma_f32_16x16x32_bf16(xnh, mk4(wlo), ut, 0, 0, 0);
      ut = __builtin_amdgcn_mfma_f32_16x16x32_bf16(xnl, mk4(whi), ut, 0, 0, 0);
      u32x2 uhi, ulo;
      split4(ut, uhi, ulo);
      const bf16x8 uhf = mk4(uhi), ulf = mk4(ulo);
      yt = __builtin_amdgcn_mfma_f32_16x16x32_bf16(xmrb, uhf, yt, 0, 0, 0);
      yt = __builtin_amdgcn_mfma_f32_16x16x32_bf16(xmrb, ulf, yt, 0, 0, 0);
      yt = __builtin_amdgcn_mfma_f32_16x16x32_bf16(xmrk, vmf, yt, 0, 0, 0);
#pragma unroll
      for (int e = 0; e < 4; ++e) ys[(sc * 16 + fq * 4 + e) * 64 + vcol] = yt[e];
#pragma unroll
      for (int kt = 0; kt < 4; ++kt) {
        const bf16x8 xb = mk4(*(const u32x2*)(smem + SC_BTT + (kt * 16 + fr) * 72 + (sc * 16 + fq * 4) * 2));
        const bf16x8 xk = mk4(*(const u32x2*)(smem + SC_KTT + (kt * 16 + fr) * 72 + (sc * 16 + fq * 4) * 2));
        ST[kt] = __builtin_amdgcn_mfma_f32_16x16x32_bf16(xb, uhf, ST[kt], 0, 0, 0);
        ST[kt] = __builtin_amdgcn_mfma_f32_16x16x32_bf16(xb, ulf, ST[kt], 0, 0, 0);
        ST[kt] = __builtin_amdgcn_mfma_f32_16x16x32_bf16(xk, vmf, ST[kt], 0, 0, 0);
        const f32x4 pc = *(const f32x4*)(Pbuf + (sc * 16 + 15) * 64 + kt * 16 + fq * 4);
        ST[kt] = ST[kt] * pc;
      }
    }
    lds_barrier();
    {
      const size_t row = (size_t)(rowbase + sgn * tt);
      const f32x4 y0 = *(const f32x4*)(ys + tt * 64 + c8 * 8), y1 = *(const f32x4*)(ys + tt * 64 + c8 * 8 + 4);
      *(u32x4*)(Ydst + row * ldy + h * 64 + c8 * 8) = (u32x4){pk2(y0.x, y0.y), pk2(y0.z, y0.w), pk2(y1.x, y1.y), pk2(y1.z, y1.w)};
    }
    lds_barrier();
  }
  }
}

__device__ void og_phase(const Params& p, int j) {
  const int tid = otid(), lane = tid & 63;
  const int gw = blockIdx.x * 4 + (tid >> 6), nw = gridDim.x * 4;
  const bf* Vsrc = (j == 0) ? p.VF : p.V2;
  const int col = lane * 16, hh = lane >> 2;
  float lw[16], lb[16];
#pragma unroll
  for (int e = 0; e < 16; ++e) { lw[e] = p.rw_lnx_w[j * 1024 + col + e]; lb[e] = p.rw_lnx_b[j * 1024 + col + e]; }
  for (int row = gw; row < MT; row += nw) {
    const size_t off = (size_t)row * 1024 + col, offh = (size_t)row * LDH + col;
    u32x4 u0[2], u1[2], uv[2], ug[2];
#pragma unroll
    for (int q = 0; q < 2; ++q) {
      u0[q] = *(const u32x4*)(p.H + offh + q * 8);
      u1[q] = *(const u32x4*)(p.Y1 + off + q * 8);
      uv[q] = *(const u32x4*)(Vsrc + off + q * 8);
      ug[q] = *(const u32x4*)(p.G + off + q * 8);
    }
    const float bsum = p.beta[(size_t)row * 16 + hh] + p.beta[(size_t)MT * 16 + (size_t)row * 16 + hh];
    float y[16], v[16], g[16];
    float s = 0.f;
#pragma unroll
    for (int e = 0; e < 8; ++e) {
      y[2 * e] = bflo(u0[e >> 2][e & 3]) + bflo(u1[e >> 2][e & 3]); y[2 * e + 1] = bfhi(u0[e >> 2][e & 3]) + bfhi(u1[e >> 2][e & 3]);
      v[2 * e] = bflo(uv[e >> 2][e & 3]); v[2 * e + 1] = bfhi(uv[e >> 2][e & 3]);
      g[2 * e] = bflo(ug[e >> 2][e & 3]); g[2 * e + 1] = bfhi(ug[e >> 2][e & 3]);
      s += y[2 * e] + y[2 * e + 1];
    }
    s = quad_sum(s);
    const float mean = s * (1.f / 64.f);
    float q2 = 0.f;
#pragma unroll
    for (int e = 0; e < 16; ++e) { const float dd = y[e] - mean; q2 += dd * dd; }
    q2 = quad_sum(q2);
    const float rstd = rsqrtf(q2 * (1.f / 64.f) + 64e-5f);
    unsigned o[8];
#pragma unroll
    for (int e = 0; e < 8; ++e) {
      const float r0 = ((y[2 * e] - mean) * rstd * lw[2 * e] + lb[2 * e] + bsum * v[2 * e]) * g[2 * e];
      const float r1 = ((y[2 * e + 1] - mean) * rstd * lw[2 * e + 1] + lb[2 * e + 1] + bsum * v[2 * e + 1]) * g[2 * e + 1];
      o[e] = pk2(r0, r1);
    }
    *(u32x4*)(p.H + offh) = (u32x4){o[0], o[1], o[2], o[3]};
    *(u32x4*)(p.H + offh + 8) = (u32x4){o[4], o[5], o[6], o[7]};
  }
}

__device__ void attn_phase(const Params& p, int j, bool ctx_out, char* smem) {
  const int tid = otid(), lane = tid & 63, cgp = tid >> 6, fr = lane & 15, fq = lane >> 4;
  char* Ks = smem;
  bf* Vs = (bf*)smem;
  float* rpbs = (float*)(smem + 36864);
  const bf* Q = p.R; const bf* Kb = p.K; const bf* Vt = p.V2; const bf* Gb = p.G;
  const int nitems = 16384 + (ctx_out ? 512 : 0);
  for (int item = blockIdx.x; item < nitems; item += gridDim.x) {
    int b, h, r = 0, qrow0; bool haswin;
    if (item < 16384) { h = item & 15; r = (item >> 4) & 127; b = item >> 11; haswin = true; qrow0 = b * SEQ + r * 64; }
    else { const int it = item - 16384; h = it & 15; const int qb = (it >> 4) & 3; b = it >> 6; haswin = false; qrow0 = NL + b * CTXL + qb * 64; }
    const int qtok = qrow0 + cgp * 16 + fr;
    bf16x8 qf[2];
#pragma unroll
    for (int ks = 0; ks < 2; ++ks) qf[ks] = *(const bf16x8*)(Q + (size_t)qtok * 1024 + h * 64 + ks * 32 + fq * 8);
    const int rs = min(max(r - 4, 0), 120);
    const int qcol = cgp * 16 + fr;
    const int wsq = min(max(qcol - 8, 0), 48);
    const int bs = min(max(16 * cgp - 8, 0), 32);
    lds_barrier();
    if (haswin) for (int idx = tid; idx < 465; idx += 256) rpbs[idx] = p.na_rpb[((size_t)j * 16 + h) * 465 + idx];
    f32x4 sw[8][2], sc[4][4];
    bf16x8 pw[8];
    float m1 = NEGV, l1 = 0.f;
#pragma unroll
    for (int i = 0; i < 8; ++i) pw[i] = (bf16x8){0, 0, 0, 0, 0, 0, 0, 0};
#pragma unroll
    for (int i = 0; i < 8; ++i)
#pragma unroll
      for (int k2 = 0; k2 < 2; ++k2) sw[i][k2] = (f32x4){NEGV, NEGV, NEGV, NEGV};
#pragma unroll
    for (int st = 0; st < 3; ++st) {
      if (st < 2 && !haswin) continue;
      lds_barrier();
      int tq = tid; asm volatile("" : "+v"(tq));
#pragma unroll
      for (int hf = 0; hf < 2; ++hf) {
        u32x4 u[4];
#pragma unroll
        for (int i = 0; i < 4; ++i) {
          const int q = tq + (hf * 4 + i) * 256, key = q >> 3, c = q & 7, tl = key >> 6;
          const int base = (st < 2) ? b * SEQ + (rs + st * 4 + tl) * 64 : NL + b * CTXL + tl * 64;
          u[i] = *(const u32x4*)(Kb + (size_t)(base + (key & 63)) * 1024 + h * 64 + c * 8);
        }
#pragma unroll
        for (int i = 0; i < 4; ++i) {
          const int q = tq + (hf * 4 + i) * 256, key = q >> 3, c = q & 7;
          *(u32x4*)(Ks + lds_off(key, c)) = u[i];
        }
        __builtin_amdgcn_sched_barrier(0);
      }
      lds_barrier();
      if (st < 2) {
#pragma unroll
        for (int tl = 0; tl < 4; ++tl) {
          const int i = st * 4 + tl;
          const int dr = rs + i - r + 7;
#pragma unroll
          for (int k2 = 0; k2 < 2; ++k2) {
            f32x4 acc = (f32x4){0.f, 0.f, 0.f, 0.f};
#pragma unroll
            for (int ks = 0; ks < 2; ++ks) {
              const bf16x8 kf = *(const bf16x8*)(Ks + lds_off(tl * 64 + bs + k2 * 16 + fr, ks * 4 + fq));
              acc = __builtin_amdgcn_mfma_f32_16x16x32_bf16(kf, qf[ks], acc, 0, 0, 0);
            }
#pragma unroll
            for (int e = 0; e < 4; ++e) {
              const int kc = bs + k2 * 16 + fq * 4 + e;
              const bool valid = (kc >= wsq) && (kc < wsq + 16);
              const int dc = min(max(kc - qcol, -15), 15) + 15;
              sw[i][k2][e] = valid ? acc[e] + rpbs[dr * 31 + dc] : NEGV;
            }
          }
          __builtin_amdgcn_sched_barrier(0);
        }
      } else {
#pragma unroll
        for (int tl = 0; tl < 4; ++tl)
#pragma unroll
          for (int k4 = 0; k4 < 4; ++k4) {
            f32x4 acc = (f32x4){0.f, 0.f, 0.f, 0.f};
#pragma unroll
            for (int ks = 0; ks < 2; ++ks) {
              const bf16x8 kf = *(const bf16x8*)(Ks + lds_off(tl * 64 + k4 * 16 + fr, ks * 4 + fq));
              acc = __builtin_amdgcn_mfma_f32_16x16x32_bf16(kf, qf[ks], acc, 0, 0, 0);
            }
            sc[tl][k4] = acc;
            if (k4 & 1) __builtin_amdgcn_sched_barrier(0);
          }
      }
      if (st == 1) {
#pragma unroll
        for (int i = 0; i < 8; ++i)
#pragma unroll
          for (int k2 = 0; k2 < 2; ++k2)
#pragma unroll
            for (int e = 0; e < 4; ++e) m1 = fmaxf(m1, sw[i][k2][e]);
        m1 = fmaxf(m1, __shfl_xor(m1, 16));
        m1 = fmaxf(m1, __shfl_xor(m1, 32));
#pragma unroll
        for (int i = 0; i < 8; ++i) {
          float e0[4], e1[4];
#pragma unroll
          for (int e = 0; e < 4; ++e) { e0[e] = __expf(sw[i][0][e] - m1); e1[e] = __expf(sw[i][1][e] - m1); l1 += e0[e] + e1[e]; }
          u32x4 u = (u32x4){pk2(e0[0], e0[1]), pk2(e0[2], e0[3]), pk2(e1[0], e1[1]), pk2(e1[2], e1[3])};
          pw[i] = __builtin_bit_cast(bf16x8, u);
        }
        l1 += __shfl_xor(l1, 16);
        l1 += __shfl_xor(l1, 32);
      }
    }
    float m2 = NEGV;
#pragma unroll
    for (int tl = 0; tl < 4; ++tl)
#pragma unroll
      for (int k4 = 0; k4 < 4; ++k4)
#pragma unroll
        for (int e = 0; e < 4; ++e) m2 = fmaxf(m2, sc[tl][k4][e]);
    m2 = fmaxf(m2, __shfl_xor(m2, 16));
    m2 = fmaxf(m2, __shfl_xor(m2, 32));
    const float mx = fmaxf(m1, m2);
    const float alpha1 = __expf(m1 - mx);
    float l2 = 0.f;
    bf16x8 pc[4][2];
#pragma unroll
    for (int tl = 0; tl < 4; ++tl)
#pragma unroll
      for (int g2 = 0; g2 < 2; ++g2) {
        float e0[4], e1[4];
#pragma unroll
        for (int e = 0; e < 4; ++e) { e0[e] = __expf(sc[tl][2 * g2][e] - mx); e1[e] = __expf(sc[tl][2 * g2 + 1][e] - mx); l2 += e0[e] + e1[e]; }
        u32x4 u = (u32x4){pk2(e0[0], e0[1]), pk2(e0[2], e0[3]), pk2(e1[0], e1[1]), pk2(e1[2], e1[3])};
        pc[tl][g2] = __builtin_bit_cast(bf16x8, u);
      }
    l2 += __shfl_xor(l2, 16);
    l2 += __shfl_xor(l2, 32);
    const float l = alpha1 * l1 + l2;
    f32x4 o[4];
#pragma unroll
    for (int dt = 0; dt < 4; ++dt) o[dt] = (f32x4){0.f, 0.f, 0.f, 0.f};
#pragma unroll
    for (int st = 0; st < 3; ++st) {
      if (st < 2 && !haswin) continue;
      lds_barrier();
      int tq = tid; asm volatile("" : "+v"(tq));
#pragma unroll
      for (int hf = 0; hf < 2; ++hf) {
        u32x4 u[4];
#pragma unroll
        for (int i = 0; i < 4; ++i) {
          const int q = tq + (hf * 4 + i) * 256, tl = q >> 9, dd = (q >> 3) & 63, c = q & 7;
          const int base = (st < 2) ? b * SEQ + (rs + st * 4 + tl) * 64 : NL + b * CTXL + tl * 64;
          u[i] = *(const u32x4*)(Vt + (size_t)(h * 64 + dd) * MT + base + c * 8);
        }
#pragma unroll
        for (int i = 0; i < 4; ++i) {
          const int q = tq + (hf * 4 + i) * 256, tl = q >> 9, dd = (q >> 3) & 63, c = q & 7;
          *(u32x4*)(Vs + tl * 4608 + dd * 72 + c * 8) = u[i];
        }
        __builtin_amdgcn_sched_barrier(0);
      }
      lds_barrier();
      if (st < 2) {
#pragma unroll
        for (int tl = 0; tl < 4; ++tl) {
          const int i = st * 4 + tl;
#pragma unroll
          for (int dt = 0; dt < 4; ++dt) {
            const bf* vp = Vs + tl * 4608 + (dt * 16 + fr) * 72 + bs + fq * 4;
            const u32x2 lo = *(const u32x2*)vp, hi = *(const u32x2*)(vp + 16);
            u32x4 u = (u32x4){lo.x, lo.y, hi.x, hi.y};
            o[dt] = __builtin_amdgcn_mfma_f32_16x16x32_bf16(__builtin_bit_cast(bf16x8, u), pw[i], o[dt], 0, 0, 0);
          }
          __builtin_amdgcn_sched_barrier(0);
        }
      } else {
#pragma unroll
        for (int tl = 0; tl < 4; ++tl)
#pragma unroll
          for (int g2 = 0; g2 < 2; ++g2)
#pragma unroll
            for (int dt = 0; dt < 4; ++dt) {
              const bf* vp = Vs + tl * 4608 + (dt * 16 + fr) * 72 + g2 * 32 + fq * 4;
              const u32x2 lo = *(const u32x2*)vp, hi = *(const u32x2*)(vp + 16);
              u32x4 u = (u32x4){lo.x, lo.y, hi.x, hi.y};
              o[dt] = __builtin_amdgcn_mfma_f32_16x16x32_bf16(__builtin_bit_cast(bf16x8, u), pc[tl][g2], o[dt], 0, 0, 0);
              if (dt == 3) __builtin_amdgcn_sched_barrier(0);
            }
      }
      if (st == 1) {
#pragma unroll
        for (int dt = 0; dt < 4; ++dt) o[dt] *= alpha1;
      }
    }
    const float inv = 1.f / l;
#pragma unroll
    for (int dt = 0; dt < 4; ++dt) {
      const size_t off = (size_t)qtok * 1024 + h * 64 + dt * 16 + fq * 4;
      const u32x2 ug = *(const u32x2*)(Gb + off);
      const float g0 = bflo(ug.x), g1 = bfhi(ug.x), g2 = bflo(ug.y), g3 = bfhi(ug.y);
      *(u32x2*)(p.H + (size_t)qtok * LDH + h * 64 + dt * 16 + fq * 4) = (u32x2){pk2(o[dt][0] * inv * siluf(g0), o[dt][1] * inv * siluf(g1)),
                                        pk2(o[dt][2] * inv * siluf(g2), o[dt][3] * inv * siluf(g3))};
    }
  }
}


#define XB_TMO      128
#define XB_XCNT(j)  (256  + 64 * (j))
#define XB_XSUB(j)  (1280 + 64 * (j))
#define XB_XGEN(j)  (2304 + 64 * (j))
#define XB_TOP      3328
#define XB_TOPGEN   3392
#define XCD_BAR_WORDS 3456
#define XB_SPIN_CAP (1u << 18)
__device__ __forceinline__ unsigned xb_ld(unsigned* q) { return __hip_atomic_load(q, __ATOMIC_RELAXED, __HIP_MEMORY_SCOPE_AGENT); }
__device__ __forceinline__ unsigned xb_add(unsigned* q, unsigned v) { return __hip_atomic_fetch_add(q, v, __ATOMIC_RELAXED, __HIP_MEMORY_SCOPE_AGENT); }
__device__ __forceinline__ unsigned xb_xcc_id() { return (unsigned)__builtin_amdgcn_s_getreg((3 << 11) | 20) & 0xFu; }
#define XB_SPIN(cond, bar) do { unsigned _sp = 0; while (cond) { __builtin_amdgcn_s_sleep(1); \
    if ((++_sp & 255u) == 0u) { if (xb_ld(&(bar)[XB_TMO])) break; if (_sp > XB_SPIN_CAP) { atomicAdd(&(bar)[XB_TMO], 1u); break; } } } } while (0)
struct XcdBarrier { unsigned* bar; unsigned x, nloc, nx; };
__device__ __forceinline__ void xcd_barrier(const XcdBarrier& b) {
  asm volatile("s_waitcnt vmcnt(0)" ::: "memory");
  __syncthreads();
  if (threadIdx.x == 0) {
    unsigned* bar = b.bar;
    __builtin_amdgcn_s_waitcnt(0);
    const unsigned nloc = b.nloc, nx = b.nx;
    const unsigned old = xb_add(&bar[XB_XSUB(b.x)], 1u);
    const unsigned gen = old / nloc;
    if (old + 1u == (gen + 1u) * nloc) {
      __builtin_amdgcn_fence(__ATOMIC_RELEASE, "agent");
      asm volatile("s_waitcnt vmcnt(0)" ::: "memory");
      const unsigned og = xb_add(&bar[XB_TOP], 1u);
      const unsigned tg = og / nx;
      if (og + 1u == (tg + 1u) * nx) xb_add(&bar[XB_TOPGEN], 1u);
      else XB_SPIN(xb_ld(&bar[XB_TOPGEN]) == tg, bar);
      __builtin_amdgcn_fence(__ATOMIC_ACQUIRE, "agent");
      xb_add(&bar[XB_XGEN(b.x)], 1u);
      asm volatile("s_waitcnt vmcnt(0)" ::: "memory");
    } else {
      XB_SPIN(xb_ld(&bar[XB_XGEN(b.x)]) == gen, bar);
      __builtin_amdgcn_fence(__ATOMIC_ACQUIRE, "agent");
      asm volatile("s_waitcnt vmcnt(0)" ::: "memory");
    }
  }
  __syncthreads();
}

#ifndef DUP_SCAN
#define DUP_SCAN 0
#endif
#ifndef DUP_ATTN
#define DUP_ATTN 0
#endif
#ifndef DUP_GEMM
#define DUP_GEMM 0
#endif
#ifndef MULTI_LAUNCH
#define MULTI_LAUNCH 0
#endif
__device__ __forceinline__ bool step_exists(int i, int s) {
  if (s == 2) return i == 2;
  if (s == 4) return (i & 1) == 0;
  return true;
}
__device__ __forceinline__ void run_step(const Params& p, int i, int s, char* smem) {
  asm volatile("" : "+s"(i));
  const int j = i >> 1;
  if (s == 0) { transpose_phase(p, i, smem); row_phase(p, i); }
  else if (s == 1) {
    if ((i & 1) == 0) {
      EpiRwkvProj ep{p.R, p.K, (j == 0) ? p.VF : p.V2, p.G, p.HID};
#pragma unroll 1
      for (int rep = PROBE_GEMM ? 0 : 1; rep < 2; ++rep)
      gemm_phase<1>(p.H, LDH, p.Wp, LDW, 16, MT / 128, (j == 0) ? 34 : 35, p.rw_mu + (size_t)j * 6 * 1024, ep, smem, rep == 0);
    } else {
      EpiNaProj ep{p.R, p.K, p.V2, p.G, p.na_b_in + (size_t)j * 4096};
#pragma unroll 1
      for (int rep = PROBE_GEMM ? 0 : 1; rep < 2; ++rep)
      gemm_phase<0>(p.H, LDH, p.Wp, LDW, 16, MT / 128, 32, nullptr, ep, smem, rep == 0);
    }
  } else if (s == 2) {
    EpiVres ev{p.V2, p.VF, p.rw_v0};
    gemm_phase<0>(p.HID + 256, HIDW, p.v2t, 64, 1, MT / 128, 8, nullptr, ev, smem);
  } else if (s == 3) {
    if ((i & 1) == 0) scan_phase(p, j, smem);
    else attn_phase(p, j, i != 3, smem);
  } else if (s == 4) {
    og_phase(p, j);
  } else {
    EpiOut eo{p.R};
#pragma unroll 1
    for (int rep = PROBE_GEMM ? 0 : 1; rep < 2; ++rep)
    gemm_phase<0>(p.H, LDH, p.Wo, LDW, 16, (i == 3) ? NL / 128 : MT / 128, 8, nullptr, eo, smem, rep == 0);
  }
}

__global__ void __launch_bounds__(256, 2) fwd_megakernel(Params p0) {
  __shared__ __attribute__((aligned(16))) char smem[SMEM_BYTES];
  cg::grid_group grid = cg::this_grid();
  XcdBarrier xb;
  xb.bar = p0.bar; xb.x = xb_xcc_id(); xb.nloc = 0u; xb.nx = 0u;
  if (threadIdx.x == 0) (void)xb_add(&xb.bar[XB_XCNT(xb.x)], 1u);
  pre_phase(p0, smem);
  grid.sync();
  {
    unsigned cnt = 0u, mine = 0u;
#pragma unroll 1
    for (unsigned jj = 0; jj < 16; ++jj) { const unsigned c = xb_ld(&xb.bar[XB_XCNT(jj)]); cnt += (c > 0u) ? 1u : 0u; mine = (jj == xb.x) ? c : mine; }
    xb.nloc = mine > 0u ? mine : 1u; xb.nx = cnt > 0u ? cnt : 1u;
  }
  const Params& p = p0;
#pragma unroll 1
  for (int i = 0; i < 4; ++i) {
#pragma unroll 1
    for (int s = 0; s < 6; ++s) {
      if (!step_exists(i, s)) continue;
      int reps = 1;
      if (DUP_SCAN && s == 3 && (i & 1) == 0) reps = 2;
      if (DUP_ATTN && s == 3 && (i & 1) == 1) reps = 2;
      if (DUP_GEMM && (s == 1 || s == 5)) reps = 2;
#pragma unroll 1
      for (int rep = 0; rep < reps; ++rep) {
        run_step(p, i, s, smem);
        xcd_barrier(xb);
      }
    }
  }
  row_phase(p, 4);
}

#if MULTI_LAUNCH
template <int S> __global__ void __launch_bounds__(256, 2) step_kernel(Params p0, int i) {
  __shared__ __attribute__((aligned(16))) char smem[SMEM_BYTES];
  if (S == -1) { pre_phase(p0, smem); return; }
  if (S == 6) { row_phase(p0, 4); return; }
  run_step(p0, i, S, smem);
}
#endif

extern "C" void kernel_launch(void* const* d_in, const int* in_sizes, int n_in, void* d_out, int out_size, void* d_ws, size_t ws_size,
                              hipStream_t stream) {
  static int grid_blocks = 0;
  if (!grid_blocks) {
    int dev = 0, cus = 0, per_cu = 0;
    hipGetDevice(&dev);
    hipDeviceGetAttribute(&cus, hipDeviceAttributeMultiprocessorCount, dev);
    hipOccupancyMaxActiveBlocksPerMultiprocessor(&per_cu, fwd_megakernel, 256, 0);
    if (per_cu > 2) per_cu = 2;
    if (per_cu < 1) per_cu = 1;
    grid_blocks = cus * per_cu;
  }
  Params p{};
  const float** f = (const float**)&p;
  for (int i = 0; i < 29; ++i) f[i] = (const float*)d_in[i];
  p.out = (float*)d_out;
  char* w = (char*)d_ws;
  size_t off = 0;
  auto take = [&](size_t bytes) { char* r = w + off; off += (bytes + 255) & ~(size_t)255; return r; };
  p.gp = (Params*)take(sizeof(Params));
  p.bar = (unsigned*)take((size_t)XCD_BAR_WORDS * 4);
  p.mod = (float*)take((size_t)4 * 9 * 3072 * 4);
  p.ctxbuf = (float*)take((size_t)NC * 1024 * 4);
  p.beta = (float*)take((size_t)2 * MT * 16 * 4);
  p.Wp = (bf*)take((size_t)4480 * LDW * 2);
  p.Wo = (bf*)take((size_t)1024 * LDW * 2);
  p.w2t = (bf*)take((size_t)2 * 65536 * 2);
  p.a2t = (bf*)take((size_t)2 * 65536 * 2);
  p.v2t = (bf*)take((size_t)65536 * 2);
  const size_t big = (size_t)MT * 1024 * 2;
  p.H = (bf*)take((size_t)MT * LDH * 2); p.R = (bf*)take(big); p.K = (bf*)take(big); p.VF = (bf*)take(big);
  p.V2 = (bf*)take(big); p.G = (bf*)take(big); p.Y1 = (bf*)take(big);
  p.HID = (bf*)take((size_t)MT * HIDW * 2);
  if (off > ws_size) fprintf(stderr, "workspace too small: need %zu have %zu\n", off, ws_size);
#if MULTI_LAUNCH
  step_kernel<-1><<<grid_blocks, 256, 0, stream>>>(p, 0);
  for (int i = 0; i < 4; ++i) {
    step_kernel<0><<<grid_blocks, 256, 0, stream>>>(p, i);
    step_kernel<1><<<grid_blocks, 256, 0, stream>>>(p, i);
    if (i == 2) step_kernel<2><<<grid_blocks, 256, 0, stream>>>(p, i);
    step_kernel<3><<<grid_blocks, 256, 0, stream>>>(p, i);
    if ((i & 1) == 0) step_kernel<4><<<grid_blocks, 256, 0, stream>>>(p, i);
    step_kernel<5><<<grid_blocks, 256, 0, stream>>>(p, i);
  }
  step_kernel<6><<<grid_blocks, 256, 0, stream>>>(p, 0);
#else
  (void)hipMemsetAsync(p.bar, 0, (size_t)XCD_BAR_WORDS * 4, stream);
  void* args[] = {&p};
  hipError_t e = hipLaunchCooperativeKernel((void*)fwd_megakernel, dim3(grid_blocks), dim3(256), args, 0, stream);
  if (e != hipSuccess) fprintf(stderr, "cooperative launch failed: %s (grid %d)\n", hipGetErrorString(e), grid_blocks);
#endif
}
```

```cpp
#include <hip/hip_runtime.h>
#include <hip/hip_cooperative_groups.h>
#include <cstdint>
#include <cstdio>
namespace cg = cooperative_groups;

typedef unsigned short bf;
typedef short bf16x8 __attribute__((ext_vector_type(8)));
typedef float f32x4 __attribute__((ext_vector_type(4)));
typedef unsigned u32x4 __attribute__((ext_vector_type(4)));
typedef unsigned u32x2 __attribute__((ext_vector_type(2)));

constexpr int DM = 1024, NB = 8, SEQ = 8192, NL = NB * SEQ, CTXL = 256, NC = NB * CTXL, MT = NL + NC;
constexpr int HIDW = 384;
constexpr int LDH = 1088, LDW = 1088;
constexpr int SMEM_BYTES = 65536;
#define NEGV (-1e30f)
#ifndef PROBE_GEMM
#define PROBE_GEMM 0
#endif

struct Params {
  const float *x, *c, *ctx, *c_ctx, *ada_w, *ada_b, *pre_g, *post_g, *rw_mu, *rw_w_rkvg, *rw_w0, *rw_w1, *rw_w2,
      *rw_a0, *rw_a1, *rw_a2, *rw_v0, *rw_v1, *rw_v2, *rw_k_k, *rw_k_a, *rw_r_k, *rw_lnx_w, *rw_lnx_b, *rw_w_out,
      *na_w_in, *na_b_in, *na_rpb, *na_w_out;
  float* out;
  float *mod, *ctxbuf, *beta;
  bf *Wp, *Wo, *w2t, *a2t, *v2t;
  bf *H, *R, *K, *VF, *V2, *G, *Y1, *HID;
  Params* gp;
  unsigned* bar;
};

__device__ __forceinline__ float bflo(unsigned w) { return __uint_as_float(w << 16); }
__device__ __forceinline__ float bfhi(unsigned w) { return __uint_as_float(w & 0xffff0000u); }
typedef __bf16 bf16x2_t __attribute__((ext_vector_type(2)));
__device__ __forceinline__ unsigned pk2(float lo, float hi) {
  bf16x2_t v = {(__bf16)lo, (__bf16)hi};
  return __builtin_bit_cast(unsigned, v);
}
__device__ __forceinline__ float siluf(float v) { return v * __builtin_amdgcn_rcpf(1.f + __expf(-v)); }
__device__ __forceinline__ float sigmf(float v) { return __builtin_amdgcn_rcpf(1.f + __expf(-v)); }
__device__ __forceinline__ float tanh_fast(float v) { return 1.f - 2.f * __builtin_amdgcn_rcpf(1.f + __expf(2.f * v)); }
__device__ __forceinline__ float quad_sum(float v) {
  int t = __builtin_amdgcn_update_dpp(0, __float_as_int(v), 0xB1, 0xF, 0xF, true);
  v += __int_as_float(t);
  t = __builtin_amdgcn_update_dpp(0, __float_as_int(v), 0x4E, 0xF, 0xF, true);
  v += __int_as_float(t);
  return v;
}
__device__ __forceinline__ float wave_sum(float v) {
#pragma unroll
  for (int o = 32; o >= 1; o >>= 1) v += __shfl_xor(v, o);
  return v;
}
__device__ __forceinline__ int otid() { int t = threadIdx.x; asm volatile("" : "+v"(t)); return t; }
__device__ __forceinline__ void lds_barrier() { asm volatile("s_waitcnt lgkmcnt(0)\n\ts_barrier" ::: "memory"); }
__device__ __forceinline__ int lds_off(int row, int c) { return row * 128 + ((c ^ ((row >> 1) & 7)) << 4); }
__device__ __forceinline__ unsigned lerp2(unsigned hm, unsigned h0, unsigned hp, float m0, float m1) {
  const float c0 = bflo(h0), c1 = bfhi(h0);
  const float x0 = 0.5f * (bflo(hm) + bflo(hp)) - c0;
  const float x1 = 0.5f * (bfhi(hm) + bfhi(hp)) - c1;
  return pk2(c0 + x0 * m0, c1 + x1 * m1);
}
__device__ __forceinline__ int mod_idx(int row) { return row < NL ? (row >> 13) : 8; }

__device__ void pre_phase(const Params& p, char* smem) {
  float* s = (float*)smem;
  float* red = s + 9 * 1024;
  const int tid = otid();
  for (int item = blockIdx.x; item < 4 * 48; item += gridDim.x) {
    const int i = item / 48, cb = item % 48;
    __syncthreads();
    for (int idx = tid; idx < 9 * 1024; idx += 256) {
      const int m = idx >> 10, k = idx & 1023;
      const float v = (m < 8) ? p.c[m * 1024 + k] : p.c_ctx[k];
      s[idx] = siluf(v);
    }
    __syncthreads();
    const int cc = tid & 63, kq = tid >> 6;
    float acc[9];
#pragma unroll
    for (int m = 0; m < 9; ++m) acc[m] = 0.f;
    const float* W = p.ada_w + (size_t)i * 1024 * 3072 + cb * 64 + cc;
    for (int k = kq * 256; k < kq * 256 + 256; ++k) {
      const float w = W[(size_t)k * 3072];
#pragma unroll
      for (int m = 0; m < 9; ++m) acc[m] += s[m * 1024 + k] * w;
    }
#pragma unroll
    for (int m = 0; m < 9; ++m) red[(kq * 9 + m) * 64 + cc] = acc[m];
    __syncthreads();
    for (int idx = tid; idx < 9 * 64; idx += 256) {
      const int m = idx >> 6, c2 = idx & 63;
      float v = red[(0 * 9 + m) * 64 + c2] + red[(1 * 9 + m) * 64 + c2] + red[(2 * 9 + m) * 64 + c2] + red[(3 * 9 + m) * 64 + c2];
      v += p.ada_b[i * 3072 + cb * 64 + c2];
      p.mod[(size_t)(i * 9 + m) * 3072 + cb * 64 + c2] = v;
    }
  }
}

struct TOp { const float* src; bf* dst; int K, N, Kp, Np, ldd; };
__device__ bool get_op(const Params& p, int i, int op, TOp& o) {
  const int j = i >> 1;
  if (i & 1) {
    if (op == 0) { o = {p.na_w_in + (size_t)j * 1024 * 4096, p.Wp, 1024, 4096, 1024, 4096, LDW}; return true; }
    if (op == 1) { o = {p.na_w_out + (size_t)j * 1024 * 1024, p.Wo, 1024, 1024, 1024, 1024, LDW}; return true; }
    return false;
  }
  if (op < 4) { o = {p.rw_w_rkvg + ((size_t)j * 4 + op) * 1024 * 1024, p.Wp + (size_t)op * 1024 * LDW, 1024, 1024, 1024, 1024, LDW}; return true; }
  if (op < 6) { const int d = op - 4; o = {p.rw_w1 + ((size_t)j * 2 + d) * 1024 * 64, p.Wp + (size_t)(4096 + d * 64) * LDW, 1024, 64, 1024, 64, LDW}; return true; }
  if (op < 8) { const int d = op - 6; o = {p.rw_a1 + ((size_t)j * 2 + d) * 1024 * 64, p.Wp + (size_t)(4224 + d * 64) * LDW, 1024, 64, 1024, 64, LDW}; return true; }
  if (op < 10) { const int d = op - 8; o = {p.rw_w2 + ((size_t)j * 2 + d) * 64 * 1024, p.w2t + (size_t)d * 65536, 64, 1024, 64, 1024, 64}; return true; }
  if (op < 12) { const int d = op - 10; o = {p.rw_a2 + ((size_t)j * 2 + d) * 64 * 1024, p.a2t + (size_t)d * 65536, 64, 1024, 64, 1024, 64}; return true; }
  if (op == 12) { o = {p.rw_w_out + (size_t)j * 1024 * 1024, p.Wo, 1024, 1024, 1024, 1024, LDW}; return true; }
  if (j == 1 && op == 13) { o = {p.rw_v1, p.Wp + (size_t)4352 * LDW, 1024, 32, 1024, 128, LDW}; return true; }
  if (j == 1 && op == 14) { o = {p.rw_v2, p.v2t, 32, 1024, 64, 1024, 64}; return true; }
  return false;
}

__device__ void transpose_phase(const Params& p, int i, char* smem) {
  float* t = (float*)smem;
  const int tid = otid();
  int base = 0;
  for (int op = 0;; ++op) {
    TOp o;
    if (!get_op(p, i, op, o)) break;
    const int tk = o.Kp / 64, tn = o.Np / 64, nt = tk * tn;
    int first = blockIdx.x - (base % (int)gridDim.x);
    if (first < 0) first += gridDim.x;
    for (int g = first; g < nt; g += gridDim.x) {
      const int kt = g / tn, ntile = g % tn;
      __syncthreads();
#pragma unroll
      for (int ps = 0; ps < 4; ++ps) {
        const int kr = ps * 16 + (tid >> 4), c4 = (tid & 15) * 4;
        const int k = kt * 64 + kr, n = ntile * 64 + c4;
        f32x4 v = (f32x4){0.f, 0.f, 0.f, 0.f};
        if (k < o.K && n < o.N) v = *(const f32x4*)(o.src + (size_t)k * o.N + n);
        t[kr * 65 + c4 + 0] = v.x; t[kr * 65 + c4 + 1] = v.y; t[kr * 65 + c4 + 2] = v.z; t[kr * 65 + c4 + 3] = v.w;
      }
      __syncthreads();
      const int n = tid >> 2, kc = (tid & 3) * 16;
      unsigned w[8];
#pragma unroll
      for (int e = 0; e < 8; ++e) w[e] = pk2(t[(kc + 2 * e) * 65 + n], t[(kc + 2 * e + 1) * 65 + n]);
      bf* d = o.dst + (size_t)(ntile * 64 + n) * o.ldd + kt * 64 + kc;
      *(u32x4*)d = (u32x4){w[0], w[1], w[2], w[3]};
      *(u32x4*)(d + 8) = (u32x4){w[4], w[5], w[6], w[7]};
    }
    base += nt;
  }
}

template <bool UPD, bool MKH>
__device__ __forceinline__ void row_phase_t(const Params& p, int i) {
  const int tid = otid(), lane = tid & 63;
  const int gw = blockIdx.x * 4 + (tid >> 6), nw = gridDim.x * 4;
  const int nrows = MKH ? MT : NL;
  for (int row0 = gw; row0 < nrows; row0 += 2 * nw) {
    const bool valid1 = (row0 + nw) < nrows;
    const int rws[2] = {row0, valid1 ? row0 + nw : row0};
    f32x4 xv[2][4];
    u32x2 ou[2][4];
#pragma unroll
    for (int u = 0; u < 2; ++u) {
      const int row = rws[u];
      const float* xs;
      if (i <= 1) xs = (row < NL) ? p.x + (size_t)row * 1024 : p.ctx + (size_t)(row - NL) * 1024;
      else xs = (row < NL) ? p.out + (size_t)row * 1024 : p.ctxbuf + (size_t)(row - NL) * 1024;
#pragma unroll
      for (int q = 0; q < 4; ++q) xv[u][q] = *(const f32x4*)(xs + q * 256 + lane * 4);
      if (UPD) {
        const bf* orow = p.R + (size_t)row * 1024;
#pragma unroll
        for (int q = 0; q < 4; ++q) ou[u][q] = *(const u32x2*)(orow + q * 256 + lane * 4);
      }
    }
#pragma unroll
    for (int u = 0; u < 2; ++u) {
      const int row = rws[u];
      const bool st = (u == 0) || valid1;
      const int m = mod_idx(row);
      if (UPD) {
        float ov[4][4];
        float ss = 0.f;
#pragma unroll
        for (int q = 0; q < 4; ++q) {
          ov[q][0] = bflo(ou[u][q].x); ov[q][1] = bfhi(ou[u][q].x); ov[q][2] = bflo(ou[u][q].y); ov[q][3] = bfhi(ou[u][q].y);
          ss += ov[q][0] * ov[q][0] + ov[q][1] * ov[q][1] + ov[q][2] * ov[q][2] + ov[q][3] * ov[q][3];
        }
        ss = wave_sum(ss);
        const float rs = rsqrtf(ss * (1.f / 1024.f) + 1e-6f);
        const float* gate = p.mod + (size_t)((i - 1) * 9 + m) * 3072 + 2048;
        const float* pg = p.post_g + (i - 1) * 1024;
        float* xd = (row < NL) ? p.out + (size_t)row * 1024 : p.ctxbuf + (size_t)(row - NL) * 1024;
#pragma unroll
        for (int q = 0; q < 4; ++q) {
          const int col = q * 256 + lane * 4;
          const f32x4 gv = *(const f32x4*)(gate + col);
          const f32x4 pv = *(const f32x4*)(pg + col);
          xv[u][q].x += gv.x * ov[q][0] * rs * pv.x;
          xv[u][q].y += gv.y * ov[q][1] * rs * pv.y;
          xv[u][q].z += gv.z * ov[q][2] * rs * pv.z;
          xv[u][q].w += gv.w * ov[q][3] * rs * pv.w;
          if (st) *(f32x4*)(xd + col) = xv[u][q];
        }
      }
      if (MKH) {
        float ss = 0.f;
#pragma unroll
        for (int q = 0; q < 4; ++q) ss += xv[u][q].x * xv[u][q].x + xv[u][q].y * xv[u][q].y + xv[u][q].z * xv[u][q].z + xv[u][q].w * xv[u][q].w;
        ss = wave_sum(ss);
        const float rs = rsqrtf(ss * (1.f / 1024.f) + 1e-6f);
        const float* md = p.mod + (size_t)(i * 9 + m) * 3072;
        const float* pg = p.pre_g + i * 1024;
        bf* hd = p.H + (size_t)row * LDH;
#pragma unroll
        for (int q = 0; q < 4; ++q) {
          const int col = q * 256 + lane * 4;
          const f32x4 sh = *(const f32x4*)(md + col);
          const f32x4 sc = *(const f32x4*)(md + 1024 + col);
          const f32x4 pv = *(const f32x4*)(pg + col);
          const float h0 = xv[u][q].x * rs * pv.x * (1.f + sc.x) + sh.x;
          const float h1 = xv[u][q].y * rs * pv.y * (1.f + sc.y) + sh.y;
          const float h2 = xv[u][q].z * rs * pv.z * (1.f + sc.z) + sh.z;
          const float h3 = xv[u][q].w * rs * pv.w * (1.f + sc.w) + sh.w;
          if (st) *(u32x2*)(hd + col) = (u32x2){pk2(h0, h1), pk2(h2, h3)};
        }
      }
    }
  }
}
__device__ __forceinline__ void row_phase(const Params& p, int i) {
  if (i == 0) row_phase_t<false, true>(p, i);
  else if (i < 4) row_phase_t<true, true>(p, i);
  else row_phase_t<true, false>(p, i);
}

struct EpiRwkvProj {
  bf *R, *K, *V, *G, *HID;
  __device__ __forceinline__ void operator()(int nt, int tok, int col, f32x4 v) const {
    bf* dst;
    if (nt < 8) dst = R + (size_t)tok * 1024 + col;
    else if (nt < 16) dst = K + (size_t)tok * 1024 + (col - 1024);
    else if (nt < 24) dst = V + (size_t)tok * 1024 + (col - 2048);
    else if (nt < 32) {
      dst = G + (size_t)tok * 1024 + (col - 3072);
#pragma unroll
      for (int e = 0; e < 4; ++e) v[e] = siluf(v[e]);
    } else {
      dst = HID + (size_t)tok * HIDW + (col - 4096);
      if (nt == 32) {
#pragma unroll
        for (int e = 0; e < 4; ++e) v[e] = tanh_fast(v[e]);
      }
    }
    *(u32x2*)dst = (u32x2){pk2(v[0], v[1]), pk2(v[2], v[3])};
  }
};
struct EpiNaProj {
  bf *Q, *K, *Vt, *G; const float* bias;
  __device__ __forceinline__ void operator()(int nt, int tok, int col, f32x4 v) const {
    const f32x4 b = *(const f32x4*)(bias + col);
    v[0] += b.x; v[1] += b.y; v[2] += b.z; v[3] += b.w;
    if (nt >= 16 && nt < 24) {
      const int c = col - 2048;
#pragma unroll
      for (int e = 0; e < 4; ++e) Vt[(size_t)(c + e) * MT + tok] = (bf)(pk2(v[e], 0.f) & 0xffffu);
      return;
    }
    bf* dst;
    if (nt < 8) { dst = Q + (size_t)tok * 1024 + col; v[0] *= 0.125f; v[1] *= 0.125f; v[2] *= 0.125f; v[3] *= 0.125f; }
    else if (nt < 16) dst = K + (size_t)tok * 1024 + (col - 1024);
    else dst = G + (size_t)tok * 1024 + (col - 3072);
    *(u32x2*)dst = (u32x2){pk2(v[0], v[1]), pk2(v[2], v[3])};
  }
};
struct EpiOut {
  bf* O;
  __device__ __forceinline__ void operator()(int nt, int tok, int col, f32x4 v) const {
    *(u32x2*)(O + (size_t)tok * 1024 + col) = (u32x2){pk2(v[0], v[1]), pk2(v[2], v[3])};
  }
};
struct EpiVres {
  bf* V2; const bf* VF; const float* v0;
  __device__ __forceinline__ void operator()(int nt, int tok, int col, f32x4 z) const {
    const f32x4 b = *(const f32x4*)(v0 + col);
    const u32x2 uv = *(const u32x2*)(V2 + (size_t)tok * 1024 + col);
    const u32x2 uf = *(const u32x2*)(VF + (size_t)tok * 1024 + col);
    const float v[4] = {bflo(uv.x), bfhi(uv.x), bflo(uv.y), bfhi(uv.y)};
    const float f[4] = {bflo(uf.x), bfhi(uf.x), bflo(uf.y), bfhi(uf.y)};
    const float zz[4] = {z[0] + b.x, z[1] + b.y, z[2] + b.z, z[3] + b.w};
    float r[4];
#pragma unroll
    for (int e = 0; e < 4; ++e) r[e] = v[e] + (f[e] - v[e]) * sigmf(zz[e]);
    *(u32x2*)(V2 + (size_t)tok * 1024 + col) = (u32x2){pk2(r[0], r[1]), pk2(r[2], r[3])};
  }
};

template <int AMODE, class Epi>
__device__ void gemm_phase(const bf* __restrict__ A, int lda, const bf* __restrict__ Bt, int ldb, int nkt, int mtiles, int ntiles,
                           const float* __restrict__ mu, const Epi& epi, char* smem, bool fake = false) {
  const int tid = otid(), lane = tid & 63, wid = tid >> 6, wr = wid >> 1, wc = wid & 1, fr = lane & 15, fq = lane >> 4;
  const int rg = tid >> 3, cch = tid & 7;
  char* As = smem;
  char* Bs = smem + 32768;
  constexpr int GM = 6;
  const int xcd = blockIdx.x & 7, slot = blockIdx.x >> 3, nslots = gridDim.x >> 3;
  const int per_group = GM * ntiles;
  const int ngroups = (mtiles + GM - 1) / GM;
  const int my_groups = (ngroups - xcd + 7) >> 3;
  const int my_total = my_groups * per_group;
  for (int q = slot; q < my_total; q += nslots) {
    const int gi = q / per_group, e = q - gi * per_group;
    const int nt = e / GM, mt = (xcd + 8 * gi) * GM + (e - nt * GM);
    if (mt >= mtiles) continue;
    const int row0 = mt * 128, col0 = nt * 128;
    int lerp = 0; bool sstart = false, send = false;
    if (AMODE == 1) {
      lerp = (nt < 8) ? 0 : (nt < 16) ? 2 : (nt < 24) ? 3 : (nt < 32) ? 5 : (nt == 32) ? 1 : (nt == 33) ? 4 : 3;
      if (row0 < NL) { sstart = (row0 & (SEQ - 1)) == 0; send = ((row0 + 128) & (SEQ - 1)) == 0; }
      else { sstart = ((row0 - NL) & (CTXL - 1)) == 0; send = ((row0 + 128 - NL) & (CTXL - 1)) == 0; }
    }
    f32x4 acc[4][4];
#pragma unroll
    for (int m = 0; m < 4; ++m)
#pragma unroll
      for (int n = 0; n < 4; ++n) acc[m][n] = (f32x4){0.f, 0.f, 0.f, 0.f};
    u32x4 ra[6];
    f32x4 muv[2];
    auto glds_tile = [&](const bf* G, int ld, int grow0, int kt, char* ldsbase) {
#pragma unroll
      for (int pc = 0; pc < 4; ++pc) {
        const int row = wid * 32 + pc * 8 + (lane >> 3), cp = lane & 7, c = cp ^ ((row >> 1) & 7);
        const bf* src = G + (size_t)(grow0 + row) * ld + kt * 64 + c * 8;
        __builtin_amdgcn_global_load_lds((const __attribute__((address_space(1))) void*)src,
                                         (__attribute__((address_space(3))) void*)(ldsbase + row * 128 + cp * 16), 16, 0, 0);
      }
    };
    auto gloadA = [&](int kt) {
      const int kc = kt * 64 + cch * 8;
#pragma unroll
      for (int i = 0; i < 6; ++i) {
        const int r = row0 + rg * 4 + i - 1;
        const bool zero = (i == 0 && rg == 0 && sstart) || (i == 5 && rg == 31 && send);
        ra[i] = zero ? (u32x4){0, 0, 0, 0} : *(const u32x4*)(A + (size_t)r * lda + kc);
      }
      muv[0] = *(const f32x4*)(mu + lerp * 1024 + kc);
      muv[1] = *(const f32x4*)(mu + lerp * 1024 + kc + 4);
    };
    auto lstoreA = [&](int buf) {
      char* a = As + buf * 16384;
#pragma unroll
      for (int i = 0; i < 4; ++i) {
        const u32x4 hm = ra[i], h0 = ra[i + 1], hp = ra[i + 2];
        u32x4 o;
        o.x = lerp2(hm.x, h0.x, hp.x, muv[0].x, muv[0].y);
        o.y = lerp2(hm.y, h0.y, hp.y, muv[0].z, muv[0].w);
        o.z = lerp2(hm.z, h0.z, hp.z, muv[1].x, muv[1].y);
        o.w = lerp2(hm.w, h0.w, hp.w, muv[1].z, muv[1].w);
        *(u32x4*)(a + lds_off(rg * 4 + i, cch)) = o;
      }
    };
    lds_barrier();
    glds_tile(Bt, ldb, col0, 0, Bs);
    if (AMODE == 0) glds_tile(A, lda, row0, 0, As);
    else { gloadA(0); lstoreA(0); }
    asm volatile("s_waitcnt vmcnt(0)" ::: "memory");
    lds_barrier();
    for (int kt = 0; kt < nkt; ++kt) {
      const int buf = kt & 1;
      if (!fake && kt + 1 < nkt) {
        glds_tile(Bt, ldb, col0, kt + 1, Bs + (buf ^ 1) * 16384);
        if (AMODE == 0) glds_tile(A, lda, row0, kt + 1, As + (buf ^ 1) * 16384);
        else gloadA(kt + 1);
      }
      const char* a = As + buf * 16384;
      const char* b = Bs + buf * 16384;
#pragma unroll
      for (int ks = 0; ks < 2; ++ks) {
        bf16x8 af[4], bfr[4];
#pragma unroll
        for (int m = 0; m < 4; ++m) af[m] = *(const bf16x8*)(a + lds_off(wr * 64 + m * 16 + fr, ks * 4 + fq));
#pragma unroll
        for (int n = 0; n < 4; ++n) bfr[n] = *(const bf16x8*)(b + lds_off(wc * 64 + n * 16 + fr, ks * 4 + fq));
        __builtin_amdgcn_s_setprio(1);
#pragma unroll
        for (int m = 0; m < 4; ++m)
#pragma unroll
          for (int n = 0; n < 4; ++n) acc[m][n] = __builtin_amdgcn_mfma_f32_16x16x32_bf16(bfr[n], af[m], acc[m][n], 0, 0, 0);
        __builtin_amdgcn_s_setprio(0);
      }
      if (AMODE == 1 && kt + 1 < nkt) lstoreA(buf ^ 1);
      asm volatile("s_waitcnt vmcnt(0)" ::: "memory");
      lds_barrier();
    }
#pragma unroll
    for (int m = 0; m < 4; ++m)
#pragma unroll
      for (int n = 0; n < 4; ++n) epi(nt, row0 + wr * 64 + m * 16 + fr, col0 + wc * 64 + n * 16 + fq * 4, acc[m][n]);
  }
}

typedef float f32x2 __attribute__((ext_vector_type(2)));
__device__ __forceinline__ float oct_sum(float v) {
  int t = __builtin_amdgcn_update_dpp(0, __float_as_int(v), 0xB1, 0xF, 0xF, true);
  v += __int_as_float(t);
  t = __builtin_amdgcn_update_dpp(0, __float_as_int(v), 0x4E, 0xF, 0xF, true);
  v += __int_as_float(t);
  t = __builtin_amdgcn_update_dpp(0, __float_as_int(v), 0x141, 0xF, 0xF, true);
  v += __int_as_float(t);
  return v;
}
__device__ __forceinline__ f32x2 fma2(f32x2 a, f32x2 b, f32x2 c) { return __builtin_elementwise_fma(a, b, c); }
__device__ __forceinline__ float fma_s(float a, float b, float c) { float d; asm("v_fma_f32 %0, %1, %2, %3" : "=v"(d) : "v"(a), "v"(b), "v"(c)); return d; }
__device__ __forceinline__ float mul_s(float a, float b) { float d; asm("v_mul_f32 %0, %1, %2" : "=v"(d) : "v"(a), "v"(b)); return d; }
struct ScanOps { f32x4 w[2], nk[2], bb[2], kd[2], rr[2]; f32x2 vv; };
__device__ __forceinline__ ScanOps scan_load(const float* ops, const float* vs, int t, int kq, int vrow) {
  ScanOps r;
  const float* o = ops + t * 320 + kq * 8;
  r.w[0] = *(const f32x4*)(o); r.w[1] = *(const f32x4*)(o + 4);
  r.nk[0] = *(const f32x4*)(o + 64); r.nk[1] = *(const f32x4*)(o + 68);
  r.bb[0] = *(const f32x4*)(o + 128); r.bb[1] = *(const f32x4*)(o + 132);
  r.kd[0] = *(const f32x4*)(o + 192); r.kd[1] = *(const f32x4*)(o + 196);
  r.rr[0] = *(const f32x4*)(o + 256); r.rr[1] = *(const f32x4*)(o + 260);
  r.vv = *(const f32x2*)(vs + t * 64 + vrow);
  return r;
}
#define PR(v, i) ((f32x2){(v)[(i) >> 1][((i) & 1) * 2], (v)[(i) >> 1][((i) & 1) * 2 + 1]})

constexpr int SC_P = 0, SC_YA = 8192, SC_V = 16384, SC_AT = 24576, SC_RT = SC_AT + 4352, SC_BT = SC_RT + 4352, SC_KT = SC_BT + 4352;
constexpr int SC_BTT = 41984, SC_KTT = SC_BTT + 4608, SC_MABT = 51200, SC_SM = 53248;
__device__ __forceinline__ bf16x8 mk8(u32x2 lo, u32x2 hi) { u32x4 u = (u32x4){lo.x, lo.y, hi.x, hi.y}; return __builtin_bit_cast(bf16x8, u); }
__device__ __forceinline__ bf16x8 mk4(u32x2 lo) { u32x4 u = (u32x4){lo.x, lo.y, 0u, 0u}; return __builtin_bit_cast(bf16x8, u); }
__device__ __forceinline__ float bfround(float x) { return bflo(pk2(x, 0.f) & 0xffffu); }
__device__ __forceinline__ void split4(f32x4 x, u32x2& hi, u32x2& lo) {
  hi = (u32x2){pk2(x[0], x[1]), pk2(x[2], x[3])};
  const float r0 = x[0] - bflo(hi.x), r1 = x[1] - bfhi(hi.x), r2 = x[2] - bflo(hi.y), r3 = x[3] - bfhi(hi.y);
  lo = (u32x2){pk2(r0, r1), pk2(r2, r3)};
}

__device__ void scan_phase(const Params& p, int j, char* smem) {
  const int tid = otid(), lane = tid & 63, wid = tid >> 6, fr = lane & 15, fq = lane >> 4;
  float* Pbuf = (float*)(smem + SC_P);
  float* abuf = (float*)(smem + SC_YA);
  float* ys = (float*)(smem + SC_YA);
  float* vs = (float*)(smem + SC_V);
  for (int item = blockIdx.x; item < 256; item += gridDim.x) {
  const int b = item >> 5, h = (item >> 1) & 15, d = item & 1;
  lds_barrier();
  const bf* Vsrc = (j == 0) ? p.VF : p.V2;
  bf* Ydst = (d == 0) ? p.H : p.Y1;
  const int ldy = (d == 0) ? LDH : 1024;
  float* betad = p.beta + (size_t)d * MT * 16;
  bf16x8 bw[2], ba[2];
  {
    const int n = h * 64 + wid * 16 + fr;
#pragma unroll
    for (int ks = 0; ks < 2; ++ks) {
      bw[ks] = *(const bf16x8*)(p.w2t + (size_t)d * 65536 + (size_t)n * 64 + ks * 32 + fq * 8);
      ba[ks] = *(const bf16x8*)(p.a2t + (size_t)d * 65536 + (size_t)n * 64 + ks * 32 + fq * 8);
    }
  }
  float w0v[4], a0v[4];
#pragma unroll
  for (int e = 0; e < 4; ++e) {
    w0v[e] = p.rw_w0[(size_t)(j * 2 + d) * 1024 + h * 64 + wid * 16 + fq * 4 + e];
    a0v[e] = p.rw_a0[(size_t)(j * 2 + d) * 1024 + h * 64 + wid * 16 + fq * 4 + e];
  }
  const int tt = tid >> 3, c8 = tid & 7;
  float kkv[8], kav[8], rkv[8];
#pragma unroll
  for (int e = 0; e < 8; ++e) {
    kkv[e] = p.rw_k_k[j * 1024 + h * 64 + c8 * 8 + e];
    kav[e] = p.rw_k_a[j * 1024 + h * 64 + c8 * 8 + e];
    rkv[e] = p.rw_r_k[j * 1024 + h * 64 + c8 * 8 + e];
  }
  f32x4 ST[4];
#pragma unroll
  for (int kt = 0; kt < 4; ++kt) ST[kt] = (f32x4){0.f, 0.f, 0.f, 0.f};

  bf16x8 phw[2][2], pha[2][2];
  u32x4 puk, pur, puv;
  auto rowbase_of = [&](int ch, int& sgn) -> int {
    if (d == 0) { sgn = 1; return (ch < 8) ? NL + b * CTXL + ch * 32 : b * SEQ + (ch - 8) * 32; }
    sgn = -1; return (ch < 8) ? NL + b * CTXL + 255 - ch * 32 : b * SEQ + 8191 - (ch - 8) * 32;
  };
  auto prefetch = [&](int ch) {
    int sgn; const int rowbase = rowbase_of(ch, sgn);
#pragma unroll
    for (int m = 0; m < 2; ++m) {
      const size_t row = (size_t)(rowbase + sgn * (m * 16 + fr));
#pragma unroll
      for (int ks = 0; ks < 2; ++ks) {
        phw[m][ks] = *(const bf16x8*)(p.HID + row * HIDW + d * 64 + ks * 32 + fq * 8);
        pha[m][ks] = *(const bf16x8*)(p.HID + row * HIDW + 128 + d * 64 + ks * 32 + fq * 8);
      }
    }
    const size_t off = (size_t)(rowbase + sgn * tt) * 1024 + h * 64 + c8 * 8;
    puk = *(const u32x4*)(p.K + off);
    pur = *(const u32x4*)(p.R + off);
    puv = *(const u32x4*)(Vsrc + off);
  };
  prefetch(0);

  for (int ch = 0; ch < 264; ++ch) {
    int sgn; const int rowbase = rowbase_of(ch, sgn);
#pragma unroll
    for (int m = 0; m < 2; ++m) {
      const int tok = m * 16 + fr;
      f32x4 aw = (f32x4){0.f, 0.f, 0.f, 0.f}, aa = aw;
#pragma unroll
      for (int ks = 0; ks < 2; ++ks) {
        aw = __builtin_amdgcn_mfma_f32_16x16x32_bf16(bw[ks], phw[m][ks], aw, 0, 0, 0);
        aa = __builtin_amdgcn_mfma_f32_16x16x32_bf16(ba[ks], pha[m][ks], aa, 0, 0, 0);
      }
      f32x4 wd, av;
#pragma unroll
      for (int e = 0; e < 4; ++e) {
        const float ez = __expf(-(w0v[e] + aw[e]));
        wd[e] = __expf(-0.60653066f * __builtin_amdgcn_rcpf(1.f + ez));
        av[e] = __builtin_amdgcn_rcpf(1.f + __expf(-(a0v[e] + aa[e])));
      }
      *(f32x4*)(Pbuf + tok * 64 + wid * 16 + fq * 4) = wd;
      *(f32x4*)(abuf + tok * 64 + wid * 16 + fq * 4) = av;
    }
    lds_barrier();
    if (tid < 128) {
      const int k = tid & 63, sc = tid >> 6;
      float P = 1.f;
#pragma unroll
      for (int t = 0; t < 16; ++t) { float* q = Pbuf + (sc * 16 + t) * 64 + k; P *= *q; *q = P; }
    }
    lds_barrier();
    {
      const size_t row = (size_t)(rowbase + sgn * tt);
      float k[8], r[8], kk[8];
#pragma unroll
      for (int e = 0; e < 4; ++e) {
        k[2 * e] = bflo(puk[e]); k[2 * e + 1] = bfhi(puk[e]);
        r[2 * e] = bflo(pur[e]); r[2 * e + 1] = bfhi(pur[e]);
      }
      float ss = 0.f;
#pragma unroll
      for (int e = 0; e < 8; ++e) { kk[e] = k[e] * kkv[e]; ss += kk[e] * kk[e]; }
      ss = oct_sum(ss);
      const float inv = __builtin_amdgcn_rsqf(fmaxf(ss, 1e-24f));
      const f32x4 a0 = *(const f32x4*)(abuf + tt * 64 + c8 * 8), a1 = *(const f32x4*)(abuf + tt * 64 + c8 * 8 + 4);
      const f32x4 p0 = *(const f32x4*)(Pbuf + tt * 64 + c8 * 8), p1 = *(const f32x4*)(Pbuf + tt * 64 + c8 * 8 + 4);
      f32x4 q0 = (f32x4){1.f, 1.f, 1.f, 1.f}, q1 = q0;
      if (tt & 15) { q0 = *(const f32x4*)(Pbuf + (tt - 1) * 64 + c8 * 8); q1 = *(const f32x4*)(Pbuf + (tt - 1) * 64 + c8 * 8 + 4); }
      const float a[8] = {a0.x, a0.y, a0.z, a0.w, a1.x, a1.y, a1.z, a1.w};
      const float Pt[8] = {p0.x, p0.y, p0.z, p0.w, p1.x, p1.y, p1.z, p1.w};
      const float Pm[8] = {q0.x, q0.y, q0.z, q0.w, q1.x, q1.y, q1.z, q1.w};
      float at[8], bt_[8], kt_[8], rt[8];
      float bsum = 0.f;
#pragma unroll
      for (int e = 0; e < 8; ++e) {
        const float kkn = kk[e] * inv;
        const float kd = k[e] * (1.f + (a[e] - 1.f) * kav[e]);
        bsum += r[e] * kd * rkv[e];
        const float ip = __builtin_amdgcn_rcpf(Pt[e]);
        at[e] = -kkn * Pm[e];
        bt_[e] = kkn * a[e] * ip;
        kt_[e] = kd * ip;
        rt[e] = r[e] * Pt[e];
      }
      bsum = oct_sum(bsum);
      if (c8 == 0) betad[row * 16 + h] = bsum;
      char* ro = smem + tt * 136 + c8 * 16;
      *(u32x2*)(ro + SC_AT) = (u32x2){pk2(at[0], at[1]), pk2(at[2], at[3])};   *(u32x2*)(ro + SC_AT + 8) = (u32x2){pk2(at[4], at[5]), pk2(at[6], at[7])};
      *(u32x2*)(ro + SC_RT) = (u32x2){pk2(rt[0], rt[1]), pk2(rt[2], rt[3])};   *(u32x2*)(ro + SC_RT + 8) = (u32x2){pk2(rt[4], rt[5]), pk2(rt[6], rt[7])};
      *(u32x2*)(ro + SC_BT) = (u32x2){pk2(bt_[0], bt_[1]), pk2(bt_[2], bt_[3])}; *(u32x2*)(ro + SC_BT + 8) = (u32x2){pk2(bt_[4], bt_[5]), pk2(bt_[6], bt_[7])};
      *(u32x2*)(ro + SC_KT) = (u32x2){pk2(kt_[0], kt_[1]), pk2(kt_[2], kt_[3])}; *(u32x2*)(ro + SC_KT + 8) = (u32x2){pk2(kt_[4], kt_[5]), pk2(kt_[6], kt_[7])};
#pragma unroll
      for (int e = 0; e < 8; ++e) {
        *(bf*)(smem + SC_BTT + (c8 * 8 + e) * 72 + tt * 2) = (bf)(pk2(bt_[e], 0.f) & 0xffffu);
        *(bf*)(smem + SC_KTT + (c8 * 8 + e) * 72 + tt * 2) = (bf)(pk2(kt_[e], 0.f) & 0xffffu);
      }
      *(f32x4*)(vs + tt * 64 + c8 * 8) = (f32x4){bflo(puv[0]), bfhi(puv[0]), bflo(puv[1]), bfhi(puv[1])};
      *(f32x4*)(vs + tt * 64 + c8 * 8 + 4) = (f32x4){bflo(puv[2]), bfhi(puv[2]), bflo(puv[3]), bfhi(puv[3])};
    }
    lds_barrier();
    if (ch + 1 < 264) prefetch(ch + 1);
    {
      auto gram = [&](int xbase, int ybase, int sc) -> f32x4 {
        f32x4 acc = (f32x4){0.f, 0.f, 0.f, 0.f};
#pragma unroll
        for (int ks = 0; ks < 2; ++ks) {
          const char* xp = smem + xbase + (sc * 16 + fr) * 136 + ks * 64 + fq * 16;
          const char* yp = smem + ybase + (sc * 16 + fr) * 136 + ks * 64 + fq * 16;
          const bf16x8 xf = mk8(*(const u32x2*)xp, *(const u32x2*)(xp + 8));
          const bf16x8 yf = mk8(*(const u32x2*)yp, *(const u32x2*)(yp + 8));
          acc = __builtin_amdgcn_mfma_f32_16x16x32_bf16(xf, yf, acc, 0, 0, 0);
        }
        return acc;
      };
      auto store_small = [&](f32x4 g, int sc, int kind, bool strict) {
#pragma unroll
        for (int e = 0; e < 4; ++e) { const int sidx = fq * 4 + e; const bool keep = strict ? (sidx < fr) : (sidx <= fr); g[e] = keep ? g[e] : 0.f; }
        *(u32x2*)(smem + SC_SM + (sc * 5 + kind) * 640 + fr * 40 + fq * 8) = (u32x2){pk2(g[0], g[1]), pk2(g[2], g[3])};
      };
      if (wid < 2) {
        const int sc = wid;
        f32x4 g = gram(SC_BT, SC_AT, sc);
#pragma unroll
        for (int e = 0; e < 4; ++e) g[e] = (fq * 4 + e < fr) ? g[e] : 0.f;
        *(f32x4*)(smem + SC_MABT + sc * 1024 + fr * 64 + fq * 16) = g;
        asm volatile("s_waitcnt lgkmcnt(0)" ::: "memory");
        if (lane < 16) {
          float n[16];
#pragma unroll
          for (int t = 0; t < 16; ++t) {
            const float* mc = (const float*)(smem + SC_MABT + sc * 1024 + t * 64);
            float acc = (t == lane) ? 1.f : 0.f;
#pragma unroll
            for (int sp = 0; sp < t; ++sp) acc = fmaf(n[sp], mc[sp], acc);
            n[t] = acc;
          }
#pragma unroll
          for (int t = 0; t < 16; ++t) {
            const unsigned hi = pk2(n[t], 0.f) & 0xffffu;
            const unsigned lo = pk2(n[t] - bflo(hi), 0.f) & 0xffffu;
            *(bf*)(smem + SC_SM + (sc * 5 + 0) * 640 + t * 40 + lane * 2) = (bf)hi;
            *(bf*)(smem + SC_SM + (sc * 5 + 1) * 640 + t * 40 + lane * 2) = (bf)lo;
          }
        }
      } else {
        const int sc = wid - 2;
        store_small(gram(SC_KT, SC_AT, sc), sc, 2, true);
        store_small(gram(SC_BT, SC_RT, sc), sc, 3, false);
        store_small(gram(SC_KT, SC_RT, sc), sc, 4, false);
      }
    }
    lds_barrier();
#pragma unroll
    for (int sc = 0; sc < 2; ++sc) {
      bf16x8 shi[2], slo[2];
#pragma unroll
      for (int g = 0; g < 2; ++g) {
        u32x2 h0, l0, h1, l1;
        split4(ST[2 * g], h0, l0); split4(ST[2 * g + 1], h1, l1);
        shi[g] = mk8(h0, h1); slo[g] = mk8(l0, l1);
      }
      const char* arow = smem + SC_AT + (sc * 16 + fr) * 136 + fq * 8;
      const char* rrow = smem + SC_RT + (sc * 16 + fr) * 136 + fq * 8;
      f32x4 wt = (f32x4){0.f, 0.f, 0.f, 0.f}, yt = wt;
#pragma unroll
      for (int g = 0; g < 2; ++g) {
        const bf16x8 xa = mk8(*(const u32x2*)(arow + g * 64), *(const u32x2*)(arow + g * 64 + 32));
        const bf16x8 xr = mk8(*(const u32x2*)(rrow + g * 64), *(const u32x2*)(rrow + g * 64 + 32));
        wt = __builtin_amdgcn_mfma_f32_16x16x32_bf16(xa, shi[g], wt, 0, 0, 0);
        wt = __builtin_amdgcn_mfma_f32_16x16x32_bf16(xa, slo[g], wt, 0, 0, 0);
        yt = __builtin_amdgcn_mfma_f32_16x16x32_bf16(xr, shi[g], yt, 0, 0, 0);
        yt = __builtin_amdgcn_mfma_f32_16x16x32_bf16(xr, slo[g], yt, 0, 0, 0);
      }
      const int vcol = wid * 16 + fr;
      const float* vp = vs + (sc * 16 + fq * 4) * 64 + vcol;
      const bf16x8 vmf = mk4((u32x2){pk2(vp[0], vp[64]), pk2(vp[128], vp[192])});
      const char* smb = smem + SC_SM + sc * 5 * 640 + fr * 40 + fq * 8;
      const bf16x8 xnh = mk4(*(const u32x2*)(smb)), xnl = mk4(*(const u32x2*)(smb + 640));
      const bf16x8 xmak = mk4(*(const u32x2*)(smb + 2 * 640)), xmrb = mk4(*(const u32x2*)(smb + 3 * 640)), xmrk = mk4(*(const u32x2*)(smb + 4 * 640));
      wt = __builtin_amdgcn_mfma_f32_16x16x32_bf16(xmak, vmf, wt, 0, 0, 0);
      u32x2 whi, wlo;
      split4(wt, whi, wlo);
      f32x4 ut = (f32x4){0.f, 0.f, 0.f, 0.f};
      ut = __builtin_amdgcn_mfma_f32_16x16x32_bf16(xnh, mk4(whi), ut, 0, 0, 0);
      ut = __builtin_amdgcn_mfma_f32_16x16x32_bf16(xnh, mk4(wlo), ut, 0, 0, 0);
      ut = __builtin_amdgcn_mfma_f32_16x16x32_bf16(xnl, mk4(whi), ut, 0, 0, 0);
      u32x2 uhi, ulo;
      split4(ut, uhi, ulo);
      const bf16x8 uhf = mk4(uhi), ulf = mk4(ulo);
      yt = __builtin_amdgcn_mfma_f32_16x16x32_bf16(xmrb, uhf, yt, 0, 0, 0);
      yt = __builtin_amdgcn_mfma_f32_16x16x32_bf16(xmrb, ulf, yt, 0, 0, 0);
      yt = __builtin_amdgcn_mfma_f32_16x16x32_bf16(xmrk, vmf, yt, 0, 0, 0);
#pragma unroll
      for (int e = 0; e < 4; ++e) ys[(sc * 16 + fq * 4 + e) * 64 + vcol] = yt[e];
#pragma unroll
      for (int kt = 0; kt < 4; ++kt) {
        const bf16x8 xb = mk4(*(const u32x2*)(smem + SC_BTT + (kt * 16 + fr) * 72 + (sc * 16 + fq * 4) * 2));
        const bf16x8 xk = mk4(*(const u32x2*)(smem + SC_KTT + (kt * 16 + fr) * 72 + (sc * 16 + fq * 4) * 2));
        ST[kt] = __builtin_amdgcn_mfma_f32_16x16x32_bf16(xb, uhf, ST[kt], 0, 0, 0);
        ST[kt] = __builtin_amdgcn_mfma_f32_16x16x32_bf16(xb, ulf, ST[kt], 0, 0, 0);
        ST[kt] = __builtin_amdgcn_mfma_f32_16x16x32_bf16(xk, vmf, ST[kt], 0, 0, 0);
        const f32x4 pc = *(const f32x4*)(Pbuf + (sc * 16 + 15) * 64 + kt * 16 + fq * 4);
        ST[kt] = ST[kt] * pc;
      }
    }
    lds_barrier();
    {
      const size_t row = (size_t)(rowbase + sgn * tt);
      const f32x4 y0 = *(const f32x4*)(ys + tt * 64 + c8 * 8), y1 = *(const f32x4*)(ys + tt * 64 + c8 * 8 + 4);
      *(u32x4*)(Ydst + row * ldy + h * 64 + c8 * 8) = (u32x4){pk2(y0.x, y0.y), pk2(y0.z, y0.w), pk2(y1.x, y1.y), pk2(y1.z, y1.w)};
    }
    lds_barrier();
  }
  }
}

__device__ void og_phase(const Params& p, int j) {
  const int tid = otid(), lane = tid & 63;
  const int gw = blockIdx.x * 4 + (tid >> 6), nw = gridDim.x * 4;
  const bf* Vsrc = (j == 0) ? p.VF : p.V2;
  const int col = lane * 16, hh = lane >> 2;
  float lw[16], lb[16];
#pragma unroll
  for (int e = 0; e < 16; ++e) { lw[e] = p.rw_lnx_w[j * 1024 + col + e]; lb[e] = p.rw_lnx_b[j * 1024 + col + e]; }
  for (int row = gw; row < MT; row += nw) {
    const size_t off = (size_t)row * 1024 + col, offh = (size_t)row * LDH + col;
    u32x4 u0[2], u1[2], uv[2], ug[2];
#pragma unroll
    for (int q = 0; q < 2; ++q) {
      u0[q] = *(const u32x4*)(p.H + offh + q * 8);
      u1[q] = *(const u32x4*)(p.Y1 + off + q * 8);
      uv[q] = *(const u32x4*)(Vsrc + off + q * 8);
      ug[q] = *(const u32x4*)(p.G + off + q * 8);
    }
    const float bsum = p.beta[(size_t)row * 16 + hh] + p.beta[(size_t)MT * 16 + (size_t)row * 16 + hh];
    float y[16], v[16], g[16];
    float s = 0.f;
#pragma unroll
    for (int e = 0; e < 8; ++e) {
      y[2 * e] = bflo(u0[e >> 2][e & 3]) + bflo(u1[e >> 2][e & 3]); y[2 * e + 1] = bfhi(u0[e >> 2][e & 3]) + bfhi(u1[e >> 2][e & 3]);
      v[2 * e] = bflo(uv[e >> 2][e & 3]); v[2 * e + 1] = bfhi(uv[e >> 2][e & 3]);
      g[2 * e] = bflo(ug[e >> 2][e & 3]); g[2 * e + 1] = bfhi(ug[e >> 2][e & 3]);
      s += y[2 * e] + y[2 * e + 1];
    }
    s = quad_sum(s);
    const float mean = s * (1.f / 64.f);
    float q2 = 0.f;
#pragma unroll
    for (int e = 0; e < 16; ++e) { const float dd = y[e] - mean; q2 += dd * dd; }
    q2 = quad_sum(q2);
    const float rstd = rsqrtf(q2 * (1.f / 64.f) + 64e-5f);
    unsigned o[8];
#pragma unroll
    for (int e = 0; e < 8; ++e) {
      const float r0 = ((y[2 * e] - mean) * rstd * lw[2 * e] + lb[2 * e] + bsum * v[2 * e]) * g[2 * e];
      const float r1 = ((y[2 * e + 1] - mean) * rstd * lw[2 * e + 1] + lb[2 * e + 1] + bsum * v[2 * e + 1]) * g[2 * e + 1];
      o[e] = pk2(r0, r1);
    }
    *(u32x4*)(p.H + offh) = (u32x4){o[0], o[1], o[2], o[3]};
    *(u32x4*)(p.H + offh + 8) = (u32x4){o[4], o[5], o[6], o[7]};
  }
}

__device__ void attn_phase(const Params& p, int j, bool ctx_out, char* smem) {
  const int tid = otid(), lane = tid & 63, cgp = tid >> 6, fr = lane & 15, fq = lane >> 4;
  char* Ks = smem;
  bf* Vs = (bf*)smem;
  float* rpbs = (float*)(smem + 36864);
  const bf* Q = p.R; const bf* Kb = p.K; const bf* Vt = p.V2; const bf* Gb = p.G;
  const int nitems = 16384 + (ctx_out ? 512 : 0);
  for (int item = blockIdx.x; item < nitems; item += gridDim.x) {
    int b, h, r = 0, qrow0; bool haswin;
    if (item < 16384) { h = item & 15; r = (item >> 4) & 127; b = item >> 11; haswin = true; qrow0 = b * SEQ + r * 64; }
    else { const int it = item - 16384; h = it & 15; const int qb = (it >> 4) & 3; b = it >> 6; haswin = false; qrow0 = NL + b * CTXL + qb * 64; }
    const int qtok = qrow0 + cgp * 16 + fr;
    bf16x8 qf[2];
#pragma unroll
    for (int ks = 0; ks < 2; ++ks) qf[ks] = *(const bf16x8*)(Q + (size_t)qtok * 1024 + h * 64 + ks * 32 + fq * 8);
    const int rs = min(max(r - 4, 0), 120);
    const int qcol = cgp * 16 + fr;
    const int wsq = min(max(qcol - 8, 0), 48);
    const int bs = min(max(16 * cgp - 8, 0), 32);
    lds_barrier();
    if (haswin) for (int idx = tid; idx < 465; idx += 256) rpbs[idx] = p.na_rpb[((size_t)j * 16 + h) * 465 + idx];
    f32x4 sw[8][2], sc[4][4];
    bf16x8 pw[8];
    float m1 = NEGV, l1 = 0.f;
#pragma unroll
    for (int i = 0; i < 8; ++i) pw[i] = (bf16x8){0, 0, 0, 0, 0, 0, 0, 0};
#pragma unroll
    for (int i = 0; i < 8; ++i)
#pragma unroll
      for (int k2 = 0; k2 < 2; ++k2) sw[i][k2] = (f32x4){NEGV, NEGV, NEGV, NEGV};
#pragma unroll
    for (int st = 0; st < 3; ++st) {
      if (st < 2 && !haswin) continue;
      lds_barrier();
      int tq = tid; asm volatile("" : "+v"(tq));
#pragma unroll
      for (int hf = 0; hf < 2; ++hf) {
        u32x4 u[4];
#pragma unroll
        for (int i = 0; i < 4; ++i) {
          const int q = tq + (hf * 4 + i) * 256, key = q >> 3, c = q & 7, tl = key >> 6;
          const int base = (st < 2) ? b * SEQ + (rs + st * 4 + tl) * 64 : NL + b * CTXL + tl * 64;
          u[i] = *(const u32x4*)(Kb + (size_t)(base + (key & 63)) * 1024 + h * 64 + c * 8);
        }
#pragma unroll
        for (int i = 0; i < 4; ++i) {
          const int q = tq + (hf * 4 + i) * 256, key = q >> 3, c = q & 7;
          *(u32x4*)(Ks + lds_off(key, c)) = u[i];
        }
        __builtin_amdgcn_sched_barrier(0);
      }
      lds_barrier();
      if (st < 2) {
#pragma unroll
        for (int tl = 0; tl < 4; ++tl) {
          const int i = st * 4 + tl;
          const int dr = rs + i - r + 7;
#pragma unroll
          for (int k2 = 0; k2 < 2; ++k2) {
            f32x4 acc = (f32x4){0.f, 0.f, 0.f, 0.f};
#pragma unroll
            for (int ks = 0; ks < 2; ++ks) {
              const bf16x8 kf = *(const bf16x8*)(Ks + lds_off(tl * 64 + bs + k2 * 16 + fr, ks * 4 + fq));
              acc = __builtin_amdgcn_mfma_f32_16x16x32_bf16(kf, qf[ks], acc, 0, 0, 0);
            }
#pragma unroll
            for (int e = 0; e < 4; ++e) {
              const int kc = bs + k2 * 16 + fq * 4 + e;
              const bool valid = (kc >= wsq) && (kc < wsq + 16);
              const int dc = min(max(kc - qcol, -15), 15) + 15;
              sw[i][k2][e] = valid ? acc[e] + rpbs[dr * 31 + dc] : NEGV;
            }
          }
          __builtin_amdgcn_sched_barrier(0);
        }
      } else {
#pragma unroll
        for (int tl = 0; tl < 4; ++tl)
#pragma unroll
          for (int k4 = 0; k4 < 4; ++k4) {
            f32x4 acc = (f32x4){0.f, 0.f, 0.f, 0.f};
#pragma unroll
            for (int ks = 0; ks < 2; ++ks) {
              const bf16x8 kf = *(const bf16x8*)(Ks + lds_off(tl * 64 + k4 * 16 + fr, ks * 4 + fq));
              acc = __builtin_amdgcn_mfma_f32_16x16x32_bf16(kf, qf[ks], acc, 0, 0, 0);
            }
            sc[tl][k4] = acc;
            if (k4 & 1) __builtin_amdgcn_sched_barrier(0);
          }
      }
      if (st == 1) {
#pragma unroll
        for (int i = 0; i < 8; ++i)
#pragma unroll
          for (int k2 = 0; k2 < 2; ++k2)
#pragma unroll
            for (int e = 0; e < 4; ++e) m1 = fmaxf(m1, sw[i][k2][e]);
        m1 = fmaxf(m1, __shfl_xor(m1, 16));
        m1 = fmaxf(m1, __shfl_xor(m1, 32));
#pragma unroll
        for (int i = 0; i < 8; ++i) {
          float e0[4], e1[4];
#pragma unroll
          for (int e = 0; e < 4; ++e) { e0[e] = __expf(sw[i][0][e] - m1); e1[e] = __expf(sw[i][1][e] - m1); l1 += e0[e] + e1[e]; }
          u32x4 u = (u32x4){pk2(e0[0], e0[1]), pk2(e0[2], e0[3]), pk2(e1[0], e1[1]), pk2(e1[2], e1[3])};
          pw[i] = __builtin_bit_cast(bf16x8, u);
        }
        l1 += __shfl_xor(l1, 16);
        l1 += __shfl_xor(l1, 32);
      }
    }
    float m2 = NEGV;
#pragma unroll
    for (int tl = 0; tl < 4; ++tl)
#pragma unroll
      for (int k4 = 0; k4 < 4; ++k4)
#pragma unroll
        for (int e = 0; e < 4; ++e) m2 = fmaxf(m2, sc[tl][k4][e]);
    m2 = fmaxf(m2, __shfl_xor(m2, 16));
    m2 = fmaxf(m2, __shfl_xor(m2, 32));
    const float mx = fmaxf(m1, m2);
    const float alpha1 = __expf(m1 - mx);
    float l2 = 0.f;
    bf16x8 pc[4][2];
#pragma unroll
    for (int tl = 0; tl < 4; ++tl)
#pragma unroll
      for (int g2 = 0; g2 < 2; ++g2) {
        float e0[4], e1[4];
#pragma unroll
        for (int e = 0; e < 4; ++e) { e0[e] = __expf(sc[tl][2 * g2][e] - mx); e1[e] = __expf(sc[tl][2 * g2 + 1][e] - mx); l2 += e0[e] + e1[e]; }
        u32x4 u = (u32x4){pk2(e0[0], e0[1]), pk2(e0[2], e0[3]), pk2(e1[0], e1[1]), pk2(e1[2], e1[3])};
        pc[tl][g2] = __builtin_bit_cast(bf16x8, u);
      }
    l2 += __shfl_xor(l2, 16);
    l2 += __shfl_xor(l2, 32);
    const float l = alpha1 * l1 + l2;
    f32x4 o[4];
#pragma unroll
    for (int dt = 0; dt < 4; ++dt) o[dt] = (f32x4){0.f, 0.f, 0.f, 0.f};
#pragma unroll
    for (int st = 0; st < 3; ++st) {
      if (st < 2 && !haswin) continue;
      lds_barrier();
      int tq = tid; asm volatile("" : "+v"(tq));
#pragma unroll
      for (int hf = 0; hf < 2; ++hf) {
        u32x4 u[4];
#pragma unroll
        for (int i = 0; i < 4; ++i) {
          const int q = tq + (hf * 4 + i) * 256, tl = q >> 9, dd = (q >> 3) & 63, c = q & 7;
          const int base = (st < 2) ? b * SEQ + (rs + st * 4 + tl) * 64 : NL + b * CTXL + tl * 64;
          u[i] = *(const u32x4*)(Vt + (size_t)(h * 64 + dd) * MT + base + c * 8);
        }
#pragma unroll
        for (int i = 0; i < 4; ++i) {
          const int q = tq + (hf * 4 + i) * 256, tl = q >> 9, dd = (q >> 3) & 63, c = q & 7;
          *(u32x4*)(Vs + tl * 4608 + dd * 72 + c * 8) = u[i];
        }
        __builtin_amdgcn_sched_barrier(0);
      }
      lds_barrier();
      if (st < 2) {
#pragma unroll
        for (int tl = 0; tl < 4; ++tl) {
          const int i = st * 4 + tl;
#pragma unroll
          for (int dt = 0; dt < 4; ++dt) {
            const bf* vp = Vs + tl * 4608 + (dt * 16 + fr) * 72 + bs + fq * 4;
            const u32x2 lo = *(const u32x2*)vp, hi = *(const u32x2*)(vp + 16);
            u32x4 u = (u32x4){lo.x, lo.y, hi.x, hi.y};
            o[dt] = __builtin_amdgcn_mfma_f32_16x16x32_bf16(__builtin_bit_cast(bf16x8, u), pw[i], o[dt], 0, 0, 0);
          }
          __builtin_amdgcn_sched_barrier(0);
        }
      } else {
#pragma unroll
        for (int tl = 0; tl < 4; ++tl)
#pragma unroll
          for (int g2 = 0; g2 < 2; ++g2)
#pragma unroll
            for (int dt = 0; dt < 4; ++dt) {
              const bf* vp = Vs + tl * 4608 + (dt * 16 + fr) * 72 + g2 * 32 + fq * 4;
              const u32x2 lo = *(const u32x2*)vp, hi = *(const u32x2*)(vp + 16);
              u32x4 u = (u32x4){lo.x, lo.y, hi.x, hi.y};
              o[dt] = __builtin_amdgcn_mfma_f32_16x16x32_bf16(__builtin_bit_cast(bf16x8, u), pc[tl][g2], o[dt], 0, 0, 0);
              if (dt == 3) __builtin_amdgcn_sched_barrier(0);
            }
      }
      if (st == 1) {
#pragma unroll
        for (int dt = 0; dt < 4; ++dt) o[dt] *= alpha1;
      }
    }
    const float inv = 1.f / l;
#pragma unroll
    for (int dt = 0; dt < 4; ++dt) {
      const size_t off = (size_t)qtok * 1024 + h * 64 + dt * 16 + fq * 4;
      const u32x2 ug = *(const u32x2*)(Gb + off);
      const float g0 = bflo(ug.x), g1 = bfhi(ug.x), g2 = bflo(ug.y), g3 = bfhi(ug.y);
      *(u32x2*)(p.H + (size_t)qtok * LDH + h * 64 + dt * 16 + fq * 4) = (u32x2){pk2(o[dt][0] * inv * siluf(g0), o[dt][1] * inv * siluf(g1)),
                                        pk2(o[dt][2] * inv * siluf(g2), o[dt][3] * inv * siluf(g3))};
    }
  }
}


#define XB_TMO      128
#define XB_XCNT(j)  (256  + 64 * (j))
#define XB_XSUB(j)  (1280 + 64 * (j))
#define XB_XGEN(j)  (2304 + 64 * (j))
#define XB_TOP      3328
#define XB_TOPGEN   3392
#define XCD_BAR_WORDS 3456
#define XB_SPIN_CAP (1u << 18)
__device__ __forceinline__ unsigned xb_ld(unsigned* q) { return __hip_atomic_load(q, __ATOMIC_RELAXED, __HIP_MEMORY_SCOPE_AGENT); }
__device__ __forceinline__ unsigned xb_add(unsigned* q, unsigned v) { return __hip_atomic_fetch_add(q, v, __ATOMIC_RELAXED, __HIP_MEMORY_SCOPE_AGENT); }
__device__ __forceinline__ unsigned xb_xcc_id() { return (unsigned)__builtin_amdgcn_s_getreg((3 << 11) | 20) & 0xFu; }
#define XB_SPIN(cond, bar) do { unsigned _sp = 0; while (cond) { __builtin_amdgcn_s_sleep(1); \
    if ((++_sp & 255u) == 0u) { if (xb_ld(&(bar)[XB_TMO])) break; if (_sp > XB_SPIN_CAP) { atomicAdd(&(bar)[XB_TMO], 1u); break; } } } } while (0)
struct XcdBarrier { unsigned* bar; unsigned x, nloc, nx; };
__device__ __forceinline__ void xcd_barrier(const XcdBarrier& b) {
  asm volatile("s_waitcnt vmcnt(0)" ::: "memory");
  __syncthreads();
  if (threadIdx.x == 0) {
    unsigned* bar = b.bar;
    __builtin_amdgcn_s_waitcnt(0);
    const unsigned nloc = b.nloc, nx = b.nx;
    const unsigned old = xb_add(&bar[XB_XSUB(b.x)], 1u);
    const unsigned gen = old / nloc;
    if (old + 1u == (gen + 1u) * nloc) {
      __builtin_amdgcn_fence(__ATOMIC_RELEASE, "agent");
      asm volatile("s_waitcnt vmcnt(0)" ::: "memory");
      const unsigned og = xb_add(&bar[XB_TOP], 1u);
      const unsigned tg = og / nx;
      if (og + 1u == (tg + 1u) * nx) xb_add(&bar[XB_TOPGEN], 1u);
      else XB_SPIN(xb_ld(&bar[XB_TOPGEN]) == tg, bar);
      __builtin_amdgcn_fence(__ATOMIC_ACQUIRE, "agent");
      xb_add(&bar[XB_XGEN(b.x)], 1u);
      asm volatile("s_waitcnt vmcnt(0)" ::: "memory");
    } else {
      XB_SPIN(xb_ld(&bar[XB_XGEN(b.x)]) == gen, bar);
      __builtin_amdgcn_fence(__ATOMIC_ACQUIRE, "agent");
      asm volatile("s_waitcnt vmcnt(0)" ::: "memory");
    }
  }
  __syncthreads();
}

#ifndef DUP_SCAN
#define DUP_SCAN 0
#endif
#ifndef DUP_ATTN
#define DUP_ATTN 0
#endif
#ifndef DUP_GEMM
#define DUP_GEMM 0
#endif
#ifndef MULTI_LAUNCH
#define MULTI_LAUNCH 0
#endif
__device__ __forceinline__ bool step_exists(int i, int s) {
  if (s == 2) return i == 2;
  if (s == 4) return (i & 1) == 0;
  return true;
}
__device__ __forceinline__ void run_step(const Params& p, int i, int s, char* smem) {
  asm volatile("" : "+s"(i));
  const int j = i >> 1;
  if (s == 0) { transpose_phase(p, i, smem); row_phase(p, i); }
  else if (s == 1) {
    if ((i & 1) == 0) {
      EpiRwkvProj ep{p.R, p.K, (j == 0) ? p.VF : p.V2, p.G, p.HID};
#pragma unroll 1
      for (int rep = PROBE_GEMM ? 0 : 1; rep < 2; ++rep)
      gemm_phase<1>(p.H, LDH, p.Wp, LDW, 16, MT / 128, (j == 0) ? 34 : 35, p.rw_mu + (size_t)j * 6 * 1024, ep, smem, rep == 0);
    } else {
      EpiNaProj ep{p.R, p.K, p.V2, p.G, p.na_b_in + (size_t)j * 4096};
#pragma unroll 1
      for (int rep = PROBE_GEMM ? 0 : 1; rep < 2; ++rep)
      gemm_phase<0>(p.H, LDH, p.Wp, LDW, 16, MT / 128, 32, nullptr, ep, smem, rep == 0);
    }
  } else if (s == 2) {
    EpiVres ev{p.V2, p.VF, p.rw_v0};
    gemm_phase<0>(p.HID + 256, HIDW, p.v2t, 64, 1, MT / 128, 8, nullptr, ev, smem);
  } else if (s == 3) {
    if ((i & 1) == 0) scan_phase(p, j, smem);
    else attn_phase(p, j, i != 3, smem);
  } else if (s == 4) {
    og_phase(p, j);
  } else {
    EpiOut eo{p.R};
#pragma unroll 1
    for (int rep = PROBE_GEMM ? 0 : 1; rep < 2; ++rep)
    gemm_phase<0>(p.H, LDH, p.Wo, LDW, 16, (i == 3) ? NL / 128 : MT / 128, 8, nullptr, eo, smem, rep == 0);
  }
}

__global__ void __launch_bounds__(256, 2) fwd_megakernel(Params p0) {
  __shared__ __attribute__((aligned(16))) char smem[SMEM_BYTES];
  cg::grid_group grid = cg::this_grid();
  XcdBarrier xb;
  xb.bar = p0.bar; xb.x = xb_xcc_id(); xb.nloc = 0u; xb.nx = 0u;
  if (threadIdx.x == 0) (void)xb_add(&xb.bar[XB_XCNT(xb.x)], 1u);
  pre_phase(p0, smem);
  grid.sync();
  {
    unsigned cnt = 0u, mine = 0u;
#pragma unroll 1
    for (unsigned jj = 0; jj < 16; ++jj) { const unsigned c = xb_ld(&xb.bar[XB_XCNT(jj)]); cnt += (c > 0u) ? 1u : 0u; mine = (jj == xb.x) ? c : mine; }
    xb.nloc = mine > 0u ? mine : 1u; xb.nx = cnt > 0u ? cnt : 1u;
  }
  const Params& p = p0;
#pragma unroll 1
  for (int i = 0; i < 4; ++i) {
#pragma unroll 1
    for (int s = 0; s < 6; ++s) {
      if (!step_exists(i, s)) continue;
      int reps = 1;
      if (DUP_SCAN && s == 3 && (i & 1) == 0) reps = 2;
      if (DUP_ATTN && s == 3 && (i & 1) == 1) reps = 2;
      if (DUP_GEMM && (s == 1 || s == 5)) reps = 2;
#pragma unroll 1
      for (int rep = 0; rep < reps; ++rep) {
        run_step(p, i, s, smem);
        xcd_barrier(xb);
      }
    }
  }
  row_phase(p, 4);
}

#if MULTI_LAUNCH
template <int S> __global__ void __launch_bounds__(256, 2) step_kernel(Params p0, int i) {
  __shared__ __attribute__((aligned(16))) char smem[SMEM_BYTES];
  if (S == -1) { pre_phase(p0, smem); return; }
  if (S == 6) { row_phase(p0, 4); return; }
  run_step(p0, i, S, smem);
}
#endif

extern "C" void kernel_launch(void* const* d_in, const int* in_sizes, int n_in, void* d_out, int out_size, void* d_ws, size_t ws_size,
                              hipStream_t stream) {
  static int grid_blocks = 0;
  if (!grid_blocks) {
    int dev = 0, cus = 0, per_cu = 0;
    hipGetDevice(&dev);
    hipDeviceGetAttribute(&cus, hipDeviceAttributeMultiprocessorCount, dev);
    hipOccupancyMaxActiveBlocksPerMultiprocessor(&per_cu, fwd_megakernel, 256, 0);
    if (per_cu > 2) per_cu = 2;
    if (per_cu < 1) per_cu = 1;
    grid_blocks = cus * per_cu;
  }
  Params p{};
  const float** f = (const float**)&p;
  for (int i = 0; i < 29; ++i) f[i] = (const float*)d_in[i];
  p.out = (float*)d_out;
  char* w = (char*)d_ws;
  size_t off = 0;
  auto take = [&](size_t bytes) { char* r = w + off; off += (bytes + 255) & ~(size_t)255; return r; };
  p.gp = (Params*)take(sizeof(Params));
  p.bar = (unsigned*)take((size_t)XCD_BAR_WORDS * 4);
  p.mod = (float*)take((size_t)4 * 9 * 3072 * 4);
  p.ctxbuf = (float*)take((size_t)NC * 1024 * 4);
  p.beta = (float*)take((size_t)2 * MT * 16 * 4);
  p.Wp = (bf*)take((size_t)4480 * LDW * 2);
  p.Wo = (bf*)take((size_t)1024 * LDW * 2);
  p.w2t = (bf*)take((size_t)2 * 65536 * 2);
  p.a2t = (bf*)take((size_t)2 * 65536 * 2);
  p.v2t = (bf*)take((size_t)65536 * 2);
  const size_t big = (size_t)MT * 1024 * 2;
  p.H = (bf*)take((size_t)MT * LDH * 2); p.R = (bf*)take(big); p.K = (bf*)take(big); p.VF = (bf*)take(big);
  p.V2 = (bf*)take(big); p.G = (bf*)take(big); p.Y1 = (bf*)take(big);
  p.HID = (bf*)take((size_t)MT * HIDW * 2);
  if (off > ws_size) fprintf(stderr, "workspace too small: need %zu have %zu\n", off, ws_size);
#if MULTI_LAUNCH
  step_kernel<-1><<<grid_blocks, 256, 0, stream>>>(p, 0);
  for (int i = 0; i < 4; ++i) {
    step_kernel<0><<<grid_blocks, 256, 0, stream>>>(p, i);
    step_kernel<1><<<grid_blocks, 256, 0, stream>>>(p, i);
    if (i == 2) step_kernel<2><<<grid_blocks, 256, 0, stream>>>(p, i);
    step_kernel<3><<<grid_blocks, 256, 0, stream>>>(p, i);
    if ((i & 1) == 0) step_kernel<4><<<grid_blocks, 256, 0, stream>>>(p, i);
    step_kernel<5><<<grid_blocks, 256, 0, stream>>>(p, i);
  }
  step_kernel<6><<<grid_blocks, 256, 0, stream>>>(p, 0);
#else
  (void)hipMemsetAsync(p.bar, 0, (size_t)XCD_BAR_WORDS * 4, stream);
  void* args[] = {&p};
  hipError_t e = hipLaunchCooperativeKernel((void*)fwd_megakernel, dim3(grid_blocks), dim3(256), args, 0, stream);
  if (e != hipSuccess) fprintf(stderr, "cooperative launch failed: %s (grid %d)\n", hipGetErrorString(e), grid_blocks);
#endif
}
```

```cpp
#include <hip/hip_runtime.h>
#include <hip/hip_cooperative_groups.h>
#include <cstdint>
#include <cstdio>
namespace cg = cooperative_groups;

typedef unsigned short bf;
typedef short bf16x8 __attribute__((ext_vector_type(8)));
typedef float f32x4 __attribute__((ext_vector_type(4)));
typedef unsigned u32x4 __attribute__((ext_vector_type(4)));
typedef unsigned u32x2 __attribute__((ext_vector_type(2)));

constexpr int DM = 1024, NB = 8, SEQ = 8192, NL = NB * SEQ, CTXL = 256, NC = NB * CTXL, MT = NL + NC;
constexpr int HIDW = 384;
constexpr int LDH = 1088, LDW = 1088;
constexpr int SMEM_BYTES = 65536;
#define NEGV (-1e30f)
#ifndef PROBE_GEMM
#define PROBE_GEMM 0
#endif

struct Params {
  const float *x, *c, *ctx, *c_ctx, *ada_w, *ada_b, *pre_g, *post_g, *rw_mu, *rw_w_rkvg, *rw_w0, *rw_w1, *rw_w2,
      *rw_a0, *rw_a1, *rw_a2, *rw_v0, *rw_v1, *rw_v2, *rw_k_k, *rw_k_a, *rw_r_k, *rw_lnx_w, *rw_lnx_b, *rw_w_out,
      *na_w_in, *na_b_in, *na_rpb, *na_w_out;
  float* out;
  float *mod, *ctxbuf, *beta;
  bf *Wp, *Wo, *w2t, *a2t, *v2t;
  bf *H, *R, *K, *VF, *V2, *G, *Y1, *HID;
  Params* gp;
  unsigned* bar;
};

__device__ __forceinline__ float bflo(unsigned w) { return __uint_as_float(w << 16); }
__device__ __forceinline__ float bfhi(unsigned w) { return __uint_as_float(w & 0xffff0000u); }
typedef __bf16 bf16x2_t __attribute__((ext_vector_type(2)));
__device__ __forceinline__ unsigned pk2(float lo, float hi) {
  bf16x2_t v = {(__bf16)lo, (__bf16)hi};
  return __builtin_bit_cast(unsigned, v);
}
__device__ __forceinline__ float siluf(float v) { return v * __builtin_amdgcn_rcpf(1.f + __expf(-v)); }
__device__ __forceinline__ float sigmf(float v) { return __builtin_amdgcn_rcpf(1.f + __expf(-v)); }
__device__ __forceinline__ float tanh_fast(float v) { return 1.f - 2.f * __builtin_amdgcn_rcpf(1.f + __expf(2.f * v)); }
__device__ __forceinline__ float quad_sum(float v) {
  int t = __builtin_amdgcn_update_dpp(0, __float_as_int(v), 0xB1, 0xF, 0xF, true);
  v += __int_as_float(t);
  t = __builtin_amdgcn_update_dpp(0, __float_as_int(v), 0x4E, 0xF, 0xF, true);
  v += __int_as_float(t);
  return v;
}
__device__ __forceinline__ float wave_sum(float v) {
#pragma unroll
  for (int o = 32; o >= 1; o >>= 1) v += __shfl_xor(v, o);
  return v;
}
__device__ __forceinline__ int otid() { int t = threadIdx.x; asm volatile("" : "+v"(t)); return t; }
__device__ __forceinline__ void lds_barrier() { asm volatile("s_waitcnt lgkmcnt(0)\n\ts_barrier" ::: "memory"); }
__device__ __forceinline__ int lds_off(int row, int c) { return row * 128 + ((c ^ ((row >> 1) & 7)) << 4); }
__device__ __forceinline__ unsigned lerp2(unsigned hm, unsigned h0, unsigned hp, float m0, float m1) {
  const float c0 = bflo(h0), c1 = bfhi(h0);
  const float x0 = 0.5f * (bflo(hm) + bflo(hp)) - c0;
  const float x1 = 0.5f * (bfhi(hm) + bfhi(hp)) - c1;
  return pk2(c0 + x0 * m0, c1 + x1 * m1);
}
__device__ __forceinline__ int mod_idx(int row) { return row < NL ? (row >> 13) : 8; }

__device__ void pre_phase(const Params& p, char* smem) {
  float* s = (float*)smem;
  float* red = s + 9 * 1024;
  const int tid = otid();
  for (int item = blockIdx.x; item < 4 * 48; item += gridDim.x) {
    const int i = item / 48, cb = item % 48;
    __syncthreads();
    for (int idx = tid; idx < 9 * 1024; idx += 256) {
      const int m = idx >> 10, k = idx & 1023;
      const float v = (m < 8) ? p.c[m * 1024 + k] : p.c_ctx[k];
      s[idx] = siluf(v);
    }
    __syncthreads();
    const int cc = tid & 63, kq = tid >> 6;
    float acc[9];
#pragma unroll
    for (int m = 0; m < 9; ++m) acc[m] = 0.f;
    const float* W = p.ada_w + (size_t)i * 1024 * 3072 + cb * 64 + cc;
    for (int k = kq * 256; k < kq * 256 + 256; ++k) {
      const float w = W[(size_t)k * 3072];
#pragma unroll
      for (int m = 0; m < 9; ++m) acc[m] += s[m * 1024 + k] * w;
    }
#pragma unroll
    for (int m = 0; m < 9; ++m) red[(kq * 9 + m) * 64 + cc] = acc[m];
    __syncthreads();
    for (int idx = tid; idx < 9 * 64; idx += 256) {
      const int m = idx >> 6, c2 = idx & 63;
      float v = red[(0 * 9 + m) * 64 + c2] + red[(1 * 9 + m) * 64 + c2] + red[(2 * 9 + m) * 64 + c2] + red[(3 * 9 + m) * 64 + c2];
      v += p.ada_b[i * 3072 + cb * 64 + c2];
      p.mod[(size_t)(i * 9 + m) * 3072 + cb * 64 + c2] = v;
    }
  }
}

struct TOp { const float* src; bf* dst; int K, N, Kp, Np, ldd; };
__device__ bool get_op(const Params& p, int i, int op, TOp& o) {
  const int j = i >> 1;
  if (i & 1) {
    if (op == 0) { o = {p.na_w_in + (size_t)j * 1024 * 4096, p.Wp, 1024, 4096, 1024, 4096, LDW}; return true; }
    if (op == 1) { o = {p.na_w_out + (size_t)j * 1024 * 1024, p.Wo, 1024, 1024, 1024, 1024, LDW}; return true; }
    return false;
  }
  if (op < 4) { o = {p.rw_w_rkvg + ((size_t)j * 4 + op) * 1024 * 1024, p.Wp + (size_t)op * 1024 * LDW, 1024, 1024, 1024, 1024, LDW}; return true; }
  if (op < 6) { const int d = op - 4; o = {p.rw_w1 + ((size_t)j * 2 + d) * 1024 * 64, p.Wp + (size_t)(4096 + d * 64) * LDW, 1024, 64, 1024, 64, LDW}; return true; }
  if (op < 8) { const int d = op - 6; o = {p.rw_a1 + ((size_t)j * 2 + d) * 1024 * 64, p.Wp + (size_t)(4224 + d * 64) * LDW, 1024, 64, 1024, 64, LDW}; return true; }
  if (op < 10) { const int d = op - 8; o = {p.rw_w2 + ((size_t)j * 2 + d) * 64 * 1024, p.w2t + (size_t)d * 65536, 64, 1024, 64, 1024, 64}; return true; }
  if (op < 12) { const int d = op - 10; o = {p.rw_a2 + ((size_t)j * 2 + d) * 64 * 1024, p.a2t + (size_t)d * 65536, 64, 1024, 64, 1024, 64}; return true; }
  if (op == 12) { o = {p.rw_w_out + (size_t)j * 1024 * 1024, p.Wo, 1024, 1024, 1024, 1024, LDW}; return true; }
  if (j == 1 && op == 13) { o = {p.rw_v1, p.Wp + (size_t)4352 * LDW, 1024, 32, 1024, 128, LDW}; return true; }
  if (j == 1 && op == 14) { o = {p.rw_v2, p.v2t, 32, 1024, 64, 1024, 64}; return true; }
  return false;
}

__device__ void transpose_phase(const Params& p, int i, char* smem) {
  float* t = (float*)smem;
  const int tid = otid();
  int base = 0;
  for (int op = 0;; ++op) {
    TOp o;
    if (!get_op(p, i, op, o)) break;
    const int tk = o.Kp / 64, tn = o.Np / 64, nt = tk * tn;
    int first = blockIdx.x - (base % (int)gridDim.x);
    if (first < 0) first += gridDim.x;
    for (int g = first; g < nt; g += gridDim.x) {
      const int kt = g / tn, ntile = g % tn;
      __syncthreads();
#pragma unroll
      for (int ps = 0; ps < 4; ++ps) {
        const int kr = ps * 16 + (tid >> 4), c4 = (tid & 15) * 4;
        const int k = kt * 64 + kr, n = ntile * 64 + c4;
        f32x4 v = (f32x4){0.f, 0.f, 0.f, 0.f};
        if (k < o.K && n < o.N) v = *(const f32x4*)(o.src + (size_t)k * o.N + n);
        t[kr * 65 + c4 + 0] = v.x; t[kr * 65 + c4 + 1] = v.y; t[kr * 65 + c4 + 2] = v.z; t[kr * 65 + c4 + 3] = v.w;
      }
      __syncthreads();
      const int n = tid >> 2, kc = (tid & 3) * 16;
      unsigned w[8];
#pragma unroll
      for (int e = 0; e < 8; ++e) w[e] = pk2(t[(kc + 2 * e) * 65 + n], t[(kc + 2 * e + 1) * 65 + n]);
      bf* d = o.dst + (size_t)(ntile * 64 + n) * o.ldd + kt * 64 + kc;
      *(u32x4*)d = (u32x4){w[0], w[1], w[2], w[3]};
      *(u32x4*)(d + 8) = (u32x4){w[4], w[5], w[6], w[7]};
    }
    base += nt;
  }
}

template <bool UPD, bool MKH>
__device__ __forceinline__ void row_phase_t(const Params& p, int i) {
  const int tid = otid(), lane = tid & 63;
  const int gw = blockIdx.x * 4 + (tid >> 6), nw = gridDim.x * 4;
  const int nrows = MKH ? MT : NL;
  for (int row0 = gw; row0 < nrows; row0 += 2 * nw) {
    const bool valid1 = (row0 + nw) < nrows;
    const int rws[2] = {row0, valid1 ? row0 + nw : row0};
    f32x4 xv[2][4];
    u32x2 ou[2][4];
#pragma unroll
    for (int u = 0; u < 2; ++u) {
      const int row = rws[u];
      const float* xs;
      if (i <= 1) xs = (row < NL) ? p.x + (size_t)row * 1024 : p.ctx + (size_t)(row - NL) * 1024;
      else xs = (row < NL) ? p.out + (size_t)row * 1024 : p.ctxbuf + (size_t)(row - NL) * 1024;
#pragma unroll
      for (int q = 0; q < 4; ++q) xv[u][q] = *(const f32x4*)(xs + q * 256 + lane * 4);
      if (UPD) {
        const bf* orow = p.R + (size_t)row * 1024;
#pragma unroll
        for (int q = 0; q < 4; ++q) ou[u][q] = *(const u32x2*)(orow + q * 256 + lane * 4);
      }
    }
#pragma unroll
    for (int u = 0; u < 2; ++u) {
      const int row = rws[u];
      const bool st = (u == 0) || valid1;
      const int m = mod_idx(row);
      if (UPD) {
        float ov[4][4];
        float ss = 0.f;
#pragma unroll
        for (int q = 0; q < 4; ++q) {
          ov[q][0] = bflo(ou[u][q].x); ov[q][1] = bfhi(ou[u][q].x); ov[q][2] = bflo(ou[u][q].y); ov[q][3] = bfhi(ou[u][q].y);
          ss += ov[q][0] * ov[q][0] + ov[q][1] * ov[q][1] + ov[q][2] * ov[q][2] + ov[q][3] * ov[q][3];
        }
        ss = wave_sum(ss);
        const float rs = rsqrtf(ss * (1.f / 1024.f) + 1e-6f);
        const float* gate = p.mod + (size_t)((i - 1) * 9 + m) * 3072 + 2048;
        const float* pg = p.post_g + (i - 1) * 1024;
        float* xd = (row < NL) ? p.out + (size_t)row * 1024 : p.ctxbuf + (size_t)(row - NL) * 1024;
#pragma unroll
        for (int q = 0; q < 4; ++q) {
          const int col = q * 256 + lane * 4;
          const f32x4 gv = *(const f32x4*)(gate + col);
          const f32x4 pv = *(const f32x4*)(pg + col);
          xv[u][q].x += gv.x * ov[q][0] * rs * pv.x;
          xv[u][q].y += gv.y * ov[q][1] * rs * pv.y;
          xv[u][q].z += gv.z * ov[q][2] * rs * pv.z;
          xv[u][q].w += gv.w * ov[q][3] * rs * pv.w;
          if (st) *(f32x4*)(xd + col) = xv[u][q];
        }
      }
      if (MKH) {
        float ss = 0.f;
#pragma unroll
        for (int q = 0; q < 4; ++q) ss += xv[u][q].x * xv[u][q].x + xv[u][q].y * xv[u][q].y + xv[u][q].z * xv[u][q].z + xv[u][q].w * xv[u][q].w;
        ss = wave_sum(ss);
        const float rs = rsqrtf(ss * (1.f / 1024.f) + 1e-6f);
        const float* md = p.mod + (size_t)(i * 9 + m) * 3072;
        const float* pg = p.pre_g + i * 1024;
        bf* hd = p.H + (size_t)row * LDH;
#pragma unroll
        for (int q = 0; q < 4; ++q) {
          const int col = q * 256 + lane * 4;
          const f32x4 sh = *(const f32x4*)(md + col);
          const f32x4 sc = *(const f32x4*)(md + 1024 + col);
          const f32x4 pv = *(const f32x4*)(pg + col);
          const float h0 = xv[u][q].x * rs * pv.x * (1.f + sc.x) + sh.x;
          const float h1 = xv[u][q].y * rs * pv.y * (1.f + sc.y) + sh.y;
          const float h2 = xv[u][q].z * rs * pv.z * (1.f + sc.z) + sh.z;
          const float h3 = xv[u][q].w * rs * pv.w * (1.f + sc.w) + sh.w;
          if (st) *(u32x2*)(hd + col) = (u32x2){pk2(h0, h1), pk2(h2, h3)};
        }
      }
    }
  }
}
__device__ __forceinline__ void row_phase(const Params& p, int i) {
  if (i == 0) row_phase_t<false, true>(p, i);
  else if (i < 4) row_phase_t<true, true>(p, i);
  else row_phase_t<true, false>(p, i);
}

struct EpiRwkvProj {
  bf *R, *K, *V, *G, *HID;
  __device__ __forceinline__ void operator()(int nt, int tok, int col, f32x4 v) const {
    bf* dst;
    if (nt < 8) dst = R + (size_t)tok * 1024 + col;
    else if (nt < 16) dst = K + (size_t)tok * 1024 + (col - 1024);
    else if (nt < 24) dst = V + (size_t)tok * 1024 + (col - 2048);
    else if (nt < 32) {
      dst = G + (size_t)tok * 1024 + (col - 3072);
#pragma unroll
      for (int e = 0; e < 4; ++e) v[e] = siluf(v[e]);
    } else {
      dst = HID + (size_t)tok * HIDW + (col - 4096);
      if (nt == 32) {
#pragma unroll
        for (int e = 0; e < 4; ++e) v[e] = tanh_fast(v[e]);
      }
    }
    *(u32x2*)dst = (u32x2){pk2(v[0], v[1]), pk2(v[2], v[3])};
  }
};
struct EpiNaProj {
  bf *Q, *K, *Vt, *G; const float* bias;
  __device__ __forceinline__ void operator()(int nt, int tok, int col, f32x4 v) const {
    const f32x4 b = *(const f32x4*)(bias + col);
    v[0] += b.x; v[1] += b.y; v[2] += b.z; v[3] += b.w;
    if (nt >= 16 && nt < 24) {
      const int c = col - 2048;
#pragma unroll
      for (int e = 0; e < 4; ++e) Vt[(size_t)(c + e) * MT + tok] = (bf)(pk2(v[e], 0.f) & 0xffffu);
      return;
    }
    bf* dst;
    if (nt < 8) { dst = Q + (size_t)tok * 1024 + col; v[0] *= 0.125f; v[1] *= 0.125f; v[2] *= 0.125f; v[3] *= 0.125f; }
    else if (nt < 16) dst = K + (size_t)tok * 1024 + (col - 1024);
    else dst = G + (size_t)tok * 1024 + (col - 3072);
    *(u32x2*)dst = (u32x2){pk2(v[0], v[1]), pk2(v[2], v[3])};
  }
};
struct EpiOut {
  bf* O;
  __device__ __forceinline__ void operator()(int nt, int tok, int col, f32x4 v) const {
    *(u32x2*)(O + (size_t)tok * 1024 + col) = (u32x2){pk2(v[0], v[1]), pk2(v[2], v[3])};
  }
};
struct EpiVres {
  bf* V2; const bf* VF; const float* v0;
  __device__ __forceinline__ void operator()(int nt, int tok, int col, f32x4 z) const {
    const f32x4 b = *(const f32x4*)(v0 + col);
    const u32x2 uv = *(const u32x2*)(V2 + (size_t)tok * 1024 + col);
    const u32x2 uf = *(const u32x2*)(VF + (size_t)tok * 1024 + col);
    const float v[4] = {bflo(uv.x), bfhi(uv.x), bflo(uv.y), bfhi(uv.y)};
    const float f[4] = {bflo(uf.x), bfhi(uf.x), bflo(uf.y), bfhi(uf.y)};
    const float zz[4] = {z[0] + b.x, z[1] + b.y, z[2] + b.z, z[3] + b.w};
    float r[4];
#pragma unroll
    for (int e = 0; e < 4; ++e) r[e] = v[e] + (f[e] - v[e]) * sigmf(zz[e]);
    *(u32x2*)(V2 + (size_t)tok * 1024 + col) = (u32x2){pk2(r[0], r[1]), pk2(r[2], r[3])};
  }
};

template <int AMODE, class Epi>
__device__ void gemm_phase(const bf* __restrict__ A, int lda, const bf* __restrict__ Bt, int ldb, int nkt, int mtiles, int ntiles,
                           const float* __restrict__ mu, const Epi& epi, char* smem, bool fake = false) {
  const int tid = otid(), lane = tid & 63, wid = tid >> 6, wr = wid >> 1, wc = wid & 1, fr = lane & 15, fq = lane >> 4;
  const int rg = tid >> 3, cch = tid & 7;
  char* As = smem;
  char* Bs = smem + 32768;
  constexpr int GM = 6;
  const int xcd = blockIdx.x & 7, slot = blockIdx.x >> 3, nslots = gridDim.x >> 3;
  const int per_group = GM * ntiles;
  const int ngroups = (mtiles + GM - 1) / GM;
  const int my_groups = (ngroups - xcd + 7) >> 3;
  const int my_total = my_groups * per_group;
  for (int q = slot; q < my_total; q += nslots) {
    const int gi = q / per_group, e = q - gi * per_group;
    const int nt = e / GM, mt = (xcd + 8 * gi) * GM + (e - nt * GM);
    if (mt >= mtiles) continue;
    const int row0 = mt * 128, col0 = nt * 128;
    int lerp = 0; bool sstart = false, send = false;
    if (AMODE == 1) {
      lerp = (nt < 8) ? 0 : (nt < 16) ? 2 : (nt < 24) ? 3 : (nt < 32) ? 5 : (nt == 32) ? 1 : (nt == 33) ? 4 : 3;
      if (row0 < NL) { sstart = (row0 & (SEQ - 1)) == 0; send = ((row0 + 128) & (SEQ - 1)) == 0; }
      else { sstart = ((row0 - NL) & (CTXL - 1)) == 0; send = ((row0 + 128 - NL) & (CTXL - 1)) == 0; }
    }
    f32x4 acc[4][4];
#pragma unroll
    for (int m = 0; m < 4; ++m)
#pragma unroll
      for (int n = 0; n < 4; ++n) acc[m][n] = (f32x4){0.f, 0.f, 0.f, 0.f};
    u32x4 ra[6];
    f32x4 muv[2];
    auto glds_tile = [&](const bf* G, int ld, int grow0, int kt, char* ldsbase) {
#pragma unroll
      for (int pc = 0; pc < 4; ++pc) {
        const int row = wid * 32 + pc * 8 + (lane >> 3), cp = lane & 7, c = cp ^ ((row >> 1) & 7);
        const bf* src = G + (size_t)(grow0 + row) * ld + kt * 64 + c * 8;
        __builtin_amdgcn_global_load_lds((const __attribute__((address_space(1))) void*)src,
                                         (__attribute__((address_space(3))) void*)(ldsbase + row * 128 + cp * 16), 16, 0, 0);
      }
    };
    auto gloadA = [&](int kt) {
      const int kc = kt * 64 + cch * 8;
#pragma unroll
      for (int i = 0; i < 6; ++i) {
        const int r = row0 + rg * 4 + i - 1;
        const bool zero = (i == 0 && rg == 0 && sstart) || (i == 5 && rg == 31 && send);
        ra[i] = zero ? (u32x4){0, 0, 0, 0} : *(const u32x4*)(A + (size_t)r * lda + kc);
      }
      muv[0] = *(const f32x4*)(mu + lerp * 1024 + kc);
      muv[1] = *(const f32x4*)(mu + lerp * 1024 + kc + 4);
    };
    auto lstoreA = [&](int buf) {
      char* a = As + buf * 16384;
#pragma unroll
      for (int i = 0; i < 4; ++i) {
        const u32x4 hm = ra[i], h0 = ra[i + 1], hp = ra[i + 2];
        u32x4 o;
        o.x = lerp2(hm.x, h0.x, hp.x, muv[0].x, muv[0].y);
        o.y = lerp2(hm.y, h0.y, hp.y, muv[0].z, muv[0].w);
        o.z = lerp2(hm.z, h0.z, hp.z, muv[1].x, muv[1].y);
        o.w = lerp2(hm.w, h0.w, hp.w, muv[1].z, muv[1].w);
        *(u32x4*)(a + lds_off(rg * 4 + i, cch)) = o;
      }
    };
    lds_barrier();
    glds_tile(Bt, ldb, col0, 0, Bs);
    if (AMODE == 0) glds_tile(A, lda, row0, 0, As);
    else { gloadA(0); lstoreA(0); }
    asm volatile("s_waitcnt vmcnt(0)" ::: "memory");
    lds_barrier();
    for (int kt = 0; kt < nkt; ++kt) {
      const int buf = kt & 1;
      if (!fake && kt + 1 < nkt) {
        glds_tile(Bt, ldb, col0, kt + 1, Bs + (buf ^ 1) * 16384);
        if (AMODE == 0) glds_tile(A, lda, row0, kt + 1, As + (buf ^ 1) * 16384);
        else gloadA(kt + 1);
      }
      const char* a = As + buf * 16384;
      const char* b = Bs + buf * 16384;
#pragma unroll
      for (int ks = 0; ks < 2; ++ks) {
        bf16x8 af[4], bfr[4];
#pragma unroll
        for (int m = 0; m < 4; ++m) af[m] = *(const bf16x8*)(a + lds_off(wr * 64 + m * 16 + fr, ks * 4 + fq));
#pragma unroll
        for (int n = 0; n < 4; ++n) bfr[n] = *(const bf16x8*)(b + lds_off(wc * 64 + n * 16 + fr, ks * 4 + fq));
        __builtin_amdgcn_s_setprio(1);
#pragma unroll
        for (int m = 0; m < 4; ++m)
#pragma unroll
          for (int n = 0; n < 4; ++n) acc[m][n] = __builtin_amdgcn_mfma_f32_16x16x32_bf16(bfr[n], af[m], acc[m][n], 0, 0, 0);
        __builtin_amdgcn_s_setprio(0);
      }
      if (AMODE == 1 && kt + 1 < nkt) lstoreA(buf ^ 1);
      asm volatile("s_waitcnt vmcnt(0)" ::: "memory");
      lds_barrier();
    }
#pragma unroll
    for (int m = 0; m < 4; ++m)
#pragma unroll
      for (int n = 0; n < 4; ++n) epi(nt, row0 + wr * 64 + m * 16 + fr, col0 + wc * 64 + n * 16 + fq * 4, acc[m][n]);
  }
}

typedef float f32x2 __attribute__((ext_vector_type(2)));
__device__ __forceinline__ float oct_sum(float v) {
  int t = __builtin_amdgcn_update_dpp(0, __float_as_int(v), 0xB1, 0xF, 0xF, true);
  v += __int_as_float(t);
  t = __builtin_amdgcn_update_dpp(0, __float_as_int(v), 0x4E, 0xF, 0xF, true);
  v += __int_as_float(t);
  t = __builtin_amdgcn_update_dpp(0, __float_as_int(v), 0x141, 0xF, 0xF, true);
  v += __int_as_float(t);
  return v;
}
__device__ __forceinline__ f32x2 fma2(f32x2 a, f32x2 b, f32x2 c) { return __builtin_elementwise_fma(a, b, c); }
__device__ __forceinline__ float fma_s(float a, float b, float c) { float d; asm("v_fma_f32 %0, %1, %2, %3" : "=v"(d) : "v"(a), "v"(b), "v"(c)); return d; }
__device__ __forceinline__ float mul_s(float a, float b) { float d; asm("v_mul_f32 %0, %1, %2" : "=v"(d) : "v"(a), "v"(b)); return d; }
struct ScanOps { f32x4 w[2], nk[2], bb[2], kd[2], rr[2]; f32x2 vv; };
__device__ __forceinline__ ScanOps scan_load(const float* ops, const float* vs, int t, int kq, int vrow) {
  ScanOps r;
  const float* o = ops + t * 320 + kq * 8;
  r.w[0] = *(const f32x4*)(o); r.w[1] = *(const f32x4*)(o + 4);
  r.nk[0] = *(const f32x4*)(o + 64); r.nk[1] = *(const f32x4*)(o + 68);
  r.bb[0] = *(const f32x4*)(o + 128); r.bb[1] = *(const f32x4*)(o + 132);
  r.kd[0] = *(const f32x4*)(o + 192); r.kd[1] = *(const f32x4*)(o + 196);
  r.rr[0] = *(const f32x4*)(o + 256); r.rr[1] = *(const f32x4*)(o + 260);
  r.vv = *(const f32x2*)(vs + t * 64 + vrow);
  return r;
}
#define PR(v, i) ((f32x2){(v)[(i) >> 1][((i) & 1) * 2], (v)[(i) >> 1][((i) & 1) * 2 + 1]})

constexpr int SC_P = 0, SC_YA = 8192, SC_V = 16384, SC_AT = 24576, SC_RT = SC_AT + 4352, SC_BT = SC_RT + 4352, SC_KT = SC_BT + 4352;
constexpr int SC_BTT = 41984, SC_KTT = SC_BTT + 4608, SC_MABT = 51200, SC_SM = 53248;
__device__ __forceinline__ bf16x8 mk8(u32x2 lo, u32x2 hi) { u32x4 u = (u32x4){lo.x, lo.y, hi.x, hi.y}; return __builtin_bit_cast(bf16x8, u); }
__device__ __forceinline__ bf16x8 mk4(u32x2 lo) { u32x4 u = (u32x4){lo.x, lo.y, 0u, 0u}; return __builtin_bit_cast(bf16x8, u); }
__device__ __forceinline__ float bfround(float x) { return bflo(pk2(x, 0.f) & 0xffffu); }
__device__ __forceinline__ void split4(f32x4 x, u32x2& hi, u32x2& lo) {
  hi = (u32x2){pk2(x[0], x[1]), pk2(x[2], x[3])};
  const float r0 = x[0] - bflo(hi.x), r1 = x[1] - bfhi(hi.x), r2 = x[2] - bflo(hi.y), r3 = x[3] - bfhi(hi.y);
  lo = (u32x2){pk2(r0, r1), pk2(r2, r3)};
}

__device__ void scan_phase(const Params& p, int j, char* smem) {
  const int tid = otid(), lane = tid & 63, wid = tid >> 6, fr = lane & 15, fq = lane >> 4;
  float* Pbuf = (float*)(smem + SC_P);
  float* abuf = (float*)(smem + SC_YA);
  float* ys = (float*)(smem + SC_YA);
  float* vs = (float*)(smem + SC_V);
  for (int item = blockIdx.x; item < 256; item += gridDim.x) {
  const int b = item >> 5, h = (item >> 1) & 15, d = item & 1;
  lds_barrier();
  const bf* Vsrc = (j == 0) ? p.VF : p.V2;
  bf* Ydst = (d == 0) ? p.H : p.Y1;
  const int ldy = (d == 0) ? LDH : 1024;
  float* betad = p.beta + (size_t)d * MT * 16;
  bf16x8 bw[2], ba[2];
  {
    const int n = h * 64 + wid * 16 + fr;
#pragma unroll
    for (int ks = 0; ks < 2; ++ks) {
      bw[ks] = *(const bf16x8*)(p.w2t + (size_t)d * 65536 + (size_t)n * 64 + ks * 32 + fq * 8);
      ba[ks] = *(const bf16x8*)(p.a2t + (size_t)d * 65536 + (size_t)n * 64 + ks * 32 + fq * 8);
    }
  }
  float w0v[4], a0v[4];
#pragma unroll
  for (int e = 0; e < 4; ++e) {
    w0v[e] = p.rw_w0[(size_t)(j * 2 + d) * 1024 + h * 64 + wid * 16 + fq * 4 + e];
    a0v[e] = p.rw_a0[(size_t)(j * 2 + d) * 1024 + h * 64 + wid * 16 + fq * 4 + e];
  }
  const int tt = tid >> 3, c8 = tid & 7;
  float kkv[8], kav[8], rkv[8];
#pragma unroll
  for (int e = 0; e < 8; ++e) {
    kkv[e] = p.rw_k_k[j * 1024 + h * 64 + c8 * 8 + e];
    kav[e] = p.rw_k_a[j * 1024 + h * 64 + c8 * 8 + e];
    rkv[e] = p.rw_r_k[j * 1024 + h * 64 + c8 * 8 + e];
  }
  f32x4 ST[4];
#pragma unroll
  for (int kt = 0; kt < 4; ++kt) ST[kt] = (f32x4){0.f, 0.f, 0.f, 0.f};

  bf16x8 phw[2][2], pha[2][2];
  u32x4 puk, pur, puv;
  auto rowbase_of = [&](int ch, int& sgn) -> int {
    if (d == 0) { sgn = 1; return (ch < 8) ? NL + b * CTXL + ch * 32 : b * SEQ + (ch - 8) * 32; }
    sgn = -1; return (ch < 8) ? NL + b * CTXL + 255 - ch * 32 : b * SEQ + 8191 - (ch - 8) * 32;
  };
  auto prefetch = [&](int ch) {
    int sgn; const int rowbase = rowbase_of(ch, sgn);
#pragma unroll
    for (int m = 0; m < 2; ++m) {
      const size_t row = (size_t)(rowbase + sgn * (m * 16 + fr));
#pragma unroll
      for (int ks = 0; ks < 2; ++ks) {
        phw[m][ks] = *(const bf16x8*)(p.HID + row * HIDW + d * 64 + ks * 32 + fq * 8);
        pha[m][ks] = *(const bf16x8*)(p.HID + row * HIDW + 128 + d * 64 + ks * 32 + fq * 8);
      }
    }
    const size_t off = (size_t)(rowbase + sgn * tt) * 1024 + h * 64 + c8 * 8;
    puk = *(const u32x4*)(p.K + off);
    pur = *(const u32x4*)(p.R + off);
    puv = *(const u32x4*)(Vsrc + off);
  };
  prefetch(0);

  for (int ch = 0; ch < 264; ++ch) {
    int sgn; const int rowbase = rowbase_of(ch, sgn);
#pragma unroll
    for (int m = 0; m < 2; ++m) {
      const int tok = m * 16 + fr;
      f32x4 aw = (f32x4){0.f, 0.f, 0.f, 0.f}, aa = aw;
#pragma unroll
      for (int ks = 0; ks < 2; ++ks) {
        aw = __builtin_amdgcn_mfma_f32_16x16x32_bf16(bw[ks], phw[m][ks], aw, 0, 0, 0);
        aa = __builtin_amdgcn_mfma_f32_16x16x32_bf16(ba[ks], pha[m][ks], aa, 0, 0, 0);
      }
      f32x4 wd, av;
#pragma unroll
      for (int e = 0; e < 4; ++e) {
        const float ez = __expf(-(w0v[e] + aw[e]));
        wd[e] = __expf(-0.60653066f * __builtin_amdgcn_rcpf(1.f + ez));
        av[e] = __builtin_amdgcn_rcpf(1.f + __expf(-(a0v[e] + aa[e])));
      }
#pragma unroll
      for (int e = 0; e < 4; ++e) {
        float x = wd[e];
        x *= __int_as_float(__builtin_amdgcn_update_dpp(0x3f800000, __float_as_int(x), 0x111, 0xF, 0xF, false));
        x *= __int_as_float(__builtin_amdgcn_update_dpp(0x3f800000, __float_as_int(x), 0x112, 0xF, 0xF, false));
        x *= __int_as_float(__builtin_amdgcn_update_dpp(0x3f800000, __float_as_int(x), 0x114, 0xF, 0xF, false));
        x *= __int_as_float(__builtin_amdgcn_update_dpp(0x3f800000, __float_as_int(x), 0x118, 0xF, 0xF, false));
        wd[e] = x;
      }
      *(f32x4*)(Pbuf + tok * 64 + wid * 16 + fq * 4) = wd;
      *(f32x4*)(abuf + tok * 64 + wid * 16 + fq * 4) = av;
    }
    lds_barrier();
    {
      const size_t row = (size_t)(rowbase + sgn * tt);
      float k[8], r[8], kk[8];
#pragma unroll
      for (int e = 0; e < 4; ++e) {
        k[2 * e] = bflo(puk[e]); k[2 * e + 1] = bfhi(puk[e]);
        r[2 * e] = bflo(pur[e]); r[2 * e + 1] = bfhi(pur[e]);
      }
      float ss = 0.f;
#pragma unroll
      for (int e = 0; e < 8; ++e) { kk[e] = k[e] * kkv[e]; ss += kk[e] * kk[e]; }
      ss = oct_sum(ss);
      const float inv = __builtin_amdgcn_rsqf(fmaxf(ss, 1e-24f));
      const f32x4 a0 = *(const f32x4*)(abuf + tt * 64 + c8 * 8), a1 = *(const f32x4*)(abuf + tt * 64 + c8 * 8 + 4);
      const f32x4 p0 = *(const f32x4*)(Pbuf + tt * 64 + c8 * 8), p1 = *(const f32x4*)(Pbuf + tt * 64 + c8 * 8 + 4);
      f32x4 q0 = (f32x4){1.f, 1.f, 1.f, 1.f}, q1 = q0;
      if (tt & 15) { q0 = *(const f32x4*)(Pbuf + (tt - 1) * 64 + c8 * 8); q1 = *(const f32x4*)(Pbuf + (tt - 1) * 64 + c8 * 8 + 4); }
      const float a[8] = {a0.x, a0.y, a0.z, a0.w, a1.x, a1.y, a1.z, a1.w};
      const float Pt[8] = {p0.x, p0.y, p0.z, p0.w, p1.x, p1.y, p1.z, p1.w};
      const float Pm[8] = {q0.x, q0.y, q0.z, q0.w, q1.x, q1.y, q1.z, q1.w};
      float at[8], bt_[8], kt_[8], rt[8];
      float bsum = 0.f;
#pragma unroll
      for (int e = 0; e < 8; ++e) {
        const float kkn = kk[e] * inv;
        const float kd = k[e] * (1.f + (a[e] - 1.f) * kav[e]);
        bsum += r[e] * kd * rkv[e];
        const float ip = __builtin_amdgcn_rcpf(Pt[e]);
        at[e] = -kkn * Pm[e];
        bt_[e] = kkn * a[e] * ip;
        kt_[e] = kd * ip;
        rt[e] = r[e] * Pt[e];
      }
      bsum = oct_sum(bsum);
      if (c8 == 0) betad[row * 16 + h] = bsum;
      char* ro = smem + tt * 136 + c8 * 16;
      *(u32x2*)(ro + SC_AT) = (u32x2){pk2(at[0], at[1]), pk2(at[2], at[3])};   *(u32x2*)(ro + SC_AT + 8) = (u32x2){pk2(at[4], at[5]), pk2(at[6], at[7])};
      *(u32x2*)(ro + SC_RT) = (u32x2){pk2(rt[0], rt[1]), pk2(rt[2], rt[3])};   *(u32x2*)(ro + SC_RT + 8) = (u32x2){pk2(rt[4], rt[5]), pk2(rt[6], rt[7])};
      *(u32x2*)(ro + SC_BT) = (u32x2){pk2(bt_[0], bt_[1]), pk2(bt_[2], bt_[3])}; *(u32x2*)(ro + SC_BT + 8) = (u32x2){pk2(bt_[4], bt_[5]), pk2(bt_[6], bt_[7])};
      *(u32x2*)(ro + SC_KT) = (u32x2){pk2(kt_[0], kt_[1]), pk2(kt_[2], kt_[3])}; *(u32x2*)(ro + SC_KT + 8) = (u32x2){pk2(kt_[4], kt_[5]), pk2(kt_[6], kt_[7])};
#pragma unroll
      for (int e = 0; e < 8; ++e) {
        *(bf*)(smem + SC_BTT + (c8 * 8 + e) * 72 + tt * 2) = (bf)(pk2(bt_[e], 0.f) & 0xffffu);
        *(bf*)(smem + SC_KTT + (c8 * 8 + e) * 72 + tt * 2) = (bf)(pk2(kt_[e], 0.f) & 0xffffu);
      }
      *(f32x4*)(vs + tt * 64 + c8 * 8) = (f32x4){bflo(puv[0]), bfhi(puv[0]), bflo(puv[1]), bfhi(puv[1])};
      *(f32x4*)(vs + tt * 64 + c8 * 8 + 4) = (f32x4){bflo(puv[2]), bfhi(puv[2]), bflo(puv[3]), bfhi(puv[3])};
    }
    lds_barrier();
    if (ch + 1 < 264) prefetch(ch + 1);
    {
      auto gram = [&](int xbase, int ybase, int sc) -> f32x4 {
        f32x4 acc = (f32x4){0.f, 0.f, 0.f, 0.f};
#pragma unroll
        for (int ks = 0; ks < 2; ++ks) {
          const char* xp = smem + xbase + (sc * 16 + fr) * 136 + ks * 64 + fq * 16;
          const char* yp = smem + ybase + (sc * 16 + fr) * 136 + ks * 64 + fq * 16;
          const bf16x8 xf = mk8(*(const u32x2*)xp, *(const u32x2*)(xp + 8));
          const bf16x8 yf = mk8(*(const u32x2*)yp, *(const u32x2*)(yp + 8));
          acc = __builtin_amdgcn_mfma_f32_16x16x32_bf16(xf, yf, acc, 0, 0, 0);
        }
        return acc;
      };
      auto store_small = [&](f32x4 g, int sc, int kind, bool strict) {
#pragma unroll
        for (int e = 0; e < 4; ++e) { const int sidx = fq * 4 + e; const bool keep = strict ? (sidx < fr) : (sidx <= fr); g[e] = keep ? g[e] : 0.f; }
        *(u32x2*)(smem + SC_SM + (sc * 5 + kind) * 640 + fr * 40 + fq * 8) = (u32x2){pk2(g[0], g[1]), pk2(g[2], g[3])};
      };
      if (wid < 2) {
        const int sc = wid;
        f32x4 g = gram(SC_BT, SC_AT, sc);
#pragma unroll
        for (int e = 0; e < 4; ++e) g[e] = (fq * 4 + e < fr) ? g[e] : 0.f;
        *(f32x4*)(smem + SC_MABT + sc * 1024 + fr * 64 + fq * 16) = g;
        asm volatile("s_waitcnt lgkmcnt(0)" ::: "memory");
        if (lane < 16) {
          float n[16];
#pragma unroll
          for (int t = 0; t < 16; ++t) {
            const float* mc = (const float*)(smem + SC_MABT + sc * 1024 + t * 64);
            float acc = (t == lane) ? 1.f : 0.f;
#pragma unroll
            for (int sp = 0; sp < t; ++sp) acc = fmaf(n[sp], mc[sp], acc);
            n[t] = acc;
          }
#pragma unroll
          for (int t = 0; t < 16; ++t) {
            const unsigned hi = pk2(n[t], 0.f) & 0xffffu;
            const unsigned lo = pk2(n[t] - bflo(hi), 0.f) & 0xffffu;
            *(bf*)(smem + SC_SM + (sc * 5 + 0) * 640 + t * 40 + lane * 2) = (bf)hi;
            *(bf*)(smem + SC_SM + (sc * 5 + 1) * 640 + t * 40 + lane * 2) = (bf)lo;
          }
        }
      } else {
        const int sc = wid - 2;
        store_small(gram(SC_KT, SC_AT, sc), sc, 2, true);
        store_small(gram(SC_BT, SC_RT, sc), sc, 3, false);
        store_small(gram(SC_KT, SC_RT, sc), sc, 4, false);
      }
    }
    lds_barrier();
#pragma unroll
    for (int sc = 0; sc < 2; ++sc) {
      bf16x8 shi[2], slo[2];
#pragma unroll
      for (int g = 0; g < 2; ++g) {
        u32x2 h0, l0, h1, l1;
        split4(ST[2 * g], h0, l0); split4(ST[2 * g + 1], h1, l1);
        shi[g] = mk8(h0, h1); slo[g] = mk8(l0, l1);
      }
      const char* arow = smem + SC_AT + (sc * 16 + fr) * 136 + fq * 8;
      const char* rrow = smem + SC_RT + (sc * 16 + fr) * 136 + fq * 8;
      f32x4 wt = (f32x4){0.f, 0.f, 0.f, 0.f}, yt = wt;
#pragma unroll
      for (int g = 0; g < 2; ++g) {
        const bf16x8 xa = mk8(*(const u32x2*)(arow + g * 64), *(const u32x2*)(arow + g * 64 + 32));
        const bf16x8 xr = mk8(*(const u32x2*)(rrow + g * 64), *(const u32x2*)(rrow + g * 64 + 32));
        wt = __builtin_amdgcn_mfma_f32_16x16x32_bf16(xa, shi[g], wt, 0, 0, 0);
        wt = __builtin_amdgcn_mfma_f32_16x16x32_bf16(xa, slo[g], wt, 0, 0, 0);
        yt = __builtin_amdgcn_mfma_f32_16x16x32_bf16(xr, shi[g], yt, 0, 0, 0);
        yt = __builtin_amdgcn_mfma_f32_16x16x32_bf16(xr, slo[g], yt, 0, 0, 0);
      }
      const int vcol = wid * 16 + fr;
      const float* vp = vs + (sc * 16 + fq * 4) * 64 + vcol;
      const bf16x8 vmf = mk4((u32x2){pk2(vp[0], vp[64]), pk2(vp[128], vp[192])});
      const char* smb = smem + SC_SM + sc * 5 * 640 + fr * 40 + fq * 8;
      const bf16x8 xnh = mk4(*(const u32x2*)(smb)), xnl = mk4(*(const u32x2*)(smb + 640));
      const bf16x8 xmak = mk4(*(const u32x2*)(smb + 2 * 640)), xmrb = mk4(*(const u32x2*)(smb + 3 * 640)), xmrk = mk4(*(const u32x2*)(smb + 4 * 640));
      wt = __builtin_amdgcn_mfma_f32_16x16x32_bf16(xmak, vmf, wt, 0, 0, 0);
      u32x2 whi, wlo;
      split4(wt, whi, wlo);
      f32x4 ut = (f32x4){0.f, 0.f, 0.f, 0.f};
      ut = __builtin_amdgcn_mfma_f32_16x16x32_bf16(xnh, mk4(whi), ut, 0, 0, 0);
      ut = __builtin_amdgcn_mfma_f32_16x16x32_bf16(xnh, mk4(wlo), ut, 0, 0, 0);
      ut = __builtin_amdgcn_mfma_f32_16x16x32_bf16(xnl, mk4(whi), ut, 0, 0, 0);
      u32x2 uhi, ulo;
      split4(ut, uhi, ulo);
      const bf16x8 uhf = mk4(uhi), ulf = mk4(ulo);
      yt = __builtin_amdgcn_mfma_f32_16x16x32_bf16(xmrb, uhf, yt, 0, 0, 0);
      yt = __builtin_amdgcn_mfma_f32_16x16x32_bf16(xmrb, ulf, yt, 0, 0, 0);
      yt = __builtin_amdgcn_mfma_f32_16x16x32_bf16(xmrk, vmf, yt, 0, 0, 0);
#pragma unroll
      for (int e = 0; e < 4; ++e) ys[(sc * 16 + fq * 4 + e) * 64 + vcol] = yt[e];
#pragma unroll
      for (int kt = 0; kt < 4; ++kt) {
        const bf16x8 xb = mk4(*(const u32x2*)(smem + SC_BTT + (kt * 16 + fr) * 72 + (sc * 16 + fq * 4) * 2));
        const bf16x8 xk = mk4(*(const u32x2*)(smem + SC_KTT + (kt * 16 + fr) * 72 + (sc * 16 + fq * 4) * 2));
        ST[kt] = __builtin_amdgcn_mfma_f32_16x16x32_bf16(xb, uhf, ST[kt], 0, 0, 0);
        ST[kt] = __builtin_amdgcn_mfma_f32_16x16x32_bf16(xb, ulf, ST[kt], 0, 0, 0);
        ST[kt] = __builtin_amdgcn_mfma_f32_16x16x32_bf16(xk, vmf, ST[kt], 0, 0, 0);
        const f32x4 pc = *(const f32x4*)(Pbuf + (sc * 16 + 15) * 64 + kt * 16 + fq * 4);
        ST[kt] = ST[kt] * pc;
      }
    }
    lds_barrier();
    {
      const size_t row = (size_t)(rowbase + sgn * tt);
      const f32x4 y0 = *(const f32x4*)(ys + tt * 64 + c8 * 8), y1 = *(const f32x4*)(ys + tt * 64 + c8 * 8 + 4);
      *(u32x4*)(Ydst + row * ldy + h * 64 + c8 * 8) = (u32x4){pk2(y0.x, y0.y), pk2(y0.z, y0.w), pk2(y1.x, y1.y), pk2(y1.z, y1.w)};
    }
    lds_barrier();
  }
  }
}

__device__ void og_phase(const Params& p, int j) {
  const int tid = otid(), lane = tid & 63;
  const int gw = blockIdx.x * 4 + (tid >> 6), nw = gridDim.x * 4;
  const bf* Vsrc = (j == 0) ? p.VF : p.V2;
  const int col = lane * 16, hh = lane >> 2;
  float lw[16], lb[16];
#pragma unroll
  for (int e = 0; e < 16; ++e) { lw[e] = p.rw_lnx_w[j * 1024 + col + e]; lb[e] = p.rw_lnx_b[j * 1024 + col + e]; }
  for (int row = gw; row < MT; row += nw) {
    const size_t off = (size_t)row * 1024 + col, offh = (size_t)row * LDH + col;
    u32x4 u0[2], u1[2], uv[2], ug[2];
#pragma unroll
    for (int q = 0; q < 2; ++q) {
      u0[q] = *(const u32x4*)(p.H + offh + q * 8);
      u1[q] = *(const u32x4*)(p.Y1 + off + q * 8);
      uv[q] = *(const u32x4*)(Vsrc + off + q * 8);
      ug[q] = *(const u32x4*)(p.G + off + q * 8);
    }
    const float bsum = p.beta[(size_t)row * 16 + hh] + p.beta[(size_t)MT * 16 + (size_t)row * 16 + hh];
    float y[16], v[16], g[16];
    float s = 0.f;
#pragma unroll
    for (int e = 0; e < 8; ++e) {
      y[2 * e] = bflo(u0[e >> 2][e & 3]) + bflo(u1[e >> 2][e & 3]); y[2 * e + 1] = bfhi(u0[e >> 2][e & 3]) + bfhi(u1[e >> 2][e & 3]);
      v[2 * e] = bflo(uv[e >> 2][e & 3]); v[2 * e + 1] = bfhi(uv[e >> 2][e & 3]);
      g[2 * e] = bflo(ug[e >> 2][e & 3]); g[2 * e + 1] = bfhi(ug[e >> 2][e & 3]);
      s += y[2 * e] + y[2 * e + 1];
    }
    s = quad_sum(s);
    const float mean = s * (1.f / 64.f);
    float q2 = 0.f;
#pragma unroll
    for (int e = 0; e < 16; ++e) { const float dd = y[e] - mean; q2 += dd * dd; }
    q2 = quad_sum(q2);
    const float rstd = rsqrtf(q2 * (1.f / 64.f) + 64e-5f);
    unsigned o[8];
#pragma unroll
    for (int e = 0; e < 8; ++e) {
      const float r0 = ((y[2 * e] - mean) * rstd * lw[2 * e] + lb[2 * e] + bsum * v[2 * e]) * g[2 * e];
      const float r1 = ((y[2 * e + 1] - mean) * rstd * lw[2 * e + 1] + lb[2 * e + 1] + bsum * v[2 * e + 1]) * g[2 * e + 1];
      o[e] = pk2(r0, r1);
    }
    *(u32x4*)(p.H + offh) = (u32x4){o[0], o[1], o[2], o[3]};
    *(u32x4*)(p.H + offh + 8) = (u32x4){o[4], o[5], o[6], o[7]};
  }
}

__device__ void attn_phase(const Params& p, int j, bool ctx_out, char* smem) {
  const int tid = otid(), lane = tid & 63, cgp = tid >> 6, fr = lane & 15, fq = lane >> 4;
  char* Ks = smem;
  bf* Vs = (bf*)smem;
  float* rpbs = (float*)(smem + 36864);
  const bf* Q = p.R; const bf* Kb = p.K; const bf* Vt = p.V2; const bf* Gb = p.G;
  const int nitems = 16384 + (ctx_out ? 512 : 0);
  for (int item = blockIdx.x; item < nitems; item += gridDim.x) {
    int b, h, r = 0, qrow0; bool haswin;
    if (item < 16384) { h = item & 15; r = (item >> 4) & 127; b = item >> 11; haswin = true; qrow0 = b * SEQ + r * 64; }
    else { const int it = item - 16384; h = it & 15; const int qb = (it >> 4) & 3; b = it >> 6; haswin = false; qrow0 = NL + b * CTXL + qb * 64; }
    const int qtok = qrow0 + cgp * 16 + fr;
    bf16x8 qf[2];
#pragma unroll
    for (int ks = 0; ks < 2; ++ks) qf[ks] = *(const bf16x8*)(Q + (size_t)qtok * 1024 + h * 64 + ks * 32 + fq * 8);
    const int rs = min(max(r - 4, 0), 120);
    const int qcol = cgp * 16 + fr;
    const int wsq = min(max(qcol - 8, 0), 48);
    const int bs = min(max(16 * cgp - 8, 0), 32);
    lds_barrier();
    if (haswin) for (int idx = tid; idx < 465; idx += 256) rpbs[idx] = p.na_rpb[((size_t)j * 16 + h) * 465 + idx];
    f32x4 sw[8][2], sc[4][4];
    bf16x8 pw[8];
    float m1 = NEGV, l1 = 0.f;
#pragma unroll
    for (int i = 0; i < 8; ++i) pw[i] = (bf16x8){0, 0, 0, 0, 0, 0, 0, 0};
#pragma unroll
    for (int i = 0; i < 8; ++i)
#pragma unroll
      for (int k2 = 0; k2 < 2; ++k2) sw[i][k2] = (f32x4){NEGV, NEGV, NEGV, NEGV};
#pragma unroll
    for (int st = 0; st < 3; ++st) {
      if (st < 2 && !haswin) continue;
      lds_barrier();
      int tq = tid; asm volatile("" : "+v"(tq));
#pragma unroll
      for (int hf = 0; hf < 2; ++hf) {
        u32x4 u[4];
#pragma unroll
        for (int i = 0; i < 4; ++i) {
          const int q = tq + (hf * 4 + i) * 256, key = q >> 3, c = q & 7, tl = key >> 6;
          const int base = (st < 2) ? b * SEQ + (rs + st * 4 + tl) * 64 : NL + b * CTXL + tl * 64;
          u[i] = *(const u32x4*)(Kb + (size_t)(base + (key & 63)) * 1024 + h * 64 + c * 8);
        }
#pragma unroll
        for (int i = 0; i < 4; ++i) {
          const int q = tq + (hf * 4 + i) * 256, key = q >> 3, c = q & 7;
          *(u32x4*)(Ks + lds_off(key, c)) = u[i];
        }
        __builtin_amdgcn_sched_barrier(0);
      }
      lds_barrier();
      if (st < 2) {
#pragma unroll
        for (int tl = 0; tl < 4; ++tl) {
          const int i = st * 4 + tl;
          const int dr = rs + i - r + 7;
#pragma unroll
          for (int k2 = 0; k2 < 2; ++k2) {
            f32x4 acc = (f32x4){0.f, 0.f, 0.f, 0.f};
#pragma unroll
            for (int ks = 0; ks < 2; ++ks) {
              const bf16x8 kf = *(const bf16x8*)(Ks + lds_off(tl * 64 + bs + k2 * 16 + fr, ks * 4 + fq));
              acc = __builtin_amdgcn_mfma_f32_16x16x32_bf16(kf, qf[ks], acc, 0, 0, 0);
            }
#pragma unroll
            for (int e = 0; e < 4; ++e) {
              const int kc = bs + k2 * 16 + fq * 4 + e;
              const bool valid = (kc >= wsq) && (kc < wsq + 16);
              const int dc = min(max(kc - qcol, -15), 15) + 15;
              sw[i][k2][e] = valid ? acc[e] + rpbs[dr * 31 + dc] : NEGV;
            }
          }
          __builtin_amdgcn_sched_barrier(0);
        }
      } else {
#pragma unroll
        for (int tl = 0; tl < 4; ++tl)
#pragma unroll
          for (int k4 = 0; k4 < 4; ++k4) {
            f32x4 acc = (f32x4){0.f, 0.f, 0.f, 0.f};
#pragma unroll
            for (int ks = 0; ks < 2; ++ks) {
              const bf16x8 kf = *(const bf16x8*)(Ks + lds_off(tl * 64 + k4 * 16 + fr, ks * 4 + fq));
              acc = __builtin_amdgcn_mfma_f32_16x16x32_bf16(kf, qf[ks], acc, 0, 0, 0);
            }
            sc[tl][k4] = acc;
            if (k4 & 1) __builtin_amdgcn_sched_barrier(0);
          }
      }
      if (st == 1) {
#pragma unroll
        for (int i = 0; i < 8; ++i)
#pragma unroll
          for (int k2 = 0; k2 < 2; ++k2)
#pragma unroll
            for (int e = 0; e < 4; ++e) m1 = fmaxf(m1, sw[i][k2][e]);
        m1 = fmaxf(m1, __shfl_xor(m1, 16));
        m1 = fmaxf(m1, __shfl_xor(m1, 32));
#pragma unroll
        for (int i = 0; i < 8; ++i) {
          float e0[4], e1[4];
#pragma unroll
          for (int e = 0; e < 4; ++e) { e0[e] = __expf(sw[i][0][e] - m1); e1[e] = __expf(sw[i][1][e] - m1); l1 += e0[e] + e1[e]; }
          u32x4 u = (u32x4){pk2(e0[0], e0[1]), pk2(e0[2], e0[3]), pk2(e1[0], e1[1]), pk2(e1[2], e1[3])};
          pw[i] = __builtin_bit_cast(bf16x8, u);
        }
        l1 += __shfl_xor(l1, 16);
        l1 += __shfl_xor(l1, 32);
      }
    }
    float m2 = NEGV;
#pragma unroll
    for (int tl = 0; tl < 4; ++tl)
#pragma unroll
      for (int k4 = 0; k4 < 4; ++k4)
#pragma unroll
        for (int e = 0; e < 4; ++e) m2 = fmaxf(m2, sc[tl][k4][e]);
    m2 = fmaxf(m2, __shfl_xor(m2, 16));
    m2 = fmaxf(m2, __shfl_xor(m2, 32));
    const float mx = fmaxf(m1, m2);
    const float alpha1 = __expf(m1 - mx);
    float l2 = 0.f;
    bf16x8 pc[4][2];
#pragma unroll
    for (int tl = 0; tl < 4; ++tl)
#pragma unroll
      for (int g2 = 0; g2 < 2; ++g2) {
        float e0[4], e1[4];
#pragma unroll
        for (int e = 0; e < 4; ++e) { e0[e] = __expf(sc[tl][2 * g2][e] - mx); e1[e] = __expf(sc[tl][2 * g2 + 1][e] - mx); l2 += e0[e] + e1[e]; }
        u32x4 u = (u32x4){pk2(e0[0], e0[1]), pk2(e0[2], e0[3]), pk2(e1[0], e1[1]), pk2(e1[2], e1[3])};
        pc[tl][g2] = __builtin_bit_cast(bf16x8, u);
      }
    l2 += __shfl_xor(l2, 16);
    l2 += __shfl_xor(l2, 32);
    const float l = alpha1 * l1 + l2;
    f32x4 o[4];
#pragma unroll
    for (int dt = 0; dt < 4; ++dt) o[dt] = (f32x4){0.f, 0.f, 0.f, 0.f};
#pragma unroll
    for (int st = 0; st < 3; ++st) {
      if (st < 2 && !haswin) continue;
      lds_barrier();
      int tq = tid; asm volatile("" : "+v"(tq));
#pragma unroll
      for (int hf = 0; hf < 2; ++hf) {
        u32x4 u[4];
#pragma unroll
        for (int i = 0; i < 4; ++i) {
          const int q = tq + (hf * 4 + i) * 256, tl = q >> 9, dd = (q >> 3) & 63, c = q & 7;
          const int base = (st < 2) ? b * SEQ + (rs + st * 4 + tl) * 64 : NL + b * CTXL + tl * 64;
          u[i] = *(const u32x4*)(Vt + (size_t)(h * 64 + dd) * MT + base + c * 8);
        }
#pragma unroll
        for (int i = 0; i < 4; ++i) {
          const int q = tq + (hf * 4 + i) * 256, tl = q >> 9, dd = (q >> 3) & 63, c = q & 7;
          *(u32x4*)(Vs + tl * 4608 + dd * 72 + c * 8) = u[i];
        }
        __builtin_amdgcn_sched_barrier(0);
      }
      lds_barrier();
      if (st < 2) {
#pragma unroll
        for (int tl = 0; tl < 4; ++tl) {
          const int i = st * 4 + tl;
#pragma unroll
          for (int dt = 0; dt < 4; ++dt) {
            const bf* vp = Vs + tl * 4608 + (dt * 16 + fr) * 72 + bs + fq * 4;
            const u32x2 lo = *(const u32x2*)vp, hi = *(const u32x2*)(vp + 16);
            u32x4 u = (u32x4){lo.x, lo.y, hi.x, hi.y};
            o[dt] = __builtin_amdgcn_mfma_f32_16x16x32_bf16(__builtin_bit_cast(bf16x8, u), pw[i], o[dt], 0, 0, 0);
          }
          __builtin_amdgcn_sched_barrier(0);
        }
      } else {
#pragma unroll
        for (int tl = 0; tl < 4; ++tl)
#pragma unroll
          for (int g2 = 0; g2 < 2; ++g2)
#pragma unroll
            for (int dt = 0; dt < 4; ++dt) {
              const bf* vp = Vs + tl * 4608 + (dt * 16 + fr) * 72 + g2 * 32 + fq * 4;
              const u32x2 lo = *(const u32x2*)vp, hi = *(const u32x2*)(vp + 16);
              u32x4 u = (u32x4){lo.x, lo.y, hi.x, hi.y};
              o[dt] = __builtin_amdgcn_mfma_f32_16x16x32_bf16(__builtin_bit_cast(bf16x8, u), pc[tl][g2], o[dt], 0, 0, 0);
              if (dt == 3) __builtin_amdgcn_sched_barrier(0);
            }
      }
      if (st == 1) {
#pragma unroll
        for (int dt = 0; dt < 4; ++dt) o[dt] *= alpha1;
      }
    }
    const float inv = 1.f / l;
#pragma unroll
    for (int dt = 0; dt < 4; ++dt) {
      const size_t off = (size_t)qtok * 1024 + h * 64 + dt * 16 + fq * 4;
      const u32x2 ug = *(const u32x2*)(Gb + off);
      const float g0 = bflo(ug.x), g1 = bfhi(ug.x), g2 = bflo(ug.y), g3 = bfhi(ug.y);
      *(u32x2*)(p.H + (size_t)qtok * LDH + h * 64 + dt * 16 + fq * 4) = (u32x2){pk2(o[dt][0] * inv * siluf(g0), o[dt][1] * inv * siluf(g1)),
                                        pk2(o[dt][2] * inv * siluf(g2), o[dt][3] * inv * siluf(g3))};
    }
  }
}


#define XB_TMO      128
#define XB_XCNT(j)  (256  + 64 * (j))
#define XB_XSUB(j)  (1280 + 64 * (j))
#define XB_XGEN(j)  (2304 + 64 * (j))
#define XB_TOP      3328
#define XB_TOPGEN   3392
#define XCD_BAR_WORDS 3456
#define XB_SPIN_CAP (1u << 18)
__device__ __forceinline__ unsigned xb_ld(unsigned* q) { return __hip_atomic_load(q, __ATOMIC_RELAXED, __HIP_MEMORY_SCOPE_AGENT); }
__device__ __forceinline__ unsigned xb_add(unsigned* q, unsigned v) { return __hip_atomic_fetch_add(q, v, __ATOMIC_RELAXED, __HIP_MEMORY_SCOPE_AGENT); }
__device__ __forceinline__ unsigned xb_xcc_id() { return (unsigned)__builtin_amdgcn_s_getreg((3 << 11) | 20) & 0xFu; }
#define XB_SPIN(cond, bar) do { unsigned _sp = 0; while (cond) { __builtin_amdgcn_s_sleep(1); \
    if ((++_sp & 255u) == 0u) { if (xb_ld(&(bar)[XB_TMO])) break; if (_sp > XB_SPIN_CAP) { atomicAdd(&(bar)[XB_TMO], 1u); break; } } } } while (0)
struct XcdBarrier { unsigned* bar; unsigned x, nloc, nx; };
__device__ __forceinline__ void xcd_barrier(const XcdBarrier& b) {
  asm volatile("s_waitcnt vmcnt(0)" ::: "memory");
  __syncthreads();
  if (threadIdx.x == 0) {
    unsigned* bar = b.bar;
    __builtin_amdgcn_s_waitcnt(0);
    const unsigned nloc = b.nloc, nx = b.nx;
    const unsigned old = xb_add(&bar[XB_XSUB(b.x)], 1u);
    const unsigned gen = old / nloc;
    if (old + 1u == (gen + 1u) * nloc) {
      __builtin_amdgcn_fence(__ATOMIC_RELEASE, "agent");
      asm volatile("s_waitcnt vmcnt(0)" ::: "memory");
      const unsigned og = xb_add(&bar[XB_TOP], 1u);
      const unsigned tg = og / nx;
      if (og + 1u == (tg + 1u) * nx) xb_add(&bar[XB_TOPGEN], 1u);
      else XB_SPIN(xb_ld(&bar[XB_TOPGEN]) == tg, bar);
      __builtin_amdgcn_fence(__ATOMIC_ACQUIRE, "agent");
      xb_add(&bar[XB_XGEN(b.x)], 1u);
      asm volatile("s_waitcnt vmcnt(0)" ::: "memory");
    } else {
      XB_SPIN(xb_ld(&bar[XB_XGEN(b.x)]) == gen, bar);
      __builtin_amdgcn_fence(__ATOMIC_ACQUIRE, "agent");
      asm volatile("s_waitcnt vmcnt(0)" ::: "memory");
    }
  }
  __syncthreads();
}

#ifndef DUP_SCAN
#define DUP_SCAN 0
#endif
#ifndef DUP_ATTN
#define DUP_ATTN 0
#endif
#ifndef DUP_GEMM
#define DUP_GEMM 0
#endif
#ifndef MULTI_LAUNCH
#define MULTI_LAUNCH 0
#endif
__device__ __forceinline__ bool step_exists(int i, int s) {
  if (s == 2) return i == 2;
  if (s == 4) return (i & 1) == 0;
  return true;
}
__device__ __forceinline__ void run_step(const Params& p, int i, int s, char* smem) {
  asm volatile("" : "+s"(i));
  const int j = i >> 1;
  if (s == 0) { transpose_phase(p, i, smem); row_phase(p, i); }
  else if (s == 1) {
    if ((i & 1) == 0) {
      EpiRwkvProj ep{p.R, p.K, (j == 0) ? p.VF : p.V2, p.G, p.HID};
#pragma unroll 1
      for (int rep = PROBE_GEMM ? 0 : 1; rep < 2; ++rep)
      gemm_phase<1>(p.H, LDH, p.Wp, LDW, 16, MT / 128, (j == 0) ? 34 : 35, p.rw_mu + (size_t)j * 6 * 1024, ep, smem, rep == 0);
    } else {
      EpiNaProj ep{p.R, p.K, p.V2, p.G, p.na_b_in + (size_t)j * 4096};
#pragma unroll 1
      for (int rep = PROBE_GEMM ? 0 : 1; rep < 2; ++rep)
      gemm_phase<0>(p.H, LDH, p.Wp, LDW, 16, MT / 128, 32, nullptr, ep, smem, rep == 0);
    }
  } else if (s == 2) {
    EpiVres ev{p.V2, p.VF, p.rw_v0};
    gemm_phase<0>(p.HID + 256, HIDW, p.v2t, 64, 1, MT / 128, 8, nullptr, ev, smem);
  } else if (s == 3) {
    if ((i & 1) == 0) scan_phase(p, j, smem);
    else attn_phase(p, j, i != 3, smem);
  } else if (s == 4) {
    og_phase(p, j);
  } else {
    EpiOut eo{p.R};
#pragma unroll 1
    for (int rep = PROBE_GEMM ? 0 : 1; rep < 2; ++rep)
    gemm_phase<0>(p.H, LDH, p.Wo, LDW, 16, (i == 3) ? NL / 128 : MT / 128, 8, nullptr, eo, smem, rep == 0);
  }
}

__global__ void __launch_bounds__(256, 2) fwd_megakernel(Params p0) {
  __shared__ __attribute__((aligned(16))) char smem[SMEM_BYTES];
  cg::grid_group grid = cg::this_grid();
  XcdBarrier xb;
  xb.bar = p0.bar; xb.x = xb_xcc_id(); xb.nloc = 0u; xb.nx = 0u;
  if (threadIdx.x == 0) (void)xb_add(&xb.bar[XB_XCNT(xb.x)], 1u);
  pre_phase(p0, smem);
  grid.sync();
  {
    unsigned cnt = 0u, mine = 0u;
#pragma unroll 1
    for (unsigned jj = 0; jj < 16; ++jj) { const unsigned c = xb_ld(&xb.bar[XB_XCNT(jj)]); cnt += (c > 0u) ? 1u : 0u; mine = (jj == xb.x) ? c : mine; }
    xb.nloc = mine > 0u ? mine : 1u; xb.nx = cnt > 0u ? cnt : 1u;
  }
  const Params& p = p0;
#pragma unroll 1
  for (int i = 0; i < 4; ++i) {
#pragma unroll 1
    for (int s = 0; s < 6; ++s) {
      if (!step_exists(i, s)) continue;
      int reps = 1;
      if (DUP_SCAN && s == 3 && (i & 1) == 0) reps = 2;
      if (DUP_ATTN && s == 3 && (i & 1) == 1) reps = 2;
      if (DUP_GEMM && (s == 1 || s == 5)) reps = 2;
#pragma unroll 1
      for (int rep = 0; rep < reps; ++rep) {
        run_step(p, i, s, smem);
        xcd_barrier(xb);
      }
    }
  }
  row_phase(p, 4);
}

#if MULTI_LAUNCH
template <int S> __global__ void __launch_bounds__(256, 2) step_kernel(Params p0, int i) {
  __shared__ __attribute__((aligned(16))) char smem[SMEM_BYTES];
  if (S == -1) { pre_phase(p0, smem); return; }
  if (S == 6) { row_phase(p0, 4); return; }
  run_step(p0, i, S, smem);
}
#endif

extern "C" void kernel_launch(void* const* d_in, const int* in_sizes, int n_in, void* d_out, int out_size, void* d_ws, size_t ws_size,
                              hipStream_t stream) {
  static int grid_blocks = 0;
  if (!grid_blocks) {
    int dev = 0, cus = 0, per_cu = 0;
    hipGetDevice(&dev);
    hipDeviceGetAttribute(&cus, hipDeviceAttributeMultiprocessorCount, dev);
    hipOccupancyMaxActiveBlocksPerMultiprocessor(&per_cu, fwd_megakernel, 256, 0);
    if (per_cu > 2) per_cu = 2;
    if (per_cu < 1) per_cu = 1;
    grid_blocks = cus * per_cu;
  }
  Params p{};
  const float** f = (const float**)&p;
  for (int i = 0; i < 29; ++i) f[i] = (const float*)d_in[i];
  p.out = (float*)d_out;
  char* w = (char*)d_ws;
  size_t off = 0;
  auto take = [&](size_t bytes) { char* r = w + off; off += (bytes + 255) & ~(size_t)255; return r; };
  p.gp = (Params*)take(sizeof(Params));
  p.bar = (unsigned*)take((size_t)XCD_BAR_WORDS * 4);
  p.mod = (float*)take((size_t)4 * 9 * 3072 * 4);
  p.ctxbuf = (float*)take((size_t)NC * 1024 * 4);
  p.beta = (float*)take((size_t)2 * MT * 16 * 4);
  p.Wp = (bf*)take((size_t)4480 * LDW * 2);
  p.Wo = (bf*)take((size_t)1024 * LDW * 2);
  p.w2t = (bf*)take((size_t)2 * 65536 * 2);
  p.a2t = (bf*)take((size_t)2 * 65536 * 2);
  p.v2t = (bf*)take((size_t)65536 * 2);
  const size_t big = (size_t)MT * 1024 * 2;
  p.H = (bf*)take((size_t)MT * LDH * 2); p.R = (bf*)take(big); p.K = (bf*)take(big); p.VF = (bf*)take(big);
  p.V2 = (bf*)take(big); p.G = (bf*)take(big); p.Y1 = (bf*)take(big);
  p.HID = (bf*)take((size_t)MT * HIDW * 2);
  if (off > ws_size) fprintf(stderr, "workspace too small: need %zu have %zu\n", off, ws_size);
#if MULTI_LAUNCH
  step_kernel<-1><<<grid_blocks, 256, 0, stream>>>(p, 0);
  for (int i = 0; i < 4; ++i) {
    step_kernel<0><<<grid_blocks, 256, 0, stream>>>(p, i);
    step_kernel<1><<<grid_blocks, 256, 0, stream>>>(p, i);
    if (i == 2) step_kernel<2><<<grid_blocks, 256, 0, stream>>>(p, i);
    step_kernel<3><<<grid_blocks, 256, 0, stream>>>(p, i);
    if ((i & 1) == 0) step_kernel<4><<<grid_blocks, 256, 0, stream>>>(p, i);
    step_kernel<5><<<grid_blocks, 256, 0, stream>>>(p, i);
  }
  step_kernel<6><<<grid_blocks, 256, 0, stream>>>(p, 0);
#else
  (void)hipMemsetAsync(p.bar, 0, (size_t)XCD_BAR_WORDS * 4, stream);
  void* args[] = {&p};
  hipError_t e = hipLaunchCooperativeKernel((void*)fwd_megakernel, dim3(grid_blocks), dim3(256), args, 0, stream);
  if (e != hipSuccess) fprintf(stderr, "cooperative launch failed: %s (grid %d)\n", hipGetErrorString(e), grid_blocks);
#endif
}
```

```cpp
#include <hip/hip_runtime.h>
#include <hip/hip_cooperative_groups.h>
#include <cstdint>
#include <cstdio>
namespace cg = cooperative_groups;

typedef unsigned short bf;
typedef short bf16x8 __attribute__((ext_vector_type(8)));
typedef float f32x4 __attribute__((ext_vector_type(4)));
typedef unsigned u32x4 __attribute__((ext_vector_type(4)));
typedef unsigned u32x2 __attribute__((ext_vector_type(2)));

constexpr int DM = 1024, NB = 8, SEQ = 8192, NL = NB * SEQ, CTXL = 256, NC = NB * CTXL, MT = NL + NC;
constexpr int HIDW = 384;
constexpr int LDH = 1088, LDW = 1088;
constexpr int SMEM_BYTES = 65536;
#define NEGV (-1e30f)
#ifndef PROBE_GEMM
#define PROBE_GEMM 0
#endif

struct Params {
  const float *x, *c, *ctx, *c_ctx, *ada_w, *ada_b, *pre_g, *post_g, *rw_mu, *rw_w_rkvg, *rw_w0, *rw_w1, *rw_w2,
      *rw_a0, *rw_a1, *rw_a2, *rw_v0, *rw_v1, *rw_v2, *rw_k_k, *rw_k_a, *rw_r_k, *rw_lnx_w, *rw_lnx_b, *rw_w_out,
      *na_w_in, *na_b_in, *na_rpb, *na_w_out;
  float* out;
  float *mod, *ctxbuf, *beta;
  bf *Wp, *Wo, *w2t, *a2t, *v2t;
  bf *H, *R, *K, *VF, *V2, *G, *Y1, *HID;
  Params* gp;
  unsigned* bar;
};

__device__ __forceinline__ float bflo(unsigned w) { return __uint_as_float(w << 16); }
__device__ __forceinline__ float bfhi(unsigned w) { return __uint_as_float(w & 0xffff0000u); }
typedef __bf16 bf16x2_t __attribute__((ext_vector_type(2)));
__device__ __forceinline__ unsigned pk2(float lo, float hi) {
  bf16x2_t v = {(__bf16)lo, (__bf16)hi};
  return __builtin_bit_cast(unsigned, v);
}
__device__ __forceinline__ float siluf(float v) { return v * __builtin_amdgcn_rcpf(1.f + __expf(-v)); }
__device__ __forceinline__ float sigmf(float v) { return __builtin_amdgcn_rcpf(1.f + __expf(-v)); }
__device__ __forceinline__ float tanh_fast(float v) { return 1.f - 2.f * __builtin_amdgcn_rcpf(1.f + __expf(2.f * v)); }
__device__ __forceinline__ float quad_sum(float v) {
  int t = __builtin_amdgcn_update_dpp(0, __float_as_int(v), 0xB1, 0xF, 0xF, true);
  v += __int_as_float(t);
  t = __builtin_amdgcn_update_dpp(0, __float_as_int(v), 0x4E, 0xF, 0xF, true);
  v += __int_as_float(t);
  return v;
}
__device__ __forceinline__ float wave_sum(float v) {
#pragma unroll
  for (int o = 32; o >= 1; o >>= 1) v += __shfl_xor(v, o);
  return v;
}
__device__ __forceinline__ int otid() { int t = threadIdx.x; asm volatile("" : "+v"(t)); return t; }
__device__ __forceinline__ void lds_barrier() { asm volatile("s_waitcnt lgkmcnt(0)\n\ts_barrier" ::: "memory"); }
__device__ __forceinline__ int lds_off(int row, int c) { return row * 128 + ((c ^ ((row >> 1) & 7)) << 4); }
__device__ __forceinline__ unsigned lerp2(unsigned hm, unsigned h0, unsigned hp, float m0, float m1) {
  const float c0 = bflo(h0), c1 = bfhi(h0);
  const float x0 = 0.5f * (bflo(hm) + bflo(hp)) - c0;
  const float x1 = 0.5f * (bfhi(hm) + bfhi(hp)) - c1;
  return pk2(c0 + x0 * m0, c1 + x1 * m1);
}
__device__ __forceinline__ int mod_idx(int row) { return row < NL ? (row >> 13) : 8; }

__device__ void pre_phase(const Params& p, char* smem) {
  float* s = (float*)smem;
  float* red = s + 9 * 1024;
  const int tid = otid();
  for (int item = blockIdx.x; item < 4 * 48; item += gridDim.x) {
    const int i = item / 48, cb = item % 48;
    __syncthreads();
    for (int idx = tid; idx < 9 * 1024; idx += 256) {
      const int m = idx >> 10, k = idx & 1023;
      const float v = (m < 8) ? p.c[m * 1024 + k] : p.c_ctx[k];
      s[idx] = siluf(v);
    }
    __syncthreads();
    const int cc = tid & 63, kq = tid >> 6;
    float acc[9];
#pragma unroll
    for (int m = 0; m < 9; ++m) acc[m] = 0.f;
    const float* W = p.ada_w + (size_t)i * 1024 * 3072 + cb * 64 + cc;
    for (int k = kq * 256; k < kq * 256 + 256; ++k) {
      const float w = W[(size_t)k * 3072];
#pragma unroll
      for (int m = 0; m < 9; ++m) acc[m] += s[m * 1024 + k] * w;
    }
#pragma unroll
    for (int m = 0; m < 9; ++m) red[(kq * 9 + m) * 64 + cc] = acc[m];
    __syncthreads();
    for (int idx = tid; idx < 9 * 64; idx += 256) {
      const int m = idx >> 6, c2 = idx & 63;
      float v = red[(0 * 9 + m) * 64 + c2] + red[(1 * 9 + m) * 64 + c2] + red[(2 * 9 + m) * 64 + c2] + red[(3 * 9 + m) * 64 + c2];
      v += p.ada_b[i * 3072 + cb * 64 + c2];
      p.mod[(size_t)(i * 9 + m) * 3072 + cb * 64 + c2] = v;
    }
  }
}

struct TOp { const float* src; bf* dst; int K, N, Kp, Np, ldd; };
__device__ bool get_op(const Params& p, int i, int op, TOp& o) {
  const int j = i >> 1;
  if (i & 1) {
    if (op == 0) { o = {p.na_w_in + (size_t)j * 1024 * 4096, p.Wp, 1024, 4096, 1024, 4096, LDW}; return true; }
    if (op == 1) { o = {p.na_w_out + (size_t)j * 1024 * 1024, p.Wo, 1024, 1024, 1024, 1024, LDW}; return true; }
    return false;
  }
  if (op < 4) { o = {p.rw_w_rkvg + ((size_t)j * 4 + op) * 1024 * 1024, p.Wp + (size_t)op * 1024 * LDW, 1024, 1024, 1024, 1024, LDW}; return true; }
  if (op < 6) { const int d = op - 4; o = {p.rw_w1 + ((size_t)j * 2 + d) * 1024 * 64, p.Wp + (size_t)(4096 + d * 64) * LDW, 1024, 64, 1024, 64, LDW}; return true; }
  if (op < 8) { const int d = op - 6; o = {p.rw_a1 + ((size_t)j * 2 + d) * 1024 * 64, p.Wp + (size_t)(4224 + d * 64) * LDW, 1024, 64, 1024, 64, LDW}; return true; }
  if (op < 10) { const int d = op - 8; o = {p.rw_w2 + ((size_t)j * 2 + d) * 64 * 1024, p.w2t + (size_t)d * 65536, 64, 1024, 64, 1024, 64}; return true; }
  if (op < 12) { const int d = op - 10; o = {p.rw_a2 + ((size_t)j * 2 + d) * 64 * 1024, p.a2t + (size_t)d * 65536, 64, 1024, 64, 1024, 64}; return true; }
  if (op == 12) { o = {p.rw_w_out + (size_t)j * 1024 * 1024, p.Wo, 1024, 1024, 1024, 1024, LDW}; return true; }
  if (j == 1 && op == 13) { o = {p.rw_v1, p.Wp + (size_t)4352 * LDW, 1024, 32, 1024, 128, LDW}; return true; }
  if (j == 1 && op == 14) { o = {p.rw_v2, p.v2t, 32, 1024, 64, 1024, 64}; return true; }
  return false;
}

__device__ void transpose_phase(const Params& p, int i, char* smem) {
  float* t = (float*)smem;
  const int tid = otid();
  int base = 0;
  for (int op = 0;; ++op) {
    TOp o;
    if (!get_op(p, i, op, o)) break;
    const int tk = o.Kp / 64, tn = o.Np / 64, nt = tk * tn;
    int first = blockIdx.x - (base % (int)gridDim.x);
    if (first < 0) first += gridDim.x;
    for (int g = first; g < nt; g += gridDim.x) {
      const int kt = g / tn, ntile = g % tn;
      __syncthreads();
#pragma unroll
      for (int ps = 0; ps < 4; ++ps) {
        const int kr = ps * 16 + (tid >> 4), c4 = (tid & 15) * 4;
        const int k = kt * 64 + kr, n = ntile * 64 + c4;
        f32x4 v = (f32x4){0.f, 0.f, 0.f, 0.f};
        if (k < o.K && n < o.N) v = *(const f32x4*)(o.src + (size_t)k * o.N + n);
        t[kr * 65 + c4 + 0] = v.x; t[kr * 65 + c4 + 1] = v.y; t[kr * 65 + c4 + 2] = v.z; t[kr * 65 + c4 + 3] = v.w;
      }
      __syncthreads();
      const int n = tid >> 2, kc = (tid & 3) * 16;
      unsigned w[8];
#pragma unroll
      for (int e = 0; e < 8; ++e) w[e] = pk2(t[(kc + 2 * e) * 65 + n], t[(kc + 2 * e + 1) * 65 + n]);
      bf* d = o.dst + (size_t)(ntile * 64 + n) * o.ldd + kt * 64 + kc;
      *(u32x4*)d = (u32x4){w[0], w[1], w[2], w[3]};
      *(u32x4*)(d + 8) = (u32x4){w[4], w[5], w[6], w[7]};
    }
    base += nt;
  }
}

template <bool UPD, bool MKH>
__device__ __forceinline__ void row_phase_t(const Params& p, int i) {
  const int tid = otid(), lane = tid & 63;
  const int gw = blockIdx.x * 4 + (tid >> 6), nw = gridDim.x * 4;
  const int nrows = MKH ? MT : NL;
  for (int row0 = gw; row0 < nrows; row0 += 2 * nw) {
    const bool valid1 = (row0 + nw) < nrows;
    const int rws[2] = {row0, valid1 ? row0 + nw : row0};
    f32x4 xv[2][4];
    u32x2 ou[2][4];
#pragma unroll
    for (int u = 0; u < 2; ++u) {
      const int row = rws[u];
      const float* xs;
      if (i <= 1) xs = (row < NL) ? p.x + (size_t)row * 1024 : p.ctx + (size_t)(row - NL) * 1024;
      else xs = (row < NL) ? p.out + (size_t)row * 1024 : p.ctxbuf + (size_t)(row - NL) * 1024;
#pragma unroll
      for (int q = 0; q < 4; ++q) xv[u][q] = *(const f32x4*)(xs + q * 256 + lane * 4);
      if (UPD) {
        const bf* orow = p.R + (size_t)row * 1024;
#pragma unroll
        for (int q = 0; q < 4; ++q) ou[u][q] = *(const u32x2*)(orow + q * 256 + lane * 4);
      }
    }
#pragma unroll
    for (int u = 0; u < 2; ++u) {
      const int row = rws[u];
      const bool st = (u == 0) || valid1;
      const int m = mod_idx(row);
      if (UPD) {
        float ov[4][4];
        float ss = 0.f;
#pragma unroll
        for (int q = 0; q < 4; ++q) {
          ov[q][0] = bflo(ou[u][q].x); ov[q][1] = bfhi(ou[u][q].x); ov[q][2] = bflo(ou[u][q].y); ov[q][3] = bfhi(ou[u][q].y);
          ss += ov[q][0] * ov[q][0] + ov[q][1] * ov[q][1] + ov[q][2] * ov[q][2] + ov[q][3] * ov[q][3];
        }
        ss = wave_sum(ss);
        const float rs = rsqrtf(ss * (1.f / 1024.f) + 1e-6f);
        const float* gate = p.mod + (size_t)((i - 1) * 9 + m) * 3072 + 2048;
        const float* pg = p.post_g + (i - 1) * 1024;
        float* xd = (row < NL) ? p.out + (size_t)row * 1024 : p.ctxbuf + (size_t)(row - NL) * 1024;
#pragma unroll
        for (int q = 0; q < 4; ++q) {
          const int col = q * 256 + lane * 4;
          const f32x4 gv = *(const f32x4*)(gate + col);
          const f32x4 pv = *(const f32x4*)(pg + col);
          xv[u][q].x += gv.x * ov[q][0] * rs * pv.x;
          xv[u][q].y += gv.y * ov[q][1] * rs * pv.y;
          xv[u][q].z += gv.z * ov[q][2] * rs * pv.z;
          xv[u][q].w += gv.w * ov[q][3] * rs * pv.w;
          if (st) *(f32x4*)(xd + col) = xv[u][q];
        }
      }
      if (MKH) {
        float ss = 0.f;
#pragma unroll
        for (int q = 0; q < 4; ++q) ss += xv[u][q].x * xv[u][q].x + xv[u][q].y * xv[u][q].y + xv[u][q].z * xv[u][q].z + xv[u][q].w * xv[u][q].w;
        ss = wave_sum(ss);
        const float rs = rsqrtf(ss * (1.f / 1024.f) + 1e-6f);
        const float* md = p.mod + (size_t)(i * 9 + m) * 3072;
        const float* pg = p.pre_g + i * 1024;
        bf* hd = p.H + (size_t)row * LDH;
#pragma unroll
        for (int q = 0; q < 4; ++q) {
          const int col = q * 256 + lane * 4;
          const f32x4 sh = *(const f32x4*)(md + col);
          const f32x4 sc = *(const f32x4*)(md + 1024 + col);
          const f32x4 pv = *(const f32x4*)(pg + col);
          const float h0 = xv[u][q].x * rs * pv.x * (1.f + sc.x) + sh.x;
          const float h1 = xv[u][q].y * rs * pv.y * (1.f + sc.y) + sh.y;
          const float h2 = xv[u][q].z * rs * pv.z * (1.f + sc.z) + sh.z;
          const float h3 = xv[u][q].w * rs * pv.w * (1.f + sc.w) + sh.w;
          if (st) *(u32x2*)(hd + col) = (u32x2){pk2(h0, h1), pk2(h2, h3)};
        }
      }
    }
  }
}
__device__ __forceinline__ void row_phase(const Params& p, int i) {
  if (i == 0) row_phase_t<false, true>(p, i);
  else if (i < 4) row_phase_t<true, true>(p, i);
  else row_phase_t<true, false>(p, i);
}

struct EpiRwkvProj {
  bf *R, *K, *V, *G, *HID;
  __device__ __forceinline__ bf* xform(int nt, int tok, int col, f32x4& v) const {
    bf* dst;
    if (nt < 8) dst = R + (size_t)tok * 1024 + col;
    else if (nt < 16) dst = K + (size_t)tok * 1024 + (col - 1024);
    else if (nt < 24) dst = V + (size_t)tok * 1024 + (col - 2048);
    else if (nt < 32) {
      dst = G + (size_t)tok * 1024 + (col - 3072);
#pragma unroll
      for (int e = 0; e < 4; ++e) v[e] = siluf(v[e]);
    } else {
      dst = HID + (size_t)tok * HIDW + (col - 4096);
      if (nt == 32) {
#pragma unroll
        for (int e = 0; e < 4; ++e) v[e] = tanh_fast(v[e]);
      }
    }
    return dst;
  }
};
struct EpiNaProj {
  bf *Q, *K, *Vt, *G; const float* bias;
  __device__ __forceinline__ bf* xform(int nt, int tok, int col, f32x4& v) const {
    const f32x4 b = *(const f32x4*)(bias + col);
    v[0] += b.x; v[1] += b.y; v[2] += b.z; v[3] += b.w;
    if (nt >= 16 && nt < 24) {
      const int c = col - 2048;
#pragma unroll
      for (int e = 0; e < 4; ++e) Vt[(size_t)(c + e) * MT + tok] = (bf)(pk2(v[e], 0.f) & 0xffffu);
      return nullptr;
    }
    bf* dst;
    if (nt < 8) { dst = Q + (size_t)tok * 1024 + col; v[0] *= 0.125f; v[1] *= 0.125f; v[2] *= 0.125f; v[3] *= 0.125f; }
    else if (nt < 16) dst = K + (size_t)tok * 1024 + (col - 1024);
    else dst = G + (size_t)tok * 1024 + (col - 3072);
    return dst;
  }
};
struct EpiOut {
  bf* O;
  __device__ __forceinline__ bf* xform(int nt, int tok, int col, f32x4& v) const { return O + (size_t)tok * 1024 + col; }
};
struct EpiVres {
  bf* V2; const bf* VF; const float* v0;
  __device__ __forceinline__ bf* xform(int nt, int tok, int col, f32x4& z) const {
    const f32x4 b = *(const f32x4*)(v0 + col);
    const u32x2 uv = *(const u32x2*)(V2 + (size_t)tok * 1024 + col);
    const u32x2 uf = *(const u32x2*)(VF + (size_t)tok * 1024 + col);
    const float v[4] = {bflo(uv.x), bfhi(uv.x), bflo(uv.y), bfhi(uv.y)};
    const float f[4] = {bflo(uf.x), bfhi(uf.x), bflo(uf.y), bfhi(uf.y)};
    const float zz[4] = {z[0] + b.x, z[1] + b.y, z[2] + b.z, z[3] + b.w};
#pragma unroll
    for (int e = 0; e < 4; ++e) z[e] = v[e] + (f[e] - v[e]) * sigmf(zz[e]);
    return V2 + (size_t)tok * 1024 + col;
  }
};

template <int AMODE, class Epi>
__device__ void gemm_phase(const bf* __restrict__ A, int lda, const bf* __restrict__ Bt, int ldb, int nkt, int mtiles, int ntiles,
                           const float* __restrict__ mu, const Epi& epi, char* smem, bool fake = false) {
  const int tid = otid(), lane = tid & 63, wid = tid >> 6, wr = wid >> 1, wc = wid & 1, fr = lane & 15, fq = lane >> 4;
  const int rg = tid >> 3, cch = tid & 7;
  char* As = smem;
  char* Bs = smem + 32768;
  constexpr int GM = 6;
  const int xcd = blockIdx.x & 7, slot = blockIdx.x >> 3, nslots = gridDim.x >> 3;
  const int per_group = GM * ntiles;
  const int ngroups = (mtiles + GM - 1) / GM;
  const int my_groups = (ngroups - xcd + 7) >> 3;
  const int my_total = my_groups * per_group;
  for (int q = slot; q < my_total; q += nslots) {
    const int gi = q / per_group, e = q - gi * per_group;
    const int nt = e / GM, mt = (xcd + 8 * gi) * GM + (e - nt * GM);
    if (mt >= mtiles) continue;
    const int row0 = mt * 128, col0 = nt * 128;
    int lerp = 0; bool sstart = false, send = false;
    if (AMODE == 1) {
      lerp = (nt < 8) ? 0 : (nt < 16) ? 2 : (nt < 24) ? 3 : (nt < 32) ? 5 : (nt == 32) ? 1 : (nt == 33) ? 4 : 3;
      if (row0 < NL) { sstart = (row0 & (SEQ - 1)) == 0; send = ((row0 + 128) & (SEQ - 1)) == 0; }
      else { sstart = ((row0 - NL) & (CTXL - 1)) == 0; send = ((row0 + 128 - NL) & (CTXL - 1)) == 0; }
    }
    f32x4 acc[4][4];
#pragma unroll
    for (int m = 0; m < 4; ++m)
#pragma unroll
      for (int n = 0; n < 4; ++n) acc[m][n] = (f32x4){0.f, 0.f, 0.f, 0.f};
    u32x4 ra[6];
    f32x4 muv[2];
    auto glds_tile = [&](const bf* G, int ld, int grow0, int kt, char* ldsbase, bool perm) {
#pragma unroll
      for (int pc = 0; pc < 4; ++pc) {
        const int row = wid * 32 + pc * 8 + (lane >> 3), cp = lane & 7, c = cp ^ ((row >> 1) & 7);
        const int srow = perm ? ((row & ~31) | (8 * ((row & 15) >> 2) + 4 * ((row >> 4) & 1) + (row & 3))) : row;
        const bf* src = G + (size_t)(grow0 + srow) * ld + kt * 64 + c * 8;
        __builtin_amdgcn_global_load_lds((const __attribute__((address_space(1))) void*)src,
                                         (__attribute__((address_space(3))) void*)(ldsbase + row * 128 + cp * 16), 16, 0, 0);
      }
    };
    auto gloadA = [&](int kt) {
      const int kc = kt * 64 + cch * 8;
#pragma unroll
      for (int i = 0; i < 6; ++i) {
        const int r = row0 + rg * 4 + i - 1;
        const bool zero = (i == 0 && rg == 0 && sstart) || (i == 5 && rg == 31 && send);
        ra[i] = zero ? (u32x4){0, 0, 0, 0} : *(const u32x4*)(A + (size_t)r * lda + kc);
      }
      muv[0] = *(const f32x4*)(mu + lerp * 1024 + kc);
      muv[1] = *(const f32x4*)(mu + lerp * 1024 + kc + 4);
    };
    auto lstoreA = [&](int buf) {
      char* a = As + buf * 16384;
#pragma unroll
      for (int i = 0; i < 4; ++i) {
        const u32x4 hm = ra[i], h0 = ra[i + 1], hp = ra[i + 2];
        u32x4 o;
        o.x = lerp2(hm.x, h0.x, hp.x, muv[0].x, muv[0].y);
        o.y = lerp2(hm.y, h0.y, hp.y, muv[0].z, muv[0].w);
        o.z = lerp2(hm.z, h0.z, hp.z, muv[1].x, muv[1].y);
        o.w = lerp2(hm.w, h0.w, hp.w, muv[1].z, muv[1].w);
        *(u32x4*)(a + lds_off(rg * 4 + i, cch)) = o;
      }
    };
    lds_barrier();
    glds_tile(Bt, ldb, col0, 0, Bs, true);
    if (AMODE == 0) glds_tile(A, lda, row0, 0, As, false);
    else { gloadA(0); lstoreA(0); }
    asm volatile("s_waitcnt vmcnt(0)" ::: "memory");
    lds_barrier();
    for (int kt = 0; kt < nkt; ++kt) {
      const int buf = kt & 1;
      if (!fake && kt + 1 < nkt) {
        glds_tile(Bt, ldb, col0, kt + 1, Bs + (buf ^ 1) * 16384, true);
        if (AMODE == 0) glds_tile(A, lda, row0, kt + 1, As + (buf ^ 1) * 16384, false);
        else gloadA(kt + 1);
      }
      const char* a = As + buf * 16384;
      const char* b = Bs + buf * 16384;
#pragma unroll
      for (int ks = 0; ks < 2; ++ks) {
        bf16x8 af[4], bfr[4];
#pragma unroll
        for (int m = 0; m < 4; ++m) af[m] = *(const bf16x8*)(a + lds_off(wr * 64 + m * 16 + fr, ks * 4 + fq));
#pragma unroll
        for (int n = 0; n < 4; ++n) bfr[n] = *(const bf16x8*)(b + lds_off(wc * 64 + n * 16 + fr, ks * 4 + fq));
        __builtin_amdgcn_s_setprio(1);
#pragma unroll
        for (int m = 0; m < 4; ++m)
#pragma unroll
          for (int n = 0; n < 4; ++n) acc[m][n] = __builtin_amdgcn_mfma_f32_16x16x32_bf16(bfr[n], af[m], acc[m][n], 0, 0, 0);
        __builtin_amdgcn_s_setprio(0);
      }
      if (AMODE == 1 && kt + 1 < nkt) lstoreA(buf ^ 1);
      asm volatile("s_waitcnt vmcnt(0)" ::: "memory");
      lds_barrier();
    }
#pragma unroll
    for (int m = 0; m < 4; ++m)
#pragma unroll
      for (int q2 = 0; q2 < 2; ++q2) {
        const int tok = row0 + wr * 64 + m * 16 + fr, col = col0 + wc * 64 + q2 * 32 + fq * 8;
        f32x4 lo = acc[m][2 * q2], hi = acc[m][2 * q2 + 1];
        bf* d0 = epi.xform(nt, tok, col, lo);
        bf* d1 = epi.xform(nt, tok, col + 4, hi);
        (void)d1;
        if (d0) *(u32x4*)d0 = (u32x4){pk2(lo[0], lo[1]), pk2(lo[2], lo[3]), pk2(hi[0], hi[1]), pk2(hi[2], hi[3])};
      }
  }
}

typedef float f32x2 __attribute__((ext_vector_type(2)));
__device__ __forceinline__ float oct_sum(float v) {
  int t = __builtin_amdgcn_update_dpp(0, __float_as_int(v), 0xB1, 0xF, 0xF, true);
  v += __int_as_float(t);
  t = __builtin_amdgcn_update_dpp(0, __float_as_int(v), 0x4E, 0xF, 0xF, true);
  v += __int_as_float(t);
  t = __builtin_amdgcn_update_dpp(0, __float_as_int(v), 0x141, 0xF, 0xF, true);
  v += __int_as_float(t);
  return v;
}
__device__ __forceinline__ f32x2 fma2(f32x2 a, f32x2 b, f32x2 c) { return __builtin_elementwise_fma(a, b, c); }
__device__ __forceinline__ float fma_s(float a, float b, float c) { float d; asm("v_fma_f32 %0, %1, %2, %3" : "=v"(d) : "v"(a), "v"(b), "v"(c)); return d; }
__device__ __forceinline__ float mul_s(float a, float b) { float d; asm("v_mul_f32 %0, %1, %2" : "=v"(d) : "v"(a), "v"(b)); return d; }
struct ScanOps { f32x4 w[2], nk[2], bb[2], kd[2], rr[2]; f32x2 vv; };
__device__ __forceinline__ ScanOps scan_load(const float* ops, const float* vs, int t, int kq, int vrow) {
  ScanOps r;
  const float* o = ops + t * 320 + kq * 8;
  r.w[0] = *(const f32x4*)(o); r.w[1] = *(const f32x4*)(o + 4);
  r.nk[0] = *(const f32x4*)(o + 64); r.nk[1] = *(const f32x4*)(o + 68);
  r.bb[0] = *(const f32x4*)(o + 128); r.bb[1] = *(const f32x4*)(o + 132);
  r.kd[0] = *(const f32x4*)(o + 192); r.kd[1] = *(const f32x4*)(o + 196);
  r.rr[0] = *(const f32x4*)(o + 256); r.rr[1] = *(const f32x4*)(o + 260);
  r.vv = *(const f32x2*)(vs + t * 64 + vrow);
  return r;
}
#define PR(v, i) ((f32x2){(v)[(i) >> 1][((i) & 1) * 2], (v)[(i) >> 1][((i) & 1) * 2 + 1]})

constexpr int SC_P = 0, SC_YA = 8192, SC_V = 16384, SC_AT = 24576, SC_RT = SC_AT + 4352, SC_BT = SC_RT + 4352, SC_KT = SC_BT + 4352;
constexpr int SC_BTT = 41984, SC_KTT = SC_BTT + 4608, SC_MABT = 51200, SC_SM = 53248;
__device__ __forceinline__ bf16x8 mk8(u32x2 lo, u32x2 hi) { u32x4 u = (u32x4){lo.x, lo.y, hi.x, hi.y}; return __builtin_bit_cast(bf16x8, u); }
__device__ __forceinline__ bf16x8 mk4(u32x2 lo) { u32x4 u = (u32x4){lo.x, lo.y, 0u, 0u}; return __builtin_bit_cast(bf16x8, u); }
__device__ __forceinline__ float bfround(float x) { return bflo(pk2(x, 0.f) & 0xffffu); }
__device__ __forceinline__ void split4(f32x4 x, u32x2& hi, u32x2& lo) {
  hi = (u32x2){pk2(x[0], x[1]), pk2(x[2], x[3])};
  const float r0 = x[0] - bflo(hi.x), r1 = x[1] - bfhi(hi.x), r2 = x[2] - bflo(hi.y), r3 = x[3] - bfhi(hi.y);
  lo = (u32x2){pk2(r0, r1), pk2(r2, r3)};
}

__device__ void scan_phase(const Params& p, int j, char* smem) {
  const int tid = otid(), lane = tid & 63, wid = tid >> 6, fr = lane & 15, fq = lane >> 4;
  float* Pbuf = (float*)(smem + SC_P);
  float* abuf = (float*)(smem + SC_YA);
  float* ys = (float*)(smem + SC_YA);
  float* vs = (float*)(smem + SC_V);
  for (int item = blockIdx.x; item < 256; item += gridDim.x) {
  const int b = item >> 5, h = (item >> 1) & 15, d = item & 1;
  lds_barrier();
  const bf* Vsrc = (j == 0) ? p.VF : p.V2;
  bf* Ydst = (d == 0) ? p.H : p.Y1;
  const int ldy = (d == 0) ? LDH : 1024;
  float* betad = p.beta + (size_t)d * MT * 16;
  bf16x8 bw[2], ba[2];
  {
    const int n = h * 64 + wid * 16 + fr;
#pragma unroll
    for (int ks = 0; ks < 2; ++ks) {
      bw[ks] = *(const bf16x8*)(p.w2t + (size_t)d * 65536 + (size_t)n * 64 + ks * 32 + fq * 8);
      ba[ks] = *(const bf16x8*)(p.a2t + (size_t)d * 65536 + (size_t)n * 64 + ks * 32 + fq * 8);
    }
  }
  float w0v[4], a0v[4];
#pragma unroll
  for (int e = 0; e < 4; ++e) {
    w0v[e] = p.rw_w0[(size_t)(j * 2 + d) * 1024 + h * 64 + wid * 16 + fq * 4 + e];
    a0v[e] = p.rw_a0[(size_t)(j * 2 + d) * 1024 + h * 64 + wid * 16 + fq * 4 + e];
  }
  const int tt = tid >> 3, c8 = tid & 7;
  float kkv[8], kav[8], rkv[8];
#pragma unroll
  for (int e = 0; e < 8; ++e) {
    kkv[e] = p.rw_k_k[j * 1024 + h * 64 + c8 * 8 + e];
    kav[e] = p.rw_k_a[j * 1024 + h * 64 + c8 * 8 + e];
    rkv[e] = p.rw_r_k[j * 1024 + h * 64 + c8 * 8 + e];
  }
  f32x4 ST[4];
#pragma unroll
  for (int kt = 0; kt < 4; ++kt) ST[kt] = (f32x4){0.f, 0.f, 0.f, 0.f};

  bf16x8 phw[2][2], pha[2][2];
  u32x4 puk, pur, puv;
  auto rowbase_of = [&](int ch, int& sgn) -> int {
    if (d == 0) { sgn = 1; return (ch < 8) ? NL + b * CTXL + ch * 32 : b * SEQ + (ch - 8) * 32; }
    sgn = -1; return (ch < 8) ? NL + b * CTXL + 255 - ch * 32 : b * SEQ + 8191 - (ch - 8) * 32;
  };
  auto prefetch = [&](int ch) {
    int sgn; const int rowbase = rowbase_of(ch, sgn);
#pragma unroll
    for (int m = 0; m < 2; ++m) {
      const size_t row = (size_t)(rowbase + sgn * (m * 16 + fr));
#pragma unroll
      for (int ks = 0; ks < 2; ++ks) {
        phw[m][ks] = *(const bf16x8*)(p.HID + row * HIDW + d * 64 + ks * 32 + fq * 8);
        pha[m][ks] = *(const bf16x8*)(p.HID + row * HIDW + 128 + d * 64 + ks * 32 + fq * 8);
      }
    }
    const size_t off = (size_t)(rowbase + sgn * tt) * 1024 + h * 64 + c8 * 8;
    puk = *(const u32x4*)(p.K + off);
    pur = *(const u32x4*)(p.R + off);
    puv = *(const u32x4*)(Vsrc + off);
  };
  prefetch(0);

  for (int ch = 0; ch < 264; ++ch) {
    int sgn; const int rowbase = rowbase_of(ch, sgn);
#pragma unroll
    for (int m = 0; m < 2; ++m) {
      const int tok = m * 16 + fr;
      f32x4 aw = (f32x4){0.f, 0.f, 0.f, 0.f}, aa = aw;
#pragma unroll
      for (int ks = 0; ks < 2; ++ks) {
        aw = __builtin_amdgcn_mfma_f32_16x16x32_bf16(bw[ks], phw[m][ks], aw, 0, 0, 0);
        aa = __builtin_amdgcn_mfma_f32_16x16x32_bf16(ba[ks], pha[m][ks], aa, 0, 0, 0);
      }
      f32x4 wd, av;
#pragma unroll
      for (int e = 0; e < 4; ++e) {
        const float ez = __expf(-(w0v[e] + aw[e]));
        wd[e] = __expf(-0.60653066f * __builtin_amdgcn_rcpf(1.f + ez));
        av[e] = __builtin_amdgcn_rcpf(1.f + __expf(-(a0v[e] + aa[e])));
      }
#pragma unroll
      for (int e = 0; e < 4; ++e) {
        float x = wd[e];
        x *= __int_as_float(__builtin_amdgcn_update_dpp(0x3f800000, __float_as_int(x), 0x111, 0xF, 0xF, false));
        x *= __int_as_float(__builtin_amdgcn_update_dpp(0x3f800000, __float_as_int(x), 0x112, 0xF, 0xF, false));
        x *= __int_as_float(__builtin_amdgcn_update_dpp(0x3f800000, __float_as_int(x), 0x114, 0xF, 0xF, false));
        x *= __int_as_float(__builtin_amdgcn_update_dpp(0x3f800000, __float_as_int(x), 0x118, 0xF, 0xF, false));
        wd[e] = x;
      }
      *(f32x4*)(Pbuf + tok * 64 + wid * 16 + fq * 4) = wd;
      *(f32x4*)(abuf + tok * 64 + wid * 16 + fq * 4) = av;
    }
    lds_barrier();
    {
      const size_t row = (size_t)(rowbase + sgn * tt);
      float k[8], r[8], kk[8];
#pragma unroll
      for (int e = 0; e < 4; ++e) {
        k[2 * e] = bflo(puk[e]); k[2 * e + 1] = bfhi(puk[e]);
        r[2 * e] = bflo(pur[e]); r[2 * e + 1] = bfhi(pur[e]);
      }
      float ss = 0.f;
#pragma unroll
      for (int e = 0; e < 8; ++e) { kk[e] = k[e] * kkv[e]; ss += kk[e] * kk[e]; }
      ss = oct_sum(ss);
      const float inv = __builtin_amdgcn_rsqf(fmaxf(ss, 1e-24f));
      const f32x4 a0 = *(const f32x4*)(abuf + tt * 64 + c8 * 8), a1 = *(const f32x4*)(abuf + tt * 64 + c8 * 8 + 4);
      const f32x4 p0 = *(const f32x4*)(Pbuf + tt * 64 + c8 * 8), p1 = *(const f32x4*)(Pbuf + tt * 64 + c8 * 8 + 4);
      f32x4 q0 = (f32x4){1.f, 1.f, 1.f, 1.f}, q1 = q0;
      if (tt & 15) { q0 = *(const f32x4*)(Pbuf + (tt - 1) * 64 + c8 * 8); q1 = *(const f32x4*)(Pbuf + (tt - 1) * 64 + c8 * 8 + 4); }
      const float a[8] = {a0.x, a0.y, a0.z, a0.w, a1.x, a1.y, a1.z, a1.w};
      const float Pt[8] = {p0.x, p0.y, p0.z, p0.w, p1.x, p1.y, p1.z, p1.w};
      const float Pm[8] = {q0.x, q0.y, q0.z, q0.w, q1.x, q1.y, q1.z, q1.w};
      float at[8], bt_[8], kt_[8], rt[8];
      float bsum = 0.f;
#pragma unroll
      for (int e = 0; e < 8; ++e) {
        const float kkn = kk[e] * inv;
        const float kd = k[e] * (1.f + (a[e] - 1.f) * kav[e]);
        bsum += r[e] * kd * rkv[e];
        const float ip = __builtin_amdgcn_rcpf(Pt[e]);
        at[e] = -kkn * Pm[e];
        bt_[e] = kkn * a[e] * ip;
        kt_[e] = kd * ip;
        rt[e] = r[e] * Pt[e];
      }
      bsum = oct_sum(bsum);
      if (c8 == 0) betad[row * 16 + h] = bsum;
      char* ro = smem + tt * 136 + c8 * 16;
      *(u32x2*)(ro + SC_AT) = (u32x2){pk2(at[0], at[1]), pk2(at[2], at[3])};   *(u32x2*)(ro + SC_AT + 8) = (u32x2){pk2(at[4], at[5]), pk2(at[6], at[7])};
      *(u32x2*)(ro + SC_RT) = (u32x2){pk2(rt[0], rt[1]), pk2(rt[2], rt[3])};   *(u32x2*)(ro + SC_RT + 8) = (u32x2){pk2(rt[4], rt[5]), pk2(rt[6], rt[7])};
      *(u32x2*)(ro + SC_BT) = (u32x2){pk2(bt_[0], bt_[1]), pk2(bt_[2], bt_[3])}; *(u32x2*)(ro + SC_BT + 8) = (u32x2){pk2(bt_[4], bt_[5]), pk2(bt_[6], bt_[7])};
      *(u32x2*)(ro + SC_KT) = (u32x2){pk2(kt_[0], kt_[1]), pk2(kt_[2], kt_[3])}; *(u32x2*)(ro + SC_KT + 8) = (u32x2){pk2(kt_[4], kt_[5]), pk2(kt_[6], kt_[7])};
#pragma unroll
      for (int e = 0; e < 8; ++e) {
        *(bf*)(smem + SC_BTT + (c8 * 8 + e) * 72 + tt * 2) = (bf)(pk2(bt_[e], 0.f) & 0xffffu);
        *(bf*)(smem + SC_KTT + (c8 * 8 + e) * 72 + tt * 2) = (bf)(pk2(kt_[e], 0.f) & 0xffffu);
      }
      *(f32x4*)(vs + tt * 64 + c8 * 8) = (f32x4){bflo(puv[0]), bfhi(puv[0]), bflo(puv[1]), bfhi(puv[1])};
      *(f32x4*)(vs + tt * 64 + c8 * 8 + 4) = (f32x4){bflo(puv[2]), bfhi(puv[2]), bflo(puv[3]), bfhi(puv[3])};
    }
    lds_barrier();
    if (ch + 1 < 264) prefetch(ch + 1);
    {
      auto gram = [&](int xbase, int ybase, int sc) -> f32x4 {
        f32x4 acc = (f32x4){0.f, 0.f, 0.f, 0.f};
#pragma unroll
        for (int ks = 0; ks < 2; ++ks) {
          const char* xp = smem + xbase + (sc * 16 + fr) * 136 + ks * 64 + fq * 16;
          const char* yp = smem + ybase + (sc * 16 + fr) * 136 + ks * 64 + fq * 16;
          const bf16x8 xf = mk8(*(const u32x2*)xp, *(const u32x2*)(xp + 8));
          const bf16x8 yf = mk8(*(const u32x2*)yp, *(const u32x2*)(yp + 8));
          acc = __builtin_amdgcn_mfma_f32_16x16x32_bf16(xf, yf, acc, 0, 0, 0);
        }
        return acc;
      };
      auto store_small = [&](f32x4 g, int sc, int kind, bool strict) {
#pragma unroll
        for (int e = 0; e < 4; ++e) { const int sidx = fq * 4 + e; const bool keep = strict ? (sidx < fr) : (sidx <= fr); g[e] = keep ? g[e] : 0.f; }
        *(u32x2*)(smem + SC_SM + (sc * 5 + kind) * 640 + fr * 40 + fq * 8) = (u32x2){pk2(g[0], g[1]), pk2(g[2], g[3])};
      };
      if (wid < 2) {
        const int sc = wid;
        f32x4 g = gram(SC_BT, SC_AT, sc);
#pragma unroll
        for (int e = 0; e < 4; ++e) g[e] = (fq * 4 + e < fr) ? g[e] : 0.f;
        *(f32x4*)(smem + SC_MABT + sc * 1024 + fr * 64 + fq * 16) = g;
        asm volatile("s_waitcnt lgkmcnt(0)" ::: "memory");
        if (lane < 16) {
          float n[16];
#pragma unroll
          for (int t = 0; t < 16; ++t) {
            const float* mc = (const float*)(smem + SC_MABT + sc * 1024 + t * 64);
            float acc = (t == lane) ? 1.f : 0.f;
#pragma unroll
            for (int sp = 0; sp < t; ++sp) acc = fmaf(n[sp], mc[sp], acc);
            n[t] = acc;
          }
#pragma unroll
          for (int t = 0; t < 16; ++t) {
            const unsigned hi = pk2(n[t], 0.f) & 0xffffu;
            const unsigned lo = pk2(n[t] - bflo(hi), 0.f) & 0xffffu;
            *(bf*)(smem + SC_SM + (sc * 5 + 0) * 640 + t * 40 + lane * 2) = (bf)hi;
            *(bf*)(smem + SC_SM + (sc * 5 + 1) * 640 + t * 40 + lane * 2) = (bf)lo;
          }
        }
      } else {
        const int sc = wid - 2;
        store_small(gram(SC_KT, SC_AT, sc), sc, 2, true);
        store_small(gram(SC_BT, SC_RT, sc), sc, 3, false);
        store_small(gram(SC_KT, SC_RT, sc), sc, 4, false);
      }
    }
    lds_barrier();
#pragma unroll
    for (int sc = 0; sc < 2; ++sc) {
      bf16x8 shi[2], slo[2];
#pragma unroll
      for (int g = 0; g < 2; ++g) {
        u32x2 h0, l0, h1, l1;
        split4(ST[2 * g], h0, l0); split4(ST[2 * g + 1], h1, l1);
        shi[g] = mk8(h0, h1); slo[g] = mk8(l0, l1);
      }
      const char* arow = smem + SC_AT + (sc * 16 + fr) * 136 + fq * 8;
      const char* rrow = smem + SC_RT + (sc * 16 + fr) * 136 + fq * 8;
      f32x4 wt = (f32x4){0.f, 0.f, 0.f, 0.f}, yt = wt;
#pragma unroll
      for (int g = 0; g < 2; ++g) {
        const bf16x8 xa = mk8(*(const u32x2*)(arow + g * 64), *(const u32x2*)(arow + g * 64 + 32));
        const bf16x8 xr = mk8(*(const u32x2*)(rrow + g * 64), *(const u32x2*)(rrow + g * 64 + 32));
        wt = __builtin_amdgcn_mfma_f32_16x16x32_bf16(xa, shi[g], wt, 0, 0, 0);
        wt = __builtin_amdgcn_mfma_f32_16x16x32_bf16(xa, slo[g], wt, 0, 0, 0);
        yt = __builtin_amdgcn_mfma_f32_16x16x32_bf16(xr, shi[g], yt, 0, 0, 0);
        yt = __builtin_amdgcn_mfma_f32_16x16x32_bf16(xr, slo[g], yt, 0, 0, 0);
      }
      const int vcol = wid * 16 + fr;
      const float* vp = vs + (sc * 16 + fq * 4) * 64 + vcol;
      const bf16x8 vmf = mk4((u32x2){pk2(vp[0], vp[64]), pk2(vp[128], vp[192])});
      const char* smb = smem + SC_SM + sc * 5 * 640 + fr * 40 + fq * 8;
      const bf16x8 xnh = mk4(*(const u32x2*)(smb)), xnl = mk4(*(const u32x2*)(smb + 640));
      const bf16x8 xmak = mk4(*(const u32x2*)(smb + 2 * 640)), xmrb = mk4(*(const u32x2*)(smb + 3 * 640)), xmrk = mk4(*(const u32x2*)(smb + 4 * 640));
      wt = __builtin_amdgcn_mfma_f32_16x16x32_bf16(xmak, vmf, wt, 0, 0, 0);
      u32x2 whi, wlo;
      split4(wt, whi, wlo);
      f32x4 ut = (f32x4){0.f, 0.f, 0.f, 0.f};
      ut = __builtin_amdgcn_mfma_f32_16x16x32_bf16(xnh, mk4(whi), ut, 0, 0, 0);
      ut = __builtin_amdgcn_mfma_f32_16x16x32_bf16(xnh, mk4(wlo), ut, 0, 0, 0);
      ut = __builtin_amdgcn_mfma_f32_16x16x32_bf16(xnl, mk4(whi), ut, 0, 0, 0);
      u32x2 uhi, ulo;
      split4(ut, uhi, ulo);
      const bf16x8 uhf = mk4(uhi), ulf = mk4(ulo);
      yt = __builtin_amdgcn_mfma_f32_16x16x32_bf16(xmrb, uhf, yt, 0, 0, 0);
      yt = __builtin_amdgcn_mfma_f32_16x16x32_bf16(xmrb, ulf, yt, 0, 0, 0);
      yt = __builtin_amdgcn_mfma_f32_16x16x32_bf16(xmrk, vmf, yt, 0, 0, 0);
#pragma unroll
      for (int e = 0; e < 4; ++e) ys[(sc * 16 + fq * 4 + e) * 64 + vcol] = yt[e];
#pragma unroll
      for (int kt = 0; kt < 4; ++kt) {
        const bf16x8 xb = mk4(*(const u32x2*)(smem + SC_BTT + (kt * 16 + fr) * 72 + (sc * 16 + fq * 4) * 2));
        const bf16x8 xk = mk4(*(const u32x2*)(smem + SC_KTT + (kt * 16 + fr) * 72 + (sc * 16 + fq * 4) * 2));
        ST[kt] = __builtin_amdgcn_mfma_f32_16x16x32_bf16(xb, uhf, ST[kt], 0, 0, 0);
        ST[kt] = __builtin_amdgcn_mfma_f32_16x16x32_bf16(xb, ulf, ST[kt], 0, 0, 0);
        ST[kt] = __builtin_amdgcn_mfma_f32_16x16x32_bf16(xk, vmf, ST[kt], 0, 0, 0);
        const f32x4 pc = *(const f32x4*)(Pbuf + (sc * 16 + 15) * 64 + kt * 16 + fq * 4);
        ST[kt] = ST[kt] * pc;
      }
    }
    lds_barrier();
    {
      const size_t row = (size_t)(rowbase + sgn * tt);
      const f32x4 y0 = *(const f32x4*)(ys + tt * 64 + c8 * 8), y1 = *(const f32x4*)(ys + tt * 64 + c8 * 8 + 4);
      *(u32x4*)(Ydst + row * ldy + h * 64 + c8 * 8) = (u32x4){pk2(y0.x, y0.y), pk2(y0.z, y0.w), pk2(y1.x, y1.y), pk2(y1.z, y1.w)};
    }
    lds_barrier();
  }
  }
}

__device__ void og_phase(const Params& p, int j) {
  const int tid = otid(), lane = tid & 63;
  const int gw = blockIdx.x * 4 + (tid >> 6), nw = gridDim.x * 4;
  const bf* Vsrc = (j == 0) ? p.VF : p.V2;
  const int col = lane * 16, hh = lane >> 2;
  float lw[16], lb[16];
#pragma unroll
  for (int e = 0; e < 16; ++e) { lw[e] = p.rw_lnx_w[j * 1024 + col + e]; lb[e] = p.rw_lnx_b[j * 1024 + col + e]; }
  for (int row = gw; row < MT; row += nw) {
    const size_t off = (size_t)row * 1024 + col, offh = (size_t)row * LDH + col;
    u32x4 u0[2], u1[2], uv[2], ug[2];
#pragma unroll
    for (int q = 0; q < 2; ++q) {
      u0[q] = *(const u32x4*)(p.H + offh + q * 8);
      u1[q] = *(const u32x4*)(p.Y1 + off + q * 8);
      uv[q] = *(const u32x4*)(Vsrc + off + q * 8);
      ug[q] = *(const u32x4*)(p.G + off + q * 8);
    }
    const float bsum = p.beta[(size_t)row * 16 + hh] + p.beta[(size_t)MT * 16 + (size_t)row * 16 + hh];
    float y[16], v[16], g[16];
    float s = 0.f;
#pragma unroll
    for (int e = 0; e < 8; ++e) {
      y[2 * e] = bflo(u0[e >> 2][e & 3]) + bflo(u1[e >> 2][e & 3]); y[2 * e + 1] = bfhi(u0[e >> 2][e & 3]) + bfhi(u1[e >> 2][e & 3]);
      v[2 * e] = bflo(uv[e >> 2][e & 3]); v[2 * e + 1] = bfhi(uv[e >> 2][e & 3]);
      g[2 * e] = bflo(ug[e >> 2][e & 3]); g[2 * e + 1] = bfhi(ug[e >> 2][e & 3]);
      s += y[2 * e] + y[2 * e + 1];
    }
    s = quad_sum(s);
    const float mean = s * (1.f / 64.f);
    float q2 = 0.f;
#pragma unroll
    for (int e = 0; e < 16; ++e) { const float dd = y[e] - mean; q2 += dd * dd; }
    q2 = quad_sum(q2);
    const float rstd = rsqrtf(q2 * (1.f / 64.f) + 64e-5f);
    unsigned o[8];
#pragma unroll
    for (int e = 0; e < 8; ++e) {
      const float r0 = ((y[2 * e] - mean) * rstd * lw[2 * e] + lb[2 * e] + bsum * v[2 * e]) * g[2 * e];
      const float r1 = ((y[2 * e + 1] - mean) * rstd * lw[2 * e + 1] + lb[2 * e + 1] + bsum * v[2 * e + 1]) * g[2 * e + 1];
      o[e] = pk2(r0, r1);
    }
    *(u32x4*)(p.H + offh) = (u32x4){o[0], o[1], o[2], o[3]};
    *(u32x4*)(p.H + offh + 8) = (u32x4){o[4], o[5], o[6], o[7]};
  }
}

__device__ void attn_phase(const Params& p, int j, bool ctx_out, char* smem) {
  const int tid = otid(), lane = tid & 63, cgp = tid >> 6, fr = lane & 15, fq = lane >> 4;
  char* Ks = smem;
  bf* Vs = (bf*)smem;
  float* rpbs = (float*)(smem + 36864);
  const bf* Q = p.R; const bf* Kb = p.K; const bf* Vt = p.V2; const bf* Gb = p.G;
  const int nitems = 16384 + (ctx_out ? 512 : 0);
  for (int item = blockIdx.x; item < nitems; item += gridDim.x) {
    int b, h, r = 0, qrow0; bool haswin;
    if (item < 16384) { h = item & 15; r = (item >> 4) & 127; b = item >> 11; haswin = true; qrow0 = b * SEQ + r * 64; }
    else { const int it = item - 16384; h = it & 15; const int qb = (it >> 4) & 3; b = it >> 6; haswin = false; qrow0 = NL + b * CTXL + qb * 64; }
    const int qtok = qrow0 + cgp * 16 + fr;
    bf16x8 qf[2];
#pragma unroll
    for (int ks = 0; ks < 2; ++ks) qf[ks] = *(const bf16x8*)(Q + (size_t)qtok * 1024 + h * 64 + ks * 32 + fq * 8);
    const int rs = min(max(r - 4, 0), 120);
    const int qcol = cgp * 16 + fr;
    const int wsq = min(max(qcol - 8, 0), 48);
    const int bs = min(max(16 * cgp - 8, 0), 32);
    lds_barrier();
    if (haswin) for (int idx = tid; idx < 465; idx += 256) rpbs[idx] = p.na_rpb[((size_t)j * 16 + h) * 465 + idx];
    f32x4 sw[8][2], sc[4][4];
    bf16x8 pw[8];
    float m1 = NEGV, l1 = 0.f;
#pragma unroll
    for (int i = 0; i < 8; ++i) pw[i] = (bf16x8){0, 0, 0, 0, 0, 0, 0, 0};
#pragma unroll
    for (int i = 0; i < 8; ++i)
#pragma unroll
      for (int k2 = 0; k2 < 2; ++k2) sw[i][k2] = (f32x4){NEGV, NEGV, NEGV, NEGV};
#pragma unroll
    for (int st = 0; st < 3; ++st) {
      if (st < 2 && !haswin) continue;
      lds_barrier();
      int tq = tid; asm volatile("" : "+v"(tq));
#pragma unroll
      for (int hf = 0; hf < 2; ++hf) {
        u32x4 u[4];
#pragma unroll
        for (int i = 0; i < 4; ++i) {
          const int q = tq + (hf * 4 + i) * 256, key = q >> 3, c = q & 7, tl = key >> 6;
          const int base = (st < 2) ? b * SEQ + (rs + st * 4 + tl) * 64 : NL + b * CTXL + tl * 64;
          u[i] = *(const u32x4*)(Kb + (size_t)(base + (key & 63)) * 1024 + h * 64 + c * 8);
        }
#pragma unroll
        for (int i = 0; i < 4; ++i) {
          const int q = tq + (hf * 4 + i) * 256, key = q >> 3, c = q & 7;
          *(u32x4*)(Ks + lds_off(key, c)) = u[i];
        }
        __builtin_amdgcn_sched_barrier(0);
      }
      lds_barrier();
      if (st < 2) {
#pragma unroll
        for (int tl = 0; tl < 4; ++tl) {
          const int i = st * 4 + tl;
          const int dr = rs + i - r + 7;
#pragma unroll
          for (int k2 = 0; k2 < 2; ++k2) {
            f32x4 acc = (f32x4){0.f, 0.f, 0.f, 0.f};
#pragma unroll
            for (int ks = 0; ks < 2; ++ks) {
              const bf16x8 kf = *(const bf16x8*)(Ks + lds_off(tl * 64 + bs + k2 * 16 + fr, ks * 4 + fq));
              acc = __builtin_amdgcn_mfma_f32_16x16x32_bf16(kf, qf[ks], acc, 0, 0, 0);
            }
#pragma unroll
            for (int e = 0; e < 4; ++e) {
              const int kc = bs + k2 * 16 + fq * 4 + e;
              const bool valid = (kc >= wsq) && (kc < wsq + 16);
              const int dc = min(max(kc - qcol, -15), 15) + 15;
              sw[i][k2][e] = valid ? acc[e] + rpbs[dr * 31 + dc] : NEGV;
            }
          }
          __builtin_amdgcn_sched_barrier(0);
        }
      } else {
#pragma unroll
        for (int tl = 0; tl < 4; ++tl)
#pragma unroll
          for (int k4 = 0; k4 < 4; ++k4) {
            f32x4 acc = (f32x4){0.f, 0.f, 0.f, 0.f};
#pragma unroll
            for (int ks = 0; ks < 2; ++ks) {
              const bf16x8 kf = *(const bf16x8*)(Ks + lds_off(tl * 64 + k4 * 16 + fr, ks * 4 + fq));
              acc = __builtin_amdgcn_mfma_f32_16x16x32_bf16(kf, qf[ks], acc, 0, 0, 0);
            }
            sc[tl][k4] = acc;
            if (k4 & 1) __builtin_amdgcn_sched_barrier(0);
          }
      }
      if (st == 1) {
#pragma unroll
        for (int i = 0; i < 8; ++i)
#pragma unroll
          for (int k2 = 0; k2 < 2; ++k2)
#pragma unroll
            for (int e = 0; e < 4; ++e) m1 = fmaxf(m1, sw[i][k2][e]);
        m1 = fmaxf(m1, __shfl_xor(m1, 16));
        m1 = fmaxf(m1, __shfl_xor(m1, 32));
#pragma unroll
        for (int i = 0; i < 8; ++i) {
          float e0[4], e1[4];
#pragma unroll
          for (int e = 0; e < 4; ++e) { e0[e] = __expf(sw[i][0][e] - m1); e1[e] = __expf(sw[i][1][e] - m1); l1 += e0[e] + e1[e]; }
          u32x4 u = (u32x4){pk2(e0[0], e0[1]), pk2(e0[2], e0[3]), pk2(e1[0], e1[1]), pk2(e1[2], e1[3])};
          pw[i] = __builtin_bit_cast(bf16x8, u);
        }
        l1 += __shfl_xor(l1, 16);
        l1 += __shfl_xor(l1, 32);
      }
    }
    float m2 = NEGV;
#pragma unroll
    for (int tl = 0; tl < 4; ++tl)
#pragma unroll
      for (int k4 = 0; k4 < 4; ++k4)
#pragma unroll
        for (int e = 0; e < 4; ++e) m2 = fmaxf(m2, sc[tl][k4][e]);
    m2 = fmaxf(m2, __shfl_xor(m2, 16));
    m2 = fmaxf(m2, __shfl_xor(m2, 32));
    const float mx = fmaxf(m1, m2);
    const float alpha1 = __expf(m1 - mx);
    float l2 = 0.f;
    bf16x8 pc[4][2];
#pragma unroll
    for (int tl = 0; tl < 4; ++tl)
#pragma unroll
      for (int g2 = 0; g2 < 2; ++g2) {
        float e0[4], e1[4];
#pragma unroll
        for (int e = 0; e < 4; ++e) { e0[e] = __expf(sc[tl][2 * g2][e] - mx); e1[e] = __expf(sc[tl][2 * g2 + 1][e] - mx); l2 += e0[e] + e1[e]; }
        u32x4 u = (u32x4){pk2(e0[0], e0[1]), pk2(e0[2], e0[3]), pk2(e1[0], e1[1]), pk2(e1[2], e1[3])};
        pc[tl][g2] = __builtin_bit_cast(bf16x8, u);
      }
    l2 += __shfl_xor(l2, 16);
    l2 += __shfl_xor(l2, 32);
    const float l = alpha1 * l1 + l2;
    f32x4 o[4];
#pragma unroll
    for (int dt = 0; dt < 4; ++dt) o[dt] = (f32x4){0.f, 0.f, 0.f, 0.f};
#pragma unroll
    for (int st = 0; st < 3; ++st) {
      if (st < 2 && !haswin) continue;
      lds_barrier();
      int tq = tid; asm volatile("" : "+v"(tq));
#pragma unroll
      for (int hf = 0; hf < 2; ++hf) {
        u32x4 u[4];
#pragma unroll
        for (int i = 0; i < 4; ++i) {
          const int q = tq + (hf * 4 + i) * 256, tl = q >> 9, dd = (q >> 3) & 63, c = q & 7;
          const int base = (st < 2) ? b * SEQ + (rs + st * 4 + tl) * 64 : NL + b * CTXL + tl * 64;
          u[i] = *(const u32x4*)(Vt + (size_t)(h * 64 + dd) * MT + base + c * 8);
        }
#pragma unroll
        for (int i = 0; i < 4; ++i) {
          const int q = tq + (hf * 4 + i) * 256, tl = q >> 9, dd = (q >> 3) & 63, c = q & 7;
          *(u32x4*)(Vs + tl * 4608 + dd * 72 + c * 8) = u[i];
        }
        __builtin_amdgcn_sched_barrier(0);
      }
      lds_barrier();
      if (st < 2) {
#pragma unroll
        for (int tl = 0; tl < 4; ++tl) {
          const int i = st * 4 + tl;
#pragma unroll
          for (int dt = 0; dt < 4; ++dt) {
            const bf* vp = Vs + tl * 4608 + (dt * 16 + fr) * 72 + bs + fq * 4;
            const u32x2 lo = *(const u32x2*)vp, hi = *(const u32x2*)(vp + 16);
            u32x4 u = (u32x4){lo.x, lo.y, hi.x, hi.y};
            o[dt] = __builtin_amdgcn_mfma_f32_16x16x32_bf16(__builtin_bit_cast(bf16x8, u), pw[i], o[dt], 0, 0, 0);
          }
          __builtin_amdgcn_sched_barrier(0);
        }
      } else {
#pragma unroll
        for (int tl = 0; tl < 4; ++tl)
#pragma unroll
          for (int g2 = 0; g2 < 2; ++g2)
#pragma unroll
            for (int dt = 0; dt < 4; ++dt) {
              const bf* vp = Vs + tl * 4608 + (dt * 16 + fr) * 72 + g2 * 32 + fq * 4;
              const u32x2 lo = *(const u32x2*)vp, hi = *(const u32x2*)(vp + 16);
              u32x4 u = (u32x4){lo.x, lo.y, hi.x, hi.y};
              o[dt] = __builtin_amdgcn_mfma_f32_16x16x32_bf16(__builtin_bit_cast(bf16x8, u), pc[tl][g2], o[dt], 0, 0, 0);
              if (dt == 3) __builtin_amdgcn_sched_barrier(0);
            }
      }
      if (st == 1) {
#pragma unroll
        for (int dt = 0; dt < 4; ++dt) o[dt] *= alpha1;
      }
    }
    const float inv = 1.f / l;
#pragma unroll
    for (int dt = 0; dt < 4; ++dt) {
      const size_t off = (size_t)qtok * 1024 + h * 64 + dt * 16 + fq * 4;
      const u32x2 ug = *(const u32x2*)(Gb + off);
      const float g0 = bflo(ug.x), g1 = bfhi(ug.x), g2 = bflo(ug.y), g3 = bfhi(ug.y);
      *(u32x2*)(p.H + (size_t)qtok * LDH + h * 64 + dt * 16 + fq * 4) = (u32x2){pk2(o[dt][0] * inv * siluf(g0), o[dt][1] * inv * siluf(g1)),
                                        pk2(o[dt][2] * inv * siluf(g2), o[dt][3] * inv * siluf(g3))};
    }
  }
}


#define XB_TMO      128
#define XB_XCNT(j)  (256  + 64 * (j))
#define XB_XSUB(j)  (1280 + 64 * (j))
#define XB_XGEN(j)  (2304 + 64 * (j))
#define XB_TOP      3328
#define XB_TOPGEN   3392
#define XCD_BAR_WORDS 3456
#define XB_SPIN_CAP (1u << 18)
__device__ __forceinline__ unsigned xb_ld(unsigned* q) { return __hip_atomic_load(q, __ATOMIC_RELAXED, __HIP_MEMORY_SCOPE_AGENT); }
__device__ __forceinline__ unsigned xb_add(unsigned* q, unsigned v) { return __hip_atomic_fetch_add(q, v, __ATOMIC_RELAXED, __HIP_MEMORY_SCOPE_AGENT); }
__device__ __forceinline__ unsigned xb_xcc_id() { return (unsigned)__builtin_amdgcn_s_getreg((3 << 11) | 20) & 0xFu; }
#define XB_SPIN(cond, bar) do { unsigned _sp = 0; while (cond) { __builtin_amdgcn_s_sleep(1); \
    if ((++_sp & 255u) == 0u) { if (xb_ld(&(bar)[XB_TMO])) break; if (_sp > XB_SPIN_CAP) { atomicAdd(&(bar)[XB_TMO], 1u); break; } } } } while (0)
struct XcdBarrier { unsigned* bar; unsigned x, nloc, nx; };
__device__ __forceinline__ void xcd_barrier(const XcdBarrier& b) {
  asm volatile("s_waitcnt vmcnt(0)" ::: "memory");
  __syncthreads();
  if (threadIdx.x == 0) {
    unsigned* bar = b.bar;
    __builtin_amdgcn_s_waitcnt(0);
    const unsigned nloc = b.nloc, nx = b.nx;
    const unsigned old = xb_add(&bar[XB_XSUB(b.x)], 1u);
    const unsigned gen = old / nloc;
    if (old + 1u == (gen + 1u) * nloc) {
      __builtin_amdgcn_fence(__ATOMIC_RELEASE, "agent");
      asm volatile("s_waitcnt vmcnt(0)" ::: "memory");
      const unsigned og = xb_add(&bar[XB_TOP], 1u);
      const unsigned tg = og / nx;
      if (og + 1u == (tg + 1u) * nx) xb_add(&bar[XB_TOPGEN], 1u);
      else XB_SPIN(xb_ld(&bar[XB_TOPGEN]) == tg, bar);
      __builtin_amdgcn_fence(__ATOMIC_ACQUIRE, "agent");
      xb_add(&bar[XB_XGEN(b.x)], 1u);
      asm volatile("s_waitcnt vmcnt(0)" ::: "memory");
    } else {
      XB_SPIN(xb_ld(&bar[XB_XGEN(b.x)]) == gen, bar);
      __builtin_amdgcn_fence(__ATOMIC_ACQUIRE, "agent");
      asm volatile("s_waitcnt vmcnt(0)" ::: "memory");
    }
  }
  __syncthreads();
}

#ifndef DUP_SCAN
#define DUP_SCAN 0
#endif
#ifndef DUP_ATTN
#define DUP_ATTN 0
#endif
#ifndef DUP_GEMM
#define DUP_GEMM 0
#endif
#ifndef MULTI_LAUNCH
#define MULTI_LAUNCH 0
#endif
__device__ __forceinline__ bool step_exists(int i, int s) {
  if (s == 2) return i == 2;
  if (s == 4) return (i & 1) == 0;
  return true;
}
__device__ __forceinline__ void run_step(const Params& p, int i, int s, char* smem) {
  asm volatile("" : "+s"(i));
  const int j = i >> 1;
  if (s == 0) { transpose_phase(p, i, smem); row_phase(p, i); }
  else if (s == 1) {
    if ((i & 1) == 0) {
      EpiRwkvProj ep{p.R, p.K, (j == 0) ? p.VF : p.V2, p.G, p.HID};
#pragma unroll 1
      for (int rep = PROBE_GEMM ? 0 : 1; rep < 2; ++rep)
      gemm_phase<1>(p.H, LDH, p.Wp, LDW, 16, MT / 128, (j == 0) ? 34 : 35, p.rw_mu + (size_t)j * 6 * 1024, ep, smem, rep == 0);
    } else {
      EpiNaProj ep{p.R, p.K, p.V2, p.G, p.na_b_in + (size_t)j * 4096};
#pragma unroll 1
      for (int rep = PROBE_GEMM ? 0 : 1; rep < 2; ++rep)
      gemm_phase<0>(p.H, LDH, p.Wp, LDW, 16, MT / 128, 32, nullptr, ep, smem, rep == 0);
    }
  } else if (s == 2) {
    EpiVres ev{p.V2, p.VF, p.rw_v0};
    gemm_phase<0>(p.HID + 256, HIDW, p.v2t, 64, 1, MT / 128, 8, nullptr, ev, smem);
  } else if (s == 3) {
    if ((i & 1) == 0) scan_phase(p, j, smem);
    else attn_phase(p, j, i != 3, smem);
  } else if (s == 4) {
    og_phase(p, j);
  } else {
    EpiOut eo{p.R};
#pragma unroll 1
    for (int rep = PROBE_GEMM ? 0 : 1; rep < 2; ++rep)
    gemm_phase<0>(p.H, LDH, p.Wo, LDW, 16, (i == 3) ? NL / 128 : MT / 128, 8, nullptr, eo, smem, rep == 0);
  }
}

__global__ void __launch_bounds__(256, 2) fwd_megakernel(Params p0) {
  __shared__ __attribute__((aligned(16))) char smem[SMEM_BYTES];
  cg::grid_group grid = cg::this_grid();
  XcdBarrier xb;
  xb.bar = p0.bar; xb.x = xb_xcc_id(); xb.nloc = 0u; xb.nx = 0u;
  if (threadIdx.x == 0) (void)xb_add(&xb.bar[XB_XCNT(xb.x)], 1u);
  pre_phase(p0, smem);
  grid.sync();
  {
    unsigned cnt = 0u, mine = 0u;
#pragma unroll 1
    for (unsigned jj = 0; jj < 16; ++jj) { const unsigned c = xb_ld(&xb.bar[XB_XCNT(jj)]); cnt += (c > 0u) ? 1u : 0u; mine = (jj == xb.x) ? c : mine; }
    xb.nloc = mine > 0u ? mine : 1u; xb.nx = cnt > 0u ? cnt : 1u;
  }
  const Params& p = p0;
#pragma unroll 1
  for (int i = 0; i < 4; ++i) {
#pragma unroll 1
    for (int s = 0; s < 6; ++s) {
      if (!step_exists(i, s)) continue;
      int reps = 1;
      if (DUP_SCAN && s == 3 && (i & 1) == 0) reps = 2;
      if (DUP_ATTN && s == 3 && (i & 1) == 1) reps = 2;
      if (DUP_GEMM && (s == 1 || s == 5)) reps = 2;
#pragma unroll 1
      for (int rep = 0; rep < reps; ++rep) {
        run_step(p, i, s, smem);
        xcd_barrier(xb);
      }
    }
  }
  row_phase(p, 4);
}

#if MULTI_LAUNCH
template <int S> __global__ void __launch_bounds__(256, 2) step_kernel(Params p0, int i) {
  __shared__ __attribute__((aligned(16))) char smem[SMEM_BYTES];
  if (S == -1) { pre_phase(p0, smem); return; }
  if (S == 6) { row_phase(p0, 4); return; }
  run_step(p0, i, S, smem);
}
#endif

extern "C" void kernel_launch(void* const* d_in, const int* in_sizes, int n_in, void* d_out, int out_size, void* d_ws, size_t ws_size,
                              hipStream_t stream) {
  static int grid_blocks = 0;
  if (!grid_blocks) {
    int dev = 0, cus = 0, per_cu = 0;
    hipGetDevice(&dev);
    hipDeviceGetAttribute(&cus, hipDeviceAttributeMultiprocessorCount, dev);
    hipOccupancyMaxActiveBlocksPerMultiprocessor(&per_cu, fwd_megakernel, 256, 0);
    if (per_cu > 2) per_cu = 2;
    if (per_cu < 1) per_cu = 1;
    grid_blocks = cus * per_cu;
  }
  Params p{};
  const float** f = (const float**)&p;
  for (int i = 0; i < 29; ++i) f[i] = (const float*)d_in[i];
  p.out = (float*)d_out;
  char* w = (char*)d_ws;
  size_t off = 0;
  auto take = [&](size_t bytes) { char* r = w + off; off += (bytes + 255) & ~(size_t)255; return r; };
  p.gp = (Params*)take(sizeof(Params));
  p.bar = (unsigned*)take((size_t)XCD_BAR_WORDS * 4);
  p.mod = (float*)take((size_t)4 * 9 * 3072 * 4);
  p.ctxbuf = (float*)take((size_t)NC * 1024 * 4);
  p.beta = (float*)take((size_t)2 * MT * 16 * 4);
  p.Wp = (bf*)take((size_t)4480 * LDW * 2);
  p.Wo = (bf*)take((size_t)1024 * LDW * 2);
  p.w2t = (bf*)take((size_t)2 * 65536 * 2);
  p.a2t = (bf*)take((size_t)2 * 65536 * 2);
  p.v2t = (bf*)take((size_t)65536 * 2);
  const size_t big = (size_t)MT * 1024 * 2;
  p.H = (bf*)take((size_t)MT * LDH * 2); p.R = (bf*)take(big); p.K = (bf*)take(big); p.VF = (bf*)take(big);
  p.V2 = (bf*)take(big); p.G = (bf*)take(big); p.Y1 = (bf*)take(big);
  p.HID = (bf*)take((size_t)MT * HIDW * 2);
  if (off > ws_size) fprintf(stderr, "workspace too small: need %zu have %zu\n", off, ws_size);
#if MULTI_LAUNCH
  step_kernel<-1><<<grid_blocks, 256, 0, stream>>>(p, 0);
  for (int i = 0; i < 4; ++i) {
    step_kernel<0><<<grid_blocks, 256, 0, stream>>>(p, i);
    step_kernel<1><<<grid_blocks, 256, 0, stream>>>(p, i);
    if (i == 2) step_kernel<2><<<grid_blocks, 256, 0, stream>>>(p, i);
    step_kernel<3><<<grid_blocks, 256, 0, stream>>>(p, i);
    if ((i & 1) == 0) step_kernel<4><<<grid_blocks, 256, 0, stream>>>(p, i);
    step_kernel<5><<<grid_blocks, 256, 0, stream>>>(p, i);
  }
  step_kernel<6><<<grid_blocks, 256, 0, stream>>>(p, 0);
#else
  (void)hipMemsetAsync(p.bar, 0, (size_t)XCD_BAR_WORDS * 4, stream);
  void* args[] = {&p};
  hipError_t e = hipLaunchCooperativeKernel((void*)fwd_megakernel, dim3(grid_blocks), dim3(256), args, 0, stream);
  if (e != hipSuccess) fprintf(stderr, "cooperative launch failed: %s (grid %d)\n", hipGetErrorString(e), grid_blocks);
#endif
}
```

```cpp
#include <hip/hip_runtime.h>
#include <hip/hip_cooperative_groups.h>
#include <cstdint>
#include <cstdio>
namespace cg = cooperative_groups;

typedef unsigned short bf;
typedef short bf16x8 __attribute__((ext_vector_type(8)));
typedef float f32x4 __attribute__((ext_vector_type(4)));
typedef unsigned u32x4 __attribute__((ext_vector_type(4)));
typedef unsigned u32x2 __attribute__((ext_vector_type(2)));

constexpr int DM = 1024, NB = 8, SEQ = 8192, NL = NB * SEQ, CTXL = 256, NC = NB * CTXL, MT = NL + NC;
constexpr int HIDW = 384;
constexpr int LDH = 1088, LDW = 1088;
constexpr int SMEM_BYTES = 65536;
#define NEGV (-1e30f)
#ifndef PROBE_GEMM
#define PROBE_GEMM 0
#endif

struct Params {
  const float *x, *c, *ctx, *c_ctx, *ada_w, *ada_b, *pre_g, *post_g, *rw_mu, *rw_w_rkvg, *rw_w0, *rw_w1, *rw_w2,
      *rw_a0, *rw_a1, *rw_a2, *rw_v0, *rw_v1, *rw_v2, *rw_k_k, *rw_k_a, *rw_r_k, *rw_lnx_w, *rw_lnx_b, *rw_w_out,
      *na_w_in, *na_b_in, *na_rpb, *na_w_out;
  float* out;
  float *mod, *ctxbuf, *beta;
  bf *Wp, *Wo, *w2t, *a2t, *v2t;
  bf *H, *R, *K, *VF, *V2, *G, *Y1, *HID;
  Params* gp;
  unsigned* bar;
};

__device__ __forceinline__ float bflo(unsigned w) { return __uint_as_float(w << 16); }
__device__ __forceinline__ float bfhi(unsigned w) { return __uint_as_float(w & 0xffff0000u); }
typedef __bf16 bf16x2_t __attribute__((ext_vector_type(2)));
__device__ __forceinline__ unsigned pk2(float lo, float hi) {
  bf16x2_t v = {(__bf16)lo, (__bf16)hi};
  return __builtin_bit_cast(unsigned, v);
}
__device__ __forceinline__ float siluf(float v) { return v * __builtin_amdgcn_rcpf(1.f + __expf(-v)); }
__device__ __forceinline__ float sigmf(float v) { return __builtin_amdgcn_rcpf(1.f + __expf(-v)); }
__device__ __forceinline__ float tanh_fast(float v) { return 1.f - 2.f * __builtin_amdgcn_rcpf(1.f + __expf(2.f * v)); }
__device__ __forceinline__ float quad_sum(float v) {
  int t = __builtin_amdgcn_update_dpp(0, __float_as_int(v), 0xB1, 0xF, 0xF, true);
  v += __int_as_float(t);
  t = __builtin_amdgcn_update_dpp(0, __float_as_int(v), 0x4E, 0xF, 0xF, true);
  v += __int_as_float(t);
  return v;
}
__device__ __forceinline__ float wave_sum(float v) {
#pragma unroll
  for (int o = 32; o >= 1; o >>= 1) v += __shfl_xor(v, o);
  return v;
}
__device__ __forceinline__ int otid() { int t = threadIdx.x; asm volatile("" : "+v"(t)); return t; }
__device__ __forceinline__ void lds_barrier() { asm volatile("s_waitcnt lgkmcnt(0)\n\ts_barrier" ::: "memory"); }
__device__ __forceinline__ int lds_off(int row, int c) { return row * 128 + ((c ^ ((row >> 1) & 7)) << 4); }
__device__ __forceinline__ unsigned lerp2(unsigned hm, unsigned h0, unsigned hp, float m0, float m1) {
  const float c0 = bflo(h0), c1 = bfhi(h0);
  const float x0 = 0.5f * (bflo(hm) + bflo(hp)) - c0;
  const float x1 = 0.5f * (bfhi(hm) + bfhi(hp)) - c1;
  return pk2(c0 + x0 * m0, c1 + x1 * m1);
}
__device__ __forceinline__ int mod_idx(int row) { return row < NL ? (row >> 13) : 8; }

__device__ void pre_phase(const Params& p, char* smem) {
  float* s = (float*)smem;
  float* red = s + 9 * 1024;
  const int tid = otid();
  for (int item = blockIdx.x; item < 4 * 48; item += gridDim.x) {
    const int i = item / 48, cb = item % 48;
    __syncthreads();
    for (int idx = tid; idx < 9 * 1024; idx += 256) {
      const int m = idx >> 10, k = idx & 1023;
      const float v = (m < 8) ? p.c[m * 1024 + k] : p.c_ctx[k];
      s[idx] = siluf(v);
    }
    __syncthreads();
    const int cc = tid & 63, kq = tid >> 6;
    float acc[9];
#pragma unroll
    for (int m = 0; m < 9; ++m) acc[m] = 0.f;
    const float* W = p.ada_w + (size_t)i * 1024 * 3072 + cb * 64 + cc;
    for (int k = kq * 256; k < kq * 256 + 256; ++k) {
      const float w = W[(size_t)k * 3072];
#pragma unroll
      for (int m = 0; m < 9; ++m) acc[m] += s[m * 1024 + k] * w;
    }
#pragma unroll
    for (int m = 0; m < 9; ++m) red[(kq * 9 + m) * 64 + cc] = acc[m];
    __syncthreads();
    for (int idx = tid; idx < 9 * 64; idx += 256) {
      const int m = idx >> 6, c2 = idx & 63;
      float v = red[(0 * 9 + m) * 64 + c2] + red[(1 * 9 + m) * 64 + c2] + red[(2 * 9 + m) * 64 + c2] + red[(3 * 9 + m) * 64 + c2];
      v += p.ada_b[i * 3072 + cb * 64 + c2];
      p.mod[(size_t)(i * 9 + m) * 3072 + cb * 64 + c2] = v;
    }
  }
}

struct TOp { const float* src; bf* dst; int K, N, Kp, Np, ldd; };
__device__ bool get_op(const Params& p, int i, int op, TOp& o) {
  const int j = i >> 1;
  if (i & 1) {
    if (op == 0) { o = {p.na_w_in + (size_t)j * 1024 * 4096, p.Wp, 1024, 4096, 1024, 4096, LDW}; return true; }
    if (op == 1) { o = {p.na_w_out + (size_t)j * 1024 * 1024, p.Wo, 1024, 1024, 1024, 1024, LDW}; return true; }
    return false;
  }
  if (op < 4) { o = {p.rw_w_rkvg + ((size_t)j * 4 + op) * 1024 * 1024, p.Wp + (size_t)op * 1024 * LDW, 1024, 1024, 1024, 1024, LDW}; return true; }
  if (op < 6) { const int d = op - 4; o = {p.rw_w1 + ((size_t)j * 2 + d) * 1024 * 64, p.Wp + (size_t)(4096 + d * 64) * LDW, 1024, 64, 1024, 64, LDW}; return true; }
  if (op < 8) { const int d = op - 6; o = {p.rw_a1 + ((size_t)j * 2 + d) * 1024 * 64, p.Wp + (size_t)(4224 + d * 64) * LDW, 1024, 64, 1024, 64, LDW}; return true; }
  if (op < 10) { const int d = op - 8; o = {p.rw_w2 + ((size_t)j * 2 + d) * 64 * 1024, p.w2t + (size_t)d * 65536, 64, 1024, 64, 1024, 64}; return true; }
  if (op < 12) { const int d = op - 10; o = {p.rw_a2 + ((size_t)j * 2 + d) * 64 * 1024, p.a2t + (size_t)d * 65536, 64, 1024, 64, 1024, 64}; return true; }
  if (op == 12) { o = {p.rw_w_out + (size_t)j * 1024 * 1024, p.Wo, 1024, 1024, 1024, 1024, LDW}; return true; }
  if (j == 1 && op == 13) { o = {p.rw_v1, p.Wp + (size_t)4352 * LDW, 1024, 32, 1024, 128, LDW}; return true; }
  if (j == 1 && op == 14) { o = {p.rw_v2, p.v2t, 32, 1024, 64, 1024, 64}; return true; }
  return false;
}

__device__ void transpose_phase(const Params& p, int i, char* smem) {
  float* t = (float*)smem;
  const int tid = otid();
  int base = 0;
  for (int op = 0;; ++op) {
    TOp o;
    if (!get_op(p, i, op, o)) break;
    const int tk = o.Kp / 64, tn = o.Np / 64, nt = tk * tn;
    int first = blockIdx.x - (base % (int)gridDim.x);
    if (first < 0) first += gridDim.x;
    for (int g = first; g < nt; g += gridDim.x) {
      const int kt = g / tn, ntile = g % tn;
      __syncthreads();
#pragma unroll
      for (int ps = 0; ps < 4; ++ps) {
        const int kr = ps * 16 + (tid >> 4), c4 = (tid & 15) * 4;
        const int k = kt * 64 + kr, n = ntile * 64 + c4;
        f32x4 v = (f32x4){0.f, 0.f, 0.f, 0.f};
        if (k < o.K && n < o.N) v = *(const f32x4*)(o.src + (size_t)k * o.N + n);
        t[kr * 65 + c4 + 0] = v.x; t[kr * 65 + c4 + 1] = v.y; t[kr * 65 + c4 + 2] = v.z; t[kr * 65 + c4 + 3] = v.w;
      }
      __syncthreads();
      const int n = tid >> 2, kc = (tid & 3) * 16;
      unsigned w[8];
#pragma unroll
      for (int e = 0; e < 8; ++e) w[e] = pk2(t[(kc + 2 * e) * 65 + n], t[(kc + 2 * e + 1) * 65 + n]);
      bf* d = o.dst + (size_t)(ntile * 64 + n) * o.ldd + kt * 64 + kc;
      *(u32x4*)d = (u32x4){w[0], w[1], w[2], w[3]};
      *(u32x4*)(d + 8) = (u32x4){w[4], w[5], w[6], w[7]};
    }
    base += nt;
  }
}

template <bool UPD, bool MKH>
__device__ __forceinline__ void row_phase_t(const Params& p, int i) {
  const int tid = otid(), lane = tid & 63;
  const int gw = blockIdx.x * 4 + (tid >> 6), nw = gridDim.x * 4;
  const int nrows = MKH ? MT : NL;
  for (int row0 = gw; row0 < nrows; row0 += 2 * nw) {
    const bool valid1 = (row0 + nw) < nrows;
    const int rws[2] = {row0, valid1 ? row0 + nw : row0};
    f32x4 xv[2][4];
    u32x2 ou[2][4];
#pragma unroll
    for (int u = 0; u < 2; ++u) {
      const int row = rws[u];
      const float* xs;
      if (i <= 1) xs = (row < NL) ? p.x + (size_t)row * 1024 : p.ctx + (size_t)(row - NL) * 1024;
      else xs = (row < NL) ? p.out + (size_t)row * 1024 : p.ctxbuf + (size_t)(row - NL) * 1024;
#pragma unroll
      for (int q = 0; q < 4; ++q) xv[u][q] = *(const f32x4*)(xs + q * 256 + lane * 4);
      if (UPD) {
        const bf* orow = p.R + (size_t)row * 1024;
#pragma unroll
        for (int q = 0; q < 4; ++q) ou[u][q] = *(const u32x2*)(orow + q * 256 + lane * 4);
      }
    }
#pragma unroll
    for (int u = 0; u < 2; ++u) {
      const int row = rws[u];
      const bool st = (u == 0) || valid1;
      const int m = mod_idx(row);
      if (UPD) {
        float ov[4][4];
        float ss = 0.f;
#pragma unroll
        for (int q = 0; q < 4; ++q) {
          ov[q][0] = bflo(ou[u][q].x); ov[q][1] = bfhi(ou[u][q].x); ov[q][2] = bflo(ou[u][q].y); ov[q][3] = bfhi(ou[u][q].y);
          ss += ov[q][0] * ov[q][0] + ov[q][1] * ov[q][1] + ov[q][2] * ov[q][2] + ov[q][3] * ov[q][3];
        }
        ss = wave_sum(ss);
        const float rs = rsqrtf(ss * (1.f / 1024.f) + 1e-6f);
        const float* gate = p.mod + (size_t)((i - 1) * 9 + m) * 3072 + 2048;
        const float* pg = p.post_g + (i - 1) * 1024;
        float* xd = (row < NL) ? p.out + (size_t)row * 1024 : p.ctxbuf + (size_t)(row - NL) * 1024;
#pragma unroll
        for (int q = 0; q < 4; ++q) {
          const int col = q * 256 + lane * 4;
          const f32x4 gv = *(const f32x4*)(gate + col);
          const f32x4 pv = *(const f32x4*)(pg + col);
          xv[u][q].x += gv.x * ov[q][0] * rs * pv.x;
          xv[u][q].y += gv.y * ov[q][1] * rs * pv.y;
          xv[u][q].z += gv.z * ov[q][2] * rs * pv.z;
          xv[u][q].w += gv.w * ov[q][3] * rs * pv.w;
          if (st) *(f32x4*)(xd + col) = xv[u][q];
        }
      }
      if (MKH) {
        float ss = 0.f;
#pragma unroll
        for (int q = 0; q < 4; ++q) ss += xv[u][q].x * xv[u][q].x + xv[u][q].y * xv[u][q].y + xv[u][q].z * xv[u][q].z + xv[u][q].w * xv[u][q].w;
        ss = wave_sum(ss);
        const float rs = rsqrtf(ss * (1.f / 1024.f) + 1e-6f);
        const float* md = p.mod + (size_t)(i * 9 + m) * 3072;
        const float* pg = p.pre_g + i * 1024;
        bf* hd = p.H + (size_t)row * LDH;
#pragma unroll
        for (int q = 0; q < 4; ++q) {
          const int col = q * 256 + lane * 4;
          const f32x4 sh = *(const f32x4*)(md + col);
          const f32x4 sc = *(const f32x4*)(md + 1024 + col);
          const f32x4 pv = *(const f32x4*)(pg + col);
          const float h0 = xv[u][q].x * rs * pv.x * (1.f + sc.x) + sh.x;
          const float h1 = xv[u][q].y * rs * pv.y * (1.f + sc.y) + sh.y;
          const float h2 = xv[u][q].z * rs * pv.z * (1.f + sc.z) + sh.z;
          const float h3 = xv[u][q].w * rs * pv.w * (1.f + sc.w) + sh.w;
          if (st) *(u32x2*)(hd + col) = (u32x2){pk2(h0, h1), pk2(h2, h3)};
        }
      }
    }
  }
}
__device__ __forceinline__ void row_phase(const Params& p, int i) {
  if (i == 0) row_phase_t<false, true>(p, i);
  else if (i < 4) row_phase_t<true, true>(p, i);
  else row_phase_t<true, false>(p, i);
}

struct EpiRwkvProj {
  static constexpr bool VT = false;
  __device__ __forceinline__ void store_vt(int, int, f32x4, f32x4) const {}
  bf *R, *K, *V, *G, *HID;
  __device__ __forceinline__ bf* xform(int nt, int tok, int col, f32x4& v) const {
    bf* dst;
    if (nt < 8) dst = R + (size_t)tok * 1024 + col;
    else if (nt < 16) dst = K + (size_t)tok * 1024 + (col - 1024);
    else if (nt < 24) dst = V + (size_t)tok * 1024 + (col - 2048);
    else if (nt < 32) {
      dst = G + (size_t)tok * 1024 + (col - 3072);
#pragma unroll
      for (int e = 0; e < 4; ++e) v[e] = siluf(v[e]);
    } else {
      dst = HID + (size_t)tok * HIDW + (col - 4096);
      if (nt == 32) {
#pragma unroll
        for (int e = 0; e < 4; ++e) v[e] = tanh_fast(v[e]);
      }
    }
    return dst;
  }
};
struct EpiNaProj {
  static constexpr bool VT = true;
  bf *Q, *K, *Vt, *G; const float* bias;
  __device__ __forceinline__ void store_vt(int tok, int col, f32x4 lo, f32x4 hi) const {
    const float b = bias[col];
    *(u32x4*)(Vt + (size_t)(col - 2048) * MT + tok) = (u32x4){pk2(lo[0] + b, lo[1] + b), pk2(lo[2] + b, lo[3] + b), pk2(hi[0] + b, hi[1] + b), pk2(hi[2] + b, hi[3] + b)};
  }
  __device__ __forceinline__ bf* xform(int nt, int tok, int col, f32x4& v) const {
    const f32x4 b = *(const f32x4*)(bias + col);
    v[0] += b.x; v[1] += b.y; v[2] += b.z; v[3] += b.w;
    if (nt >= 16 && nt < 24) {
      const int c = col - 2048;
#pragma unroll
      for (int e = 0; e < 4; ++e) Vt[(size_t)(c + e) * MT + tok] = (bf)(pk2(v[e], 0.f) & 0xffffu);
      return nullptr;
    }
    bf* dst;
    if (nt < 8) { dst = Q + (size_t)tok * 1024 + col; v[0] *= 0.125f; v[1] *= 0.125f; v[2] *= 0.125f; v[3] *= 0.125f; }
    else if (nt < 16) dst = K + (size_t)tok * 1024 + (col - 1024);
    else dst = G + (size_t)tok * 1024 + (col - 3072);
    return dst;
  }
};
struct EpiOut {
  static constexpr bool VT = false;
  __device__ __forceinline__ void store_vt(int, int, f32x4, f32x4) const {}
  bf* O;
  __device__ __forceinline__ bf* xform(int nt, int tok, int col, f32x4& v) const { return O + (size_t)tok * 1024 + col; }
};
struct EpiVres {
  static constexpr bool VT = false;
  __device__ __forceinline__ void store_vt(int, int, f32x4, f32x4) const {}
  bf* V2; const bf* VF; const float* v0;
  __device__ __forceinline__ bf* xform(int nt, int tok, int col, f32x4& z) const {
    const f32x4 b = *(const f32x4*)(v0 + col);
    const u32x2 uv = *(const u32x2*)(V2 + (size_t)tok * 1024 + col);
    const u32x2 uf = *(const u32x2*)(VF + (size_t)tok * 1024 + col);
    const float v[4] = {bflo(uv.x), bfhi(uv.x), bflo(uv.y), bfhi(uv.y)};
    const float f[4] = {bflo(uf.x), bfhi(uf.x), bflo(uf.y), bfhi(uf.y)};
    const float zz[4] = {z[0] + b.x, z[1] + b.y, z[2] + b.z, z[3] + b.w};
#pragma unroll
    for (int e = 0; e < 4; ++e) z[e] = v[e] + (f[e] - v[e]) * sigmf(zz[e]);
    return V2 + (size_t)tok * 1024 + col;
  }
};

template <int AMODE, class Epi>
__device__ void gemm_phase(const bf* __restrict__ A, int lda, const bf* __restrict__ Bt, int ldb, int nkt, int mtiles, int ntiles,
                           const float* __restrict__ mu, const Epi& epi, char* smem, bool fake = false) {
  const int tid = otid(), lane = tid & 63, wid = tid >> 6, wr = wid >> 1, wc = wid & 1, fr = lane & 15, fq = lane >> 4;
  const int rg = tid >> 3, cch = tid & 7;
  char* As = smem;
  char* Bs = smem + 32768;
  constexpr int GM = 6;
  const int xcd = blockIdx.x & 7, slot = blockIdx.x >> 3, nslots = gridDim.x >> 3;
  const int per_group = GM * ntiles;
  const int ngroups = (mtiles + GM - 1) / GM;
  const int my_groups = (ngroups - xcd + 7) >> 3;
  const int my_total = my_groups * per_group;
  for (int q = slot; q < my_total; q += nslots) {
    const int gi = q / per_group, e = q - gi * per_group;
    const int nt = e / GM, mt = (xcd + 8 * gi) * GM + (e - nt * GM);
    if (mt >= mtiles) continue;
    const int row0 = mt * 128, col0 = nt * 128;
    const bool vt = Epi::VT && nt >= 16 && nt < 24;
    int lerp = 0; bool sstart = false, send = false;
    if (AMODE == 1) {
      lerp = (nt < 8) ? 0 : (nt < 16) ? 2 : (nt < 24) ? 3 : (nt < 32) ? 5 : (nt == 32) ? 1 : (nt == 33) ? 4 : 3;
      if (row0 < NL) { sstart = (row0 & (SEQ - 1)) == 0; send = ((row0 + 128) & (SEQ - 1)) == 0; }
      else { sstart = ((row0 - NL) & (CTXL - 1)) == 0; send = ((row0 + 128 - NL) & (CTXL - 1)) == 0; }
    }
    f32x4 acc[4][4];
#pragma unroll
    for (int m = 0; m < 4; ++m)
#pragma unroll
      for (int n = 0; n < 4; ++n) acc[m][n] = (f32x4){0.f, 0.f, 0.f, 0.f};
    u32x4 ra[6];
    f32x4 muv[2];
    auto glds_tile = [&](const bf* G, int ld, int grow0, int kt, char* ldsbase, bool perm) {
#pragma unroll
      for (int pc = 0; pc < 4; ++pc) {
        const int row = wid * 32 + pc * 8 + (lane >> 3), cp = lane & 7, c = cp ^ ((row >> 1) & 7);
        const int srow = perm ? ((row & ~31) | (8 * ((row & 15) >> 2) + 4 * ((row >> 4) & 1) + (row & 3))) : row;
        const bf* src = G + (size_t)(grow0 + srow) * ld + kt * 64 + c * 8;
        __builtin_amdgcn_global_load_lds((const __attribute__((address_space(1))) void*)src,
                                         (__attribute__((address_space(3))) void*)(ldsbase + row * 128 + cp * 16), 16, 0, 0);
      }
    };
    auto gloadA = [&](int kt) {
      const int kc = kt * 64 + cch * 8;
#pragma unroll
      for (int i = 0; i < 6; ++i) {
        const int r = row0 + rg * 4 + i - 1;
        const bool zero = (i == 0 && rg == 0 && sstart) || (i == 5 && rg == 31 && send);
        ra[i] = zero ? (u32x4){0, 0, 0, 0} : *(const u32x4*)(A + (size_t)r * lda + kc);
      }
      muv[0] = *(const f32x4*)(mu + lerp * 1024 + kc);
      muv[1] = *(const f32x4*)(mu + lerp * 1024 + kc + 4);
    };
    auto lstoreA = [&](int buf) {
      char* a = As + buf * 16384;
#pragma unroll
      for (int i = 0; i < 4; ++i) {
        const u32x4 hm = ra[i], h0 = ra[i + 1], hp = ra[i + 2];
        u32x4 o;
        o.x = lerp2(hm.x, h0.x, hp.x, muv[0].x, muv[0].y);
        o.y = lerp2(hm.y, h0.y, hp.y, muv[0].z, muv[0].w);
        o.z = lerp2(hm.z, h0.z, hp.z, muv[1].x, muv[1].y);
        o.w = lerp2(hm.w, h0.w, hp.w, muv[1].z, muv[1].w);
        *(u32x4*)(a + lds_off(rg * 4 + i, cch)) = o;
      }
    };
    lds_barrier();
    glds_tile(Bt, ldb, col0, 0, Bs, !vt);
    if (AMODE == 0) glds_tile(A, lda, row0, 0, As, vt);
    else { gloadA(0); lstoreA(0); }
    asm volatile("s_waitcnt vmcnt(0)" ::: "memory");
    lds_barrier();
    for (int kt = 0; kt < nkt; ++kt) {
      const int buf = kt & 1;
      if (!fake && kt + 1 < nkt) {
        glds_tile(Bt, ldb, col0, kt + 1, Bs + (buf ^ 1) * 16384, !vt);
        if (AMODE == 0) glds_tile(A, lda, row0, kt + 1, As + (buf ^ 1) * 16384, vt);
        else gloadA(kt + 1);
      }
      const char* a = As + buf * 16384;
      const char* b = Bs + buf * 16384;
#pragma unroll
      for (int ks = 0; ks < 2; ++ks) {
        bf16x8 af[4], bfr[4];
#pragma unroll
        for (int m = 0; m < 4; ++m) af[m] = *(const bf16x8*)(a + lds_off(wr * 64 + m * 16 + fr, ks * 4 + fq));
#pragma unroll
        for (int n = 0; n < 4; ++n) bfr[n] = *(const bf16x8*)(b + lds_off(wc * 64 + n * 16 + fr, ks * 4 + fq));
        __builtin_amdgcn_s_setprio(1);
        if (Epi::VT && vt) {
#pragma unroll
          for (int m = 0; m < 4; ++m)
#pragma unroll
            for (int n = 0; n < 4; ++n) acc[m][n] = __builtin_amdgcn_mfma_f32_16x16x32_bf16(af[m], bfr[n], acc[m][n], 0, 0, 0);
        } else {
#pragma unroll
          for (int m = 0; m < 4; ++m)
#pragma unroll
            for (int n = 0; n < 4; ++n) acc[m][n] = __builtin_amdgcn_mfma_f32_16x16x32_bf16(bfr[n], af[m], acc[m][n], 0, 0, 0);
        }
        __builtin_amdgcn_s_setprio(0);
      }
      if (AMODE == 1 && kt + 1 < nkt) lstoreA(buf ^ 1);
      asm volatile("s_waitcnt vmcnt(0)" ::: "memory");
      lds_barrier();
    }
    if (Epi::VT && vt) {
#pragma unroll
      for (int n = 0; n < 4; ++n)
#pragma unroll
        for (int pp = 0; pp < 2; ++pp)
          epi.store_vt(row0 + wr * 64 + pp * 32 + fq * 8, col0 + wc * 64 + n * 16 + fr, acc[2 * pp][n], acc[2 * pp + 1][n]);
      continue;
    }
#pragma unroll
    for (int m = 0; m < 4; ++m)
#pragma unroll
      for (int q2 = 0; q2 < 2; ++q2) {
        const int tok = row0 + wr * 64 + m * 16 + fr, col = col0 + wc * 64 + q2 * 32 + fq * 8;
        f32x4 lo = acc[m][2 * q2], hi = acc[m][2 * q2 + 1];
        bf* d0 = epi.xform(nt, tok, col, lo);
        bf* d1 = epi.xform(nt, tok, col + 4, hi);
        (void)d1;
        if (d0) *(u32x4*)d0 = (u32x4){pk2(lo[0], lo[1]), pk2(lo[2], lo[3]), pk2(hi[0], hi[1]), pk2(hi[2], hi[3])};
      }
  }
}

typedef float f32x2 __attribute__((ext_vector_type(2)));
__device__ __forceinline__ float oct_sum(float v) {
  int t = __builtin_amdgcn_update_dpp(0, __float_as_int(v), 0xB1, 0xF, 0xF, true);
  v += __int_as_float(t);
  t = __builtin_amdgcn_update_dpp(0, __float_as_int(v), 0x4E, 0xF, 0xF, true);
  v += __int_as_float(t);
  t = __builtin_amdgcn_update_dpp(0, __float_as_int(v), 0x141, 0xF, 0xF, true);
  v += __int_as_float(t);
  return v;
}
__device__ __forceinline__ f32x2 fma2(f32x2 a, f32x2 b, f32x2 c) { return __builtin_elementwise_fma(a, b, c); }
__device__ __forceinline__ float fma_s(float a, float b, float c) { float d; asm("v_fma_f32 %0, %1, %2, %3" : "=v"(d) : "v"(a), "v"(b), "v"(c)); return d; }
__device__ __forceinline__ float mul_s(float a, float b) { float d; asm("v_mul_f32 %0, %1, %2" : "=v"(d) : "v"(a), "v"(b)); return d; }
struct ScanOps { f32x4 w[2], nk[2], bb[2], kd[2], rr[2]; f32x2 vv; };
__device__ __forceinline__ ScanOps scan_load(const float* ops, const float* vs, int t, int kq, int vrow) {
  ScanOps r;
  const float* o = ops + t * 320 + kq * 8;
  r.w[0] = *(const f32x4*)(o); r.w[1] = *(const f32x4*)(o + 4);
  r.nk[0] = *(const f32x4*)(o + 64); r.nk[1] = *(const f32x4*)(o + 68);
  r.bb[0] = *(const f32x4*)(o + 128); r.bb[1] = *(const f32x4*)(o + 132);
  r.kd[0] = *(const f32x4*)(o + 192); r.kd[1] = *(const f32x4*)(o + 196);
  r.rr[0] = *(const f32x4*)(o + 256); r.rr[1] = *(const f32x4*)(o + 260);
  r.vv = *(const f32x2*)(vs + t * 64 + vrow);
  return r;
}
#define PR(v, i) ((f32x2){(v)[(i) >> 1][((i) & 1) * 2], (v)[(i) >> 1][((i) & 1) * 2 + 1]})

constexpr int SC_P = 0, SC_YA = 8192, SC_V = 16384, SC_AT = 24576, SC_RT = SC_AT + 4352, SC_BT = SC_RT + 4352, SC_KT = SC_BT + 4352;
constexpr int SC_BTT = 41984, SC_KTT = SC_BTT + 4608, SC_MABT = 51200, SC_SM = 53248;
__device__ __forceinline__ bf16x8 mk8(u32x2 lo, u32x2 hi) { u32x4 u = (u32x4){lo.x, lo.y, hi.x, hi.y}; return __builtin_bit_cast(bf16x8, u); }
__device__ __forceinline__ bf16x8 mk4(u32x2 lo) { u32x4 u = (u32x4){lo.x, lo.y, 0u, 0u}; return __builtin_bit_cast(bf16x8, u); }
__device__ __forceinline__ float bfround(float x) { return bflo(pk2(x, 0.f) & 0xffffu); }
__device__ __forceinline__ void split4(f32x4 x, u32x2& hi, u32x2& lo) {
  hi = (u32x2){pk2(x[0], x[1]), pk2(x[2], x[3])};
  const float r0 = x[0] - bflo(hi.x), r1 = x[1] - bfhi(hi.x), r2 = x[2] - bflo(hi.y), r3 = x[3] - bfhi(hi.y);
  lo = (u32x2){pk2(r0, r1), pk2(r2, r3)};
}

__device__ void scan_phase(const Params& p, int j, char* smem) {
  const int tid = otid(), lane = tid & 63, wid = tid >> 6, fr = lane & 15, fq = lane >> 4;
  float* Pbuf = (float*)(smem + SC_P);
  float* abuf = (float*)(smem + SC_YA);
  float* ys = (float*)(smem + SC_YA);
  float* vs = (float*)(smem + SC_V);
  for (int item = blockIdx.x; item < 256; item += gridDim.x) {
  const int b = item >> 5, h = (item >> 1) & 15, d = item & 1;
  lds_barrier();
  const bf* Vsrc = (j == 0) ? p.VF : p.V2;
  bf* Ydst = (d == 0) ? p.H : p.Y1;
  const int ldy = (d == 0) ? LDH : 1024;
  float* betad = p.beta + (size_t)d * MT * 16;
  bf16x8 bw[2], ba[2];
  {
    const int n = h * 64 + wid * 16 + fr;
#pragma unroll
    for (int ks = 0; ks < 2; ++ks) {
      bw[ks] = *(const bf16x8*)(p.w2t + (size_t)d * 65536 + (size_t)n * 64 + ks * 32 + fq * 8);
      ba[ks] = *(const bf16x8*)(p.a2t + (size_t)d * 65536 + (size_t)n * 64 + ks * 32 + fq * 8);
    }
  }
  float w0v[4], a0v[4];
#pragma unroll
  for (int e = 0; e < 4; ++e) {
    w0v[e] = p.rw_w0[(size_t)(j * 2 + d) * 1024 + h * 64 + wid * 16 + fq * 4 + e];
    a0v[e] = p.rw_a0[(size_t)(j * 2 + d) * 1024 + h * 64 + wid * 16 + fq * 4 + e];
  }
  const int tt = tid >> 3, c8 = tid & 7;
  float kkv[8], kav[8], rkv[8];
#pragma unroll
  for (int e = 0; e < 8; ++e) {
    kkv[e] = p.rw_k_k[j * 1024 + h * 64 + c8 * 8 + e];
    kav[e] = p.rw_k_a[j * 1024 + h * 64 + c8 * 8 + e];
    rkv[e] = p.rw_r_k[j * 1024 + h * 64 + c8 * 8 + e];
  }
  f32x4 ST[4];
#pragma unroll
  for (int kt = 0; kt < 4; ++kt) ST[kt] = (f32x4){0.f, 0.f, 0.f, 0.f};

  bf16x8 phw[2][2], pha[2][2];
  u32x4 puk, pur, puv;
  auto rowbase_of = [&](int ch, int& sgn) -> int {
    if (d == 0) { sgn = 1; return (ch < 8) ? NL + b * CTXL + ch * 32 : b * SEQ + (ch - 8) * 32; }
    sgn = -1; return (ch < 8) ? NL + b * CTXL + 255 - ch * 32 : b * SEQ + 8191 - (ch - 8) * 32;
  };
  auto prefetch = [&](int ch) {
    int sgn; const int rowbase = rowbase_of(ch, sgn);
#pragma unroll
    for (int m = 0; m < 2; ++m) {
      const size_t row = (size_t)(rowbase + sgn * (m * 16 + fr));
#pragma unroll
      for (int ks = 0; ks < 2; ++ks) {
        phw[m][ks] = *(const bf16x8*)(p.HID + row * HIDW + d * 64 + ks * 32 + fq * 8);
        pha[m][ks] = *(const bf16x8*)(p.HID + row * HIDW + 128 + d * 64 + ks * 32 + fq * 8);
      }
    }
    const size_t off = (size_t)(rowbase + sgn * tt) * 1024 + h * 64 + c8 * 8;
    puk = *(const u32x4*)(p.K + off);
    pur = *(const u32x4*)(p.R + off);
    puv = *(const u32x4*)(Vsrc + off);
  };
  prefetch(0);

  for (int ch = 0; ch < 264; ++ch) {
    int sgn; const int rowbase = rowbase_of(ch, sgn);
#pragma unroll
    for (int m = 0; m < 2; ++m) {
      const int tok = m * 16 + fr;
      f32x4 aw = (f32x4){0.f, 0.f, 0.f, 0.f}, aa = aw;
#pragma unroll
      for (int ks = 0; ks < 2; ++ks) {
        aw = __builtin_amdgcn_mfma_f32_16x16x32_bf16(bw[ks], phw[m][ks], aw, 0, 0, 0);
        aa = __builtin_amdgcn_mfma_f32_16x16x32_bf16(ba[ks], pha[m][ks], aa, 0, 0, 0);
      }
      f32x4 wd, av;
#pragma unroll
      for (int e = 0; e < 4; ++e) {
        const float ez = __expf(-(w0v[e] + aw[e]));
        wd[e] = __expf(-0.60653066f * __builtin_amdgcn_rcpf(1.f + ez));
        av[e] = __builtin_amdgcn_rcpf(1.f + __expf(-(a0v[e] + aa[e])));
      }
#pragma unroll
      for (int e = 0; e < 4; ++e) {
        float x = wd[e];
        x *= __int_as_float(__builtin_amdgcn_update_dpp(0x3f800000, __float_as_int(x), 0x111, 0xF, 0xF, false));
        x *= __int_as_float(__builtin_amdgcn_update_dpp(0x3f800000, __float_as_int(x), 0x112, 0xF, 0xF, false));
        x *= __int_as_float(__builtin_amdgcn_update_dpp(0x3f800000, __float_as_int(x), 0x114, 0xF, 0xF, false));
        x *= __int_as_float(__builtin_amdgcn_update_dpp(0x3f800000, __float_as_int(x), 0x118, 0xF, 0xF, false));
        wd[e] = x;
      }
      *(f32x4*)(Pbuf + tok * 64 + wid * 16 + fq * 4) = wd;
      *(f32x4*)(abuf + tok * 64 + wid * 16 + fq * 4) = av;
    }
    lds_barrier();
    {
      const size_t row = (size_t)(rowbase + sgn * tt);
      float k[8], r[8], kk[8];
#pragma unroll
      for (int e = 0; e < 4; ++e) {
        k[2 * e] = bflo(puk[e]); k[2 * e + 1] = bfhi(puk[e]);
        r[2 * e] = bflo(pur[e]); r[2 * e + 1] = bfhi(pur[e]);
      }
      float ss = 0.f;
#pragma unroll
      for (int e = 0; e < 8; ++e) { kk[e] = k[e] * kkv[e]; ss += kk[e] * kk[e]; }
      ss = oct_sum(ss);
      const float inv = __builtin_amdgcn_rsqf(fmaxf(ss, 1e-24f));
      const f32x4 a0 = *(const f32x4*)(abuf + tt * 64 + c8 * 8), a1 = *(const f32x4*)(abuf + tt * 64 + c8 * 8 + 4);
      const f32x4 p0 = *(const f32x4*)(Pbuf + tt * 64 + c8 * 8), p1 = *(const f32x4*)(Pbuf + tt * 64 + c8 * 8 + 4);
      f32x4 q0 = (f32x4){1.f, 1.f, 1.f, 1.f}, q1 = q0;
      if (tt & 15) { q0 = *(const f32x4*)(Pbuf + (tt - 1) * 64 + c8 * 8); q1 = *(const f32x4*)(Pbuf + (tt - 1) * 64 + c8 * 8 + 4); }
      const float a[8] = {a0.x, a0.y, a0.z, a0.w, a1.x, a1.y, a1.z, a1.w};
      const float Pt[8] = {p0.x, p0.y, p0.z, p0.w, p1.x, p1.y, p1.z, p1.w};
      const float Pm[8] = {q0.x, q0.y, q0.z, q0.w, q1.x, q1.y, q1.z, q1.w};
      float at[8], bt_[8], kt_[8], rt[8];
      float bsum = 0.f;
#pragma unroll
      for (int e = 0; e < 8; ++e) {
        const float kkn = kk[e] * inv;
        const float kd = k[e] * (1.f + (a[e] - 1.f) * kav[e]);
        bsum += r[e] * kd * rkv[e];
        const float ip = __builtin_amdgcn_rcpf(Pt[e]);
        at[e] = -kkn * Pm[e];
        bt_[e] = kkn * a[e] * ip;
        kt_[e] = kd * ip;
        rt[e] = r[e] * Pt[e];
      }
      bsum = oct_sum(bsum);
      if (c8 == 0) betad[row * 16 + h] = bsum;
      char* ro = smem + tt * 136 + c8 * 16;
      *(u32x2*)(ro + SC_AT) = (u32x2){pk2(at[0], at[1]), pk2(at[2], at[3])};   *(u32x2*)(ro + SC_AT + 8) = (u32x2){pk2(at[4], at[5]), pk2(at[6], at[7])};
      *(u32x2*)(ro + SC_RT) = (u32x2){pk2(rt[0], rt[1]), pk2(rt[2], rt[3])};   *(u32x2*)(ro + SC_RT + 8) = (u32x2){pk2(rt[4], rt[5]), pk2(rt[6], rt[7])};
      *(u32x2*)(ro + SC_BT) = (u32x2){pk2(bt_[0], bt_[1]), pk2(bt_[2], bt_[3])}; *(u32x2*)(ro + SC_BT + 8) = (u32x2){pk2(bt_[4], bt_[5]), pk2(bt_[6], bt_[7])};
      *(u32x2*)(ro + SC_KT) = (u32x2){pk2(kt_[0], kt_[1]), pk2(kt_[2], kt_[3])}; *(u32x2*)(ro + SC_KT + 8) = (u32x2){pk2(kt_[4], kt_[5]), pk2(kt_[6], kt_[7])};
#pragma unroll
      for (int e = 0; e < 8; ++e) {
        *(bf*)(smem + SC_BTT + (c8 * 8 + e) * 72 + tt * 2) = (bf)(pk2(bt_[e], 0.f) & 0xffffu);
        *(bf*)(smem + SC_KTT + (c8 * 8 + e) * 72 + tt * 2) = (bf)(pk2(kt_[e], 0.f) & 0xffffu);
      }
      *(f32x4*)(vs + tt * 64 + c8 * 8) = (f32x4){bflo(puv[0]), bfhi(puv[0]), bflo(puv[1]), bfhi(puv[1])};
      *(f32x4*)(vs + tt * 64 + c8 * 8 + 4) = (f32x4){bflo(puv[2]), bfhi(puv[2]), bflo(puv[3]), bfhi(puv[3])};
    }
    lds_barrier();
    if (ch + 1 < 264) prefetch(ch + 1);
    {
      auto gram = [&](int xbase, int ybase, int sc) -> f32x4 {
        f32x4 acc = (f32x4){0.f, 0.f, 0.f, 0.f};
#pragma unroll
        for (int ks = 0; ks < 2; ++ks) {
          const char* xp = smem + xbase + (sc * 16 + fr) * 136 + ks * 64 + fq * 16;
          const char* yp = smem + ybase + (sc * 16 + fr) * 136 + ks * 64 + fq * 16;
          const bf16x8 xf = mk8(*(const u32x2*)xp, *(const u32x2*)(xp + 8));
          const bf16x8 yf = mk8(*(const u32x2*)yp, *(const u32x2*)(yp + 8));
          acc = __builtin_amdgcn_mfma_f32_16x16x32_bf16(xf, yf, acc, 0, 0, 0);
        }
        return acc;
      };
      auto store_small = [&](f32x4 g, int sc, int kind, bool strict) {
#pragma unroll
        for (int e = 0; e < 4; ++e) { const int sidx = fq * 4 + e; const bool keep = strict ? (sidx < fr) : (sidx <= fr); g[e] = keep ? g[e] : 0.f; }
        *(u32x2*)(smem + SC_SM + (sc * 5 + kind) * 640 + fr * 40 + fq * 8) = (u32x2){pk2(g[0], g[1]), pk2(g[2], g[3])};
      };
      if (wid < 2) {
        const int sc = wid;
        f32x4 g = gram(SC_BT, SC_AT, sc);
#pragma unroll
        for (int e = 0; e < 4; ++e) g[e] = (fq * 4 + e < fr) ? g[e] : 0.f;
        *(f32x4*)(smem + SC_MABT + sc * 1024 + fr * 64 + fq * 16) = g;
        asm volatile("s_waitcnt lgkmcnt(0)" ::: "memory");
        if (lane < 16) {
          float n[16];
#pragma unroll
          for (int t = 0; t < 16; ++t) {
            const float* mc = (const float*)(smem + SC_MABT + sc * 1024 + t * 64);
            float acc = (t == lane) ? 1.f : 0.f;
#pragma unroll
            for (int sp = 0; sp < t; ++sp) acc = fmaf(n[sp], mc[sp], acc);
            n[t] = acc;
          }
#pragma unroll
          for (int t = 0; t < 16; ++t) {
            const unsigned hi = pk2(n[t], 0.f) & 0xffffu;
            const unsigned lo = pk2(n[t] - bflo(hi), 0.f) & 0xffffu;
            *(bf*)(smem + SC_SM + (sc * 5 + 0) * 640 + t * 40 + lane * 2) = (bf)hi;
            *(bf*)(smem + SC_SM + (sc * 5 + 1) * 640 + t * 40 + lane * 2) = (bf)lo;
          }
        }
      } else {
        const int sc = wid - 2;
        store_small(gram(SC_KT, SC_AT, sc), sc, 2, true);
        store_small(gram(SC_BT, SC_RT, sc), sc, 3, false);
        store_small(gram(SC_KT, SC_RT, sc), sc, 4, false);
      }
    }
    lds_barrier();
#pragma unroll
    for (int sc = 0; sc < 2; ++sc) {
      bf16x8 shi[2], slo[2];
#pragma unroll
      for (int g = 0; g < 2; ++g) {
        u32x2 h0, l0, h1, l1;
        split4(ST[2 * g], h0, l0); split4(ST[2 * g + 1], h1, l1);
        shi[g] = mk8(h0, h1); slo[g] = mk8(l0, l1);
      }
      const char* arow = smem + SC_AT + (sc * 16 + fr) * 136 + fq * 8;
      const char* rrow = smem + SC_RT + (sc * 16 + fr) * 136 + fq * 8;
      f32x4 wt = (f32x4){0.f, 0.f, 0.f, 0.f}, yt = wt;
#pragma unroll
      for (int g = 0; g < 2; ++g) {
        const bf16x8 xa = mk8(*(const u32x2*)(arow + g * 64), *(const u32x2*)(arow + g * 64 + 32));
        const bf16x8 xr = mk8(*(const u32x2*)(rrow + g * 64), *(const u32x2*)(rrow + g * 64 + 32));
        wt = __builtin_amdgcn_mfma_f32_16x16x32_bf16(xa, shi[g], wt, 0, 0, 0);
        wt = __builtin_amdgcn_mfma_f32_16x16x32_bf16(xa, slo[g], wt, 0, 0, 0);
        yt = __builtin_amdgcn_mfma_f32_16x16x32_bf16(xr, shi[g], yt, 0, 0, 0);
        yt = __builtin_amdgcn_mfma_f32_16x16x32_bf16(xr, slo[g], yt, 0, 0, 0);
      }
      const int vcol = wid * 16 + fr;
      const float* vp = vs + (sc * 16 + fq * 4) * 64 + vcol;
      const bf16x8 vmf = mk4((u32x2){pk2(vp[0], vp[64]), pk2(vp[128], vp[192])});
      const char* smb = smem + SC_SM + sc * 5 * 640 + fr * 40 + fq * 8;
      const bf16x8 xnh = mk4(*(const u32x2*)(smb)), xnl = mk4(*(const u32x2*)(smb + 640));
      const bf16x8 xmak = mk4(*(const u32x2*)(smb + 2 * 640)), xmrb = mk4(*(const u32x2*)(smb + 3 * 640)), xmrk = mk4(*(const u32x2*)(smb + 4 * 640));
      wt = __builtin_amdgcn_mfma_f32_16x16x32_bf16(xmak, vmf, wt, 0, 0, 0);
      u32x2 whi, wlo;
      split4(wt, whi, wlo);
      f32x4 ut = (f32x4){0.f, 0.f, 0.f, 0.f};
      ut = __builtin_amdgcn_mfma_f32_16x16x32_bf16(xnh, mk4(whi), ut, 0, 0, 0);
      ut = __builtin_amdgcn_mfma_f32_16x16x32_bf16(xnh, mk4(wlo), ut, 0, 0, 0);
      ut = __builtin_amdgcn_mfma_f32_16x16x32_bf16(xnl, mk4(whi), ut, 0, 0, 0);
      u32x2 uhi, ulo;
      split4(ut, uhi, ulo);
      const bf16x8 uhf = mk4(uhi), ulf = mk4(ulo);
      yt = __builtin_amdgcn_mfma_f32_16x16x32_bf16(xmrb, uhf, yt, 0, 0, 0);
      yt = __builtin_amdgcn_mfma_f32_16x16x32_bf16(xmrb, ulf, yt, 0, 0, 0);
      yt = __builtin_amdgcn_mfma_f32_16x16x32_bf16(xmrk, vmf, yt, 0, 0, 0);
#pragma unroll
      for (int e = 0; e < 4; ++e) ys[(sc * 16 + fq * 4 + e) * 64 + vcol] = yt[e];
#pragma unroll
      for (int kt = 0; kt < 4; ++kt) {
        const bf16x8 xb = mk4(*(const u32x2*)(smem + SC_BTT + (kt * 16 + fr) * 72 + (sc * 16 + fq * 4) * 2));
        const bf16x8 xk = mk4(*(const u32x2*)(smem + SC_KTT + (kt * 16 + fr) * 72 + (sc * 16 + fq * 4) * 2));
        ST[kt] = __builtin_amdgcn_mfma_f32_16x16x32_bf16(xb, uhf, ST[kt], 0, 0, 0);
        ST[kt] = __builtin_amdgcn_mfma_f32_16x16x32_bf16(xb, ulf, ST[kt], 0, 0, 0);
        ST[kt] = __builtin_amdgcn_mfma_f32_16x16x32_bf16(xk, vmf, ST[kt], 0, 0, 0);
        const f32x4 pc = *(const f32x4*)(Pbuf + (sc * 16 + 15) * 64 + kt * 16 + fq * 4);
        ST[kt] = ST[kt] * pc;
      }
    }
    lds_barrier();
    {
      const size_t row = (size_t)(rowbase + sgn * tt);
      const f32x4 y0 = *(const f32x4*)(ys + tt * 64 + c8 * 8), y1 = *(const f32x4*)(ys + tt * 64 + c8 * 8 + 4);
      *(u32x4*)(Ydst + row * ldy + h * 64 + c8 * 8) = (u32x4){pk2(y0.x, y0.y), pk2(y0.z, y0.w), pk2(y1.x, y1.y), pk2(y1.z, y1.w)};
    }
    lds_barrier();
  }
  }
}

__device__ void og_phase(const Params& p, int j) {
  const int tid = otid(), lane = tid & 63;
  const int gw = blockIdx.x * 4 + (tid >> 6), nw = gridDim.x * 4;
  const bf* Vsrc = (j == 0) ? p.VF : p.V2;
  const int col = lane * 16, hh = lane >> 2;
  float lw[16], lb[16];
#pragma unroll
  for (int e = 0; e < 16; ++e) { lw[e] = p.rw_lnx_w[j * 1024 + col + e]; lb[e] = p.rw_lnx_b[j * 1024 + col + e]; }
  for (int row = gw; row < MT; row += nw) {
    const size_t off = (size_t)row * 1024 + col, offh = (size_t)row * LDH + col;
    u32x4 u0[2], u1[2], uv[2], ug[2];
#pragma unroll
    for (int q = 0; q < 2; ++q) {
      u0[q] = *(const u32x4*)(p.H + offh + q * 8);
      u1[q] = *(const u32x4*)(p.Y1 + off + q * 8);
      uv[q] = *(const u32x4*)(Vsrc + off + q * 8);
      ug[q] = *(const u32x4*)(p.G + off + q * 8);
    }
    const float bsum = p.beta[(size_t)row * 16 + hh] + p.beta[(size_t)MT * 16 + (size_t)row * 16 + hh];
    float y[16], v[16], g[16];
    float s = 0.f;
#pragma unroll
    for (int e = 0; e < 8; ++e) {
      y[2 * e] = bflo(u0[e >> 2][e & 3]) + bflo(u1[e >> 2][e & 3]); y[2 * e + 1] = bfhi(u0[e >> 2][e & 3]) + bfhi(u1[e >> 2][e & 3]);
      v[2 * e] = bflo(uv[e >> 2][e & 3]); v[2 * e + 1] = bfhi(uv[e >> 2][e & 3]);
      g[2 * e] = bflo(ug[e >> 2][e & 3]); g[2 * e + 1] = bfhi(ug[e >> 2][e & 3]);
      s += y[2 * e] + y[2 * e + 1];
    }
    s = quad_sum(s);
    const float mean = s * (1.f / 64.f);
    float q2 = 0.f;
#pragma unroll
    for (int e = 0; e < 16; ++e) { const float dd = y[e] - mean; q2 += dd * dd; }
    q2 = quad_sum(q2);
    const float rstd = rsqrtf(q2 * (1.f / 64.f) + 64e-5f);
    unsigned o[8];
#pragma unroll
    for (int e = 0; e < 8; ++e) {
      const float r0 = ((y[2 * e] - mean) * rstd * lw[2 * e] + lb[2 * e] + bsum * v[2 * e]) * g[2 * e];
      const float r1 = ((y[2 * e + 1] - mean) * rstd * lw[2 * e + 1] + lb[2 * e + 1] + bsum * v[2 * e + 1]) * g[2 * e + 1];
      o[e] = pk2(r0, r1);
    }
    *(u32x4*)(p.H + offh) = (u32x4){o[0], o[1], o[2], o[3]};
    *(u32x4*)(p.H + offh + 8) = (u32x4){o[4], o[5], o[6], o[7]};
  }
}

__device__ void attn_phase(const Params& p, int j, bool ctx_out, char* smem) {
  const int tid = otid(), lane = tid & 63, cgp = tid >> 6, fr = lane & 15, fq = lane >> 4;
  char* Ks = smem;
  bf* Vs = (bf*)smem;
  float* rpbs = (float*)(smem + 36864);
  const bf* Q = p.R; const bf* Kb = p.K; const bf* Vt = p.V2; const bf* Gb = p.G;
  const int nitems = 16384 + (ctx_out ? 512 : 0);
  for (int item = blockIdx.x; item < nitems; item += gridDim.x) {
    int b, h, r = 0, qrow0; bool haswin;
    if (item < 16384) { h = item & 15; r = (item >> 4) & 127; b = item >> 11; haswin = true; qrow0 = b * SEQ + r * 64; }
    else { const int it = item - 16384; h = it & 15; const int qb = (it >> 4) & 3; b = it >> 6; haswin = false; qrow0 = NL + b * CTXL + qb * 64; }
    const int qtok = qrow0 + cgp * 16 + fr;
    bf16x8 qf[2];
#pragma unroll
    for (int ks = 0; ks < 2; ++ks) qf[ks] = *(const bf16x8*)(Q + (size_t)qtok * 1024 + h * 64 + ks * 32 + fq * 8);
    const int rs = min(max(r - 4, 0), 120);
    const int qcol = cgp * 16 + fr;
    const int wsq = min(max(qcol - 8, 0), 48);
    const int bs = min(max(16 * cgp - 8, 0), 32);
    lds_barrier();
    if (haswin) for (int idx = tid; idx < 465; idx += 256) rpbs[idx] = p.na_rpb[((size_t)j * 16 + h) * 465 + idx];
    f32x4 sw[8][2], sc[4][4];
    bf16x8 pw[8];
    float m1 = NEGV, l1 = 0.f;
#pragma unroll
    for (int i = 0; i < 8; ++i) pw[i] = (bf16x8){0, 0, 0, 0, 0, 0, 0, 0};
#pragma unroll
    for (int i = 0; i < 8; ++i)
#pragma unroll
      for (int k2 = 0; k2 < 2; ++k2) sw[i][k2] = (f32x4){NEGV, NEGV, NEGV, NEGV};
#pragma unroll
    for (int st = 0; st < 3; ++st) {
      if (st < 2 && !haswin) continue;
      lds_barrier();
      int tq = tid; asm volatile("" : "+v"(tq));
#pragma unroll
      for (int hf = 0; hf < 2; ++hf) {
        u32x4 u[4];
#pragma unroll
        for (int i = 0; i < 4; ++i) {
          const int q = tq + (hf * 4 + i) * 256, key = q >> 3, c = q & 7, tl = key >> 6;
          const int base = (st < 2) ? b * SEQ + (rs + st * 4 + tl) * 64 : NL + b * CTXL + tl * 64;
          u[i] = *(const u32x4*)(Kb + (size_t)(base + (key & 63)) * 1024 + h * 64 + c * 8);
        }
#pragma unroll
        for (int i = 0; i < 4; ++i) {
          const int q = tq + (hf * 4 + i) * 256, key = q >> 3, c = q & 7;
          *(u32x4*)(Ks + lds_off(key, c)) = u[i];
        }
        __builtin_amdgcn_sched_barrier(0);
      }
      lds_barrier();
      if (st < 2) {
#pragma unroll
        for (int tl = 0; tl < 4; ++tl) {
          const int i = st * 4 + tl;
          const int dr = rs + i - r + 7;
#pragma unroll
          for (int k2 = 0; k2 < 2; ++k2) {
            f32x4 acc = (f32x4){0.f, 0.f, 0.f, 0.f};
#pragma unroll
            for (int ks = 0; ks < 2; ++ks) {
              const bf16x8 kf = *(const bf16x8*)(Ks + lds_off(tl * 64 + bs + k2 * 16 + fr, ks * 4 + fq));
              acc = __builtin_amdgcn_mfma_f32_16x16x32_bf16(kf, qf[ks], acc, 0, 0, 0);
            }
#pragma unroll
            for (int e = 0; e < 4; ++e) {
              const int kc = bs + k2 * 16 + fq * 4 + e;
              const bool valid = (kc >= wsq) && (kc < wsq + 16);
              const int dc = min(max(kc - qcol, -15), 15) + 15;
              sw[i][k2][e] = valid ? acc[e] + rpbs[dr * 31 + dc] : NEGV;
            }
          }
          __builtin_amdgcn_sched_barrier(0);
        }
      } else {
#pragma unroll
        for (int tl = 0; tl < 4; ++tl)
#pragma unroll
          for (int k4 = 0; k4 < 4; ++k4) {
            f32x4 acc = (f32x4){0.f, 0.f, 0.f, 0.f};
#pragma unroll
            for (int ks = 0; ks < 2; ++ks) {
              const bf16x8 kf = *(const bf16x8*)(Ks + lds_off(tl * 64 + k4 * 16 + fr, ks * 4 + fq));
              acc = __builtin_amdgcn_mfma_f32_16x16x32_bf16(kf, qf[ks], acc, 0, 0, 0);
            }
            sc[tl][k4] = acc;
            if (k4 & 1) __builtin_amdgcn_sched_barrier(0);
          }
      }
      if (st == 1) {
#pragma unroll
        for (int i = 0; i < 8; ++i)
#pragma unroll
          for (int k2 = 0; k2 < 2; ++k2)
#pragma unroll
            for (int e = 0; e < 4; ++e) m1 = fmaxf(m1, sw[i][k2][e]);
        m1 = fmaxf(m1, __shfl_xor(m1, 16));
        m1 = fmaxf(m1, __shfl_xor(m1, 32));
#pragma unroll
        for (int i = 0; i < 8; ++i) {
          float e0[4], e1[4];
#pragma unroll
          for (int e = 0; e < 4; ++e) { e0[e] = __expf(sw[i][0][e] - m1); e1[e] = __expf(sw[i][1][e] - m1); l1 += e0[e] + e1[e]; }
          u32x4 u = (u32x4){pk2(e0[0], e0[1]), pk2(e0[2], e0[3]), pk2(e1[0], e1[1]), pk2(e1[2], e1[3])};
          pw[i] = __builtin_bit_cast(bf16x8, u);
        }
        l1 += __shfl_xor(l1, 16);
        l1 += __shfl_xor(l1, 32);
      }
    }
    float m2 = NEGV;
#pragma unroll
    for (int tl = 0; tl < 4; ++tl)
#pragma unroll
      for (int k4 = 0; k4 < 4; ++k4)
#pragma unroll
        for (int e = 0; e < 4; ++e) m2 = fmaxf(m2, sc[tl][k4][e]);
    m2 = fmaxf(m2, __shfl_xor(m2, 16));
    m2 = fmaxf(m2, __shfl_xor(m2, 32));
    const float mx = fmaxf(m1, m2);
    const float alpha1 = __expf(m1 - mx);
    float l2 = 0.f;
    bf16x8 pc[4][2];
#pragma unroll
    for (int tl = 0; tl < 4; ++tl)
#pragma unroll
      for (int g2 = 0; g2 < 2; ++g2) {
        float e0[4], e1[4];
#pragma unroll
        for (int e = 0; e < 4; ++e) { e0[e] = __expf(sc[tl][2 * g2][e] - mx); e1[e] = __expf(sc[tl][2 * g2 + 1][e] - mx); l2 += e0[e] + e1[e]; }
        u32x4 u = (u32x4){pk2(e0[0], e0[1]), pk2(e0[2], e0[3]), pk2(e1[0], e1[1]), pk2(e1[2], e1[3])};
        pc[tl][g2] = __builtin_bit_cast(bf16x8, u);
      }
    l2 += __shfl_xor(l2, 16);
    l2 += __shfl_xor(l2, 32);
    const float l = alpha1 * l1 + l2;
    f32x4 o[4];
#pragma unroll
    for (int dt = 0; dt < 4; ++dt) o[dt] = (f32x4){0.f, 0.f, 0.f, 0.f};
#pragma unroll
    for (int st = 0; st < 3; ++st) {
      if (st < 2 && !haswin) continue;
      lds_barrier();
      int tq = tid; asm volatile("" : "+v"(tq));
#pragma unroll
      for (int hf = 0; hf < 2; ++hf) {
        u32x4 u[4];
#pragma unroll
        for (int i = 0; i < 4; ++i) {
          const int q = tq + (hf * 4 + i) * 256, tl = q >> 9, dd = (q >> 3) & 63, c = q & 7;
          const int base = (st < 2) ? b * SEQ + (rs + st * 4 + tl) * 64 : NL + b * CTXL + tl * 64;
          u[i] = *(const u32x4*)(Vt + (size_t)(h * 64 + dd) * MT + base + c * 8);
        }
#pragma unroll
        for (int i = 0; i < 4; ++i) {
          const int q = tq + (hf * 4 + i) * 256, tl = q >> 9, dd = (q >> 3) & 63, c = q & 7;
          *(u32x4*)(Vs + tl * 4608 + dd * 72 + c * 8) = u[i];
        }
        __builtin_amdgcn_sched_barrier(0);
      }
      lds_barrier();
      if (st < 2) {
#pragma unroll
        for (int tl = 0; tl < 4; ++tl) {
          const int i = st * 4 + tl;
#pragma unroll
          for (int dt = 0; dt < 4; ++dt) {
            const bf* vp = Vs + tl * 4608 + (dt * 16 + fr) * 72 + bs + fq * 4;
            const u32x2 lo = *(const u32x2*)vp, hi = *(const u32x2*)(vp + 16);
            u32x4 u = (u32x4){lo.x, lo.y, hi.x, hi.y};
            o[dt] = __builtin_amdgcn_mfma_f32_16x16x32_bf16(__builtin_bit_cast(bf16x8, u), pw[i], o[dt], 0, 0, 0);
          }
          __builtin_amdgcn_sched_barrier(0);
        }
      } else {
#pragma unroll
        for (int tl = 0; tl < 4; ++tl)
#pragma unroll
          for (int g2 = 0; g2 < 2; ++g2)
#pragma unroll
            for (int dt = 0; dt < 4; ++dt) {
              const bf* vp = Vs + tl * 4608 + (dt * 16 + fr) * 72 + g2 * 32 + fq * 4;
              const u32x2 lo = *(const u32x2*)vp, hi = *(const u32x2*)(vp + 16);
              u32x4 u = (u32x4){lo.x, lo.y, hi.x, hi.y};
              o[dt] = __builtin_amdgcn_mfma_f32_16x16x32_bf16(__builtin_bit_cast(bf16x8, u), pc[tl][g2], o[dt], 0, 0, 0);
              if (dt == 3) __builtin_amdgcn_sched_barrier(0);
            }
      }
      if (st == 1) {
#pragma unroll
        for (int dt = 0; dt < 4; ++dt) o[dt] *= alpha1;
      }
    }
    const float inv = 1.f / l;
#pragma unroll
    for (int dt = 0; dt < 4; ++dt) {
      const size_t off = (size_t)qtok * 1024 + h * 64 + dt * 16 + fq * 4;
      const u32x2 ug = *(const u32x2*)(Gb + off);
      const float g0 = bflo(ug.x), g1 = bfhi(ug.x), g2 = bflo(ug.y), g3 = bfhi(ug.y);
      *(u32x2*)(p.H + (size_t)qtok * LDH + h * 64 + dt * 16 + fq * 4) = (u32x2){pk2(o[dt][0] * inv * siluf(g0), o[dt][1] * inv * siluf(g1)),
                                        pk2(o[dt][2] * inv * siluf(g2), o[dt][3] * inv * siluf(g3))};
    }
  }
}


#define XB_TMO      128
#define XB_XCNT(j)  (256  + 64 * (j))
#define XB_XSUB(j)  (1280 + 64 * (j))
#define XB_XGEN(j)  (2304 + 64 * (j))
#define XB_TOP      3328
#define XB_TOPGEN   3392
#define XCD_BAR_WORDS 3456
#define XB_SPIN_CAP (1u << 18)
__device__ __forceinline__ unsigned xb_ld(unsigned* q) { return __hip_atomic_load(q, __ATOMIC_RELAXED, __HIP_MEMORY_SCOPE_AGENT); }
__device__ __forceinline__ unsigned xb_add(unsigned* q, unsigned v) { return __hip_atomic_fetch_add(q, v, __ATOMIC_RELAXED, __HIP_MEMORY_SCOPE_AGENT); }
__device__ __forceinline__ unsigned xb_xcc_id() { return (unsigned)__builtin_amdgcn_s_getreg((3 << 11) | 20) & 0xFu; }
#define XB_SPIN(cond, bar) do { unsigned _sp = 0; while (cond) { __builtin_amdgcn_s_sleep(1); \
    if ((++_sp & 255u) == 0u) { if (xb_ld(&(bar)[XB_TMO])) break; if (_sp > XB_SPIN_CAP) { atomicAdd(&(bar)[XB_TMO], 1u); break; } } } } while (0)
struct XcdBarrier { unsigned* bar; unsigned x, nloc, nx; };
__device__ __forceinline__ void xcd_barrier(const XcdBarrier& b) {
  asm volatile("s_waitcnt vmcnt(0)" ::: "memory");
  __syncthreads();
  if (threadIdx.x == 0) {
    unsigned* bar = b.bar;
    __builtin_amdgcn_s_waitcnt(0);
    const unsigned nloc = b.nloc, nx = b.nx;
    const unsigned old = xb_add(&bar[XB_XSUB(b.x)], 1u);
    const unsigned gen = old / nloc;
    if (old + 1u == (gen + 1u) * nloc) {
      __builtin_amdgcn_fence(__ATOMIC_RELEASE, "agent");
      asm volatile("s_waitcnt vmcnt(0)" ::: "memory");
      const unsigned og = xb_add(&bar[XB_TOP], 1u);
      const unsigned tg = og / nx;
      if (og + 1u == (tg + 1u) * nx) xb_add(&bar[XB_TOPGEN], 1u);
      else XB_SPIN(xb_ld(&bar[XB_TOPGEN]) == tg, bar);
      __builtin_amdgcn_fence(__ATOMIC_ACQUIRE, "agent");
      xb_add(&bar[XB_XGEN(b.x)], 1u);
      asm volatile("s_waitcnt vmcnt(0)" ::: "memory");
    } else {
      XB_SPIN(xb_ld(&bar[XB_XGEN(b.x)]) == gen, bar);
      __builtin_amdgcn_fence(__ATOMIC_ACQUIRE, "agent");
      asm volatile("s_waitcnt vmcnt(0)" ::: "memory");
    }
  }
  __syncthreads();
}

#ifndef DUP_SCAN
#define DUP_SCAN 0
#endif
#ifndef DUP_ATTN
#define DUP_ATTN 0
#endif
#ifndef DUP_GEMM
#define DUP_GEMM 0
#endif
#ifndef MULTI_LAUNCH
#define MULTI_LAUNCH 0
#endif
__device__ __forceinline__ bool step_exists(int i, int s) {
  if (s == 2) return i == 2;
  if (s == 4) return (i & 1) == 0;
  return true;
}
__device__ __forceinline__ void run_step(const Params& p, int i, int s, char* smem) {
  asm volatile("" : "+s"(i));
  const int j = i >> 1;
  if (s == 0) { transpose_phase(p, i, smem); row_phase(p, i); }
  else if (s == 1) {
    if ((i & 1) == 0) {
      EpiRwkvProj ep{p.R, p.K, (j == 0) ? p.VF : p.V2, p.G, p.HID};
#pragma unroll 1
      for (int rep = PROBE_GEMM ? 0 : 1; rep < 2; ++rep)
      gemm_phase<1>(p.H, LDH, p.Wp, LDW, 16, MT / 128, (j == 0) ? 34 : 35, p.rw_mu + (size_t)j * 6 * 1024, ep, smem, rep == 0);
    } else {
      EpiNaProj ep{p.R, p.K, p.V2, p.G, p.na_b_in + (size_t)j * 4096};
#pragma unroll 1
      for (int rep = PROBE_GEMM ? 0 : 1; rep < 2; ++rep)
      gemm_phase<0>(p.H, LDH, p.Wp, LDW, 16, MT / 128, 32, nullptr, ep, smem, rep == 0);
    }
  } else if (s == 2) {
    EpiVres ev{p.V2, p.VF, p.rw_v0};
    gemm_phase<0>(p.HID + 256, HIDW, p.v2t, 64, 1, MT / 128, 8, nullptr, ev, smem);
  } else if (s == 3) {
    if ((i & 1) == 0) scan_phase(p, j, smem);
    else attn_phase(p, j, i != 3, smem);
  } else if (s == 4) {
    og_phase(p, j);
  } else {
    EpiOut eo{p.R};
#pragma unroll 1
    for (int rep = PROBE_GEMM ? 0 : 1; rep < 2; ++rep)
    gemm_phase<0>(p.H, LDH, p.Wo, LDW, 16, (i == 3) ? NL / 128 : MT / 128, 8, nullptr, eo, smem, rep == 0);
  }
}

__global__ void __launch_bounds__(256, 2) fwd_megakernel(Params p0) {
  __shared__ __attribute__((aligned(16))) char smem[SMEM_BYTES];
  cg::grid_group grid = cg::this_grid();
  XcdBarrier xb;
  xb.bar = p0.bar; xb.x = xb_xcc_id(); xb.nloc = 0u; xb.nx = 0u;
  if (threadIdx.x == 0) (void)xb_add(&xb.bar[XB_XCNT(xb.x)], 1u);
  pre_phase(p0, smem);
  grid.sync();
  {
    unsigned cnt = 0u, mine = 0u;
#pragma unroll 1
    for (unsigned jj = 0; jj < 16; ++jj) { const unsigned c = xb_ld(&xb.bar[XB_XCNT(jj)]); cnt += (c > 0u) ? 1u : 0u; mine = (jj == xb.x) ? c : mine; }
    xb.nloc = mine > 0u ? mine : 1u; xb.nx = cnt > 0u ? cnt : 1u;
  }
  const Params& p = p0;
#pragma unroll 1
  for (int i = 0; i < 4; ++i) {
#pragma unroll 1
    for (int s = 0; s < 6; ++s) {
      if (!step_exists(i, s)) continue;
      int reps = 1;
      if (DUP_SCAN && s == 3 && (i & 1) == 0) reps = 2;
      if (DUP_ATTN && s == 3 && (i & 1) == 1) reps = 2;
      if (DUP_GEMM && (s == 1 || s == 5)) reps = 2;
#pragma unroll 1
      for (int rep = 0; rep < reps; ++rep) {
        run_step(p, i, s, smem);
        xcd_barrier(xb);
      }
    }
  }
  row_phase(p, 4);
}

#if MULTI_LAUNCH
template <int S> __global__ void __launch_bounds__(256, 2) step_kernel(Params p0, int i) {
  __shared__ __attribute__((aligned(16))) char smem[SMEM_BYTES];
  if (S == -1) { pre_phase(p0, smem); return; }
  if (S == 6) { row_phase(p0, 4); return; }
  run_step(p0, i, S, smem);
}
#endif

extern "C" void kernel_launch(void* const* d_in, const int* in_sizes, int n_in, void* d_out, int out_size, void* d_ws, size_t ws_size,
                              hipStream_t stream) {
  static int grid_blocks = 0;
  if (!grid_blocks) {
    int dev = 0, cus = 0, per_cu = 0;
    hipGetDevice(&dev);
    hipDeviceGetAttribute(&cus, hipDeviceAttributeMultiprocessorCount, dev);
    hipOccupancyMaxActiveBlocksPerMultiprocessor(&per_cu, fwd_megakernel, 256, 0);
    if (per_cu > 2) per_cu = 2;
    if (per_cu < 1) per_cu = 1;
    grid_blocks = cus * per_cu;
  }
  Params p{};
  const float** f = (const float**)&p;
  for (int i = 0; i < 29; ++i) f[i] = (const float*)d_in[i];
  p.out = (float*)d_out;
  char* w = (char*)d_ws;
  size_t off = 0;
  auto take = [&](size_t bytes) { char* r = w + off; off += (bytes + 255) & ~(size_t)255; return r; };
  p.gp = (Params*)take(sizeof(Params));
  p.bar = (unsigned*)take((size_t)XCD_BAR_WORDS * 4);
  p.mod = (float*)take((size_t)4 * 9 * 3072 * 4);
  p.ctxbuf = (float*)take((size_t)NC * 1024 * 4);
  p.beta = (float*)take((size_t)2 * MT * 16 * 4);
  p.Wp = (bf*)take((size_t)4480 * LDW * 2);
  p.Wo = (bf*)take((size_t)1024 * LDW * 2);
  p.w2t = (bf*)take((size_t)2 * 65536 * 2);
  p.a2t = (bf*)take((size_t)2 * 65536 * 2);
  p.v2t = (bf*)take((size_t)65536 * 2);
  const size_t big = (size_t)MT * 1024 * 2;
  p.H = (bf*)take((size_t)MT * LDH * 2); p.R = (bf*)take(big); p.K = (bf*)take(big); p.VF = (bf*)take(big);
  p.V2 = (bf*)take(big); p.G = (bf*)take(big); p.Y1 = (bf*)take(big);
  p.HID = (bf*)take((size_t)MT * HIDW * 2);
  if (off > ws_size) fprintf(stderr, "workspace too small: need %zu have %zu\n", off, ws_size);
#if MULTI_LAUNCH
  step_kernel<-1><<<grid_blocks, 256, 0, stream>>>(p, 0);
  for (int i = 0; i < 4; ++i) {
    step_kernel<0><<<grid_blocks, 256, 0, stream>>>(p, i);
    step_kernel<1><<<grid_blocks, 256, 0, stream>>>(p, i);
    if (i == 2) step_kernel<2><<<grid_blocks, 256, 0, stream>>>(p, i);
    step_kernel<3><<<grid_blocks, 256, 0, stream>>>(p, i);
    if ((i & 1) == 0) step_kernel<4><<<grid_blocks, 256, 0, stream>>>(p, i);
    step_kernel<5><<<grid_blocks, 256, 0, stream>>>(p, i);
  }
  step_kernel<6><<<grid_blocks, 256, 0, stream>>>(p, 0);
#else
  (void)hipMemsetAsync(p.bar, 0, (size_t)XCD_BAR_WORDS * 4, stream);
  void* args[] = {&p};
  hipError_t e = hipLaunchCooperativeKernel((void*)fwd_megakernel, dim3(grid_blocks), dim3(256), args, 0, stream);
  if (e != hipSuccess) fprintf(stderr, "cooperative launch failed: %s (grid %d)\n", hipGetErrorString(e), grid_blocks);
#endif
}
```

```cpp
#include <hip/hip_runtime.h>
#include <hip/hip_cooperative_groups.h>
#include <cstdint>
#include <cstdio>
namespace cg = cooperative_groups;

typedef unsigned short bf;
typedef short bf16x8 __attribute__((ext_vector_type(8)));
typedef float f32x4 __attribute__((ext_vector_type(4)));
typedef unsigned u32x4 __attribute__((ext_vector_type(4)));
typedef unsigned u32x2 __attribute__((ext_vector_type(2)));

constexpr int DM = 1024, NB = 8, SEQ = 8192, NL = NB * SEQ, CTXL = 256, NC = NB * CTXL, MT = NL + NC;
constexpr int HIDW = 384;
constexpr int LDH = 1088, LDW = 1088;
constexpr int SMEM_BYTES = 65536;
#define NEGV (-1e30f)
#ifndef PROBE_GEMM
#define PROBE_GEMM 0
#endif

struct Params {
  const float *x, *c, *ctx, *c_ctx, *ada_w, *ada_b, *pre_g, *post_g, *rw_mu, *rw_w_rkvg, *rw_w0, *rw_w1, *rw_w2,
      *rw_a0, *rw_a1, *rw_a2, *rw_v0, *rw_v1, *rw_v2, *rw_k_k, *rw_k_a, *rw_r_k, *rw_lnx_w, *rw_lnx_b, *rw_w_out,
      *na_w_in, *na_b_in, *na_rpb, *na_w_out;
  float* out;
  float *mod, *ctxbuf, *beta;
  bf *Wp, *Wo, *w2t, *a2t, *v2t;
  bf *H, *R, *K, *VF, *V2, *G, *Y1, *HID;
  Params* gp;
  unsigned* bar;
};

__device__ __forceinline__ float bflo(unsigned w) { return __uint_as_float(w << 16); }
__device__ __forceinline__ float bfhi(unsigned w) { return __uint_as_float(w & 0xffff0000u); }
typedef __bf16 bf16x2_t __attribute__((ext_vector_type(2)));
__device__ __forceinline__ unsigned pk2(float lo, float hi) {
  bf16x2_t v = {(__bf16)lo, (__bf16)hi};
  return __builtin_bit_cast(unsigned, v);
}
__device__ __forceinline__ float siluf(float v) { return v * __builtin_amdgcn_rcpf(1.f + __expf(-v)); }
__device__ __forceinline__ float sigmf(float v) { return __builtin_amdgcn_rcpf(1.f + __expf(-v)); }
__device__ __forceinline__ float tanh_fast(float v) { return 1.f - 2.f * __builtin_amdgcn_rcpf(1.f + __expf(2.f * v)); }
__device__ __forceinline__ float quad_sum(float v) {
  int t = __builtin_amdgcn_update_dpp(0, __float_as_int(v), 0xB1, 0xF, 0xF, true);
  v += __int_as_float(t);
  t = __builtin_amdgcn_update_dpp(0, __float_as_int(v), 0x4E, 0xF, 0xF, true);
  v += __int_as_float(t);
  return v;
}
__device__ __forceinline__ float wave_sum(float v) {
#pragma unroll
  for (int o = 32; o >= 1; o >>= 1) v += __shfl_xor(v, o);
  return v;
}
__device__ __forceinline__ int otid() { int t = threadIdx.x; asm volatile("" : "+v"(t)); return t; }
__device__ __forceinline__ void lds_barrier() { asm volatile("s_waitcnt lgkmcnt(0)\n\ts_barrier" ::: "memory"); }
__device__ __forceinline__ int lds_off(int row, int c) { return row * 128 + ((c ^ ((row >> 1) & 7)) << 4); }
__device__ __forceinline__ unsigned lerp2(unsigned hm, unsigned h0, unsigned hp, float m0, float m1) {
  const float c0 = bflo(h0), c1 = bfhi(h0);
  const float x0 = 0.5f * (bflo(hm) + bflo(hp)) - c0;
  const float x1 = 0.5f * (bfhi(hm) + bfhi(hp)) - c1;
  return pk2(c0 + x0 * m0, c1 + x1 * m1);
}
__device__ __forceinline__ int mod_idx(int row) { return row < NL ? (row >> 13) : 8; }

__device__ void pre_phase(const Params& p, char* smem) {
  float* s = (float*)smem;
  float* red = s + 9 * 1024;
  const int tid = otid();
  for (int item = blockIdx.x; item < 4 * 48; item += gridDim.x) {
    const int i = item / 48, cb = item % 48;
    __syncthreads();
    for (int idx = tid; idx < 9 * 1024; idx += 256) {
      const int m = idx >> 10, k = idx & 1023;
      const float v = (m < 8) ? p.c[m * 1024 + k] : p.c_ctx[k];
      s[idx] = siluf(v);
    }
    __syncthreads();
    const int cc = tid & 63, kq = tid >> 6;
    float acc[9];
#pragma unroll
    for (int m = 0; m < 9; ++m) acc[m] = 0.f;
    const float* W = p.ada_w + (size_t)i * 1024 * 3072 + cb * 64 + cc;
    for (int k = kq * 256; k < kq * 256 + 256; ++k) {
      const float w = W[(size_t)k * 3072];
#pragma unroll
      for (int m = 0; m < 9; ++m) acc[m] += s[m * 1024 + k] * w;
    }
#pragma unroll
    for (int m = 0; m < 9; ++m) red[(kq * 9 + m) * 64 + cc] = acc[m];
    __syncthreads();
    for (int idx = tid; idx < 9 * 64; idx += 256) {
      const int m = idx >> 6, c2 = idx & 63;
      float v = red[(0 * 9 + m) * 64 + c2] + red[(1 * 9 + m) * 64 + c2] + red[(2 * 9 + m) * 64 + c2] + red[(3 * 9 + m) * 64 + c2];
      v += p.ada_b[i * 3072 + cb * 64 + c2];
      p.mod[(size_t)(i * 9 + m) * 3072 + cb * 64 + c2] = v;
    }
  }
}

struct TOp { const float* src; bf* dst; int K, N, Kp, Np, ldd; };
__device__ bool get_op(const Params& p, int i, int op, TOp& o) {
  const int j = i >> 1;
  if (i & 1) {
    if (op == 0) { o = {p.na_w_in + (size_t)j * 1024 * 4096, p.Wp, 1024, 4096, 1024, 4096, LDW}; return true; }
    if (op == 1) { o = {p.na_w_out + (size_t)j * 1024 * 1024, p.Wo, 1024, 1024, 1024, 1024, LDW}; return true; }
    return false;
  }
  if (op < 4) { o = {p.rw_w_rkvg + ((size_t)j * 4 + op) * 1024 * 1024, p.Wp + (size_t)op * 1024 * LDW, 1024, 1024, 1024, 1024, LDW}; return true; }
  if (op < 6) { const int d = op - 4; o = {p.rw_w1 + ((size_t)j * 2 + d) * 1024 * 64, p.Wp + (size_t)(4096 + d * 64) * LDW, 1024, 64, 1024, 64, LDW}; return true; }
  if (op < 8) { const int d = op - 6; o = {p.rw_a1 + ((size_t)j * 2 + d) * 1024 * 64, p.Wp + (size_t)(4224 + d * 64) * LDW, 1024, 64, 1024, 64, LDW}; return true; }
  if (op < 10) { const int d = op - 8; o = {p.rw_w2 + ((size_t)j * 2 + d) * 64 * 1024, p.w2t + (size_t)d * 65536, 64, 1024, 64, 1024, 64}; return true; }
  if (op < 12) { const int d = op - 10; o = {p.rw_a2 + ((size_t)j * 2 + d) * 64 * 1024, p.a2t + (size_t)d * 65536, 64, 1024, 64, 1024, 64}; return true; }
  if (op == 12) { o = {p.rw_w_out + (size_t)j * 1024 * 1024, p.Wo, 1024, 1024, 1024, 1024, LDW}; return true; }
  if (j == 1 && op == 13) { o = {p.rw_v1, p.Wp + (size_t)4352 * LDW, 1024, 32, 1024, 128, LDW}; return true; }
  if (j == 1 && op == 14) { o = {p.rw_v2, p.v2t, 32, 1024, 64, 1024, 64}; return true; }
  return false;
}

__device__ void transpose_phase(const Params& p, int i, char* smem) {
  float* t = (float*)smem;
  const int tid = otid();
  int base = 0;
  for (int op = 0;; ++op) {
    TOp o;
    if (!get_op(p, i, op, o)) break;
    const int tk = o.Kp / 64, tn = o.Np / 64, nt = tk * tn;
    int first = blockIdx.x - (base % (int)gridDim.x);
    if (first < 0) first += gridDim.x;
    for (int g = first; g < nt; g += gridDim.x) {
      const int kt = g / tn, ntile = g % tn;
      __syncthreads();
#pragma unroll
      for (int ps = 0; ps < 4; ++ps) {
        const int kr = ps * 16 + (tid >> 4), c4 = (tid & 15) * 4;
        const int k = kt * 64 + kr, n = ntile * 64 + c4;
        f32x4 v = (f32x4){0.f, 0.f, 0.f, 0.f};
        if (k < o.K && n < o.N) v = *(const f32x4*)(o.src + (size_t)k * o.N + n);
        t[kr * 65 + c4 + 0] = v.x; t[kr * 65 + c4 + 1] = v.y; t[kr * 65 + c4 + 2] = v.z; t[kr * 65 + c4 + 3] = v.w;
      }
      __syncthreads();
      const int n = tid >> 2, kc = (tid & 3) * 16;
      unsigned w[8];
#pragma unroll
      for (int e = 0; e < 8; ++e) w[e] = pk2(t[(kc + 2 * e) * 65 + n], t[(kc + 2 * e + 1) * 65 + n]);
      bf* d = o.dst + (size_t)(ntile * 64 + n) * o.ldd + kt * 64 + kc;
      *(u32x4*)d = (u32x4){w[0], w[1], w[2], w[3]};
      *(u32x4*)(d + 8) = (u32x4){w[4], w[5], w[6], w[7]};
    }
    base += nt;
  }
}

template <bool UPD, bool MKH>
__device__ __forceinline__ void row_phase_t(const Params& p, int i) {
  const int tid = otid(), lane = tid & 63;
  const int gw = blockIdx.x * 4 + (tid >> 6), nw = gridDim.x * 4;
  const int nrows = MKH ? MT : NL;
  for (int row0 = gw; row0 < nrows; row0 += 2 * nw) {
    const bool valid1 = (row0 + nw) < nrows;
    const int rws[2] = {row0, valid1 ? row0 + nw : row0};
    f32x4 xv[2][4];
    u32x2 ou[2][4];
#pragma unroll
    for (int u = 0; u < 2; ++u) {
      const int row = rws[u];
      const float* xs;
      if (i <= 1) xs = (row < NL) ? p.x + (size_t)row * 1024 : p.ctx + (size_t)(row - NL) * 1024;
      else xs = (row < NL) ? p.out + (size_t)row * 1024 : p.ctxbuf + (size_t)(row - NL) * 1024;
#pragma unroll
      for (int q = 0; q < 4; ++q) xv[u][q] = __builtin_nontemporal_load((const f32x4*)(xs + q * 256 + lane * 4));
      if (UPD) {
        const bf* orow = p.R + (size_t)row * 1024;
#pragma unroll
        for (int q = 0; q < 4; ++q) ou[u][q] = __builtin_nontemporal_load((const u32x2*)(orow + q * 256 + lane * 4));
      }
    }
#pragma unroll
    for (int u = 0; u < 2; ++u) {
      const int row = rws[u];
      const bool st = (u == 0) || valid1;
      const int m = mod_idx(row);
      if (UPD) {
        float ov[4][4];
        float ss = 0.f;
#pragma unroll
        for (int q = 0; q < 4; ++q) {
          ov[q][0] = bflo(ou[u][q].x); ov[q][1] = bfhi(ou[u][q].x); ov[q][2] = bflo(ou[u][q].y); ov[q][3] = bfhi(ou[u][q].y);
          ss += ov[q][0] * ov[q][0] + ov[q][1] * ov[q][1] + ov[q][2] * ov[q][2] + ov[q][3] * ov[q][3];
        }
        ss = wave_sum(ss);
        const float rs = rsqrtf(ss * (1.f / 1024.f) + 1e-6f);
        const float* gate = p.mod + (size_t)((i - 1) * 9 + m) * 3072 + 2048;
        const float* pg = p.post_g + (i - 1) * 1024;
        float* xd = (row < NL) ? p.out + (size_t)row * 1024 : p.ctxbuf + (size_t)(row - NL) * 1024;
#pragma unroll
        for (int q = 0; q < 4; ++q) {
          const int col = q * 256 + lane * 4;
          const f32x4 gv = *(const f32x4*)(gate + col);
          const f32x4 pv = *(const f32x4*)(pg + col);
          xv[u][q].x += gv.x * ov[q][0] * rs * pv.x;
          xv[u][q].y += gv.y * ov[q][1] * rs * pv.y;
          xv[u][q].z += gv.z * ov[q][2] * rs * pv.z;
          xv[u][q].w += gv.w * ov[q][3] * rs * pv.w;
          if (st) __builtin_nontemporal_store(xv[u][q], (f32x4*)(xd + col));
        }
      }
      if (MKH) {
        float ss = 0.f;
#pragma unroll
        for (int q = 0; q < 4; ++q) ss += xv[u][q].x * xv[u][q].x + xv[u][q].y * xv[u][q].y + xv[u][q].z * xv[u][q].z + xv[u][q].w * xv[u][q].w;
        ss = wave_sum(ss);
        const float rs = rsqrtf(ss * (1.f / 1024.f) + 1e-6f);
        const float* md = p.mod + (size_t)(i * 9 + m) * 3072;
        const float* pg = p.pre_g + i * 1024;
        bf* hd = p.H + (size_t)row * LDH;
#pragma unroll
        for (int q = 0; q < 4; ++q) {
          const int col = q * 256 + lane * 4;
          const f32x4 sh = *(const f32x4*)(md + col);
          const f32x4 sc = *(const f32x4*)(md + 1024 + col);
          const f32x4 pv = *(const f32x4*)(pg + col);
          const float h0 = xv[u][q].x * rs * pv.x * (1.f + sc.x) + sh.x;
          const float h1 = xv[u][q].y * rs * pv.y * (1.f + sc.y) + sh.y;
          const float h2 = xv[u][q].z * rs * pv.z * (1.f + sc.z) + sh.z;
          const float h3 = xv[u][q].w * rs * pv.w * (1.f + sc.w) + sh.w;
          if (st) *(u32x2*)(hd + col) = (u32x2){pk2(h0, h1), pk2(h2, h3)};
        }
      }
    }
  }
}
__device__ __forceinline__ void row_phase(const Params& p, int i) {
  if (i == 0) row_phase_t<false, true>(p, i);
  else if (i < 4) row_phase_t<true, true>(p, i);
  else row_phase_t<true, false>(p, i);
}

struct EpiRwkvProj {
  static constexpr bool VT = false;
  __device__ __forceinline__ void store_vt(int, int, f32x4, f32x4) const {}
  bf *R, *K, *V, *G, *HID;
  __device__ __forceinline__ bf* xform(int nt, int tok, int col, f32x4& v) const {
    bf* dst;
    if (nt < 8) dst = R + (size_t)tok * 1024 + col;
    else if (nt < 16) dst = K + (size_t)tok * 1024 + (col - 1024);
    else if (nt < 24) dst = V + (size_t)tok * 1024 + (col - 2048);
    else if (nt < 32) {
      dst = G + (size_t)tok * 1024 + (col - 3072);
#pragma unroll
      for (int e = 0; e < 4; ++e) v[e] = siluf(v[e]);
    } else {
      dst = HID + (size_t)tok * HIDW + (col - 4096);
      if (nt == 32) {
#pragma unroll
        for (int e = 0; e < 4; ++e) v[e] = tanh_fast(v[e]);
      }
    }
    return dst;
  }
};
struct EpiNaProj {
  static constexpr bool VT = true;
  bf *Q, *K, *Vt, *G; const float* bias;
  __device__ __forceinline__ void store_vt(int tok, int col, f32x4 lo, f32x4 hi) const {
    const float b = bias[col];
    *(u32x4*)(Vt + (size_t)(col - 2048) * MT + tok) = (u32x4){pk2(lo[0] + b, lo[1] + b), pk2(lo[2] + b, lo[3] + b), pk2(hi[0] + b, hi[1] + b), pk2(hi[2] + b, hi[3] + b)};
  }
  __device__ __forceinline__ bf* xform(int nt, int tok, int col, f32x4& v) const {
    const f32x4 b = *(const f32x4*)(bias + col);
    v[0] += b.x; v[1] += b.y; v[2] += b.z; v[3] += b.w;
    if (nt >= 16 && nt < 24) {
      const int c = col - 2048;
#pragma unroll
      for (int e = 0; e < 4; ++e) Vt[(size_t)(c + e) * MT + tok] = (bf)(pk2(v[e], 0.f) & 0xffffu);
      return nullptr;
    }
    bf* dst;
    if (nt < 8) { dst = Q + (size_t)tok * 1024 + col; v[0] *= 0.125f; v[1] *= 0.125f; v[2] *= 0.125f; v[3] *= 0.125f; }
    else if (nt < 16) dst = K + (size_t)tok * 1024 + (col - 1024);
    else dst = G + (size_t)tok * 1024 + (col - 3072);
    return dst;
  }
};
struct EpiOut {
  static constexpr bool VT = false;
  __device__ __forceinline__ void store_vt(int, int, f32x4, f32x4) const {}
  bf* O;
  __device__ __forceinline__ bf* xform(int nt, int tok, int col, f32x4& v) const { return O + (size_t)tok * 1024 + col; }
};
struct EpiVres {
  static constexpr bool VT = false;
  __device__ __forceinline__ void store_vt(int, int, f32x4, f32x4) const {}
  bf* V2; const bf* VF; const float* v0;
  __device__ __forceinline__ bf* xform(int nt, int tok, int col, f32x4& z) const {
    const f32x4 b = *(const f32x4*)(v0 + col);
    const u32x2 uv = *(const u32x2*)(V2 + (size_t)tok * 1024 + col);
    const u32x2 uf = *(const u32x2*)(VF + (size_t)tok * 1024 + col);
    const float v[4] = {bflo(uv.x), bfhi(uv.x), bflo(uv.y), bfhi(uv.y)};
    const float f[4] = {bflo(uf.x), bfhi(uf.x), bflo(uf.y), bfhi(uf.y)};
    const float zz[4] = {z[0] + b.x, z[1] + b.y, z[2] + b.z, z[3] + b.w};
#pragma unroll
    for (int e = 0; e < 4; ++e) z[e] = v[e] + (f[e] - v[e]) * sigmf(zz[e]);
    return V2 + (size_t)tok * 1024 + col;
  }
};

template <int AMODE, class Epi>
__device__ void gemm_phase(const bf* __restrict__ A, int lda, const bf* __restrict__ Bt, int ldb, int nkt, int mtiles, int ntiles,
                           const float* __restrict__ mu, const Epi& epi, char* smem, bool fake = false) {
  const int tid = otid(), lane = tid & 63, wid = tid >> 6, wr = wid >> 1, wc = wid & 1, fr = lane & 15, fq = lane >> 4;
  const int rg = tid >> 3, cch = tid & 7;
  char* As = smem;
  char* Bs = smem + 32768;
  constexpr int GM = 6;
  const int xcd = blockIdx.x & 7, slot = blockIdx.x >> 3, nslots = gridDim.x >> 3;
  const int per_group = GM * ntiles;
  const int ngroups = (mtiles + GM - 1) / GM;
  const int my_groups = (ngroups - xcd + 7) >> 3;
  const int my_total = my_groups * per_group;
  for (int q = slot; q < my_total; q += nslots) {
    const int gi = q / per_group, e = q - gi * per_group;
    const int nt = e / GM, mt = (xcd + 8 * gi) * GM + (e - nt * GM);
    if (mt >= mtiles) continue;
    const int row0 = mt * 128, col0 = nt * 128;
    const bool vt = Epi::VT && nt >= 16 && nt < 24;
    int lerp = 0; bool sstart = false, send = false;
    if (AMODE == 1) {
      lerp = (nt < 8) ? 0 : (nt < 16) ? 2 : (nt < 24) ? 3 : (nt < 32) ? 5 : (nt == 32) ? 1 : (nt == 33) ? 4 : 3;
      if (row0 < NL) { sstart = (row0 & (SEQ - 1)) == 0; send = ((row0 + 128) & (SEQ - 1)) == 0; }
      else { sstart = ((row0 - NL) & (CTXL - 1)) == 0; send = ((row0 + 128 - NL) & (CTXL - 1)) == 0; }
    }
    f32x4 acc[4][4];
#pragma unroll
    for (int m = 0; m < 4; ++m)
#pragma unroll
      for (int n = 0; n < 4; ++n) acc[m][n] = (f32x4){0.f, 0.f, 0.f, 0.f};
    u32x4 ra[6];
    f32x4 muv[2];
    auto glds_tile = [&](const bf* G, int ld, int grow0, int kt, char* ldsbase, bool perm) {
#pragma unroll
      for (int pc = 0; pc < 4; ++pc) {
        const int row = wid * 32 + pc * 8 + (lane >> 3), cp = lane & 7, c = cp ^ ((row >> 1) & 7);
        const int srow = perm ? ((row & ~31) | (8 * ((row & 15) >> 2) + 4 * ((row >> 4) & 1) + (row & 3))) : row;
        const bf* src = G + (size_t)(grow0 + srow) * ld + kt * 64 + c * 8;
        __builtin_amdgcn_global_load_lds((const __attribute__((address_space(1))) void*)src,
                                         (__attribute__((address_space(3))) void*)(ldsbase + row * 128 + cp * 16), 16, 0, 0);
      }
    };
    auto gloadA = [&](int kt) {
      const int kc = kt * 64 + cch * 8;
#pragma unroll
      for (int i = 0; i < 6; ++i) {
        const int r = row0 + rg * 4 + i - 1;
        const bool zero = (i == 0 && rg == 0 && sstart) || (i == 5 && rg == 31 && send);
        ra[i] = zero ? (u32x4){0, 0, 0, 0} : *(const u32x4*)(A + (size_t)r * lda + kc);
      }
      muv[0] = *(const f32x4*)(mu + lerp * 1024 + kc);
      muv[1] = *(const f32x4*)(mu + lerp * 1024 + kc + 4);
    };
    auto lstoreA = [&](int buf) {
      char* a = As + buf * 16384;
#pragma unroll
      for (int i = 0; i < 4; ++i) {
        const u32x4 hm = ra[i], h0 = ra[i + 1], hp = ra[i + 2];
        u32x4 o;
        o.x = lerp2(hm.x, h0.x, hp.x, muv[0].x, muv[0].y);
        o.y = lerp2(hm.y, h0.y, hp.y, muv[0].z, muv[0].w);
        o.z = lerp2(hm.z, h0.z, hp.z, muv[1].x, muv[1].y);
        o.w = lerp2(hm.w, h0.w, hp.w, muv[1].z, muv[1].w);
        *(u32x4*)(a + lds_off(rg * 4 + i, cch)) = o;
      }
    };
    lds_barrier();
    glds_tile(Bt, ldb, col0, 0, Bs, !vt);
    if (AMODE == 0) glds_tile(A, lda, row0, 0, As, vt);
    else { gloadA(0); lstoreA(0); }
    asm volatile("s_waitcnt vmcnt(0)" ::: "memory");
    lds_barrier();
    for (int kt = 0; kt < nkt; ++kt) {
      const int buf = kt & 1;
      if (!fake && kt + 1 < nkt) {
        glds_tile(Bt, ldb, col0, kt + 1, Bs + (buf ^ 1) * 16384, !vt);
        if (AMODE == 0) glds_tile(A, lda, row0, kt + 1, As + (buf ^ 1) * 16384, vt);
        else gloadA(kt + 1);
      }
      const char* a = As + buf * 16384;
      const char* b = Bs + buf * 16384;
#pragma unroll
      for (int ks = 0; ks < 2; ++ks) {
        bf16x8 af[4], bfr[4];
#pragma unroll
        for (int m = 0; m < 4; ++m) af[m] = *(const bf16x8*)(a + lds_off(wr * 64 + m * 16 + fr, ks * 4 + fq));
#pragma unroll
        for (int n = 0; n < 4; ++n) bfr[n] = *(const bf16x8*)(b + lds_off(wc * 64 + n * 16 + fr, ks * 4 + fq));
        __builtin_amdgcn_s_setprio(1);
        if (Epi::VT && vt) {
#pragma unroll
          for (int m = 0; m < 4; ++m)
#pragma unroll
            for (int n = 0; n < 4; ++n) acc[m][n] = __builtin_amdgcn_mfma_f32_16x16x32_bf16(af[m], bfr[n], acc[m][n], 0, 0, 0);
        } else {
#pragma unroll
          for (int m = 0; m < 4; ++m)
#pragma unroll
            for (int n = 0; n < 4; ++n) acc[m][n] = __builtin_amdgcn_mfma_f32_16x16x32_bf16(bfr[n], af[m], acc[m][n], 0, 0, 0);
        }
        __builtin_amdgcn_s_setprio(0);
      }
      if (AMODE == 1 && kt + 1 < nkt) lstoreA(buf ^ 1);
      asm volatile("s_waitcnt vmcnt(0)" ::: "memory");
      lds_barrier();
    }
    if (Epi::VT && vt) {
#pragma unroll
      for (int n = 0; n < 4; ++n)
#pragma unroll
        for (int pp = 0; pp < 2; ++pp)
          epi.store_vt(row0 + wr * 64 + pp * 32 + fq * 8, col0 + wc * 64 + n * 16 + fr, acc[2 * pp][n], acc[2 * pp + 1][n]);
      continue;
    }
#pragma unroll
    for (int m = 0; m < 4; ++m)
#pragma unroll
      for (int q2 = 0; q2 < 2; ++q2) {
        const int tok = row0 + wr * 64 + m * 16 + fr, col = col0 + wc * 64 + q2 * 32 + fq * 8;
        f32x4 lo = acc[m][2 * q2], hi = acc[m][2 * q2 + 1];
        bf* d0 = epi.xform(nt, tok, col, lo);
        bf* d1 = epi.xform(nt, tok, col + 4, hi);
        (void)d1;
        if (d0) *(u32x4*)d0 = (u32x4){pk2(lo[0], lo[1]), pk2(lo[2], lo[3]), pk2(hi[0], hi[1]), pk2(hi[2], hi[3])};
      }
  }
}

typedef float f32x2 __attribute__((ext_vector_type(2)));
__device__ __forceinline__ float oct_sum(float v) {
  int t = __builtin_amdgcn_update_dpp(0, __float_as_int(v), 0xB1, 0xF, 0xF, true);
  v += __int_as_float(t);
  t = __builtin_amdgcn_update_dpp(0, __float_as_int(v), 0x4E, 0xF, 0xF, true);
  v += __int_as_float(t);
  t = __builtin_amdgcn_update_dpp(0, __float_as_int(v), 0x141, 0xF, 0xF, true);
  v += __int_as_float(t);
  return v;
}
__device__ __forceinline__ f32x2 fma2(f32x2 a, f32x2 b, f32x2 c) { return __builtin_elementwise_fma(a, b, c); }
__device__ __forceinline__ float fma_s(float a, float b, float c) { float d; asm("v_fma_f32 %0, %1, %2, %3" : "=v"(d) : "v"(a), "v"(b), "v"(c)); return d; }
__device__ __forceinline__ float mul_s(float a, float b) { float d; asm("v_mul_f32 %0, %1, %2" : "=v"(d) : "v"(a), "v"(b)); return d; }
struct ScanOps { f32x4 w[2], nk[2], bb[2], kd[2], rr[2]; f32x2 vv; };
__device__ __forceinline__ ScanOps scan_load(const float* ops, const float* vs, int t, int kq, int vrow) {
  ScanOps r;
  const float* o = ops + t * 320 + kq * 8;
  r.w[0] = *(const f32x4*)(o); r.w[1] = *(const f32x4*)(o + 4);
  r.nk[0] = *(const f32x4*)(o + 64); r.nk[1] = *(const f32x4*)(o + 68);
  r.bb[0] = *(const f32x4*)(o + 128); r.bb[1] = *(const f32x4*)(o + 132);
  r.kd[0] = *(const f32x4*)(o + 192); r.kd[1] = *(const f32x4*)(o + 196);
  r.rr[0] = *(const f32x4*)(o + 256); r.rr[1] = *(const f32x4*)(o + 260);
  r.vv = *(const f32x2*)(vs + t * 64 + vrow);
  return r;
}
#define PR(v, i) ((f32x2){(v)[(i) >> 1][((i) & 1) * 2], (v)[(i) >> 1][((i) & 1) * 2 + 1]})

constexpr int SC_P = 0, SC_YA = 8192, SC_V = 16384, SC_AT = 24576, SC_RT = SC_AT + 4352, SC_BT = SC_RT + 4352, SC_KT = SC_BT + 4352;
constexpr int SC_BTT = 41984, SC_KTT = SC_BTT + 4608, SC_MABT = 51200, SC_SM = 53248;
__device__ __forceinline__ bf16x8 mk8(u32x2 lo, u32x2 hi) { u32x4 u = (u32x4){lo.x, lo.y, hi.x, hi.y}; return __builtin_bit_cast(bf16x8, u); }
__device__ __forceinline__ bf16x8 mk4(u32x2 lo) { u32x4 u = (u32x4){lo.x, lo.y, 0u, 0u}; return __builtin_bit_cast(bf16x8, u); }
__device__ __forceinline__ float bfround(float x) { return bflo(pk2(x, 0.f) & 0xffffu); }
__device__ __forceinline__ void split4(f32x4 x, u32x2& hi, u32x2& lo) {
  hi = (u32x2){pk2(x[0], x[1]), pk2(x[2], x[3])};
  const float r0 = x[0] - bflo(hi.x), r1 = x[1] - bfhi(hi.x), r2 = x[2] - bflo(hi.y), r3 = x[3] - bfhi(hi.y);
  lo = (u32x2){pk2(r0, r1), pk2(r2, r3)};
}

__device__ void scan_phase(const Params& p, int j, char* smem) {
  const int tid = otid(), lane = tid & 63, wid = tid >> 6, fr = lane & 15, fq = lane >> 4;
  float* Pbuf = (float*)(smem + SC_P);
  float* abuf = (float*)(smem + SC_YA);
  float* ys = (float*)(smem + SC_YA);
  float* vs = (float*)(smem + SC_V);
  for (int item = blockIdx.x; item < 256; item += gridDim.x) {
  const int b = item >> 5, h = (item >> 1) & 15, d = item & 1;
  lds_barrier();
  const bf* Vsrc = (j == 0) ? p.VF : p.V2;
  bf* Ydst = (d == 0) ? p.H : p.Y1;
  const int ldy = (d == 0) ? LDH : 1024;
  float* betad = p.beta + (size_t)d * MT * 16;
  bf16x8 bw[2], ba[2];
  {
    const int n = h * 64 + wid * 16 + fr;
#pragma unroll
    for (int ks = 0; ks < 2; ++ks) {
      bw[ks] = *(const bf16x8*)(p.w2t + (size_t)d * 65536 + (size_t)n * 64 + ks * 32 + fq * 8);
      ba[ks] = *(const bf16x8*)(p.a2t + (size_t)d * 65536 + (size_t)n * 64 + ks * 32 + fq * 8);
    }
  }
  float w0v[4], a0v[4];
#pragma unroll
  for (int e = 0; e < 4; ++e) {
    w0v[e] = p.rw_w0[(size_t)(j * 2 + d) * 1024 + h * 64 + wid * 16 + fq * 4 + e];
    a0v[e] = p.rw_a0[(size_t)(j * 2 + d) * 1024 + h * 64 + wid * 16 + fq * 4 + e];
  }
  const int tt = tid >> 3, c8 = tid & 7;
  float kkv[8], kav[8], rkv[8];
#pragma unroll
  for (int e = 0; e < 8; ++e) {
    kkv[e] = p.rw_k_k[j * 1024 + h * 64 + c8 * 8 + e];
    kav[e] = p.rw_k_a[j * 1024 + h * 64 + c8 * 8 + e];
    rkv[e] = p.rw_r_k[j * 1024 + h * 64 + c8 * 8 + e];
  }
  f32x4 ST[4];
#pragma unroll
  for (int kt = 0; kt < 4; ++kt) ST[kt] = (f32x4){0.f, 0.f, 0.f, 0.f};

  bf16x8 phw[2][2], pha[2][2];
  u32x4 puk, pur, puv;
  auto rowbase_of = [&](int ch, int& sgn) -> int {
    if (d == 0) { sgn = 1; return (ch < 8) ? NL + b * CTXL + ch * 32 : b * SEQ + (ch - 8) * 32; }
    sgn = -1; return (ch < 8) ? NL + b * CTXL + 255 - ch * 32 : b * SEQ + 8191 - (ch - 8) * 32;
  };
  auto prefetch = [&](int ch) {
    int sgn; const int rowbase = rowbase_of(ch, sgn);
#pragma unroll
    for (int m = 0; m < 2; ++m) {
      const size_t row = (size_t)(rowbase + sgn * (m * 16 + fr));
#pragma unroll
      for (int ks = 0; ks < 2; ++ks) {
        phw[m][ks] = *(const bf16x8*)(p.HID + row * HIDW + d * 64 + ks * 32 + fq * 8);
        pha[m][ks] = *(const bf16x8*)(p.HID + row * HIDW + 128 + d * 64 + ks * 32 + fq * 8);
      }
    }
    const size_t off = (size_t)(rowbase + sgn * tt) * 1024 + h * 64 + c8 * 8;
    puk = *(const u32x4*)(p.K + off);
    pur = *(const u32x4*)(p.R + off);
    puv = *(const u32x4*)(Vsrc + off);
  };
  prefetch(0);

  for (int ch = 0; ch < 264; ++ch) {
    int sgn; const int rowbase = rowbase_of(ch, sgn);
#pragma unroll
    for (int m = 0; m < 2; ++m) {
      const int tok = m * 16 + fr;
      f32x4 aw = (f32x4){0.f, 0.f, 0.f, 0.f}, aa = aw;
#pragma unroll
      for (int ks = 0; ks < 2; ++ks) {
        aw = __builtin_amdgcn_mfma_f32_16x16x32_bf16(bw[ks], phw[m][ks], aw, 0, 0, 0);
        aa = __builtin_amdgcn_mfma_f32_16x16x32_bf16(ba[ks], pha[m][ks], aa, 0, 0, 0);
      }
      f32x4 wd, av;
#pragma unroll
      for (int e = 0; e < 4; ++e) {
        const float ez = __expf(-(w0v[e] + aw[e]));
        wd[e] = __expf(-0.60653066f * __builtin_amdgcn_rcpf(1.f + ez));
        av[e] = __builtin_amdgcn_rcpf(1.f + __expf(-(a0v[e] + aa[e])));
      }
#pragma unroll
      for (int e = 0; e < 4; ++e) {
        float x = wd[e];
        x *= __int_as_float(__builtin_amdgcn_update_dpp(0x3f800000, __float_as_int(x), 0x111, 0xF, 0xF, false));
        x *= __int_as_float(__builtin_amdgcn_update_dpp(0x3f800000, __float_as_int(x), 0x112, 0xF, 0xF, false));
        x *= __int_as_float(__builtin_amdgcn_update_dpp(0x3f800000, __float_as_int(x), 0x114, 0xF, 0xF, false));
        x *= __int_as_float(__builtin_amdgcn_update_dpp(0x3f800000, __float_as_int(x), 0x118, 0xF, 0xF, false));
        wd[e] = x;
      }
      *(f32x4*)(Pbuf + tok * 64 + wid * 16 + fq * 4) = wd;
      *(f32x4*)(abuf + tok * 64 + wid * 16 + fq * 4) = av;
    }
    lds_barrier();
    {
      const size_t row = (size_t)(rowbase + sgn * tt);
      float k[8], r[8], kk[8];
#pragma unroll
      for (int e = 0; e < 4; ++e) {
        k[2 * e] = bflo(puk[e]); k[2 * e + 1] = bfhi(puk[e]);
        r[2 * e] = bflo(pur[e]); r[2 * e + 1] = bfhi(pur[e]);
      }
      float ss = 0.f;
#pragma unroll
      for (int e = 0; e < 8; ++e) { kk[e] = k[e] * kkv[e]; ss += kk[e] * kk[e]; }
      ss = oct_sum(ss);
      const float inv = __builtin_amdgcn_rsqf(fmaxf(ss, 1e-24f));
      const f32x4 a0 = *(const f32x4*)(abuf + tt * 64 + c8 * 8), a1 = *(const f32x4*)(abuf + tt * 64 + c8 * 8 + 4);
      const f32x4 p0 = *(const f32x4*)(Pbuf + tt * 64 + c8 * 8), p1 = *(const f32x4*)(Pbuf + tt * 64 + c8 * 8 + 4);
      f32x4 q0 = (f32x4){1.f, 1.f, 1.f, 1.f}, q1 = q0;
      if (tt & 15) { q0 = *(const f32x4*)(Pbuf + (tt - 1) * 64 + c8 * 8); q1 = *(const f32x4*)(Pbuf + (tt - 1) * 64 + c8 * 8 + 4); }
      const float a[8] = {a0.x, a0.y, a0.z, a0.w, a1.x, a1.y, a1.z, a1.w};
      const float Pt[8] = {p0.x, p0.y, p0.z, p0.w, p1.x, p1.y, p1.z, p1.w};
      const float Pm[8] = {q0.x, q0.y, q0.z, q0.w, q1.x, q1.y, q1.z, q1.w};
      float at[8], bt_[8], kt_[8], rt[8];
      float bsum = 0.f;
#pragma unroll
      for (int e = 0; e < 8; ++e) {
        const float kkn = kk[e] * inv;
        const float kd = k[e] * (1.f + (a[e] - 1.f) * kav[e]);
        bsum += r[e] * kd * rkv[e];
        const float ip = __builtin_amdgcn_rcpf(Pt[e]);
        at[e] = -kkn * Pm[e];
        bt_[e] = kkn * a[e] * ip;
        kt_[e] = kd * ip;
        rt[e] = r[e] * Pt[e];
      }
      bsum = oct_sum(bsum);
      if (c8 == 0) betad[row * 16 + h] = bsum;
      char* ro = smem + tt * 136 + c8 * 16;
      *(u32x2*)(ro + SC_AT) = (u32x2){pk2(at[0], at[1]), pk2(at[2], at[3])};   *(u32x2*)(ro + SC_AT + 8) = (u32x2){pk2(at[4], at[5]), pk2(at[6], at[7])};
      *(u32x2*)(ro + SC_RT) = (u32x2){pk2(rt[0], rt[1]), pk2(rt[2], rt[3])};   *(u32x2*)(ro + SC_RT + 8) = (u32x2){pk2(rt[4], rt[5]), pk2(rt[6], rt[7])};
      *(u32x2*)(ro + SC_BT) = (u32x2){pk2(bt_[0], bt_[1]), pk2(bt_[2], bt_[3])}; *(u32x2*)(ro + SC_BT + 8) = (u32x2){pk2(bt_[4], bt_[5]), pk2(bt_[6], bt_[7])};
      *(u32x2*)(ro + SC_KT) = (u32x2){pk2(kt_[0], kt_[1]), pk2(kt_[2], kt_[3])}; *(u32x2*)(ro + SC_KT + 8) = (u32x2){pk2(kt_[4], kt_[5]), pk2(kt_[6], kt_[7])};
#pragma unroll
      for (int e = 0; e < 8; ++e) {
        *(bf*)(smem + SC_BTT + (c8 * 8 + e) * 72 + tt * 2) = (bf)(pk2(bt_[e], 0.f) & 0xffffu);
        *(bf*)(smem + SC_KTT + (c8 * 8 + e) * 72 + tt * 2) = (bf)(pk2(kt_[e], 0.f) & 0xffffu);
      }
      *(f32x4*)(vs + tt * 64 + c8 * 8) = (f32x4){bflo(puv[0]), bfhi(puv[0]), bflo(puv[1]), bfhi(puv[1])};
      *(f32x4*)(vs + tt * 64 + c8 * 8 + 4) = (f32x4){bflo(puv[2]), bfhi(puv[2]), bflo(puv[3]), bfhi(puv[3])};
    }
    lds_barrier();
    if (ch + 1 < 264) prefetch(ch + 1);
    {
      auto gram = [&](int xbase, int ybase, int sc) -> f32x4 {
        f32x4 acc = (f32x4){0.f, 0.f, 0.f, 0.f};
#pragma unroll
        for (int ks = 0; ks < 2; ++ks) {
          const char* xp = smem + xbase + (sc * 16 + fr) * 136 + ks * 64 + fq * 16;
          const char* yp = smem + ybase + (sc * 16 + fr) * 136 + ks * 64 + fq * 16;
          const bf16x8 xf = mk8(*(const u32x2*)xp, *(const u32x2*)(xp + 8));
          const bf16x8 yf = mk8(*(const u32x2*)yp, *(const u32x2*)(yp + 8));
          acc = __builtin_amdgcn_mfma_f32_16x16x32_bf16(xf, yf, acc, 0, 0, 0);
        }
        return acc;
      };
      auto store_small = [&](f32x4 g, int sc, int kind, bool strict) {
#pragma unroll
        for (int e = 0; e < 4; ++e) { const int sidx = fq * 4 + e; const bool keep = strict ? (sidx < fr) : (sidx <= fr); g[e] = keep ? g[e] : 0.f; }
        *(u32x2*)(smem + SC_SM + (sc * 5 + kind) * 640 + fr * 40 + fq * 8) = (u32x2){pk2(g[0], g[1]), pk2(g[2], g[3])};
      };
      if (wid < 2) {
        const int sc = wid;
        f32x4 g = gram(SC_BT, SC_AT, sc);
#pragma unroll
        for (int e = 0; e < 4; ++e) g[e] = (fq * 4 + e < fr) ? g[e] : 0.f;
        *(f32x4*)(smem + SC_MABT + sc * 1024 + fr * 64 + fq * 16) = g;
        asm volatile("s_waitcnt lgkmcnt(0)" ::: "memory");
        if (lane < 16) {
          float n[16];
#pragma unroll
          for (int t = 0; t < 16; ++t) {
            const float* mc = (const float*)(smem + SC_MABT + sc * 1024 + t * 64);
            float acc = (t == lane) ? 1.f : 0.f;
#pragma unroll
            for (int sp = 0; sp < t; ++sp) acc = fmaf(n[sp], mc[sp], acc);
            n[t] = acc;
          }
#pragma unroll
          for (int t = 0; t < 16; ++t) {
            const unsigned hi = pk2(n[t], 0.f) & 0xffffu;
            const unsigned lo = pk2(n[t] - bflo(hi), 0.f) & 0xffffu;
            *(bf*)(smem + SC_SM + (sc * 5 + 0) * 640 + t * 40 + lane * 2) = (bf)hi;
            *(bf*)(smem + SC_SM + (sc * 5 + 1) * 640 + t * 40 + lane * 2) = (bf)lo;
          }
        }
      } else {
        const int sc = wid - 2;
        store_small(gram(SC_KT, SC_AT, sc), sc, 2, true);
        store_small(gram(SC_BT, SC_RT, sc), sc, 3, false);
        store_small(gram(SC_KT, SC_RT, sc), sc, 4, false);
      }
    }
    lds_barrier();
#pragma unroll
    for (int sc = 0; sc < 2; ++sc) {
      bf16x8 shi[2], slo[2];
#pragma unroll
      for (int g = 0; g < 2; ++g) {
        u32x2 h0, l0, h1, l1;
        split4(ST[2 * g], h0, l0); split4(ST[2 * g + 1], h1, l1);
        shi[g] = mk8(h0, h1); slo[g] = mk8(l0, l1);
      }
      const char* arow = smem + SC_AT + (sc * 16 + fr) * 136 + fq * 8;
      const char* rrow = smem + SC_RT + (sc * 16 + fr) * 136 + fq * 8;
      f32x4 wt = (f32x4){0.f, 0.f, 0.f, 0.f}, yt = wt;
#pragma unroll
      for (int g = 0; g < 2; ++g) {
        const bf16x8 xa = mk8(*(const u32x2*)(arow + g * 64), *(const u32x2*)(arow + g * 64 + 32));
        const bf16x8 xr = mk8(*(const u32x2*)(rrow + g * 64), *(const u32x2*)(rrow + g * 64 + 32));
        wt = __builtin_amdgcn_mfma_f32_16x16x32_bf16(xa, shi[g], wt, 0, 0, 0);
        wt = __builtin_amdgcn_mfma_f32_16x16x32_bf16(xa, slo[g], wt, 0, 0, 0);
        yt = __builtin_amdgcn_mfma_f32_16x16x32_bf16(xr, shi[g], yt, 0, 0, 0);
        yt = __builtin_amdgcn_mfma_f32_16x16x32_bf16(xr, slo[g], yt, 0, 0, 0);
      }
      const int vcol = wid * 16 + fr;
      const float* vp = vs + (sc * 16 + fq * 4) * 64 + vcol;
      const bf16x8 vmf = mk4((u32x2){pk2(vp[0], vp[64]), pk2(vp[128], vp[192])});
      const char* smb = smem + SC_SM + sc * 5 * 640 + fr * 40 + fq * 8;
      const bf16x8 xnh = mk4(*(const u32x2*)(smb)), xnl = mk4(*(const u32x2*)(smb + 640));
      const bf16x8 xmak = mk4(*(const u32x2*)(smb + 2 * 640)), xmrb = mk4(*(const u32x2*)(smb + 3 * 640)), xmrk = mk4(*(const u32x2*)(smb + 4 * 640));
      wt = __builtin_amdgcn_mfma_f32_16x16x32_bf16(xmak, vmf, wt, 0, 0, 0);
      u32x2 whi, wlo;
      split4(wt, whi, wlo);
      f32x4 ut = (f32x4){0.f, 0.f, 0.f, 0.f};
      ut = __builtin_amdgcn_mfma_f32_16x16x32_bf16(xnh, mk4(whi), ut, 0, 0, 0);
      ut = __builtin_amdgcn_mfma_f32_16x16x32_bf16(xnh, mk4(wlo), ut, 0, 0, 0);
      ut = __builtin_amdgcn_mfma_f32_16x16x32_bf16(xnl, mk4(whi), ut, 0, 0, 0);
      u32x2 uhi, ulo;
      split4(ut, uhi, ulo);
      const bf16x8 uhf = mk4(uhi), ulf = mk4(ulo);
      yt = __builtin_amdgcn_mfma_f32_16x16x32_bf16(xmrb, uhf, yt, 0, 0, 0);
      yt = __builtin_amdgcn_mfma_f32_16x16x32_bf16(xmrb, ulf, yt, 0, 0, 0);
      yt = __builtin_amdgcn_mfma_f32_16x16x32_bf16(xmrk, vmf, yt, 0, 0, 0);
#pragma unroll
      for (int e = 0; e < 4; ++e) ys[(sc * 16 + fq * 4 + e) * 64 + vcol] = yt[e];
#pragma unroll
      for (int kt = 0; kt < 4; ++kt) {
        const bf16x8 xb = mk4(*(const u32x2*)(smem + SC_BTT + (kt * 16 + fr) * 72 + (sc * 16 + fq * 4) * 2));
        const bf16x8 xk = mk4(*(const u32x2*)(smem + SC_KTT + (kt * 16 + fr) * 72 + (sc * 16 + fq * 4) * 2));
        ST[kt] = __builtin_amdgcn_mfma_f32_16x16x32_bf16(xb, uhf, ST[kt], 0, 0, 0);
        ST[kt] = __builtin_amdgcn_mfma_f32_16x16x32_bf16(xb, ulf, ST[kt], 0, 0, 0);
        ST[kt] = __builtin_amdgcn_mfma_f32_16x16x32_bf16(xk, vmf, ST[kt], 0, 0, 0);
        const f32x4 pc = *(const f32x4*)(Pbuf + (sc * 16 + 15) * 64 + kt * 16 + fq * 4);
        ST[kt] = ST[kt] * pc;
      }
    }
    lds_barrier();
    {
      const size_t row = (size_t)(rowbase + sgn * tt);
      const f32x4 y0 = *(const f32x4*)(ys + tt * 64 + c8 * 8), y1 = *(const f32x4*)(ys + tt * 64 + c8 * 8 + 4);
      *(u32x4*)(Ydst + row * ldy + h * 64 + c8 * 8) = (u32x4){pk2(y0.x, y0.y), pk2(y0.z, y0.w), pk2(y1.x, y1.y), pk2(y1.z, y1.w)};
    }
    lds_barrier();
  }
  }
}

__device__ void og_phase(const Params& p, int j) {
  const int tid = otid(), lane = tid & 63;
  const int gw = blockIdx.x * 4 + (tid >> 6), nw = gridDim.x * 4;
  const bf* Vsrc = (j == 0) ? p.VF : p.V2;
  const int col = lane * 16, hh = lane >> 2;
  float lw[16], lb[16];
#pragma unroll
  for (int e = 0; e < 16; ++e) { lw[e] = p.rw_lnx_w[j * 1024 + col + e]; lb[e] = p.rw_lnx_b[j * 1024 + col + e]; }
  for (int row = gw; row < MT; row += nw) {
    const size_t off = (size_t)row * 1024 + col, offh = (size_t)row * LDH + col;
    u32x4 u0[2], u1[2], uv[2], ug[2];
#pragma unroll
    for (int q = 0; q < 2; ++q) {
      u0[q] = __builtin_nontemporal_load((const u32x4*)(p.H + offh + q * 8));
      u1[q] = __builtin_nontemporal_load((const u32x4*)(p.Y1 + off + q * 8));
      uv[q] = __builtin_nontemporal_load((const u32x4*)(Vsrc + off + q * 8));
      ug[q] = __builtin_nontemporal_load((const u32x4*)(p.G + off + q * 8));
    }
    const float bsum = p.beta[(size_t)row * 16 + hh] + p.beta[(size_t)MT * 16 + (size_t)row * 16 + hh];
    float y[16], v[16], g[16];
    float s = 0.f;
#pragma unroll
    for (int e = 0; e < 8; ++e) {
      y[2 * e] = bflo(u0[e >> 2][e & 3]) + bflo(u1[e >> 2][e & 3]); y[2 * e + 1] = bfhi(u0[e >> 2][e & 3]) + bfhi(u1[e >> 2][e & 3]);
      v[2 * e] = bflo(uv[e >> 2][e & 3]); v[2 * e + 1] = bfhi(uv[e >> 2][e & 3]);
      g[2 * e] = bflo(ug[e >> 2][e & 3]); g[2 * e + 1] = bfhi(ug[e >> 2][e & 3]);
      s += y[2 * e] + y[2 * e + 1];
    }
    s = quad_sum(s);
    const float mean = s * (1.f / 64.f);
    float q2 = 0.f;
#pragma unroll
    for (int e = 0; e < 16; ++e) { const float dd = y[e] - mean; q2 += dd * dd; }
    q2 = quad_sum(q2);
    const float rstd = rsqrtf(q2 * (1.f / 64.f) + 64e-5f);
    unsigned o[8];
#pragma unroll
    for (int e = 0; e < 8; ++e) {
      const float r0 = ((y[2 * e] - mean) * rstd * lw[2 * e] + lb[2 * e] + bsum * v[2 * e]) * g[2 * e];
      const float r1 = ((y[2 * e + 1] - mean) * rstd * lw[2 * e + 1] + lb[2 * e + 1] + bsum * v[2 * e + 1]) * g[2 * e + 1];
      o[e] = pk2(r0, r1);
    }
    *(u32x4*)(p.H + offh) = (u32x4){o[0], o[1], o[2], o[3]};
    *(u32x4*)(p.H + offh + 8) = (u32x4){o[4], o[5], o[6], o[7]};
  }
}

__device__ void attn_phase(const Params& p, int j, bool ctx_out, char* smem) {
  const int tid = otid(), lane = tid & 63, cgp = tid >> 6, fr = lane & 15, fq = lane >> 4;
  char* Ks = smem;
  bf* Vs = (bf*)smem;
  float* rpbs = (float*)(smem + 36864);
  const bf* Q = p.R; const bf* Kb = p.K; const bf* Vt = p.V2; const bf* Gb = p.G;
  const int nitems = 16384 + (ctx_out ? 512 : 0);
  for (int item = blockIdx.x; item < nitems; item += gridDim.x) {
    int b, h, r = 0, qrow0; bool haswin;
    if (item < 16384) { h = item & 15; r = (item >> 4) & 127; b = item >> 11; haswin = true; qrow0 = b * SEQ + r * 64; }
    else { const int it = item - 16384; h = it & 15; const int qb = (it >> 4) & 3; b = it >> 6; haswin = false; qrow0 = NL + b * CTXL + qb * 64; }
    const int qtok = qrow0 + cgp * 16 + fr;
    bf16x8 qf[2];
#pragma unroll
    for (int ks = 0; ks < 2; ++ks) qf[ks] = *(const bf16x8*)(Q + (size_t)qtok * 1024 + h * 64 + ks * 32 + fq * 8);
    const int rs = min(max(r - 4, 0), 120);
    const int qcol = cgp * 16 + fr;
    const int wsq = min(max(qcol - 8, 0), 48);
    const int bs = min(max(16 * cgp - 8, 0), 32);
    lds_barrier();
    if (haswin) for (int idx = tid; idx < 465; idx += 256) rpbs[idx] = p.na_rpb[((size_t)j * 16 + h) * 465 + idx];
    f32x4 sw[8][2], sc[4][4];
    bf16x8 pw[8];
    float m1 = NEGV, l1 = 0.f;
#pragma unroll
    for (int i = 0; i < 8; ++i) pw[i] = (bf16x8){0, 0, 0, 0, 0, 0, 0, 0};
#pragma unroll
    for (int i = 0; i < 8; ++i)
#pragma unroll
      for (int k2 = 0; k2 < 2; ++k2) sw[i][k2] = (f32x4){NEGV, NEGV, NEGV, NEGV};
#pragma unroll
    for (int st = 0; st < 3; ++st) {
      if (st < 2 && !haswin) continue;
      lds_barrier();
      int tq = tid; asm volatile("" : "+v"(tq));
#pragma unroll
      for (int hf = 0; hf < 2; ++hf) {
        u32x4 u[4];
#pragma unroll
        for (int i = 0; i < 4; ++i) {
          const int q = tq + (hf * 4 + i) * 256, key = q >> 3, c = q & 7, tl = key >> 6;
          const int base = (st < 2) ? b * SEQ + (rs + st * 4 + tl) * 64 : NL + b * CTXL + tl * 64;
          u[i] = *(const u32x4*)(Kb + (size_t)(base + (key & 63)) * 1024 + h * 64 + c * 8);
        }
#pragma unroll
        for (int i = 0; i < 4; ++i) {
          const int q = tq + (hf * 4 + i) * 256, key = q >> 3, c = q & 7;
          *(u32x4*)(Ks + lds_off(key, c)) = u[i];
        }
        __builtin_amdgcn_sched_barrier(0);
      }
      lds_barrier();
      if (st < 2) {
#pragma unroll
        for (int tl = 0; tl < 4; ++tl) {
          const int i = st * 4 + tl;
          const int dr = rs + i - r + 7;
#pragma unroll
          for (int k2 = 0; k2 < 2; ++k2) {
            f32x4 acc = (f32x4){0.f, 0.f, 0.f, 0.f};
#pragma unroll
            for (int ks = 0; ks < 2; ++ks) {
              const bf16x8 kf = *(const bf16x8*)(Ks + lds_off(tl * 64 + bs + k2 * 16 + fr, ks * 4 + fq));
              acc = __builtin_amdgcn_mfma_f32_16x16x32_bf16(kf, qf[ks], acc, 0, 0, 0);
            }
#pragma unroll
            for (int e = 0; e < 4; ++e) {
              const int kc = bs + k2 * 16 + fq * 4 + e;
              const bool valid = (kc >= wsq) && (kc < wsq + 16);
              const int dc = min(max(kc - qcol, -15), 15) + 15;
              sw[i][k2][e] = valid ? acc[e] + rpbs[dr * 31 + dc] : NEGV;
            }
          }
          __builtin_amdgcn_sched_barrier(0);
        }
      } else {
#pragma unroll
        for (int tl = 0; tl < 4; ++tl)
#pragma unroll
          for (int k4 = 0; k4 < 4; ++k4) {
            f32x4 acc = (f32x4){0.f, 0.f, 0.f, 0.f};
#pragma unroll
            for (int ks = 0; ks < 2; ++ks) {
              const bf16x8 kf = *(const bf16x8*)(Ks + lds_off(tl * 64 + k4 * 16 + fr, ks * 4 + fq));
              acc = __builtin_amdgcn_mfma_f32_16x16x32_bf16(kf, qf[ks], acc, 0, 0, 0);
            }
            sc[tl][k4] = acc;
            if (k4 & 1) __builtin_amdgcn_sched_barrier(0);
          }
      }
      if (st == 1) {
#pragma unroll
        for (int i = 0; i < 8; ++i)
#pragma unroll
          for (int k2 = 0; k2 < 2; ++k2)
#pragma unroll
            for (int e = 0; e < 4; ++e) m1 = fmaxf(m1, sw[i][k2][e]);
        m1 = fmaxf(m1, __shfl_xor(m1, 16));
        m1 = fmaxf(m1, __shfl_xor(m1, 32));
#pragma unroll
        for (int i = 0; i < 8; ++i) {
          float e0[4], e1[4];
#pragma unroll
          for (int e = 0; e < 4; ++e) { e0[e] = __expf(sw[i][0][e] - m1); e1[e] = __expf(sw[i][1][e] - m1); l1 += e0[e] + e1[e]; }
          u32x4 u = (u32x4){pk2(e0[0], e0[1]), pk2(e0[2], e0[3]), pk2(e1[0], e1[1]), pk2(e1[2], e1[3])};
          pw[i] = __builtin_bit_cast(bf16x8, u);
        }
        l1 += __shfl_xor(l1, 16);
        l1 += __shfl_xor(l1, 32);
      }
    }
    float m2 = NEGV;
#pragma unroll
    for (int tl = 0; tl < 4; ++tl)
#pragma unroll
      for (int k4 = 0; k4 < 4; ++k4)
#pragma unroll
        for (int e = 0; e < 4; ++e) m2 = fmaxf(m2, sc[tl][k4][e]);
    m2 = fmaxf(m2, __shfl_xor(m2, 16));
    m2 = fmaxf(m2, __shfl_xor(m2, 32));
    const float mx = fmaxf(m1, m2);
    const float alpha1 = __expf(m1 - mx);
    float l2 = 0.f;
    bf16x8 pc[4][2];
#pragma unroll
    for (int tl = 0; tl < 4; ++tl)
#pragma unroll
      for (int g2 = 0; g2 < 2; ++g2) {
        float e0[4], e1[4];
#pragma unroll
        for (int e = 0; e < 4; ++e) { e0[e] = __expf(sc[tl][2 * g2][e] - mx); e1[e] = __expf(sc[tl][2 * g2 + 1][e] - mx); l2 += e0[e] + e1[e]; }
        u32x4 u = (u32x4){pk2(e0[0], e0[1]), pk2(e0[2], e0[3]), pk2(e1[0], e1[1]), pk2(e1[2], e1[3])};
        pc[tl][g2] = __builtin_bit_cast(bf16x8, u);
      }
    l2 += __shfl_xor(l2, 16);
    l2 += __shfl_xor(l2, 32);
    const float l = alpha1 * l1 + l2;
    f32x4 o[4];
#pragma unroll
    for (int dt = 0; dt < 4; ++dt) o[dt] = (f32x4){0.f, 0.f, 0.f, 0.f};
#pragma unroll
    for (int st = 0; st < 3; ++st) {
      if (st < 2 && !haswin) continue;
      lds_barrier();
      int tq = tid; asm volatile("" : "+v"(tq));
#pragma unroll
      for (int hf = 0; hf < 2; ++hf) {
        u32x4 u[4];
#pragma unroll
        for (int i = 0; i < 4; ++i) {
          const int q = tq + (hf * 4 + i) * 256, tl = q >> 9, dd = (q >> 3) & 63, c = q & 7;
          const int base = (st < 2) ? b * SEQ + (rs + st * 4 + tl) * 64 : NL + b * CTXL + tl * 64;
          u[i] = *(const u32x4*)(Vt + (size_t)(h * 64 + dd) * MT + base + c * 8);
        }
#pragma unroll
        for (int i = 0; i < 4; ++i) {
          const int q = tq + (hf * 4 + i) * 256, tl = q >> 9, dd = (q >> 3) & 63, c = q & 7;
          *(u32x4*)(Vs + tl * 4608 + dd * 72 + c * 8) = u[i];
        }
        __builtin_amdgcn_sched_barrier(0);
      }
      lds_barrier();
      if (st < 2) {
#pragma unroll
        for (int tl = 0; tl < 4; ++tl) {
          const int i = st * 4 + tl;
#pragma unroll
          for (int dt = 0; dt < 4; ++dt) {
            const bf* vp = Vs + tl * 4608 + (dt * 16 + fr) * 72 + bs + fq * 4;
            const u32x2 lo = *(const u32x2*)vp, hi = *(const u32x2*)(vp + 16);
            u32x4 u = (u32x4){lo.x, lo.y, hi.x, hi.y};
            o[dt] = __builtin_amdgcn_mfma_f32_16x16x32_bf16(__builtin_bit_cast(bf16x8, u), pw[i], o[dt], 0, 0, 0);
          }
          __builtin_amdgcn_sched_barrier(0);
        }
      } else {
#pragma unroll
        for (int tl = 0; tl < 4; ++tl)
#pragma unroll
          for (int g2 = 0; g2 < 2; ++g2)
#pragma unroll
            for (int dt = 0; dt < 4; ++dt) {
              const bf* vp = Vs + tl * 4608 + (dt * 16 + fr) * 72 + g2 * 32 + fq * 4;
              const u32x2 lo = *(const u32x2*)vp, hi = *(const u32x2*)(vp + 16);
              u32x4 u = (u32x4){lo.x, lo.y, hi.x, hi.y};
              o[dt] = __builtin_amdgcn_mfma_f32_16x16x32_bf16(__builtin_bit_cast(bf16x8, u), pc[tl][g2], o[dt], 0, 0, 0);
              if (dt == 3) __builtin_amdgcn_sched_barrier(0);
            }
      }
      if (st == 1) {
#pragma unroll
        for (int dt = 0; dt < 4; ++dt) o[dt] *= alpha1;
      }
    }
    const float inv = 1.f / l;
#pragma unroll
    for (int dt = 0; dt < 4; ++dt) {
      const size_t off = (size_t)qtok * 1024 + h * 64 + dt * 16 + fq * 4;
      const u32x2 ug = *(const u32x2*)(Gb + off);
      const float g0 = bflo(ug.x), g1 = bfhi(ug.x), g2 = bflo(ug.y), g3 = bfhi(ug.y);
      *(u32x2*)(p.H + (size_t)qtok * LDH + h * 64 + dt * 16 + fq * 4) = (u32x2){pk2(o[dt][0] * inv * siluf(g0), o[dt][1] * inv * siluf(g1)),
                                        pk2(o[dt][2] * inv * siluf(g2), o[dt][3] * inv * siluf(g3))};
    }
  }
}


#define XB_TMO      128
#define XB_XCNT(j)  (256  + 64 * (j))
#define XB_XSUB(j)  (1280 + 64 * (j))
#define XB_XGEN(j)  (2304 + 64 * (j))
#define XB_TOP      3328
#define XB_TOPGEN   3392
#define XCD_BAR_WORDS 3456
#define XB_SPIN_CAP (1u << 18)
__device__ __forceinline__ unsigned xb_ld(unsigned* q) { return __hip_atomic_load(q, __ATOMIC_RELAXED, __HIP_MEMORY_SCOPE_AGENT); }
__device__ __forceinline__ unsigned xb_add(unsigned* q, unsigned v) { return __hip_atomic_fetch_add(q, v, __ATOMIC_RELAXED, __HIP_MEMORY_SCOPE_AGENT); }
__device__ __forceinline__ unsigned xb_xcc_id() { return (unsigned)__builtin_amdgcn_s_getreg((3 << 11) | 20) & 0xFu; }
#define XB_SPIN(cond, bar) do { unsigned _sp = 0; while (cond) { __builtin_amdgcn_s_sleep(1); \
    if ((++_sp & 255u) == 0u) { if (xb_ld(&(bar)[XB_TMO])) break; if (_sp > XB_SPIN_CAP) { atomicAdd(&(bar)[XB_TMO], 1u); break; } } } } while (0)
struct XcdBarrier { unsigned* bar; unsigned x, nloc, nx; };
__device__ __forceinline__ void xcd_barrier(const XcdBarrier& b) {
  asm volatile("s_waitcnt vmcnt(0)" ::: "memory");
  __syncthreads();
  if (threadIdx.x == 0) {
    unsigned* bar = b.bar;
    __builtin_amdgcn_s_waitcnt(0);
    const unsigned nloc = b.nloc, nx = b.nx;
    const unsigned old = xb_add(&bar[XB_XSUB(b.x)], 1u);
    const unsigned gen = old / nloc;
    if (old + 1u == (gen + 1u) * nloc) {
      __builtin_amdgcn_fence(__ATOMIC_RELEASE, "agent");
      asm volatile("s_waitcnt vmcnt(0)" ::: "memory");
      const unsigned og = xb_add(&bar[XB_TOP], 1u);
      const unsigned tg = og / nx;
      if (og + 1u == (tg + 1u) * nx) xb_add(&bar[XB_TOPGEN], 1u);
      else XB_SPIN(xb_ld(&bar[XB_TOPGEN]) == tg, bar);
      __builtin_amdgcn_fence(__ATOMIC_ACQUIRE, "agent");
      xb_add(&bar[XB_XGEN(b.x)], 1u);
      asm volatile("s_waitcnt vmcnt(0)" ::: "memory");
    } else {
      XB_SPIN(xb_ld(&bar[XB_XGEN(b.x)]) == gen, bar);
      __builtin_amdgcn_fence(__ATOMIC_ACQUIRE, "agent");
      asm volatile("s_waitcnt vmcnt(0)" ::: "memory");
    }
  }
  __syncthreads();
}

#ifndef DUP_SCAN
#define DUP_SCAN 0
#endif
#ifndef DUP_ATTN
#define DUP_ATTN 0
#endif
#ifndef DUP_GEMM
#define DUP_GEMM 0
#endif
#ifndef MULTI_LAUNCH
#define MULTI_LAUNCH 0
#endif
__device__ __forceinline__ bool step_exists(int i, int s) {
  if (s == 2) return i == 2;
  if (s == 4) return (i & 1) == 0;
  return true;
}
__device__ __forceinline__ void run_step(const Params& p, int i, int s, char* smem) {
  asm volatile("" : "+s"(i));
  const int j = i >> 1;
  if (s == 0) { transpose_phase(p, i, smem); row_phase(p, i); }
  else if (s == 1) {
    if ((i & 1) == 0) {
      EpiRwkvProj ep{p.R, p.K, (j == 0) ? p.VF : p.V2, p.G, p.HID};
#pragma unroll 1
      for (int rep = PROBE_GEMM ? 0 : 1; rep < 2; ++rep)
      gemm_phase<1>(p.H, LDH, p.Wp, LDW, 16, MT / 128, (j == 0) ? 34 : 35, p.rw_mu + (size_t)j * 6 * 1024, ep, smem, rep == 0);
    } else {
      EpiNaProj ep{p.R, p.K, p.V2, p.G, p.na_b_in + (size_t)j * 4096};
#pragma unroll 1
      for (int rep = PROBE_GEMM ? 0 : 1; rep < 2; ++rep)
      gemm_phase<0>(p.H, LDH, p.Wp, LDW, 16, MT / 128, 32, nullptr, ep, smem, rep == 0);
    }
  } else if (s == 2) {
    EpiVres ev{p.V2, p.VF, p.rw_v0};
    gemm_phase<0>(p.HID + 256, HIDW, p.v2t, 64, 1, MT / 128, 8, nullptr, ev, smem);
  } else if (s == 3) {
    if ((i & 1) == 0) scan_phase(p, j, smem);
    else attn_phase(p, j, i != 3, smem);
  } else if (s == 4) {
    og_phase(p, j);
  } else {
    EpiOut eo{p.R};
#pragma unroll 1
    for (int rep = PROBE_GEMM ? 0 : 1; rep < 2; ++rep)
    gemm_phase<0>(p.H, LDH, p.Wo, LDW, 16, (i == 3) ? NL / 128 : MT / 128, 8, nullptr, eo, smem, rep == 0);
  }
}

__global__ void __launch_bounds__(256, 2) fwd_megakernel(Params p0) {
  __shared__ __attribute__((aligned(16))) char smem[SMEM_BYTES];
  cg::grid_group grid = cg::this_grid();
  XcdBarrier xb;
  xb.bar = p0.bar; xb.x = xb_xcc_id(); xb.nloc = 0u; xb.nx = 0u;
  if (threadIdx.x == 0) (void)xb_add(&xb.bar[XB_XCNT(xb.x)], 1u);
  pre_phase(p0, smem);
  grid.sync();
  {
    unsigned cnt = 0u, mine = 0u;
#pragma unroll 1
    for (unsigned jj = 0; jj < 16; ++jj) { const unsigned c = xb_ld(&xb.bar[XB_XCNT(jj)]); cnt += (c > 0u) ? 1u : 0u; mine = (jj == xb.x) ? c : mine; }
    xb.nloc = mine > 0u ? mine : 1u; xb.nx = cnt > 0u ? cnt : 1u;
  }
  const Params& p = p0;
#pragma unroll 1
  for (int i = 0; i < 4; ++i) {
#pragma unroll 1
    for (int s = 0; s < 6; ++s) {
      if (!step_exists(i, s)) continue;
      int reps = 1;
      if (DUP_SCAN && s == 3 && (i & 1) == 0) reps = 2;
      if (DUP_ATTN && s == 3 && (i & 1) == 1) reps = 2;
      if (DUP_GEMM && (s == 1 || s == 5)) reps = 2;
#pragma unroll 1
      for (int rep = 0; rep < reps; ++rep) {
        run_step(p, i, s, smem);
        xcd_barrier(xb);
      }
    }
  }
  row_phase(p, 4);
}

#if MULTI_LAUNCH
template <int S> __global__ void __launch_bounds__(256, 2) step_kernel(Params p0, int i) {
  __shared__ __attribute__((aligned(16))) char smem[SMEM_BYTES];
  if (S == -1) { pre_phase(p0, smem); return; }
  if (S == 6) { row_phase(p0, 4); return; }
  run_step(p0, i, S, smem);
}
#endif

extern "C" void kernel_launch(void* const* d_in, const int* in_sizes, int n_in, void* d_out, int out_size, void* d_ws, size_t ws_size,
                              hipStream_t stream) {
  static int grid_blocks = 0;
  if (!grid_blocks) {
    int dev = 0, cus = 0, per_cu = 0;
    hipGetDevice(&dev);
    hipDeviceGetAttribute(&cus, hipDeviceAttributeMultiprocessorCount, dev);
    hipOccupancyMaxActiveBlocksPerMultiprocessor(&per_cu, fwd_megakernel, 256, 0);
    if (per_cu > 2) per_cu = 2;
    if (per_cu < 1) per_cu = 1;
    grid_blocks = cus * per_cu;
  }
  Params p{};
  const float** f = (const float**)&p;
  for (int i = 0; i < 29; ++i) f[i] = (const float*)d_in[i];
  p.out = (float*)d_out;
  char* w = (char*)d_ws;
  size_t off = 0;
  auto take = [&](size_t bytes) { char* r = w + off; off += (bytes + 255) & ~(size_t)255; return r; };
  p.gp = (Params*)take(sizeof(Params));
  p.bar = (unsigned*)take((size_t)XCD_BAR_WORDS * 4);
  p.mod = (float*)take((size_t)4 * 9 * 3072 * 4);
  p.ctxbuf = (float*)take((size_t)NC * 1024 * 4);
  p.beta = (float*)take((size_t)2 * MT * 16 * 4);
  p.Wp = (bf*)take((size_t)4480 * LDW * 2);
  p.Wo = (bf*)take((size_t)1024 * LDW * 2);
  p.w2t = (bf*)take((size_t)2 * 65536 * 2);
  p.a2t = (bf*)take((size_t)2 * 65536 * 2);
  p.v2t = (bf*)take((size_t)65536 * 2);
  const size_t big = (size_t)MT * 1024 * 2;
  p.H = (bf*)take((size_t)MT * LDH * 2); p.R = (bf*)take(big); p.K = (bf*)take(big); p.VF = (bf*)take(big);
  p.V2 = (bf*)take(big); p.G = (bf*)take(big); p.Y1 = (bf*)take(big);
  p.HID = (bf*)take((size_t)MT * HIDW * 2);
  if (off > ws_size) fprintf(stderr, "workspace too small: need %zu have %zu\n", off, ws_size);
#if MULTI_LAUNCH
  step_kernel<-1><<<grid_blocks, 256, 0, stream>>>(p, 0);
  for (int i = 0; i < 4; ++i) {
    step_kernel<0><<<grid_blocks, 256, 0, stream>>>(p, i);
    step_kernel<1><<<grid_blocks, 256, 0, stream>>>(p, i);
    if (i == 2) step_kernel<2><<<grid_blocks, 256, 0, stream>>>(p, i);
    step_kernel<3><<<grid_blocks, 256, 0, stream>>>(p, i);
    if ((i & 1) == 0) step_kernel<4><<<grid_blocks, 256, 0, stream>>>(p, i);
    step_kernel<5><<<grid_blocks, 256, 0, stream>>>(p, i);
  }
  step_kernel<6><<<grid_blocks, 256, 0, stream>>>(p, 0);
#else
  (void)hipMemsetAsync(p.bar, 0, (size_t)XCD_BAR_WORDS * 4, stream);
  void* args[] = {&p};
  hipError_t e = hipLaunchCooperativeKernel((void*)fwd_megakernel, dim3(grid_blocks), dim3(256), args, 0, stream);
  if (e != hipSuccess) fprintf(stderr, "cooperative launch failed: %s (grid %d)\n", hipGetErrorString(e), grid_blocks);
#endif
}
```

```cpp
#include <hip/hip_runtime.h>
#include <hip/hip_cooperative_groups.h>
#include <cstdint>
#include <cstdio>
namespace cg = cooperative_groups;

typedef unsigned short bf;
typedef short bf16x8 __attribute__((ext_vector_type(8)));
typedef float f32x4 __attribute__((ext_vector_type(4)));
typedef unsigned u32x4 __attribute__((ext_vector_type(4)));
typedef unsigned u32x2 __attribute__((ext_vector_type(2)));

constexpr int DM = 1024, NB = 8, SEQ = 8192, NL = NB * SEQ, CTXL = 256, NC = NB * CTXL, MT = NL + NC;
constexpr int HIDW = 384;
constexpr int LDH = 1088, LDW = 1088;
constexpr int SMEM_BYTES = 65536;
#define NEGV (-1e30f)
#ifndef PROBE_GEMM
#define PROBE_GEMM 0
#endif

struct Params {
  const float *x, *c, *ctx, *c_ctx, *ada_w, *ada_b, *pre_g, *post_g, *rw_mu, *rw_w_rkvg, *rw_w0, *rw_w1, *rw_w2,
      *rw_a0, *rw_a1, *rw_a2, *rw_v0, *rw_v1, *rw_v2, *rw_k_k, *rw_k_a, *rw_r_k, *rw_lnx_w, *rw_lnx_b, *rw_w_out,
      *na_w_in, *na_b_in, *na_rpb, *na_w_out;
  float* out;
  float *mod, *ctxbuf, *beta;
  bf *Wp, *Wo, *w2t, *a2t, *v2t;
  bf *H, *R, *K, *VF, *V2, *G, *Y1, *HID;
  Params* gp;
  unsigned* bar;
};

__device__ __forceinline__ float bflo(unsigned w) { return __uint_as_float(w << 16); }
__device__ __forceinline__ float bfhi(unsigned w) { return __uint_as_float(w & 0xffff0000u); }
typedef __bf16 bf16x2_t __attribute__((ext_vector_type(2)));
__device__ __forceinline__ unsigned pk2(float lo, float hi) {
  bf16x2_t v = {(__bf16)lo, (__bf16)hi};
  return __builtin_bit_cast(unsigned, v);
}
__device__ __forceinline__ float siluf(float v) { return v * __builtin_amdgcn_rcpf(1.f + __expf(-v)); }
__device__ __forceinline__ float sigmf(float v) { return __builtin_amdgcn_rcpf(1.f + __expf(-v)); }
__device__ __forceinline__ float tanh_fast(float v) { return 1.f - 2.f * __builtin_amdgcn_rcpf(1.f + __expf(2.f * v)); }
__device__ __forceinline__ float quad_sum(float v) {
  int t = __builtin_amdgcn_update_dpp(0, __float_as_int(v), 0xB1, 0xF, 0xF, true);
  v += __int_as_float(t);
  t = __builtin_amdgcn_update_dpp(0, __float_as_int(v), 0x4E, 0xF, 0xF, true);
  v += __int_as_float(t);
  return v;
}
__device__ __forceinline__ float wave_sum(float v) {
#pragma unroll
  for (int o = 32; o >= 1; o >>= 1) v += __shfl_xor(v, o);
  return v;
}
__device__ __forceinline__ int otid() { int t = threadIdx.x; asm volatile("" : "+v"(t)); return t; }
__device__ __forceinline__ void lds_barrier() { asm volatile("s_waitcnt lgkmcnt(0)\n\ts_barrier" ::: "memory"); }
__device__ __forceinline__ int lds_off(int row, int c) { return row * 128 + ((c ^ ((row >> 1) & 7)) << 4); }
__device__ __forceinline__ unsigned lerp2(unsigned hm, unsigned h0, unsigned hp, float m0, float m1) {
  const float c0 = bflo(h0), c1 = bfhi(h0);
  const float x0 = 0.5f * (bflo(hm) + bflo(hp)) - c0;
  const float x1 = 0.5f * (bfhi(hm) + bfhi(hp)) - c1;
  return pk2(c0 + x0 * m0, c1 + x1 * m1);
}
__device__ __forceinline__ int mod_idx(int row) { return row < NL ? (row >> 13) : 8; }

__device__ void pre_phase(const Params& p, char* smem) {
  float* s = (float*)smem;
  float* red = s + 9 * 1024;
  const int tid = otid();
  for (int item = blockIdx.x; item < 4 * 48; item += gridDim.x) {
    const int i = item / 48, cb = item % 48;
    __syncthreads();
    for (int idx = tid; idx < 9 * 1024; idx += 256) {
      const int m = idx >> 10, k = idx & 1023;
      const float v = (m < 8) ? p.c[m * 1024 + k] : p.c_ctx[k];
      s[idx] = siluf(v);
    }
    __syncthreads();
    const int cc = tid & 63, kq = tid >> 6;
    float acc[9];
#pragma unroll
    for (int m = 0; m < 9; ++m) acc[m] = 0.f;
    const float* W = p.ada_w + (size_t)i * 1024 * 3072 + cb * 64 + cc;
    for (int k = kq * 256; k < kq * 256 + 256; ++k) {
      const float w = W[(size_t)k * 3072];
#pragma unroll
      for (int m = 0; m < 9; ++m) acc[m] += s[m * 1024 + k] * w;
    }
#pragma unroll
    for (int m = 0; m < 9; ++m) red[(kq * 9 + m) * 64 + cc] = acc[m];
    __syncthreads();
    for (int idx = tid; idx < 9 * 64; idx += 256) {
      const int m = idx >> 6, c2 = idx & 63;
      float v = red[(0 * 9 + m) * 64 + c2] + red[(1 * 9 + m) * 64 + c2] + red[(2 * 9 + m) * 64 + c2] + red[(3 * 9 + m) * 64 + c2];
      v += p.ada_b[i * 3072 + cb * 64 + c2];
      p.mod[(size_t)(i * 9 + m) * 3072 + cb * 64 + c2] = v;
    }
  }
}

struct TOp { const float* src; bf* dst; int K, N, Kp, Np, ldd; };
__device__ bool get_op(const Params& p, int i, int op, TOp& o) {
  const int j = i >> 1;
  if (i & 1) {
    if (op == 0) { o = {p.na_w_in + (size_t)j * 1024 * 4096, p.Wp, 1024, 4096, 1024, 4096, LDW}; return true; }
    if (op == 1) { o = {p.na_w_out + (size_t)j * 1024 * 1024, p.Wo, 1024, 1024, 1024, 1024, LDW}; return true; }
    return false;
  }
  if (op < 4) { o = {p.rw_w_rkvg + ((size_t)j * 4 + op) * 1024 * 1024, p.Wp + (size_t)op * 1024 * LDW, 1024, 1024, 1024, 1024, LDW}; return true; }
  if (op < 6) { const int d = op - 4; o = {p.rw_w1 + ((size_t)j * 2 + d) * 1024 * 64, p.Wp + (size_t)(4096 + d * 64) * LDW, 1024, 64, 1024, 64, LDW}; return true; }
  if (op < 8) { const int d = op - 6; o = {p.rw_a1 + ((size_t)j * 2 + d) * 1024 * 64, p.Wp + (size_t)(4224 + d * 64) * LDW, 1024, 64, 1024, 64, LDW}; return true; }
  if (op < 10) { const int d = op - 8; o = {p.rw_w2 + ((size_t)j * 2 + d) * 64 * 1024, p.w2t + (size_t)d * 65536, 64, 1024, 64, 1024, 64}; return true; }
  if (op < 12) { const int d = op - 10; o = {p.rw_a2 + ((size_t)j * 2 + d) * 64 * 1024, p.a2t + (size_t)d * 65536, 64, 1024, 64, 1024, 64}; return true; }
  if (op == 12) { o = {p.rw_w_out + (size_t)j * 1024 * 1024, p.Wo, 1024, 1024, 1024, 1024, LDW}; return true; }
  if (j == 1 && op == 13) { o = {p.rw_v1, p.Wp + (size_t)4352 * LDW, 1024, 32, 1024, 128, LDW}; return true; }
  if (j == 1 && op == 14) { o = {p.rw_v2, p.v2t, 32, 1024, 64, 1024, 64}; return true; }
  return false;
}

__device__ void transpose_phase(const Params& p, int i, char* smem) {
  float* t = (float*)smem;
  const int tid = otid();
  int base = 0;
  for (int op = 0;; ++op) {
    TOp o;
    if (!get_op(p, i, op, o)) break;
    const int tk = o.Kp / 64, tn = o.Np / 64, nt = tk * tn;
    int first = blockIdx.x - (base % (int)gridDim.x);
    if (first < 0) first += gridDim.x;
    for (int g = first; g < nt; g += gridDim.x) {
      const int kt = g / tn, ntile = g % tn;
      __syncthreads();
#pragma unroll
      for (int ps = 0; ps < 4; ++ps) {
        const int kr = ps * 16 + (tid >> 4), c4 = (tid & 15) * 4;
        const int k = kt * 64 + kr, n = ntile * 64 + c4;
        f32x4 v = (f32x4){0.f, 0.f, 0.f, 0.f};
        if (k < o.K && n < o.N) v = *(const f32x4*)(o.src + (size_t)k * o.N + n);
        t[kr * 65 + c4 + 0] = v.x; t[kr * 65 + c4 + 1] = v.y; t[kr * 65 + c4 + 2] = v.z; t[kr * 65 + c4 + 3] = v.w;
      }
      __syncthreads();
      const int n = tid >> 2, kc = (tid & 3) * 16;
      unsigned w[8];
#pragma unroll
      for (int e = 0; e < 8; ++e) w[e] = pk2(t[(kc + 2 * e) * 65 + n], t[(kc + 2 * e + 1) * 65 + n]);
      bf* d = o.dst + (size_t)(ntile * 64 + n) * o.ldd + kt * 64 + kc;
      *(u32x4*)d = (u32x4){w[0], w[1], w[2], w[3]};
      *(u32x4*)(d + 8) = (u32x4){w[4], w[5], w[6], w[7]};
    }
    base += nt;
  }
}

template <bool UPD, bool MKH>
__device__ __forceinline__ void row_phase_t(const Params& p, int i) {
  const int tid = otid(), lane = tid & 63;
  const int gw = blockIdx.x * 4 + (tid >> 6), nw = gridDim.x * 4;
  const int nrows = MKH ? MT : NL;
  for (int row0 = gw; row0 < nrows; row0 += 2 * nw) {
    const bool valid1 = (row0 + nw) < nrows;
    const int rws[2] = {row0, valid1 ? row0 + nw : row0};
    f32x4 xv[2][4];
    u32x2 ou[2][4];
#pragma unroll
    for (int u = 0; u < 2; ++u) {
      const int row = rws[u];
      const float* xs;
      if (i <= 1) xs = (row < NL) ? p.x + (size_t)row * 1024 : p.ctx + (size_t)(row - NL) * 1024;
      else xs = (row < NL) ? p.out + (size_t)row * 1024 : p.ctxbuf + (size_t)(row - NL) * 1024;
#pragma unroll
      for (int q = 0; q < 4; ++q) xv[u][q] = __builtin_nontemporal_load((const f32x4*)(xs + q * 256 + lane * 4));
      if (UPD) {
        const bf* orow = p.R + (size_t)row * 1024;
#pragma unroll
        for (int q = 0; q < 4; ++q) ou[u][q] = __builtin_nontemporal_load((const u32x2*)(orow + q * 256 + lane * 4));
      }
    }
#pragma unroll
    for (int u = 0; u < 2; ++u) {
      const int row = rws[u];
      const bool st = (u == 0) || valid1;
      const int m = mod_idx(row);
      if (UPD) {
        float ov[4][4];
        float ss = 0.f;
#pragma unroll
        for (int q = 0; q < 4; ++q) {
          ov[q][0] = bflo(ou[u][q].x); ov[q][1] = bfhi(ou[u][q].x); ov[q][2] = bflo(ou[u][q].y); ov[q][3] = bfhi(ou[u][q].y);
          ss += ov[q][0] * ov[q][0] + ov[q][1] * ov[q][1] + ov[q][2] * ov[q][2] + ov[q][3] * ov[q][3];
        }
        ss = wave_sum(ss);
        const float rs = rsqrtf(ss * (1.f / 1024.f) + 1e-6f);
        const float* gate = p.mod + (size_t)((i - 1) * 9 + m) * 3072 + 2048;
        const float* pg = p.post_g + (i - 1) * 1024;
        float* xd = (row < NL) ? p.out + (size_t)row * 1024 : p.ctxbuf + (size_t)(row - NL) * 1024;
#pragma unroll
        for (int q = 0; q < 4; ++q) {
          const int col = q * 256 + lane * 4;
          const f32x4 gv = *(const f32x4*)(gate + col);
          const f32x4 pv = *(const f32x4*)(pg + col);
          xv[u][q].x += gv.x * ov[q][0] * rs * pv.x;
          xv[u][q].y += gv.y * ov[q][1] * rs * pv.y;
          xv[u][q].z += gv.z * ov[q][2] * rs * pv.z;
          xv[u][q].w += gv.w * ov[q][3] * rs * pv.w;
          if (st) __builtin_nontemporal_store(xv[u][q], (f32x4*)(xd + col));
        }
      }
      if (MKH) {
        float ss = 0.f;
#pragma unroll
        for (int q = 0; q < 4; ++q) ss += xv[u][q].x * xv[u][q].x + xv[u][q].y * xv[u][q].y + xv[u][q].z * xv[u][q].z + xv[u][q].w * xv[u][q].w;
        ss = wave_sum(ss);
        const float rs = rsqrtf(ss * (1.f / 1024.f) + 1e-6f);
        const float* md = p.mod + (size_t)(i * 9 + m) * 3072;
        const float* pg = p.pre_g + i * 1024;
        bf* hd = p.H + (size_t)row * LDH;
#pragma unroll
        for (int q = 0; q < 4; ++q) {
          const int col = q * 256 + lane * 4;
          const f32x4 sh = *(const f32x4*)(md + col);
          const f32x4 sc = *(const f32x4*)(md + 1024 + col);
          const f32x4 pv = *(const f32x4*)(pg + col);
          const float h0 = xv[u][q].x * rs * pv.x * (1.f + sc.x) + sh.x;
          const float h1 = xv[u][q].y * rs * pv.y * (1.f + sc.y) + sh.y;
          const float h2 = xv[u][q].z * rs * pv.z * (1.f + sc.z) + sh.z;
          const float h3 = xv[u][q].w * rs * pv.w * (1.f + sc.w) + sh.w;
          if (st) *(u32x2*)(hd + col) = (u32x2){pk2(h0, h1), pk2(h2, h3)};
        }
      }
    }
  }
}
__device__ __forceinline__ void row_phase(const Params& p, int i) {
  if (i == 0) row_phase_t<false, true>(p, i);
  else if (i < 4) row_phase_t<true, true>(p, i);
  else row_phase_t<true, false>(p, i);
}

struct EpiRwkvProj {
  static constexpr bool VT = false;
  __device__ __forceinline__ void store_vt(int, int, f32x4, f32x4) const {}
  bf *R, *K, *V, *G, *HID;
  __device__ __forceinline__ bf* xform(int nt, int tok, int col, f32x4& v) const {
    bf* dst;
    if (nt < 8) dst = R + (size_t)tok * 1024 + col;
    else if (nt < 16) dst = K + (size_t)tok * 1024 + (col - 1024);
    else if (nt < 24) dst = V + (size_t)tok * 1024 + (col - 2048);
    else if (nt < 32) {
      dst = G + (size_t)tok * 1024 + (col - 3072);
#pragma unroll
      for (int e = 0; e < 4; ++e) v[e] = siluf(v[e]);
    } else {
      dst = HID + (size_t)tok * HIDW + (col - 4096);
      if (nt == 32) {
#pragma unroll
        for (int e = 0; e < 4; ++e) v[e] = tanh_fast(v[e]);
      }
    }
    return dst;
  }
};
struct EpiNaProj {
  static constexpr bool VT = true;
  bf *Q, *K, *Vt, *G; const float* bias;
  __device__ __forceinline__ void store_vt(int tok, int col, f32x4 lo, f32x4 hi) const {
    const float b = bias[col];
    *(u32x4*)(Vt + (size_t)(col - 2048) * MT + tok) = (u32x4){pk2(lo[0] + b, lo[1] + b), pk2(lo[2] + b, lo[3] + b), pk2(hi[0] + b, hi[1] + b), pk2(hi[2] + b, hi[3] + b)};
  }
  __device__ __forceinline__ bf* xform(int nt, int tok, int col, f32x4& v) const {
    const f32x4 b = *(const f32x4*)(bias + col);
    v[0] += b.x; v[1] += b.y; v[2] += b.z; v[3] += b.w;
    if (nt >= 16 && nt < 24) {
      const int c = col - 2048;
#pragma unroll
      for (int e = 0; e < 4; ++e) Vt[(size_t)(c + e) * MT + tok] = (bf)(pk2(v[e], 0.f) & 0xffffu);
      return nullptr;
    }
    bf* dst;
    if (nt < 8) { dst = Q + (size_t)tok * 1024 + col; v[0] *= 0.125f; v[1] *= 0.125f; v[2] *= 0.125f; v[3] *= 0.125f; }
    else if (nt < 16) dst = K + (size_t)tok * 1024 + (col - 1024);
    else dst = G + (size_t)tok * 1024 + (col - 3072);
    return dst;
  }
};
struct EpiOut {
  static constexpr bool VT = false;
  __device__ __forceinline__ void store_vt(int, int, f32x4, f32x4) const {}
  bf* O;
  __device__ __forceinline__ bf* xform(int nt, int tok, int col, f32x4& v) const { return O + (size_t)tok * 1024 + col; }
};
struct EpiVres {
  static constexpr bool VT = false;
  __device__ __forceinline__ void store_vt(int, int, f32x4, f32x4) const {}
  bf* V2; const bf* VF; const float* v0;
  __device__ __forceinline__ bf* xform(int nt, int tok, int col, f32x4& z) const {
    const f32x4 b = *(const f32x4*)(v0 + col);
    const u32x2 uv = *(const u32x2*)(V2 + (size_t)tok * 1024 + col);
    const u32x2 uf = *(const u32x2*)(VF + (size_t)tok * 1024 + col);
    const float v[4] = {bflo(uv.x), bfhi(uv.x), bflo(uv.y), bfhi(uv.y)};
    const float f[4] = {bflo(uf.x), bfhi(uf.x), bflo(uf.y), bfhi(uf.y)};
    const float zz[4] = {z[0] + b.x, z[1] + b.y, z[2] + b.z, z[3] + b.w};
#pragma unroll
    for (int e = 0; e < 4; ++e) z[e] = v[e] + (f[e] - v[e]) * sigmf(zz[e]);
    return V2 + (size_t)tok * 1024 + col;
  }
};

template <int AMODE, class Epi>
__device__ void gemm_phase(const bf* __restrict__ A, int lda, const bf* __restrict__ Bt, int ldb, int nkt, int mtiles, int ntiles,
                           const float* __restrict__ mu, const Epi& epi, char* smem, bool fake = false) {
  const int tid = otid(), lane = tid & 63, wid = tid >> 6, wr = wid >> 1, wc = wid & 1, fr = lane & 15, fq = lane >> 4;
  const int rg = tid >> 3, cch = tid & 7;
  char* As = smem;
  char* Bs = smem + 32768;
  constexpr int GM = 6;
  const int xcd = blockIdx.x & 7, slot = blockIdx.x >> 3, nslots = gridDim.x >> 3;
  const int per_group = GM * ntiles;
  const int ngroups = (mtiles + GM - 1) / GM;
  const int my_groups = (ngroups - xcd + 7) >> 3;
  const int my_total = my_groups * per_group;
  for (int q = slot; q < my_total; q += nslots) {
    const int gi = q / per_group, e = q - gi * per_group;
    const int nt = e / GM, mt = (xcd + 8 * gi) * GM + (e - nt * GM);
    if (mt >= mtiles) continue;
    const int row0 = mt * 128, col0 = nt * 128;
    const bool vt = Epi::VT && nt >= 16 && nt < 24;
    int lerp = 0; bool sstart = false, send = false;
    if (AMODE == 1) {
      lerp = (nt < 8) ? 0 : (nt < 16) ? 2 : (nt < 24) ? 3 : (nt < 32) ? 5 : (nt == 32) ? 1 : (nt == 33) ? 4 : 3;
      if (row0 < NL) { sstart = (row0 & (SEQ - 1)) == 0; send = ((row0 + 128) & (SEQ - 1)) == 0; }
      else { sstart = ((row0 - NL) & (CTXL - 1)) == 0; send = ((row0 + 128 - NL) & (CTXL - 1)) == 0; }
    }
    f32x4 acc[4][4];
#pragma unroll
    for (int m = 0; m < 4; ++m)
#pragma unroll
      for (int n = 0; n < 4; ++n) acc[m][n] = (f32x4){0.f, 0.f, 0.f, 0.f};
    u32x4 ra[6];
    f32x4 muv[2];
    auto glds_tile = [&](const bf* G, int ld, int grow0, int kt, char* ldsbase, bool perm) {
#pragma unroll
      for (int pc = 0; pc < 4; ++pc) {
        const int row = wid * 32 + pc * 8 + (lane >> 3), cp = lane & 7, c = cp ^ ((row >> 1) & 7);
        const int srow = perm ? ((row & ~31) | (8 * ((row & 15) >> 2) + 4 * ((row >> 4) & 1) + (row & 3))) : row;
        const bf* src = G + (size_t)(grow0 + srow) * ld + kt * 64 + c * 8;
        __builtin_amdgcn_global_load_lds((const __attribute__((address_space(1))) void*)src,
                                         (__attribute__((address_space(3))) void*)(ldsbase + row * 128 + cp * 16), 16, 0, 0);
      }
    };
    auto gloadA = [&](int kt) {
      const int kc = kt * 64 + cch * 8;
#pragma unroll
      for (int i = 0; i < 6; ++i) {
        const int r = row0 + rg * 4 + i - 1;
        const bool zero = (i == 0 && rg == 0 && sstart) || (i == 5 && rg == 31 && send);
        ra[i] = zero ? (u32x4){0, 0, 0, 0} : *(const u32x4*)(A + (size_t)r * lda + kc);
      }
      muv[0] = *(const f32x4*)(mu + lerp * 1024 + kc);
      muv[1] = *(const f32x4*)(mu + lerp * 1024 + kc + 4);
    };
    auto lstoreA = [&](int buf) {
      char* a = As + buf * 16384;
#pragma unroll
      for (int i = 0; i < 4; ++i) {
        const u32x4 hm = ra[i], h0 = ra[i + 1], hp = ra[i + 2];
        u32x4 o;
        o.x = lerp2(hm.x, h0.x, hp.x, muv[0].x, muv[0].y);
        o.y = lerp2(hm.y, h0.y, hp.y, muv[0].z, muv[0].w);
        o.z = lerp2(hm.z, h0.z, hp.z, muv[1].x, muv[1].y);
        o.w = lerp2(hm.w, h0.w, hp.w, muv[1].z, muv[1].w);
        *(u32x4*)(a + lds_off(rg * 4 + i, cch)) = o;
      }
    };
    lds_barrier();
    glds_tile(Bt, ldb, col0, 0, Bs, !vt);
    if (AMODE == 0) glds_tile(A, lda, row0, 0, As, vt);
    else { gloadA(0); lstoreA(0); }
    asm volatile("s_waitcnt vmcnt(0)" ::: "memory");
    lds_barrier();
    for (int kt = 0; kt < nkt; ++kt) {
      const int buf = kt & 1;
      if (!fake && kt + 1 < nkt) {
        glds_tile(Bt, ldb, col0, kt + 1, Bs + (buf ^ 1) * 16384, !vt);
        if (AMODE == 0) glds_tile(A, lda, row0, kt + 1, As + (buf ^ 1) * 16384, vt);
        else gloadA(kt + 1);
      }
      const char* a = As + buf * 16384;
      const char* b = Bs + buf * 16384;
#pragma unroll
      for (int ks = 0; ks < 2; ++ks) {
        bf16x8 af[4], bfr[4];
#pragma unroll
        for (int m = 0; m < 4; ++m) af[m] = *(const bf16x8*)(a + lds_off(wr * 64 + m * 16 + fr, ks * 4 + fq));
#pragma unroll
        for (int n = 0; n < 4; ++n) bfr[n] = *(const bf16x8*)(b + lds_off(wc * 64 + n * 16 + fr, ks * 4 + fq));
        __builtin_amdgcn_s_setprio(1);
        if (Epi::VT && vt) {
#pragma unroll
          for (int m = 0; m < 4; ++m)
#pragma unroll
            for (int n = 0; n < 4; ++n) acc[m][n] = __builtin_amdgcn_mfma_f32_16x16x32_bf16(af[m], bfr[n], acc[m][n], 0, 0, 0);
        } else {
#pragma unroll
          for (int m = 0; m < 4; ++m)
#pragma unroll
            for (int n = 0; n < 4; ++n) acc[m][n] = __builtin_amdgcn_mfma_f32_16x16x32_bf16(bfr[n], af[m], acc[m][n], 0, 0, 0);
        }
        __builtin_amdgcn_s_setprio(0);
      }
      if (AMODE == 1 && kt + 1 < nkt) lstoreA(buf ^ 1);
      asm volatile("s_waitcnt vmcnt(0)" ::: "memory");
      lds_barrier();
    }
    if (Epi::VT && vt) {
#pragma unroll
      for (int n = 0; n < 4; ++n)
#pragma unroll
        for (int pp = 0; pp < 2; ++pp)
          epi.store_vt(row0 + wr * 64 + pp * 32 + fq * 8, col0 + wc * 64 + n * 16 + fr, acc[2 * pp][n], acc[2 * pp + 1][n]);
      continue;
    }
#pragma unroll
    for (int m = 0; m < 4; ++m)
#pragma unroll
      for (int q2 = 0; q2 < 2; ++q2) {
        const int tok = row0 + wr * 64 + m * 16 + fr, col = col0 + wc * 64 + q2 * 32 + fq * 8;
        f32x4 lo = acc[m][2 * q2], hi = acc[m][2 * q2 + 1];
        bf* d0 = epi.xform(nt, tok, col, lo);
        bf* d1 = epi.xform(nt, tok, col + 4, hi);
        (void)d1;
        if (d0) __builtin_nontemporal_store((u32x4){pk2(lo[0], lo[1]), pk2(lo[2], lo[3]), pk2(hi[0], hi[1]), pk2(hi[2], hi[3])}, (u32x4*)d0);
      }
  }
}

typedef float f32x2 __attribute__((ext_vector_type(2)));
__device__ __forceinline__ float oct_sum(float v) {
  int t = __builtin_amdgcn_update_dpp(0, __float_as_int(v), 0xB1, 0xF, 0xF, true);
  v += __int_as_float(t);
  t = __builtin_amdgcn_update_dpp(0, __float_as_int(v), 0x4E, 0xF, 0xF, true);
  v += __int_as_float(t);
  t = __builtin_amdgcn_update_dpp(0, __float_as_int(v), 0x141, 0xF, 0xF, true);
  v += __int_as_float(t);
  return v;
}
__device__ __forceinline__ f32x2 fma2(f32x2 a, f32x2 b, f32x2 c) { return __builtin_elementwise_fma(a, b, c); }
__device__ __forceinline__ float fma_s(float a, float b, float c) { float d; asm("v_fma_f32 %0, %1, %2, %3" : "=v"(d) : "v"(a), "v"(b), "v"(c)); return d; }
__device__ __forceinline__ float mul_s(float a, float b) { float d; asm("v_mul_f32 %0, %1, %2" : "=v"(d) : "v"(a), "v"(b)); return d; }
struct ScanOps { f32x4 w[2], nk[2], bb[2], kd[2], rr[2]; f32x2 vv; };
__device__ __forceinline__ ScanOps scan_load(const float* ops, const float* vs, int t, int kq, int vrow) {
  ScanOps r;
  const float* o = ops + t * 320 + kq * 8;
  r.w[0] = *(const f32x4*)(o); r.w[1] = *(const f32x4*)(o + 4);
  r.nk[0] = *(const f32x4*)(o + 64); r.nk[1] = *(const f32x4*)(o + 68);
  r.bb[0] = *(const f32x4*)(o + 128); r.bb[1] = *(const f32x4*)(o + 132);
  r.kd[0] = *(const f32x4*)(o + 192); r.kd[1] = *(const f32x4*)(o + 196);
  r.rr[0] = *(const f32x4*)(o + 256); r.rr[1] = *(const f32x4*)(o + 260);
  r.vv = *(const f32x2*)(vs + t * 64 + vrow);
  return r;
}
#define PR(v, i) ((f32x2){(v)[(i) >> 1][((i) & 1) * 2], (v)[(i) >> 1][((i) & 1) * 2 + 1]})

constexpr int SC_P = 0, SC_YA = 8192, SC_V = 16384, SC_AT = 24576, SC_RT = SC_AT + 4352, SC_BT = SC_RT + 4352, SC_KT = SC_BT + 4352;
constexpr int SC_BTT = 41984, SC_KTT = SC_BTT + 4608, SC_MABT = 51200, SC_SM = 53248;
__device__ __forceinline__ bf16x8 mk8(u32x2 lo, u32x2 hi) { u32x4 u = (u32x4){lo.x, lo.y, hi.x, hi.y}; return __builtin_bit_cast(bf16x8, u); }
__device__ __forceinline__ bf16x8 mk4(u32x2 lo) { u32x4 u = (u32x4){lo.x, lo.y, 0u, 0u}; return __builtin_bit_cast(bf16x8, u); }
__device__ __forceinline__ float bfround(float x) { return bflo(pk2(x, 0.f) & 0xffffu); }
__device__ __forceinline__ void split4(f32x4 x, u32x2& hi, u32x2& lo) {
  hi = (u32x2){pk2(x[0], x[1]), pk2(x[2], x[3])};
  const float r0 = x[0] - bflo(hi.x), r1 = x[1] - bfhi(hi.x), r2 = x[2] - bflo(hi.y), r3 = x[3] - bfhi(hi.y);
  lo = (u32x2){pk2(r0, r1), pk2(r2, r3)};
}

__device__ void scan_phase(const Params& p, int j, char* smem) {
  const int tid = otid(), lane = tid & 63, wid = tid >> 6, fr = lane & 15, fq = lane >> 4;
  float* Pbuf = (float*)(smem + SC_P);
  float* abuf = (float*)(smem + SC_YA);
  float* ys = (float*)(smem + SC_YA);
  float* vs = (float*)(smem + SC_V);
  for (int item = blockIdx.x; item < 256; item += gridDim.x) {
  const int b = item >> 5, h = (item >> 1) & 15, d = item & 1;
  lds_barrier();
  const bf* Vsrc = (j == 0) ? p.VF : p.V2;
  bf* Ydst = (d == 0) ? p.H : p.Y1;
  const int ldy = (d == 0) ? LDH : 1024;
  float* betad = p.beta + (size_t)d * MT * 16;
  bf16x8 bw[2], ba[2];
  {
    const int n = h * 64 + wid * 16 + fr;
#pragma unroll
    for (int ks = 0; ks < 2; ++ks) {
      bw[ks] = *(const bf16x8*)(p.w2t + (size_t)d * 65536 + (size_t)n * 64 + ks * 32 + fq * 8);
      ba[ks] = *(const bf16x8*)(p.a2t + (size_t)d * 65536 + (size_t)n * 64 + ks * 32 + fq * 8);
    }
  }
  float w0v[4], a0v[4];
#pragma unroll
  for (int e = 0; e < 4; ++e) {
    w0v[e] = p.rw_w0[(size_t)(j * 2 + d) * 1024 + h * 64 + wid * 16 + fq * 4 + e];
    a0v[e] = p.rw_a0[(size_t)(j * 2 + d) * 1024 + h * 64 + wid * 16 + fq * 4 + e];
  }
  const int tt = tid >> 3, c8 = tid & 7;
  float kkv[8], kav[8], rkv[8];
#pragma unroll
  for (int e = 0; e < 8; ++e) {
    kkv[e] = p.rw_k_k[j * 1024 + h * 64 + c8 * 8 + e];
    kav[e] = p.rw_k_a[j * 1024 + h * 64 + c8 * 8 + e];
    rkv[e] = p.rw_r_k[j * 1024 + h * 64 + c8 * 8 + e];
  }
  f32x4 ST[4];
#pragma unroll
  for (int kt = 0; kt < 4; ++kt) ST[kt] = (f32x4){0.f, 0.f, 0.f, 0.f};

  bf16x8 phw[2][2], pha[2][2];
  u32x4 puk, pur, puv;
  auto rowbase_of = [&](int ch, int& sgn) -> int {
    if (d == 0) { sgn = 1; return (ch < 8) ? NL + b * CTXL + ch * 32 : b * SEQ + (ch - 8) * 32; }
    sgn = -1; return (ch < 8) ? NL + b * CTXL + 255 - ch * 32 : b * SEQ + 8191 - (ch - 8) * 32;
  };
  auto prefetch = [&](int ch) {
    int sgn; const int rowbase = rowbase_of(ch, sgn);
#pragma unroll
    for (int m = 0; m < 2; ++m) {
      const size_t row = (size_t)(rowbase + sgn * (m * 16 + fr));
#pragma unroll
      for (int ks = 0; ks < 2; ++ks) {
        phw[m][ks] = *(const bf16x8*)(p.HID + row * HIDW + d * 64 + ks * 32 + fq * 8);
        pha[m][ks] = *(const bf16x8*)(p.HID + row * HIDW + 128 + d * 64 + ks * 32 + fq * 8);
      }
    }
    const size_t off = (size_t)(rowbase + sgn * tt) * 1024 + h * 64 + c8 * 8;
    puk = *(const u32x4*)(p.K + off);
    pur = *(const u32x4*)(p.R + off);
    puv = *(const u32x4*)(Vsrc + off);
  };
  prefetch(0);

  for (int ch = 0; ch < 264; ++ch) {
    int sgn; const int rowbase = rowbase_of(ch, sgn);
#pragma unroll
    for (int m = 0; m < 2; ++m) {
      const int tok = m * 16 + fr;
      f32x4 aw = (f32x4){0.f, 0.f, 0.f, 0.f}, aa = aw;
#pragma unroll
      for (int ks = 0; ks < 2; ++ks) {
        aw = __builtin_amdgcn_mfma_f32_16x16x32_bf16(bw[ks], phw[m][ks], aw, 0, 0, 0);
        aa = __builtin_amdgcn_mfma_f32_16x16x32_bf16(ba[ks], pha[m][ks], aa, 0, 0, 0);
      }
      f32x4 wd, av;
#pragma unroll
      for (int e = 0; e < 4; ++e) {
        const float ez = __expf(-(w0v[e] + aw[e]));
        wd[e] = __expf(-0.60653066f * __builtin_amdgcn_rcpf(1.f + ez));
        av[e] = __builtin_amdgcn_rcpf(1.f + __expf(-(a0v[e] + aa[e])));
      }
#pragma unroll
      for (int e = 0; e < 4; ++e) {
        float x = wd[e];
        x *= __int_as_float(__builtin_amdgcn_update_dpp(0x3f800000, __float_as_int(x), 0x111, 0xF, 0xF, false));
        x *= __int_as_float(__builtin_amdgcn_update_dpp(0x3f800000, __float_as_int(x), 0x112, 0xF, 0xF, false));
        x *= __int_as_float(__builtin_amdgcn_update_dpp(0x3f800000, __float_as_int(x), 0x114, 0xF, 0xF, false));
        x *= __int_as_float(__builtin_amdgcn_update_dpp(0x3f800000, __float_as_int(x), 0x118, 0xF, 0xF, false));
        wd[e] = x;
      }
      *(f32x4*)(Pbuf + tok * 64 + wid * 16 + fq * 4) = wd;
      *(f32x4*)(abuf + tok * 64 + wid * 16 + fq * 4) = av;
    }
    lds_barrier();
    {
      const size_t row = (size_t)(rowbase + sgn * tt);
      float k[8], r[8], kk[8];
#pragma unroll
      for (int e = 0; e < 4; ++e) {
        k[2 * e] = bflo(puk[e]); k[2 * e + 1] = bfhi(puk[e]);
        r[2 * e] = bflo(pur[e]); r[2 * e + 1] = bfhi(pur[e]);
      }
      float ss = 0.f;
#pragma unroll
      for (int e = 0; e < 8; ++e) { kk[e] = k[e] * kkv[e]; ss += kk[e] * kk[e]; }
      ss = oct_sum(ss);
      const float inv = __builtin_amdgcn_rsqf(fmaxf(ss, 1e-24f));
      const f32x4 a0 = *(const f32x4*)(abuf + tt * 64 + c8 * 8), a1 = *(const f32x4*)(abuf + tt * 64 + c8 * 8 + 4);
      const f32x4 p0 = *(const f32x4*)(Pbuf + tt * 64 + c8 * 8), p1 = *(const f32x4*)(Pbuf + tt * 64 + c8 * 8 + 4);
      f32x4 q0 = (f32x4){1.f, 1.f, 1.f, 1.f}, q1 = q0;
      if (tt & 15) { q0 = *(const f32x4*)(Pbuf + (tt - 1) * 64 + c8 * 8); q1 = *(const f32x4*)(Pbuf + (tt - 1) * 64 + c8 * 8 + 4); }
      const float a[8] = {a0.x, a0.y, a0.z, a0.w, a1.x, a1.y, a1.z, a1.w};
      const float Pt[8] = {p0.x, p0.y, p0.z, p0.w, p1.x, p1.y, p1.z, p1.w};
      const float Pm[8] = {q0.x, q0.y, q0.z, q0.w, q1.x, q1.y, q1.z, q1.w};
      float at[8], bt_[8], kt_[8], rt[8];
      float bsum = 0.f;
#pragma unroll
      for (int e = 0; e < 8; ++e) {
        const float kkn = kk[e] * inv;
        const float kd = k[e] * (1.f + (a[e] - 1.f) * kav[e]);
        bsum += r[e] * kd * rkv[e];
        const float ip = __builtin_amdgcn_rcpf(Pt[e]);
        at[e] = -kkn * Pm[e];
        bt_[e] = kkn * a[e] * ip;
        kt_[e] = kd * ip;
        rt[e] = r[e] * Pt[e];
      }
      bsum = oct_sum(bsum);
      if (c8 == 0) betad[row * 16 + h] = bsum;
      char* ro = smem + tt * 136 + c8 * 16;
      *(u32x2*)(ro + SC_AT) = (u32x2){pk2(at[0], at[1]), pk2(at[2], at[3])};   *(u32x2*)(ro + SC_AT + 8) = (u32x2){pk2(at[4], at[5]), pk2(at[6], at[7])};
      *(u32x2*)(ro + SC_RT) = (u32x2){pk2(rt[0], rt[1]), pk2(rt[2], rt[3])};   *(u32x2*)(ro + SC_RT + 8) = (u32x2){pk2(rt[4], rt[5]), pk2(rt[6], rt[7])};
      *(u32x2*)(ro + SC_BT) = (u32x2){pk2(bt_[0], bt_[1]), pk2(bt_[2], bt_[3])}; *(u32x2*)(ro + SC_BT + 8) = (u32x2){pk2(bt_[4], bt_[5]), pk2(bt_[6], bt_[7])};
      *(u32x2*)(ro + SC_KT) = (u32x2){pk2(kt_[0], kt_[1]), pk2(kt_[2], kt_[3])}; *(u32x2*)(ro + SC_KT + 8) = (u32x2){pk2(kt_[4], kt_[5]), pk2(kt_[6], kt_[7])};
#pragma unroll
      for (int e = 0; e < 8; ++e) {
        *(bf*)(smem + SC_BTT + (c8 * 8 + e) * 72 + tt * 2) = (bf)(pk2(bt_[e], 0.f) & 0xffffu);
        *(bf*)(smem + SC_KTT + (c8 * 8 + e) * 72 + tt * 2) = (bf)(pk2(kt_[e], 0.f) & 0xffffu);
      }
      *(f32x4*)(vs + tt * 64 + c8 * 8) = (f32x4){bflo(puv[0]), bfhi(puv[0]), bflo(puv[1]), bfhi(puv[1])};
      *(f32x4*)(vs + tt * 64 + c8 * 8 + 4) = (f32x4){bflo(puv[2]), bfhi(puv[2]), bflo(puv[3]), bfhi(puv[3])};
    }
    lds_barrier();
    if (ch + 1 < 264) prefetch(ch + 1);
    {
      auto gram = [&](int xbase, int ybase, int sc) -> f32x4 {
        f32x4 acc = (f32x4){0.f, 0.f, 0.f, 0.f};
#pragma unroll
        for (int ks = 0; ks < 2; ++ks) {
          const char* xp = smem + xbase + (sc * 16 + fr) * 136 + ks * 64 + fq * 16;
          const char* yp = smem + ybase + (sc * 16 + fr) * 136 + ks * 64 + fq * 16;
          const bf16x8 xf = mk8(*(const u32x2*)xp, *(const u32x2*)(xp + 8));
          const bf16x8 yf = mk8(*(const u32x2*)yp, *(const u32x2*)(yp + 8));
          acc = __builtin_amdgcn_mfma_f32_16x16x32_bf16(xf, yf, acc, 0, 0, 0);
        }
        return acc;
      };
      auto store_small = [&](f32x4 g, int sc, int kind, bool strict) {
#pragma unroll
        for (int e = 0; e < 4; ++e) { const int sidx = fq * 4 + e; const bool keep = strict ? (sidx < fr) : (sidx <= fr); g[e] = keep ? g[e] : 0.f; }
        *(u32x2*)(smem + SC_SM + (sc * 5 + kind) * 640 + fr * 40 + fq * 8) = (u32x2){pk2(g[0], g[1]), pk2(g[2], g[3])};
      };
      if (wid < 2) {
        const int sc = wid;
        f32x4 g = gram(SC_BT, SC_AT, sc);
#pragma unroll
        for (int e = 0; e < 4; ++e) g[e] = (fq * 4 + e < fr) ? g[e] : 0.f;
        *(f32x4*)(smem + SC_MABT + sc * 1024 + fr * 64 + fq * 16) = g;
        asm volatile("s_waitcnt lgkmcnt(0)" ::: "memory");
        if (lane < 16) {
          float n[16];
#pragma unroll
          for (int t = 0; t < 16; ++t) {
            const float* mc = (const float*)(smem + SC_MABT + sc * 1024 + t * 64);
            float acc = (t == lane) ? 1.f : 0.f;
#pragma unroll
            for (int sp = 0; sp < t; ++sp) acc = fmaf(n[sp], mc[sp], acc);
            n[t] = acc;
          }
#pragma unroll
          for (int t = 0; t < 16; ++t) {
            const unsigned hi = pk2(n[t], 0.f) & 0xffffu;
            const unsigned lo = pk2(n[t] - bflo(hi), 0.f) & 0xffffu;
            *(bf*)(smem + SC_SM + (sc * 5 + 0) * 640 + t * 40 + lane * 2) = (bf)hi;
            *(bf*)(smem + SC_SM + (sc * 5 + 1) * 640 + t * 40 + lane * 2) = (bf)lo;
          }
        }
      } else {
        const int sc = wid - 2;
        store_small(gram(SC_KT, SC_AT, sc), sc, 2, true);
        store_small(gram(SC_BT, SC_RT, sc), sc, 3, false);
        store_small(gram(SC_KT, SC_RT, sc), sc, 4, false);
      }
    }
    lds_barrier();
#pragma unroll
    for (int sc = 0; sc < 2; ++sc) {
      bf16x8 shi[2], slo[2];
#pragma unroll
      for (int g = 0; g < 2; ++g) {
        u32x2 h0, l0, h1, l1;
        split4(ST[2 * g], h0, l0); split4(ST[2 * g + 1], h1, l1);
        shi[g] = mk8(h0, h1); slo[g] = mk8(l0, l1);
      }
      const char* arow = smem + SC_AT + (sc * 16 + fr) * 136 + fq * 8;
      const char* rrow = smem + SC_RT + (sc * 16 + fr) * 136 + fq * 8;
      f32x4 wt = (f32x4){0.f, 0.f, 0.f, 0.f}, yt = wt;
#pragma unroll
      for (int g = 0; g < 2; ++g) {
        const bf16x8 xa = mk8(*(const u32x2*)(arow + g * 64), *(const u32x2*)(arow + g * 64 + 32));
        const bf16x8 xr = mk8(*(const u32x2*)(rrow + g * 64), *(const u32x2*)(rrow + g * 64 + 32));
        wt = __builtin_amdgcn_mfma_f32_16x16x32_bf16(xa, shi[g], wt, 0, 0, 0);
        wt = __builtin_amdgcn_mfma_f32_16x16x32_bf16(xa, slo[g], wt, 0, 0, 0);
        yt = __builtin_amdgcn_mfma_f32_16x16x32_bf16(xr, shi[g], yt, 0, 0, 0);
        yt = __builtin_amdgcn_mfma_f32_16x16x32_bf16(xr, slo[g], yt, 0, 0, 0);
      }
      const int vcol = wid * 16 + fr;
      const float* vp = vs + (sc * 16 + fq * 4) * 64 + vcol;
      const bf16x8 vmf = mk4((u32x2){pk2(vp[0], vp[64]), pk2(vp[128], vp[192])});
      const char* smb = smem + SC_SM + sc * 5 * 640 + fr * 40 + fq * 8;
      const bf16x8 xnh = mk4(*(const u32x2*)(smb)), xnl = mk4(*(const u32x2*)(smb + 640));
      const bf16x8 xmak = mk4(*(const u32x2*)(smb + 2 * 640)), xmrb = mk4(*(const u32x2*)(smb + 3 * 640)), xmrk = mk4(*(const u32x2*)(smb + 4 * 640));
      wt = __builtin_amdgcn_mfma_f32_16x16x32_bf16(xmak, vmf, wt, 0, 0, 0);
      u32x2 whi, wlo;
      split4(wt, whi, wlo);
      f32x4 ut = (f32x4){0.f, 0.f, 0.f, 0.f};
      ut = __builtin_amdgcn_mfma_f32_16x16x32_bf16(xnh, mk4(whi), ut, 0, 0, 0);
      ut = __builtin_amdgcn_mfma_f32_16x16x32_bf16(xnh, mk4(wlo), ut, 0, 0, 0);
      ut = __builtin_amdgcn_mfma_f32_16x16x32_bf16(xnl, mk4(whi), ut, 0, 0, 0);
      u32x2 uhi, ulo;
      split4(ut, uhi, ulo);
      const bf16x8 uhf = mk4(uhi), ulf = mk4(ulo);
      yt = __builtin_amdgcn_mfma_f32_16x16x32_bf16(xmrb, uhf, yt, 0, 0, 0);
      yt = __builtin_amdgcn_mfma_f32_16x16x32_bf16(xmrb, ulf, yt, 0, 0, 0);
      yt = __builtin_amdgcn_mfma_f32_16x16x32_bf16(xmrk, vmf, yt, 0, 0, 0);
#pragma unroll
      for (int e = 0; e < 4; ++e) ys[(sc * 16 + fq * 4 + e) * 64 + vcol] = yt[e];
#pragma unroll
      for (int kt = 0; kt < 4; ++kt) {
        const bf16x8 xb = mk4(*(const u32x2*)(smem + SC_BTT + (kt * 16 + fr) * 72 + (sc * 16 + fq * 4) * 2));
        const bf16x8 xk = mk4(*(const u32x2*)(smem + SC_KTT + (kt * 16 + fr) * 72 + (sc * 16 + fq * 4) * 2));
        ST[kt] = __builtin_amdgcn_mfma_f32_16x16x32_bf16(xb, uhf, ST[kt], 0, 0, 0);
        ST[kt] = __builtin_amdgcn_mfma_f32_16x16x32_bf16(xb, ulf, ST[kt], 0, 0, 0);
        ST[kt] = __builtin_amdgcn_mfma_f32_16x16x32_bf16(xk, vmf, ST[kt], 0, 0, 0);
        const f32x4 pc = *(const f32x4*)(Pbuf + (sc * 16 + 15) * 64 + kt * 16 + fq * 4);
        ST[kt] = ST[kt] * pc;
      }
    }
    lds_barrier();
    {
      const size_t row = (size_t)(rowbase + sgn * tt);
      const f32x4 y0 = *(const f32x4*)(ys + tt * 64 + c8 * 8), y1 = *(const f32x4*)(ys + tt * 64 + c8 * 8 + 4);
      *(u32x4*)(Ydst + row * ldy + h * 64 + c8 * 8) = (u32x4){pk2(y0.x, y0.y), pk2(y0.z, y0.w), pk2(y1.x, y1.y), pk2(y1.z, y1.w)};
    }
    lds_barrier();
  }
  }
}

__device__ void og_phase(const Params& p, int j) {
  const int tid = otid(), lane = tid & 63;
  const int gw = blockIdx.x * 4 + (tid >> 6), nw = gridDim.x * 4;
  const bf* Vsrc = (j == 0) ? p.VF : p.V2;
  const int col = lane * 16, hh = lane >> 2;
  float lw[16], lb[16];
#pragma unroll
  for (int e = 0; e < 16; ++e) { lw[e] = p.rw_lnx_w[j * 1024 + col + e]; lb[e] = p.rw_lnx_b[j * 1024 + col + e]; }
  for (int row = gw; row < MT; row += nw) {
    const size_t off = (size_t)row * 1024 + col, offh = (size_t)row * LDH + col;
    u32x4 u0[2], u1[2], uv[2], ug[2];
#pragma unroll
    for (int q = 0; q < 2; ++q) {
      u0[q] = __builtin_nontemporal_load((const u32x4*)(p.H + offh + q * 8));
      u1[q] = __builtin_nontemporal_load((const u32x4*)(p.Y1 + off + q * 8));
      uv[q] = __builtin_nontemporal_load((const u32x4*)(Vsrc + off + q * 8));
      ug[q] = __builtin_nontemporal_load((const u32x4*)(p.G + off + q * 8));
    }
    const float bsum = p.beta[(size_t)row * 16 + hh] + p.beta[(size_t)MT * 16 + (size_t)row * 16 + hh];
    float y[16], v[16], g[16];
    float s = 0.f;
#pragma unroll
    for (int e = 0; e < 8; ++e) {
      y[2 * e] = bflo(u0[e >> 2][e & 3]) + bflo(u1[e >> 2][e & 3]); y[2 * e + 1] = bfhi(u0[e >> 2][e & 3]) + bfhi(u1[e >> 2][e & 3]);
      v[2 * e] = bflo(uv[e >> 2][e & 3]); v[2 * e + 1] = bfhi(uv[e >> 2][e & 3]);
      g[2 * e] = bflo(ug[e >> 2][e & 3]); g[2 * e + 1] = bfhi(ug[e >> 2][e & 3]);
      s += y[2 * e] + y[2 * e + 1];
    }
    s = quad_sum(s);
    const float mean = s * (1.f / 64.f);
    float q2 = 0.f;
#pragma unroll
    for (int e = 0; e < 16; ++e) { const float dd = y[e] - mean; q2 += dd * dd; }
    q2 = quad_sum(q2);
    const float rstd = rsqrtf(q2 * (1.f / 64.f) + 64e-5f);
    unsigned o[8];
#pragma unroll
    for (int e = 0; e < 8; ++e) {
      const float r0 = ((y[2 * e] - mean) * rstd * lw[2 * e] + lb[2 * e] + bsum * v[2 * e]) * g[2 * e];
      const float r1 = ((y[2 * e + 1] - mean) * rstd * lw[2 * e + 1] + lb[2 * e + 1] + bsum * v[2 * e + 1]) * g[2 * e + 1];
      o[e] = pk2(r0, r1);
    }
    *(u32x4*)(p.H + offh) = (u32x4){o[0], o[1], o[2], o[3]};
    *(u32x4*)(p.H + offh + 8) = (u32x4){o[4], o[5], o[6], o[7]};
  }
}

__device__ void attn_phase(const Params& p, int j, bool ctx_out, char* smem) {
  const int tid = otid(), lane = tid & 63, cgp = tid >> 6, fr = lane & 15, fq = lane >> 4;
  char* Ks = smem;
  bf* Vs = (bf*)smem;
  float* rpbs = (float*)(smem + 36864);
  const bf* Q = p.R; const bf* Kb = p.K; const bf* Vt = p.V2; const bf* Gb = p.G;
  const int nitems = 16384 + (ctx_out ? 512 : 0);
  for (int item = blockIdx.x; item < nitems; item += gridDim.x) {
    int b, h, r = 0, qrow0; bool haswin;
    if (item < 16384) { h = item & 15; r = (item >> 4) & 127; b = item >> 11; haswin = true; qrow0 = b * SEQ + r * 64; }
    else { const int it = item - 16384; h = it & 15; const int qb = (it >> 4) & 3; b = it >> 6; haswin = false; qrow0 = NL + b * CTXL + qb * 64; }
    const int qtok = qrow0 + cgp * 16 + fr;
    bf16x8 qf[2];
#pragma unroll
    for (int ks = 0; ks < 2; ++ks) qf[ks] = *(const bf16x8*)(Q + (size_t)qtok * 1024 + h * 64 + ks * 32 + fq * 8);
    const int rs = min(max(r - 4, 0), 120);
    const int qcol = cgp * 16 + fr;
    const int wsq = min(max(qcol - 8, 0), 48);
    const int bs = min(max(16 * cgp - 8, 0), 32);
    lds_barrier();
    if (haswin) for (int idx = tid; idx < 465; idx += 256) rpbs[idx] = p.na_rpb[((size_t)j * 16 + h) * 465 + idx];
    f32x4 sw[8][2], sc[4][4];
    bf16x8 pw[8];
    float m1 = NEGV, l1 = 0.f;
#pragma unroll
    for (int i = 0; i < 8; ++i) pw[i] = (bf16x8){0, 0, 0, 0, 0, 0, 0, 0};
#pragma unroll
    for (int i = 0; i < 8; ++i)
#pragma unroll
      for (int k2 = 0; k2 < 2; ++k2) sw[i][k2] = (f32x4){NEGV, NEGV, NEGV, NEGV};
#pragma unroll
    for (int st = 0; st < 3; ++st) {
      if (st < 2 && !haswin) continue;
      lds_barrier();
      int tq = tid; asm volatile("" : "+v"(tq));
#pragma unroll
      for (int hf = 0; hf < 2; ++hf) {
        u32x4 u[4];
#pragma unroll
        for (int i = 0; i < 4; ++i) {
          const int q = tq + (hf * 4 + i) * 256, key = q >> 3, c = q & 7, tl = key >> 6;
          const int base = (st < 2) ? b * SEQ + (rs + st * 4 + tl) * 64 : NL + b * CTXL + tl * 64;
          u[i] = *(const u32x4*)(Kb + (size_t)(base + (key & 63)) * 1024 + h * 64 + c * 8);
        }
#pragma unroll
        for (int i = 0; i < 4; ++i) {
          const int q = tq + (hf * 4 + i) * 256, key = q >> 3, c = q & 7;
          *(u32x4*)(Ks + lds_off(key, c)) = u[i];
        }
        __builtin_amdgcn_sched_barrier(0);
      }
      lds_barrier();
      if (st < 2) {
#pragma unroll
        for (int tl = 0; tl < 4; ++tl) {
          const int i = st * 4 + tl;
          const int dr = rs + i - r + 7;
#pragma unroll
          for (int k2 = 0; k2 < 2; ++k2) {
            f32x4 acc = (f32x4){0.f, 0.f, 0.f, 0.f};
#pragma unroll
            for (int ks = 0; ks < 2; ++ks) {
              const bf16x8 kf = *(const bf16x8*)(Ks + lds_off(tl * 64 + bs + k2 * 16 + fr, ks * 4 + fq));
              acc = __builtin_amdgcn_mfma_f32_16x16x32_bf16(kf, qf[ks], acc, 0, 0, 0);
            }
#pragma unroll
            for (int e = 0; e < 4; ++e) {
              const int kc = bs + k2 * 16 + fq * 4 + e;
              const bool valid = (kc >= wsq) && (kc < wsq + 16);
              const int dc = min(max(kc - qcol, -15), 15) + 15;
              sw[i][k2][e] = valid ? acc[e] + rpbs[dr * 31 + dc] : NEGV;
            }
          }
          __builtin_amdgcn_sched_barrier(0);
        }
      } else {
#pragma unroll
        for (int tl = 0; tl < 4; ++tl)
#pragma unroll
          for (int k4 = 0; k4 < 4; ++k4) {
            f32x4 acc = (f32x4){0.f, 0.f, 0.f, 0.f};
#pragma unroll
            for (int ks = 0; ks < 2; ++ks) {
              const bf16x8 kf = *(const bf16x8*)(Ks + lds_off(tl * 64 + k4 * 16 + fr, ks * 4 + fq));
              acc = __builtin_amdgcn_mfma_f32_16x16x32_bf16(kf, qf[ks], acc, 0, 0, 0);
            }
            sc[tl][k4] = acc;
            if (k4 & 1) __builtin_amdgcn_sched_barrier(0);
          }
      }
      if (st == 1) {
#pragma unroll
        for (int i = 0; i < 8; ++i)
#pragma unroll
          for (int k2 = 0; k2 < 2; ++k2)
#pragma unroll
            for (int e = 0; e < 4; ++e) m1 = fmaxf(m1, sw[i][k2][e]);
        m1 = fmaxf(m1, __shfl_xor(m1, 16));
        m1 = fmaxf(m1, __shfl_xor(m1, 32));
#pragma unroll
        for (int i = 0; i < 8; ++i) {
          float e0[4], e1[4];
#pragma unroll
          for (int e = 0; e < 4; ++e) { e0[e] = __expf(sw[i][0][e] - m1); e1[e] = __expf(sw[i][1][e] - m1); l1 += e0[e] + e1[e]; }
          u32x4 u = (u32x4){pk2(e0[0], e0[1]), pk2(e0[2], e0[3]), pk2(e1[0], e1[1]), pk2(e1[2], e1[3])};
          pw[i] = __builtin_bit_cast(bf16x8, u);
        }
        l1 += __shfl_xor(l1, 16);
        l1 += __shfl_xor(l1, 32);
      }
    }
    float m2 = NEGV;
#pragma unroll
    for (int tl = 0; tl < 4; ++tl)
#pragma unroll
      for (int k4 = 0; k4 < 4; ++k4)
#pragma unroll
        for (int e = 0; e < 4; ++e) m2 = fmaxf(m2, sc[tl][k4][e]);
    m2 = fmaxf(m2, __shfl_xor(m2, 16));
    m2 = fmaxf(m2, __shfl_xor(m2, 32));
    const float mx = fmaxf(m1, m2);
    const float alpha1 = __expf(m1 - mx);
    float l2 = 0.f;
    bf16x8 pc[4][2];
#pragma unroll
    for (int tl = 0; tl < 4; ++tl)
#pragma unroll
      for (int g2 = 0; g2 < 2; ++g2) {
        float e0[4], e1[4];
#pragma unroll
        for (int e = 0; e < 4; ++e) { e0[e] = __expf(sc[tl][2 * g2][e] - mx); e1[e] = __expf(sc[tl][2 * g2 + 1][e] - mx); l2 += e0[e] + e1[e]; }
        u32x4 u = (u32x4){pk2(e0[0], e0[1]), pk2(e0[2], e0[3]), pk2(e1[0], e1[1]), pk2(e1[2], e1[3])};
        pc[tl][g2] = __builtin_bit_cast(bf16x8, u);
      }
    l2 += __shfl_xor(l2, 16);
    l2 += __shfl_xor(l2, 32);
    const float l = alpha1 * l1 + l2;
    f32x4 o[4];
#pragma unroll
    for (int dt = 0; dt < 4; ++dt) o[dt] = (f32x4){0.f, 0.f, 0.f, 0.f};
#pragma unroll
    for (int st = 0; st < 3; ++st) {
      if (st < 2 && !haswin) continue;
      lds_barrier();
      int tq = tid; asm volatile("" : "+v"(tq));
#pragma unroll
      for (int hf = 0; hf < 2; ++hf) {
        u32x4 u[4];
#pragma unroll
        for (int i = 0; i < 4; ++i) {
          const int q = tq + (hf * 4 + i) * 256, tl = q >> 9, dd = (q >> 3) & 63, c = q & 7;
          const int base = (st < 2) ? b * SEQ + (rs + st * 4 + tl) * 64 : NL + b * CTXL + tl * 64;
          u[i] = *(const u32x4*)(Vt + (size_t)(h * 64 + dd) * MT + base + c * 8);
        }
#pragma unroll
        for (int i = 0; i < 4; ++i) {
          const int q = tq + (hf * 4 + i) * 256, tl = q >> 9, dd = (q >> 3) & 63, c = q & 7;
          *(u32x4*)(Vs + tl * 4608 + dd * 72 + c * 8) = u[i];
        }
        __builtin_amdgcn_sched_barrier(0);
      }
      lds_barrier();
      if (st < 2) {
#pragma unroll
        for (int tl = 0; tl < 4; ++tl) {
          const int i = st * 4 + tl;
#pragma unroll
          for (int dt = 0; dt < 4; ++dt) {
            const bf* vp = Vs + tl * 4608 + (dt * 16 + fr) * 72 + bs + fq * 4;
            const u32x2 lo = *(const u32x2*)vp, hi = *(const u32x2*)(vp + 16);
            u32x4 u = (u32x4){lo.x, lo.y, hi.x, hi.y};
            o[dt] = __builtin_amdgcn_mfma_f32_16x16x32_bf16(__builtin_bit_cast(bf16x8, u), pw[i], o[dt], 0, 0, 0);
          }
          __builtin_amdgcn_sched_barrier(0);
        }
      } else {
#pragma unroll
        for (int tl = 0; tl < 4; ++tl)
#pragma unroll
          for (int g2 = 0; g2 < 2; ++g2)
#pragma unroll
            for (int dt = 0; dt < 4; ++dt) {
              const bf* vp = Vs + tl * 4608 + (dt * 16 + fr) * 72 + g2 * 32 + fq * 4;
              const u32x2 lo = *(const u32x2*)vp, hi = *(const u32x2*)(vp + 16);
              u32x4 u = (u32x4){lo.x, lo.y, hi.x, hi.y};
              o[dt] = __builtin_amdgcn_mfma_f32_16x16x32_bf16(__builtin_bit_cast(bf16x8, u), pc[tl][g2], o[dt], 0, 0, 0);
              if (dt == 3) __builtin_amdgcn_sched_barrier(0);
            }
      }
      if (st == 1) {
#pragma unroll
        for (int dt = 0; dt < 4; ++dt) o[dt] *= alpha1;
      }
    }
    const float inv = 1.f / l;
#pragma unroll
    for (int dt = 0; dt < 4; ++dt) {
      const size_t off = (size_t)qtok * 1024 + h * 64 + dt * 16 + fq * 4;
      const u32x2 ug = *(const u32x2*)(Gb + off);
      const float g0 = bflo(ug.x), g1 = bfhi(ug.x), g2 = bflo(ug.y), g3 = bfhi(ug.y);
      *(u32x2*)(p.H + (size_t)qtok * LDH + h * 64 + dt * 16 + fq * 4) = (u32x2){pk2(o[dt][0] * inv * siluf(g0), o[dt][1] * inv * siluf(g1)),
                                        pk2(o[dt][2] * inv * siluf(g2), o[dt][3] * inv * siluf(g3))};
    }
  }
}


#define XB_TMO      128
#define XB_XCNT(j)  (256  + 64 * (j))
#define XB_XSUB(j)  (1280 + 64 * (j))
#define XB_XGEN(j)  (2304 + 64 * (j))
#define XB_TOP      3328
#define XB_TOPGEN   3392
#define XCD_BAR_WORDS 3456
#define XB_SPIN_CAP (1u << 18)
__device__ __forceinline__ unsigned xb_ld(unsigned* q) { return __hip_atomic_load(q, __ATOMIC_RELAXED, __HIP_MEMORY_SCOPE_AGENT); }
__device__ __forceinline__ unsigned xb_add(unsigned* q, unsigned v) { return __hip_atomic_fetch_add(q, v, __ATOMIC_RELAXED, __HIP_MEMORY_SCOPE_AGENT); }
__device__ __forceinline__ unsigned xb_xcc_id() { return (unsigned)__builtin_amdgcn_s_getreg((3 << 11) | 20) & 0xFu; }
#define XB_SPIN(cond, bar) do { unsigned _sp = 0; while (cond) { __builtin_amdgcn_s_sleep(1); \
    if ((++_sp & 255u) == 0u) { if (xb_ld(&(bar)[XB_TMO])) break; if (_sp > XB_SPIN_CAP) { atomicAdd(&(bar)[XB_TMO], 1u); break; } } } } while (0)
struct XcdBarrier { unsigned* bar; unsigned x, nloc, nx; };
__device__ __forceinline__ void xcd_barrier(const XcdBarrier& b) {
  asm volatile("s_waitcnt vmcnt(0)" ::: "memory");
  __syncthreads();
  if (threadIdx.x == 0) {
    unsigned* bar = b.bar;
    __builtin_amdgcn_s_waitcnt(0);
    const unsigned nloc = b.nloc, nx = b.nx;
    const unsigned old = xb_add(&bar[XB_XSUB(b.x)], 1u);
    const unsigned gen = old / nloc;
    if (old + 1u == (gen + 1u) * nloc) {
      __builtin_amdgcn_fence(__ATOMIC_RELEASE, "agent");
      asm volatile("s_waitcnt vmcnt(0)" ::: "memory");
      const unsigned og = xb_add(&bar[XB_TOP], 1u);
      const unsigned tg = og / nx;
      if (og + 1u == (tg + 1u) * nx) xb_add(&bar[XB_TOPGEN], 1u);
      else XB_SPIN(xb_ld(&bar[XB_TOPGEN]) == tg, bar);
      __builtin_amdgcn_fence(__ATOMIC_ACQUIRE, "agent");
      xb_add(&bar[XB_XGEN(b.x)], 1u);
      asm volatile("s_waitcnt vmcnt(0)" ::: "memory");
    } else {
      XB_SPIN(xb_ld(&bar[XB_XGEN(b.x)]) == gen, bar);
      __builtin_amdgcn_fence(__ATOMIC_ACQUIRE, "agent");
      asm volatile("s_waitcnt vmcnt(0)" ::: "memory");
    }
  }
  __syncthreads();
}

#ifndef DUP_SCAN
#define DUP_SCAN 0
#endif
#ifndef DUP_ATTN
#define DUP_ATTN 0
#endif
#ifndef DUP_GEMM
#define DUP_GEMM 0
#endif
#ifndef MULTI_LAUNCH
#define MULTI_LAUNCH 0
#endif
__device__ __forceinline__ bool step_exists(int i, int s) {
  if (s == 2) return i == 2;
  if (s == 4) return (i & 1) == 0;
  return true;
}
__device__ __forceinline__ void run_step(const Params& p, int i, int s, char* smem) {
  asm volatile("" : "+s"(i));
  const int j = i >> 1;
  if (s == 0) { transpose_phase(p, i, smem); row_phase(p, i); }
  else if (s == 1) {
    if ((i & 1) == 0) {
      EpiRwkvProj ep{p.R, p.K, (j == 0) ? p.VF : p.V2, p.G, p.HID};
#pragma unroll 1
      for (int rep = PROBE_GEMM ? 0 : 1; rep < 2; ++rep)
      gemm_phase<1>(p.H, LDH, p.Wp, LDW, 16, MT / 128, (j == 0) ? 34 : 35, p.rw_mu + (size_t)j * 6 * 1024, ep, smem, rep == 0);
    } else {
      EpiNaProj ep{p.R, p.K, p.V2, p.G, p.na_b_in + (size_t)j * 4096};
#pragma unroll 1
      for (int rep = PROBE_GEMM ? 0 : 1; rep < 2; ++rep)
      gemm_phase<0>(p.H, LDH, p.Wp, LDW, 16, MT / 128, 32, nullptr, ep, smem, rep == 0);
    }
  } else if (s == 2) {
    EpiVres ev{p.V2, p.VF, p.rw_v0};
    gemm_phase<0>(p.HID + 256, HIDW, p.v2t, 64, 1, MT / 128, 8, nullptr, ev, smem);
  } else if (s == 3) {
    if ((i & 1) == 0) scan_phase(p, j, smem);
    else attn_phase(p, j, i != 3, smem);
  } else if (s == 4) {
    og_phase(p, j);
  } else {
    EpiOut eo{p.R};
#pragma unroll 1
    for (int rep = PROBE_GEMM ? 0 : 1; rep < 2; ++rep)
    gemm_phase<0>(p.H, LDH, p.Wo, LDW, 16, (i == 3) ? NL / 128 : MT / 128, 8, nullptr, eo, smem, rep == 0);
  }
}

__global__ void __launch_bounds__(256, 2) fwd_megakernel(Params p0) {
  __shared__ __attribute__((aligned(16))) char smem[SMEM_BYTES];
  cg::grid_group grid = cg::this_grid();
  XcdBarrier xb;
  xb.bar = p0.bar; xb.x = xb_xcc_id(); xb.nloc = 0u; xb.nx = 0u;
  if (threadIdx.x == 0) (void)xb_add(&xb.bar[XB_XCNT(xb.x)], 1u);
  pre_phase(p0, smem);
  grid.sync();
  {
    unsigned cnt = 0u, mine = 0u;
#pragma unroll 1
    for (unsigned jj = 0; jj < 16; ++jj) { const unsigned c = xb_ld(&xb.bar[XB_XCNT(jj)]); cnt += (c > 0u) ? 1u : 0u; mine = (jj == xb.x) ? c : mine; }
    xb.nloc = mine > 0u ? mine : 1u; xb.nx = cnt > 0u ? cnt : 1u;
  }
  const Params& p = p0;
#pragma unroll 1
  for (int i = 0; i < 4; ++i) {
#pragma unroll 1
    for (int s = 0; s < 6; ++s) {
      if (!step_exists(i, s)) continue;
      int reps = 1;
      if (DUP_SCAN && s == 3 && (i & 1) == 0) reps = 2;
      if (DUP_ATTN && s == 3 && (i & 1) == 1) reps = 2;
      if (DUP_GEMM && (s == 1 || s == 5)) reps = 2;
#pragma unroll 1
      for (int rep = 0; rep < reps; ++rep) {
        run_step(p, i, s, smem);
        xcd_barrier(xb);
      }
    }
  }
  row_phase(p, 4);
}

#if MULTI_LAUNCH
template <int S> __global__ void __launch_bounds__(256, 2) step_kernel(Params p0, int i) {
  __shared__ __attribute__((aligned(16))) char smem[SMEM_BYTES];
  if (S == -1) { pre_phase(p0, smem); return; }
  if (S == 6) { row_phase(p0, 4); return; }
  run_step(p0, i, S, smem);
}
#endif

extern "C" void kernel_launch(void* const* d_in, const int* in_sizes, int n_in, void* d_out, int out_size, void* d_ws, size_t ws_size,
                              hipStream_t stream) {
  static int grid_blocks = 0;
  if (!grid_blocks) {
    int dev = 0, cus = 0, per_cu = 0;
    hipGetDevice(&dev);
    hipDeviceGetAttribute(&cus, hipDeviceAttributeMultiprocessorCount, dev);
    hipOccupancyMaxActiveBlocksPerMultiprocessor(&per_cu, fwd_megakernel, 256, 0);
    if (per_cu > 2) per_cu = 2;
    if (per_cu < 1) per_cu = 1;
    grid_blocks = cus * per_cu;
  }
  Params p{};
  const float** f = (const float**)&p;
  for (int i = 0; i < 29; ++i) f[i] = (const float*)d_in[i];
  p.out = (float*)d_out;
  char* w = (char*)d_ws;
  size_t off = 0;
  auto take = [&](size_t bytes) { char* r = w + off; off += (bytes + 255) & ~(size_t)255; return r; };
  p.gp = (Params*)take(sizeof(Params));
  p.bar = (unsigned*)take((size_t)XCD_BAR_WORDS * 4);
  p.mod = (float*)take((size_t)4 * 9 * 3072 * 4);
  p.ctxbuf = (float*)take((size_t)NC * 1024 * 4);
  p.beta = (float*)take((size_t)2 * MT * 16 * 4);
  p.Wp = (bf*)take((size_t)4480 * LDW * 2);
  p.Wo = (bf*)take((size_t)1024 * LDW * 2);
  p.w2t = (bf*)take((size_t)2 * 65536 * 2);
  p.a2t = (bf*)take((size_t)2 * 65536 * 2);
  p.v2t = (bf*)take((size_t)65536 * 2);
  const size_t big = (size_t)MT * 1024 * 2;
  p.H = (bf*)take((size_t)MT * LDH * 2); p.R = (bf*)take(big); p.K = (bf*)take(big); p.VF = (bf*)take(big);
  p.V2 = (bf*)take(big); p.G = (bf*)take(big); p.Y1 = (bf*)take(big);
  p.HID = (bf*)take((size_t)MT * HIDW * 2);
  if (off > ws_size) fprintf(stderr, "workspace too small: need %zu have %zu\n", off, ws_size);
#if MULTI_LAUNCH
  step_kernel<-1><<<grid_blocks, 256, 0, stream>>>(p, 0);
  for (int i = 0; i < 4; ++i) {
    step_kernel<0><<<grid_blocks, 256, 0, stream>>>(p, i);
    step_kernel<1><<<grid_blocks, 256, 0, stream>>>(p, i);
    if (i == 2) step_kernel<2><<<grid_blocks, 256, 0, stream>>>(p, i);
    step_kernel<3><<<grid_blocks, 256, 0, stream>>>(p, i);
    if ((i & 1) == 0) step_kernel<4><<<grid_blocks, 256, 0, stream>>>(p, i);
    step_kernel<5><<<grid_blocks, 256, 0, stream>>>(p, i);
  }
  step_kernel<6><<<grid_blocks, 256, 0, stream>>>(p, 0);
#else
  (void)hipMemsetAsync(p.bar, 0, (size_t)XCD_BAR_WORDS * 4, stream);
  void* args[] = {&p};
  hipError_t e = hipLaunchCooperativeKernel((void*)fwd_megakernel, dim3(grid_blocks), dim3(256), args, 0, stream);
  if (e != hipSuccess) fprintf(stderr, "cooperative launch failed: %s (grid %d)\n", hipGetErrorString(e), grid_blocks);
#endif
}
```

```cpp
#include <hip/hip_runtime.h>
#include <hip/hip_cooperative_groups.h>
#include <cstdint>
#include <cstdio>
namespace cg = cooperative_groups;

typedef unsigned short bf;
typedef short bf16x8 __attribute__((ext_vector_type(8)));
typedef float f32x4 __attribute__((ext_vector_type(4)));
typedef unsigned u32x4 __attribute__((ext_vector_type(4)));
typedef unsigned u32x2 __attribute__((ext_vector_type(2)));

constexpr int DM = 1024, NB = 8, SEQ = 8192, NL = NB * SEQ, CTXL = 256, NC = NB * CTXL, MT = NL + NC;
constexpr int HIDW = 384;
constexpr int LDH = 1088, LDW = 1088;
constexpr int SMEM_BYTES = 65536;
#define NEGV (-1e30f)
#ifndef PROBE_GEMM
#define PROBE_GEMM 0
#endif

struct Params {
  const float *x, *c, *ctx, *c_ctx, *ada_w, *ada_b, *pre_g, *post_g, *rw_mu, *rw_w_rkvg, *rw_w0, *rw_w1, *rw_w2,
      *rw_a0, *rw_a1, *rw_a2, *rw_v0, *rw_v1, *rw_v2, *rw_k_k, *rw_k_a, *rw_r_k, *rw_lnx_w, *rw_lnx_b, *rw_w_out,
      *na_w_in, *na_b_in, *na_rpb, *na_w_out;
  float* out;
  float *mod, *ctxbuf, *beta;
  bf *Wp, *Wo, *w2t, *a2t, *v2t;
  bf *H, *R, *K, *VF, *V2, *G, *Y1, *HID;
  Params* gp;
  unsigned* bar;
};

__device__ __forceinline__ float bflo(unsigned w) { return __uint_as_float(w << 16); }
__device__ __forceinline__ float bfhi(unsigned w) { return __uint_as_float(w & 0xffff0000u); }
typedef __bf16 bf16x2_t __attribute__((ext_vector_type(2)));
__device__ __forceinline__ unsigned pk2(float lo, float hi) {
  bf16x2_t v = {(__bf16)lo, (__bf16)hi};
  return __builtin_bit_cast(unsigned, v);
}
__device__ __forceinline__ float siluf(float v) { return v * __builtin_amdgcn_rcpf(1.f + __expf(-v)); }
__device__ __forceinline__ float sigmf(float v) { return __builtin_amdgcn_rcpf(1.f + __expf(-v)); }
__device__ __forceinline__ float tanh_fast(float v) { return 1.f - 2.f * __builtin_amdgcn_rcpf(1.f + __expf(2.f * v)); }
__device__ __forceinline__ float quad_sum(float v) {
  int t = __builtin_amdgcn_update_dpp(0, __float_as_int(v), 0xB1, 0xF, 0xF, true);
  v += __int_as_float(t);
  t = __builtin_amdgcn_update_dpp(0, __float_as_int(v), 0x4E, 0xF, 0xF, true);
  v += __int_as_float(t);
  return v;
}
__device__ __forceinline__ float wave_sum(float v) {
#pragma unroll
  for (int o = 32; o >= 1; o >>= 1) v += __shfl_xor(v, o);
  return v;
}
__device__ __forceinline__ int otid() { int t = threadIdx.x; asm volatile("" : "+v"(t)); return t; }
__device__ __forceinline__ void lds_barrier() { asm volatile("s_waitcnt lgkmcnt(0)\n\ts_barrier" ::: "memory"); }
__device__ __forceinline__ int lds_off(int row, int c) { return row * 128 + ((c ^ ((row >> 1) & 7)) << 4); }
__device__ __forceinline__ unsigned lerp2(unsigned hm, unsigned h0, unsigned hp, float m0, float m1) {
  const float c0 = bflo(h0), c1 = bfhi(h0);
  const float x0 = 0.5f * (bflo(hm) + bflo(hp)) - c0;
  const float x1 = 0.5f * (bfhi(hm) + bfhi(hp)) - c1;
  return pk2(c0 + x0 * m0, c1 + x1 * m1);
}
__device__ __forceinline__ int mod_idx(int row) { return row < NL ? (row >> 13) : 8; }

__device__ void pre_phase(const Params& p, char* smem) {
  float* s = (float*)smem;
  float* red = s + 9 * 1024;
  const int tid = otid();
  for (int item = blockIdx.x; item < 4 * 48; item += gridDim.x) {
    const int i = item / 48, cb = item % 48;
    __syncthreads();
    for (int idx = tid; idx < 9 * 1024; idx += 256) {
      const int m = idx >> 10, k = idx & 1023;
      const float v = (m < 8) ? p.c[m * 1024 + k] : p.c_ctx[k];
      s[idx] = siluf(v);
    }
    __syncthreads();
    const int cc = tid & 63, kq = tid >> 6;
    float acc[9];
#pragma unroll
    for (int m = 0; m < 9; ++m) acc[m] = 0.f;
    const float* W = p.ada_w + (size_t)i * 1024 * 3072 + cb * 64 + cc;
    for (int k = kq * 256; k < kq * 256 + 256; ++k) {
      const float w = W[(size_t)k * 3072];
#pragma unroll
      for (int m = 0; m < 9; ++m) acc[m] += s[m * 1024 + k] * w;
    }
#pragma unroll
    for (int m = 0; m < 9; ++m) red[(kq * 9 + m) * 64 + cc] = acc[m];
    __syncthreads();
    for (int idx = tid; idx < 9 * 64; idx += 256) {
      const int m = idx >> 6, c2 = idx & 63;
      float v = red[(0 * 9 + m) * 64 + c2] + red[(1 * 9 + m) * 64 + c2] + red[(2 * 9 + m) * 64 + c2] + red[(3 * 9 + m) * 64 + c2];
      v += p.ada_b[i * 3072 + cb * 64 + c2];
      p.mod[(size_t)(i * 9 + m) * 3072 + cb * 64 + c2] = v;
    }
  }
}

struct TOp { const float* src; bf* dst; int K, N, Kp, Np, ldd; };
__device__ bool get_op(const Params& p, int i, int op, TOp& o) {
  const int j = i >> 1;
  if (i & 1) {
    if (op == 0) { o = {p.na_w_in + (size_t)j * 1024 * 4096, p.Wp, 1024, 4096, 1024, 4096, LDW}; return true; }
    if (op == 1) { o = {p.na_w_out + (size_t)j * 1024 * 1024, p.Wo, 1024, 1024, 1024, 1024, LDW}; return true; }
    return false;
  }
  if (op < 4) { o = {p.rw_w_rkvg + ((size_t)j * 4 + op) * 1024 * 1024, p.Wp + (size_t)op * 1024 * LDW, 1024, 1024, 1024, 1024, LDW}; return true; }
  if (op < 6) { const int d = op - 4; o = {p.rw_w1 + ((size_t)j * 2 + d) * 1024 * 64, p.Wp + (size_t)(4096 + d * 64) * LDW, 1024, 64, 1024, 64, LDW}; return true; }
  if (op < 8) { const int d = op - 6; o = {p.rw_a1 + ((size_t)j * 2 + d) * 1024 * 64, p.Wp + (size_t)(4224 + d * 64) * LDW, 1024, 64, 1024, 64, LDW}; return true; }
  if (op < 10) { const int d = op - 8; o = {p.rw_w2 + ((size_t)j * 2 + d) * 64 * 1024, p.w2t + (size_t)d * 65536, 64, 1024, 64, 1024, 64}; return true; }
  if (op < 12) { const int d = op - 10; o = {p.rw_a2 + ((size_t)j * 2 + d) * 64 * 1024, p.a2t + (size_t)d * 65536, 64, 1024, 64, 1024, 64}; return true; }
  if (op == 12) { o = {p.rw_w_out + (size_t)j * 1024 * 1024, p.Wo, 1024, 1024, 1024, 1024, LDW}; return true; }
  if (j == 1 && op == 13) { o = {p.rw_v1, p.Wp + (size_t)4352 * LDW, 1024, 32, 1024, 128, LDW}; return true; }
  if (j == 1 && op == 14) { o = {p.rw_v2, p.v2t, 32, 1024, 64, 1024, 64}; return true; }
  return false;
}

__device__ void transpose_phase(const Params& p, int i, char* smem) {
  float* t = (float*)smem;
  const int tid = otid();
  int base = 0;
  for (int op = 0;; ++op) {
    TOp o;
    if (!get_op(p, i, op, o)) break;
    const int tk = o.Kp / 64, tn = o.Np / 64, nt = tk * tn;
    int first = blockIdx.x - (base % (int)gridDim.x);
    if (first < 0) first += gridDim.x;
    for (int g = first; g < nt; g += gridDim.x) {
      const int kt = g / tn, ntile = g % tn;
      __syncthreads();
#pragma unroll
      for (int ps = 0; ps < 4; ++ps) {
        const int kr = ps * 16 + (tid >> 4), c4 = (tid & 15) * 4;
        const int k = kt * 64 + kr, n = ntile * 64 + c4;
        f32x4 v = (f32x4){0.f, 0.f, 0.f, 0.f};
        if (k < o.K && n < o.N) v = *(const f32x4*)(o.src + (size_t)k * o.N + n);
        t[kr * 65 + c4 + 0] = v.x; t[kr * 65 + c4 + 1] = v.y; t[kr * 65 + c4 + 2] = v.z; t[kr * 65 + c4 + 3] = v.w;
      }
      __syncthreads();
      const int n = tid >> 2, kc = (tid & 3) * 16;
      unsigned w[8];
#pragma unroll
      for (int e = 0; e < 8; ++e) w[e] = pk2(t[(kc + 2 * e) * 65 + n], t[(kc + 2 * e + 1) * 65 + n]);
      bf* d = o.dst + (size_t)(ntile * 64 + n) * o.ldd + kt * 64 + kc;
      *(u32x4*)d = (u32x4){w[0], w[1], w[2], w[3]};
      *(u32x4*)(d + 8) = (u32x4){w[4], w[5], w[6], w[7]};
    }
    base += nt;
  }
}

template <bool UPD, bool MKH>
__device__ __forceinline__ void row_phase_t(const Params& p, int i) {
  const int tid = otid(), lane = tid & 63;
  const int gw = blockIdx.x * 4 + (tid >> 6), nw = gridDim.x * 4;
  const int nrows = MKH ? MT : NL;
  for (int row0 = gw; row0 < nrows; row0 += 2 * nw) {
    const bool valid1 = (row0 + nw) < nrows;
    const int rws[2] = {row0, valid1 ? row0 + nw : row0};
    f32x4 xv[2][4];
    u32x2 ou[2][4];
#pragma unroll
    for (int u = 0; u < 2; ++u) {
      const int row = rws[u];
      const float* xs;
      if (i <= 1) xs = (row < NL) ? p.x + (size_t)row * 1024 : p.ctx + (size_t)(row - NL) * 1024;
      else xs = (row < NL) ? p.out + (size_t)row * 1024 : p.ctxbuf + (size_t)(row - NL) * 1024;
#pragma unroll
      for (int q = 0; q < 4; ++q) xv[u][q] = __builtin_nontemporal_load((const f32x4*)(xs + q * 256 + lane * 4));
      if (UPD) {
        const bf* orow = p.R + (size_t)row * 1024;
#pragma unroll
        for (int q = 0; q < 4; ++q) ou[u][q] = __builtin_nontemporal_load((const u32x2*)(orow + q * 256 + lane * 4));
      }
    }
#pragma unroll
    for (int u = 0; u < 2; ++u) {
      const int row = rws[u];
      const bool st = (u == 0) || valid1;
      const int m = mod_idx(row);
      if (UPD) {
        float ov[4][4];
        float ss = 0.f;
#pragma unroll
        for (int q = 0; q < 4; ++q) {
          ov[q][0] = bflo(ou[u][q].x); ov[q][1] = bfhi(ou[u][q].x); ov[q][2] = bflo(ou[u][q].y); ov[q][3] = bfhi(ou[u][q].y);
          ss += ov[q][0] * ov[q][0] + ov[q][1] * ov[q][1] + ov[q][2] * ov[q][2] + ov[q][3] * ov[q][3];
        }
        ss = wave_sum(ss);
        const float rs = rsqrtf(ss * (1.f / 1024.f) + 1e-6f);
        const float* gate = p.mod + (size_t)((i - 1) * 9 + m) * 3072 + 2048;
        const float* pg = p.post_g + (i - 1) * 1024;
        float* xd = (row < NL) ? p.out + (size_t)row * 1024 : p.ctxbuf + (size_t)(row - NL) * 1024;
#pragma unroll
        for (int q = 0; q < 4; ++q) {
          const int col = q * 256 + lane * 4;
          const f32x4 gv = *(const f32x4*)(gate + col);
          const f32x4 pv = *(const f32x4*)(pg + col);
          xv[u][q].x += gv.x * ov[q][0] * rs * pv.x;
          xv[u][q].y += gv.y * ov[q][1] * rs * pv.y;
          xv[u][q].z += gv.z * ov[q][2] * rs * pv.z;
          xv[u][q].w += gv.w * ov[q][3] * rs * pv.w;
          if (st) __builtin_nontemporal_store(xv[u][q], (f32x4*)(xd + col));
        }
      }
      if (MKH) {
        float ss = 0.f;
#pragma unroll
        for (int q = 0; q < 4; ++q) ss += xv[u][q].x * xv[u][q].x + xv[u][q].y * xv[u][q].y + xv[u][q].z * xv[u][q].z + xv[u][q].w * xv[u][q].w;
        ss = wave_sum(ss);
        const float rs = rsqrtf(ss * (1.f / 1024.f) + 1e-6f);
        const float* md = p.mod + (size_t)(i * 9 + m) * 3072;
        const float* pg = p.pre_g + i * 1024;
        bf* hd = p.H + (size_t)row * LDH;
#pragma unroll
        for (int q = 0; q < 4; ++q) {
          const int col = q * 256 + lane * 4;
          const f32x4 sh = *(const f32x4*)(md + col);
          const f32x4 sc = *(const f32x4*)(md + 1024 + col);
          const f32x4 pv = *(const f32x4*)(pg + col);
          const float h0 = xv[u][q].x * rs * pv.x * (1.f + sc.x) + sh.x;
          const float h1 = xv[u][q].y * rs * pv.y * (1.f + sc.y) + sh.y;
          const float h2 = xv[u][q].z * rs * pv.z * (1.f + sc.z) + sh.z;
          const float h3 = xv[u][q].w * rs * pv.w * (1.f + sc.w) + sh.w;
          if (st) *(u32x2*)(hd + col) = (u32x2){pk2(h0, h1), pk2(h2, h3)};
        }
      }
    }
  }
}
__device__ __forceinline__ void row_phase(const Params& p, int i) {
  if (i == 0) row_phase_t<false, true>(p, i);
  else if (i < 4) row_phase_t<true, true>(p, i);
  else row_phase_t<true, false>(p, i);
}

struct EpiRwkvProj {
  static constexpr bool VT = false;
  __device__ __forceinline__ void store_vt(int, int, f32x4, f32x4) const {}
  bf *R, *K, *V, *G, *HID;
  __device__ __forceinline__ bf* xform(int nt, int tok, int col, f32x4& v) const {
    bf* dst;
    if (nt < 8) dst = R + (size_t)tok * 1024 + col;
    else if (nt < 16) dst = K + (size_t)tok * 1024 + (col - 1024);
    else if (nt < 24) dst = V + (size_t)tok * 1024 + (col - 2048);
    else if (nt < 32) {
      dst = G + (size_t)tok * 1024 + (col - 3072);
#pragma unroll
      for (int e = 0; e < 4; ++e) v[e] = siluf(v[e]);
    } else {
      dst = HID + (size_t)tok * HIDW + (col - 4096);
      if (nt == 32) {
#pragma unroll
        for (int e = 0; e < 4; ++e) v[e] = tanh_fast(v[e]);
      }
    }
    return dst;
  }
};
struct EpiNaProj {
  static constexpr bool VT = true;
  bf *Q, *K, *Vt, *G; const float* bias;
  __device__ __forceinline__ void store_vt(int tok, int col, f32x4 lo, f32x4 hi) const {
    const float b = bias[col];
    *(u32x4*)(Vt + (size_t)(col - 2048) * MT + tok) = (u32x4){pk2(lo[0] + b, lo[1] + b), pk2(lo[2] + b, lo[3] + b), pk2(hi[0] + b, hi[1] + b), pk2(hi[2] + b, hi[3] + b)};
  }
  __device__ __forceinline__ bf* xform(int nt, int tok, int col, f32x4& v) const {
    const f32x4 b = *(const f32x4*)(bias + col);
    v[0] += b.x; v[1] += b.y; v[2] += b.z; v[3] += b.w;
    if (nt >= 16 && nt < 24) {
      const int c = col - 2048;
#pragma unroll
      for (int e = 0; e < 4; ++e) Vt[(size_t)(c + e) * MT + tok] = (bf)(pk2(v[e], 0.f) & 0xffffu);
      return nullptr;
    }
    bf* dst;
    if (nt < 8) { dst = Q + (size_t)tok * 1024 + col; v[0] *= 0.125f; v[1] *= 0.125f; v[2] *= 0.125f; v[3] *= 0.125f; }
    else if (nt < 16) dst = K + (size_t)tok * 1024 + (col - 1024);
    else dst = G + (size_t)tok * 1024 + (col - 3072);
    return dst;
  }
};
struct EpiOut {
  static constexpr bool VT = false;
  __device__ __forceinline__ void store_vt(int, int, f32x4, f32x4) const {}
  bf* O;
  __device__ __forceinline__ bf* xform(int nt, int tok, int col, f32x4& v) const { return O + (size_t)tok * 1024 + col; }
};
struct EpiVres {
  static constexpr bool VT = false;
  __device__ __forceinline__ void store_vt(int, int, f32x4, f32x4) const {}
  bf* V2; const bf* VF; const float* v0;
  __device__ __forceinline__ bf* xform(int nt, int tok, int col, f32x4& z) const {
    const f32x4 b = *(const f32x4*)(v0 + col);
    const u32x2 uv = *(const u32x2*)(V2 + (size_t)tok * 1024 + col);
    const u32x2 uf = *(const u32x2*)(VF + (size_t)tok * 1024 + col);
    const float v[4] = {bflo(uv.x), bfhi(uv.x), bflo(uv.y), bfhi(uv.y)};
    const float f[4] = {bflo(uf.x), bfhi(uf.x), bflo(uf.y), bfhi(uf.y)};
    const float zz[4] = {z[0] + b.x, z[1] + b.y, z[2] + b.z, z[3] + b.w};
#pragma unroll
    for (int e = 0; e < 4; ++e) z[e] = v[e] + (f[e] - v[e]) * sigmf(zz[e]);
    return V2 + (size_t)tok * 1024 + col;
  }
};

template <int AMODE, class Epi>
__device__ void gemm_phase(const bf* __restrict__ A, int lda, const bf* __restrict__ Bt, int ldb, int nkt, int mtiles, int ntiles,
                           const float* __restrict__ mu, const Epi& epi, char* smem, bool fake = false) {
  const int tid = otid(), lane = tid & 63, wid = tid >> 6, wr = wid >> 1, wc = wid & 1, fr = lane & 15, fq = lane >> 4;
  const int rg = tid >> 3, cch = tid & 7;
  char* As = smem;
  char* Bs = smem + 32768;
  constexpr int GM = 6;
  const int xcd = blockIdx.x & 7, slot = blockIdx.x >> 3, nslots = gridDim.x >> 3;
  const int per_group = GM * ntiles;
  const int ngroups = (mtiles + GM - 1) / GM;
  const int my_groups = (ngroups - xcd + 7) >> 3;
  const int my_total = my_groups * per_group;
  for (int q = slot; q < my_total; q += nslots) {
    const int gi = q / per_group, e = q - gi * per_group;
    const int nt = e / GM, mt = (xcd + 8 * gi) * GM + (e - nt * GM);
    if (mt >= mtiles) continue;
    const int row0 = mt * 128, col0 = nt * 128;
    const bool vt = Epi::VT && nt >= 16 && nt < 24;
    int lerp = 0; bool sstart = false, send = false;
    if (AMODE == 1) {
      lerp = (nt < 8) ? 0 : (nt < 16) ? 2 : (nt < 24) ? 3 : (nt < 32) ? 5 : (nt == 32) ? 1 : (nt == 33) ? 4 : 3;
      if (row0 < NL) { sstart = (row0 & (SEQ - 1)) == 0; send = ((row0 + 128) & (SEQ - 1)) == 0; }
      else { sstart = ((row0 - NL) & (CTXL - 1)) == 0; send = ((row0 + 128 - NL) & (CTXL - 1)) == 0; }
    }
    f32x4 acc[4][4];
#pragma unroll
    for (int m = 0; m < 4; ++m)
#pragma unroll
      for (int n = 0; n < 4; ++n) acc[m][n] = (f32x4){0.f, 0.f, 0.f, 0.f};
    u32x4 ra[6];
    f32x4 muv[2];
    auto glds_tile = [&](const bf* G, int ld, int grow0, int kt, char* ldsbase, bool perm) {
#pragma unroll
      for (int pc = 0; pc < 4; ++pc) {
        const int row = wid * 32 + pc * 8 + (lane >> 3), cp = lane & 7, c = cp ^ ((row >> 1) & 7);
        const int srow = perm ? ((row & ~31) | (8 * ((row & 15) >> 2) + 4 * ((row >> 4) & 1) + (row & 3))) : row;
        const bf* src = G + (size_t)(grow0 + srow) * ld + kt * 64 + c * 8;
        __builtin_amdgcn_global_load_lds((const __attribute__((address_space(1))) void*)src,
                                         (__attribute__((address_space(3))) void*)(ldsbase + row * 128 + cp * 16), 16, 0, 0);
      }
    };
    auto gloadA = [&](int kt) {
      const int kc = kt * 64 + cch * 8;
#pragma unroll
      for (int i = 0; i < 6; ++i) {
        const int r = row0 + rg * 4 + i - 1;
        const bool zero = (i == 0 && rg == 0 && sstart) || (i == 5 && rg == 31 && send);
        ra[i] = zero ? (u32x4){0, 0, 0, 0} : *(const u32x4*)(A + (size_t)r * lda + kc);
      }
      muv[0] = *(const f32x4*)(mu + lerp * 1024 + kc);
      muv[1] = *(const f32x4*)(mu + lerp * 1024 + kc + 4);
    };
    auto lstoreA = [&](int buf) {
      char* a = As + buf * 16384;
#pragma unroll
      for (int i = 0; i < 4; ++i) {
        const u32x4 hm = ra[i], h0 = ra[i + 1], hp = ra[i + 2];
        u32x4 o;
        o.x = lerp2(hm.x, h0.x, hp.x, muv[0].x, muv[0].y);
        o.y = lerp2(hm.y, h0.y, hp.y, muv[0].z, muv[0].w);
        o.z = lerp2(hm.z, h0.z, hp.z, muv[1].x, muv[1].y);
        o.w = lerp2(hm.w, h0.w, hp.w, muv[1].z, muv[1].w);
        *(u32x4*)(a + lds_off(rg * 4 + i, cch)) = o;
      }
    };
    lds_barrier();
    glds_tile(Bt, ldb, col0, 0, Bs, !vt);
    if (AMODE == 0) glds_tile(A, lda, row0, 0, As, vt);
    else { gloadA(0); lstoreA(0); }
    asm volatile("s_waitcnt vmcnt(0)" ::: "memory");
    lds_barrier();
    for (int kt = 0; kt < nkt; ++kt) {
      const int buf = kt & 1;
      if (!fake && kt + 1 < nkt) {
        glds_tile(Bt, ldb, col0, kt + 1, Bs + (buf ^ 1) * 16384, !vt);
        if (AMODE == 0) glds_tile(A, lda, row0, kt + 1, As + (buf ^ 1) * 16384, vt);
        else gloadA(kt + 1);
      }
      const char* a = As + buf * 16384;
      const char* b = Bs + buf * 16384;
#pragma unroll
      for (int ks = 0; ks < 2; ++ks) {
        bf16x8 af[4], bfr[4];
#pragma unroll
        for (int m = 0; m < 4; ++m) af[m] = *(const bf16x8*)(a + lds_off(wr * 64 + m * 16 + fr, ks * 4 + fq));
#pragma unroll
        for (int n = 0; n < 4; ++n) bfr[n] = *(const bf16x8*)(b + lds_off(wc * 64 + n * 16 + fr, ks * 4 + fq));
        __builtin_amdgcn_s_setprio(1);
        if (Epi::VT && vt) {
#pragma unroll
          for (int m = 0; m < 4; ++m)
#pragma unroll
            for (int n = 0; n < 4; ++n) acc[m][n] = __builtin_amdgcn_mfma_f32_16x16x32_bf16(af[m], bfr[n], acc[m][n], 0, 0, 0);
        } else {
#pragma unroll
          for (int m = 0; m < 4; ++m)
#pragma unroll
            for (int n = 0; n < 4; ++n) acc[m][n] = __builtin_amdgcn_mfma_f32_16x16x32_bf16(bfr[n], af[m], acc[m][n], 0, 0, 0);
        }
        __builtin_amdgcn_s_setprio(0);
      }
      if (AMODE == 1 && kt + 1 < nkt) lstoreA(buf ^ 1);
      asm volatile("s_waitcnt vmcnt(0)" ::: "memory");
      lds_barrier();
    }
    if (Epi::VT && vt) {
#pragma unroll
      for (int n = 0; n < 4; ++n)
#pragma unroll
        for (int pp = 0; pp < 2; ++pp)
          epi.store_vt(row0 + wr * 64 + pp * 32 + fq * 8, col0 + wc * 64 + n * 16 + fr, acc[2 * pp][n], acc[2 * pp + 1][n]);
      continue;
    }
#pragma unroll
    for (int m = 0; m < 4; ++m)
#pragma unroll
      for (int q2 = 0; q2 < 2; ++q2) {
        const int tok = row0 + wr * 64 + m * 16 + fr, col = col0 + wc * 64 + q2 * 32 + fq * 8;
        f32x4 lo = acc[m][2 * q2], hi = acc[m][2 * q2 + 1];
        bf* d0 = epi.xform(nt, tok, col, lo);
        bf* d1 = epi.xform(nt, tok, col + 4, hi);
        (void)d1;
        if (d0) __builtin_nontemporal_store((u32x4){pk2(lo[0], lo[1]), pk2(lo[2], lo[3]), pk2(hi[0], hi[1]), pk2(hi[2], hi[3])}, (u32x4*)d0);
      }
  }
}

typedef float f32x2 __attribute__((ext_vector_type(2)));
__device__ __forceinline__ float oct_sum(float v) {
  int t = __builtin_amdgcn_update_dpp(0, __float_as_int(v), 0xB1, 0xF, 0xF, true);
  v += __int_as_float(t);
  t = __builtin_amdgcn_update_dpp(0, __float_as_int(v), 0x4E, 0xF, 0xF, true);
  v += __int_as_float(t);
  t = __builtin_amdgcn_update_dpp(0, __float_as_int(v), 0x141, 0xF, 0xF, true);
  v += __int_as_float(t);
  return v;
}
__device__ __forceinline__ f32x2 fma2(f32x2 a, f32x2 b, f32x2 c) { return __builtin_elementwise_fma(a, b, c); }
__device__ __forceinline__ float fma_s(float a, float b, float c) { float d; asm("v_fma_f32 %0, %1, %2, %3" : "=v"(d) : "v"(a), "v"(b), "v"(c)); return d; }
__device__ __forceinline__ float mul_s(float a, float b) { float d; asm("v_mul_f32 %0, %1, %2" : "=v"(d) : "v"(a), "v"(b)); return d; }
struct ScanOps { f32x4 w[2], nk[2], bb[2], kd[2], rr[2]; f32x2 vv; };
__device__ __forceinline__ ScanOps scan_load(const float* ops, const float* vs, int t, int kq, int vrow) {
  ScanOps r;
  const float* o = ops + t * 320 + kq * 8;
  r.w[0] = *(const f32x4*)(o); r.w[1] = *(const f32x4*)(o + 4);
  r.nk[0] = *(const f32x4*)(o + 64); r.nk[1] = *(const f32x4*)(o + 68);
  r.bb[0] = *(const f32x4*)(o + 128); r.bb[1] = *(const f32x4*)(o + 132);
  r.kd[0] = *(const f32x4*)(o + 192); r.kd[1] = *(const f32x4*)(o + 196);
  r.rr[0] = *(const f32x4*)(o + 256); r.rr[1] = *(const f32x4*)(o + 260);
  r.vv = *(const f32x2*)(vs + t * 64 + vrow);
  return r;
}
#define PR(v, i) ((f32x2){(v)[(i) >> 1][((i) & 1) * 2], (v)[(i) >> 1][((i) & 1) * 2 + 1]})

constexpr int SC_P = 0, SC_YA = 8192, SC_V = 16384, SC_AT = 24576, SC_RT = SC_AT + 4352, SC_BT = SC_RT + 4352, SC_KT = SC_BT + 4352;
constexpr int SC_BTT = 41984, SC_KTT = SC_BTT + 4608, SC_MABT = 51200, SC_SM = 53248;
__device__ __forceinline__ bf16x8 mk8(u32x2 lo, u32x2 hi) { u32x4 u = (u32x4){lo.x, lo.y, hi.x, hi.y}; return __builtin_bit_cast(bf16x8, u); }
__device__ __forceinline__ bf16x8 mk4(u32x2 lo) { u32x4 u = (u32x4){lo.x, lo.y, 0u, 0u}; return __builtin_bit_cast(bf16x8, u); }
__device__ __forceinline__ float bfround(float x) { return bflo(pk2(x, 0.f) & 0xffffu); }
__device__ __forceinline__ void split4(f32x4 x, u32x2& hi, u32x2& lo) {
  hi = (u32x2){pk2(x[0], x[1]), pk2(x[2], x[3])};
  const float r0 = x[0] - bflo(hi.x), r1 = x[1] - bfhi(hi.x), r2 = x[2] - bflo(hi.y), r3 = x[3] - bfhi(hi.y);
  lo = (u32x2){pk2(r0, r1), pk2(r2, r3)};
}

__device__ void scan_phase(const Params& p, int j, char* smem) {
  const int tid = otid(), lane = tid & 63, wid = tid >> 6, fr = lane & 15, fq = lane >> 4;
  float* Pbuf = (float*)(smem + SC_P);
  float* abuf = (float*)(smem + SC_YA);
  float* ys = (float*)(smem + SC_YA);
  float* vs = (float*)(smem + SC_V);
  for (int item = blockIdx.x; item < 256; item += gridDim.x) {
  const int b = item >> 5, h = (item >> 1) & 15, d = item & 1;
  lds_barrier();
  const bf* Vsrc = (j == 0) ? p.VF : p.V2;
  bf* Ydst = (d == 0) ? p.H : p.Y1;
  const int ldy = (d == 0) ? LDH : 1024;
  float* betad = p.beta + (size_t)d * MT * 16;
  bf16x8 bw[2], ba[2];
  {
    const int n = h * 64 + wid * 16 + fr;
#pragma unroll
    for (int ks = 0; ks < 2; ++ks) {
      bw[ks] = *(const bf16x8*)(p.w2t + (size_t)d * 65536 + (size_t)n * 64 + ks * 32 + fq * 8);
      ba[ks] = *(const bf16x8*)(p.a2t + (size_t)d * 65536 + (size_t)n * 64 + ks * 32 + fq * 8);
    }
  }
  float w0v[4], a0v[4];
#pragma unroll
  for (int e = 0; e < 4; ++e) {
    w0v[e] = p.rw_w0[(size_t)(j * 2 + d) * 1024 + h * 64 + wid * 16 + fq * 4 + e];
    a0v[e] = p.rw_a0[(size_t)(j * 2 + d) * 1024 + h * 64 + wid * 16 + fq * 4 + e];
  }
  const int tt = tid >> 3, c8 = tid & 7;
  float kkv[8], kav[8], rkv[8];
#pragma unroll
  for (int e = 0; e < 8; ++e) {
    kkv[e] = p.rw_k_k[j * 1024 + h * 64 + c8 * 8 + e];
    kav[e] = p.rw_k_a[j * 1024 + h * 64 + c8 * 8 + e];
    rkv[e] = p.rw_r_k[j * 1024 + h * 64 + c8 * 8 + e];
  }
  f32x4 ST[4];
#pragma unroll
  for (int kt = 0; kt < 4; ++kt) ST[kt] = (f32x4){0.f, 0.f, 0.f, 0.f};

  bf16x8 phw[2][2], pha[2][2];
  u32x4 puk, pur, puv;
  u32x4 quk, qur, quv;
  auto rowbase_of = [&](int ch, int& sgn) -> int {
    if (d == 0) { sgn = 1; return (ch < 8) ? NL + b * CTXL + ch * 32 : b * SEQ + (ch - 8) * 32; }
    sgn = -1; return (ch < 8) ? NL + b * CTXL + 255 - ch * 32 : b * SEQ + 8191 - (ch - 8) * 32;
  };
  auto prefetch_hid = [&](int ch) {
    int sgn; const int rowbase = rowbase_of(ch, sgn);
#pragma unroll
    for (int m = 0; m < 2; ++m) {
      const size_t row = (size_t)(rowbase + sgn * (m * 16 + fr));
#pragma unroll
      for (int ks = 0; ks < 2; ++ks) {
        phw[m][ks] = *(const bf16x8*)(p.HID + row * HIDW + d * 64 + ks * 32 + fq * 8);
        pha[m][ks] = *(const bf16x8*)(p.HID + row * HIDW + 128 + d * 64 + ks * 32 + fq * 8);
      }
    }
  };
  auto prefetch_rkv = [&](int ch) {
    int sgn; const int rowbase = rowbase_of(ch, sgn);
    const size_t off = (size_t)(rowbase + sgn * tt) * 1024 + h * 64 + c8 * 8;
    quk = *(const u32x4*)(p.K + off);
    qur = *(const u32x4*)(p.R + off);
    quv = *(const u32x4*)(Vsrc + off);
  };
  prefetch_hid(0);
  prefetch_rkv(0);
  puk = quk; pur = qur; puv = quv;
  prefetch_rkv(1);

  for (int ch = 0; ch < 264; ++ch) {
    int sgn; const int rowbase = rowbase_of(ch, sgn);
#pragma unroll
    for (int m = 0; m < 2; ++m) {
      const int tok = m * 16 + fr;
      f32x4 aw = (f32x4){0.f, 0.f, 0.f, 0.f}, aa = aw;
#pragma unroll
      for (int ks = 0; ks < 2; ++ks) {
        aw = __builtin_amdgcn_mfma_f32_16x16x32_bf16(bw[ks], phw[m][ks], aw, 0, 0, 0);
        aa = __builtin_amdgcn_mfma_f32_16x16x32_bf16(ba[ks], pha[m][ks], aa, 0, 0, 0);
      }
      f32x4 wd, av;
#pragma unroll
      for (int e = 0; e < 4; ++e) {
        const float ez = __expf(-(w0v[e] + aw[e]));
        wd[e] = __expf(-0.60653066f * __builtin_amdgcn_rcpf(1.f + ez));
        av[e] = __builtin_amdgcn_rcpf(1.f + __expf(-(a0v[e] + aa[e])));
      }
#pragma unroll
      for (int e = 0; e < 4; ++e) {
        float x = wd[e];
        x *= __int_as_float(__builtin_amdgcn_update_dpp(0x3f800000, __float_as_int(x), 0x111, 0xF, 0xF, false));
        x *= __int_as_float(__builtin_amdgcn_update_dpp(0x3f800000, __float_as_int(x), 0x112, 0xF, 0xF, false));
        x *= __int_as_float(__builtin_amdgcn_update_dpp(0x3f800000, __float_as_int(x), 0x114, 0xF, 0xF, false));
        x *= __int_as_float(__builtin_amdgcn_update_dpp(0x3f800000, __float_as_int(x), 0x118, 0xF, 0xF, false));
        wd[e] = x;
      }
      *(f32x4*)(Pbuf + tok * 64 + wid * 16 + fq * 4) = wd;
      *(f32x4*)(abuf + tok * 64 + wid * 16 + fq * 4) = av;
    }
    if (ch + 1 < 264) prefetch_hid(ch + 1);
    lds_barrier();
    {
      const size_t row = (size_t)(rowbase + sgn * tt);
      float k[8], r[8], kk[8];
#pragma unroll
      for (int e = 0; e < 4; ++e) {
        k[2 * e] = bflo(puk[e]); k[2 * e + 1] = bfhi(puk[e]);
        r[2 * e] = bflo(pur[e]); r[2 * e + 1] = bfhi(pur[e]);
      }
      float ss = 0.f;
#pragma unroll
      for (int e = 0; e < 8; ++e) { kk[e] = k[e] * kkv[e]; ss += kk[e] * kk[e]; }
      ss = oct_sum(ss);
      const float inv = __builtin_amdgcn_rsqf(fmaxf(ss, 1e-24f));
      const f32x4 a0 = *(const f32x4*)(abuf + tt * 64 + c8 * 8), a1 = *(const f32x4*)(abuf + tt * 64 + c8 * 8 + 4);
      const f32x4 p0 = *(const f32x4*)(Pbuf + tt * 64 + c8 * 8), p1 = *(const f32x4*)(Pbuf + tt * 64 + c8 * 8 + 4);
      f32x4 q0 = (f32x4){1.f, 1.f, 1.f, 1.f}, q1 = q0;
      if (tt & 15) { q0 = *(const f32x4*)(Pbuf + (tt - 1) * 64 + c8 * 8); q1 = *(const f32x4*)(Pbuf + (tt - 1) * 64 + c8 * 8 + 4); }
      const float a[8] = {a0.x, a0.y, a0.z, a0.w, a1.x, a1.y, a1.z, a1.w};
      const float Pt[8] = {p0.x, p0.y, p0.z, p0.w, p1.x, p1.y, p1.z, p1.w};
      const float Pm[8] = {q0.x, q0.y, q0.z, q0.w, q1.x, q1.y, q1.z, q1.w};
      float at[8], bt_[8], kt_[8], rt[8];
      float bsum = 0.f;
#pragma unroll
      for (int e = 0; e < 8; ++e) {
        const float kkn = kk[e] * inv;
        const float kd = k[e] * (1.f + (a[e] - 1.f) * kav[e]);
        bsum += r[e] * kd * rkv[e];
        const float ip = __builtin_amdgcn_rcpf(Pt[e]);
        at[e] = -kkn * Pm[e];
        bt_[e] = kkn * a[e] * ip;
        kt_[e] = kd * ip;
        rt[e] = r[e] * Pt[e];
      }
      bsum = oct_sum(bsum);
      if (c8 == 0) betad[row * 16 + h] = bsum;
      char* ro = smem + tt * 136 + c8 * 16;
      *(u32x2*)(ro + SC_AT) = (u32x2){pk2(at[0], at[1]), pk2(at[2], at[3])};   *(u32x2*)(ro + SC_AT + 8) = (u32x2){pk2(at[4], at[5]), pk2(at[6], at[7])};
      *(u32x2*)(ro + SC_RT) = (u32x2){pk2(rt[0], rt[1]), pk2(rt[2], rt[3])};   *(u32x2*)(ro + SC_RT + 8) = (u32x2){pk2(rt[4], rt[5]), pk2(rt[6], rt[7])};
      *(u32x2*)(ro + SC_BT) = (u32x2){pk2(bt_[0], bt_[1]), pk2(bt_[2], bt_[3])}; *(u32x2*)(ro + SC_BT + 8) = (u32x2){pk2(bt_[4], bt_[5]), pk2(bt_[6], bt_[7])};
      *(u32x2*)(ro + SC_KT) = (u32x2){pk2(kt_[0], kt_[1]), pk2(kt_[2], kt_[3])}; *(u32x2*)(ro + SC_KT + 8) = (u32x2){pk2(kt_[4], kt_[5]), pk2(kt_[6], kt_[7])};
#pragma unroll
      for (int e = 0; e < 8; ++e) {
        *(bf*)(smem + SC_BTT + (c8 * 8 + e) * 72 + tt * 2) = (bf)(pk2(bt_[e], 0.f) & 0xffffu);
        *(bf*)(smem + SC_KTT + (c8 * 8 + e) * 72 + tt * 2) = (bf)(pk2(kt_[e], 0.f) & 0xffffu);
      }
      *(f32x4*)(vs + tt * 64 + c8 * 8) = (f32x4){bflo(puv[0]), bfhi(puv[0]), bflo(puv[1]), bfhi(puv[1])};
      *(f32x4*)(vs + tt * 64 + c8 * 8 + 4) = (f32x4){bflo(puv[2]), bfhi(puv[2]), bflo(puv[3]), bfhi(puv[3])};
    }
    lds_barrier();
    puk = quk; pur = qur; puv = quv;
    if (ch + 2 < 264) prefetch_rkv(ch + 2);
    {
      auto gram = [&](int xbase, int ybase, int sc) -> f32x4 {
        f32x4 acc = (f32x4){0.f, 0.f, 0.f, 0.f};
#pragma unroll
        for (int ks = 0; ks < 2; ++ks) {
          const char* xp = smem + xbase + (sc * 16 + fr) * 136 + ks * 64 + fq * 16;
          const char* yp = smem + ybase + (sc * 16 + fr) * 136 + ks * 64 + fq * 16;
          const bf16x8 xf = mk8(*(const u32x2*)xp, *(const u32x2*)(xp + 8));
          const bf16x8 yf = mk8(*(const u32x2*)yp, *(const u32x2*)(yp + 8));
          acc = __builtin_amdgcn_mfma_f32_16x16x32_bf16(xf, yf, acc, 0, 0, 0);
        }
        return acc;
      };
      auto store_small = [&](f32x4 g, int sc, int kind, bool strict) {
#pragma unroll
        for (int e = 0; e < 4; ++e) { const int sidx = fq * 4 + e; const bool keep = strict ? (sidx < fr) : (sidx <= fr); g[e] = keep ? g[e] : 0.f; }
        *(u32x2*)(smem + SC_SM + (sc * 5 + kind) * 640 + fr * 40 + fq * 8) = (u32x2){pk2(g[0], g[1]), pk2(g[2], g[3])};
      };
      if (wid < 2) {
        const int sc = wid;
        f32x4 g = gram(SC_BT, SC_AT, sc);
#pragma unroll
        for (int e = 0; e < 4; ++e) g[e] = (fq * 4 + e < fr) ? g[e] : 0.f;
        *(f32x4*)(smem + SC_MABT + sc * 1024 + fr * 64 + fq * 16) = g;
        asm volatile("s_waitcnt lgkmcnt(0)" ::: "memory");
        if (lane < 16) {
          float n[16];
#pragma unroll
          for (int t = 0; t < 16; ++t) {
            const float* mc = (const float*)(smem + SC_MABT + sc * 1024 + t * 64);
            float acc = (t == lane) ? 1.f : 0.f;
#pragma unroll
            for (int sp = 0; sp < t; ++sp) acc = fmaf(n[sp], mc[sp], acc);
            n[t] = acc;
          }
#pragma unroll
          for (int t = 0; t < 16; ++t) {
            const unsigned hi = pk2(n[t], 0.f) & 0xffffu;
            const unsigned lo = pk2(n[t] - bflo(hi), 0.f) & 0xffffu;
            *(bf*)(smem + SC_SM + (sc * 5 + 0) * 640 + t * 40 + lane * 2) = (bf)hi;
            *(bf*)(smem + SC_SM + (sc * 5 + 1) * 640 + t * 40 + lane * 2) = (bf)lo;
          }
        }
      } else {
        const int sc = wid - 2;
        store_small(gram(SC_KT, SC_AT, sc), sc, 2, true);
        store_small(gram(SC_BT, SC_RT, sc), sc, 3, false);
        store_small(gram(SC_KT, SC_RT, sc), sc, 4, false);
      }
    }
    lds_barrier();
#pragma unroll
    for (int sc = 0; sc < 2; ++sc) {
      bf16x8 shi[2], slo[2];
#pragma unroll
      for (int g = 0; g < 2; ++g) {
        u32x2 h0, l0, h1, l1;
        split4(ST[2 * g], h0, l0); split4(ST[2 * g + 1], h1, l1);
        shi[g] = mk8(h0, h1); slo[g] = mk8(l0, l1);
      }
      const char* arow = smem + SC_AT + (sc * 16 + fr) * 136 + fq * 8;
      const char* rrow = smem + SC_RT + (sc * 16 + fr) * 136 + fq * 8;
      f32x4 wt = (f32x4){0.f, 0.f, 0.f, 0.f}, yt = wt;
#pragma unroll
      for (int g = 0; g < 2; ++g) {
        const bf16x8 xa = mk8(*(const u32x2*)(arow + g * 64), *(const u32x2*)(arow + g * 64 + 32));
        const bf16x8 xr = mk8(*(const u32x2*)(rrow + g * 64), *(const u32x2*)(rrow + g * 64 + 32));
        wt = __builtin_amdgcn_mfma_f32_16x16x32_bf16(xa, shi[g], wt, 0, 0, 0);
        wt = __builtin_amdgcn_mfma_f32_16x16x32_bf16(xa, slo[g], wt, 0, 0, 0);
        yt = __builtin_amdgcn_mfma_f32_16x16x32_bf16(xr, shi[g], yt, 0, 0, 0);
        yt = __builtin_amdgcn_mfma_f32_16x16x32_bf16(xr, slo[g], yt, 0, 0, 0);
      }
      const int vcol = wid * 16 + fr;
      const float* vp = vs + (sc * 16 + fq * 4) * 64 + vcol;
      const bf16x8 vmf = mk4((u32x2){pk2(vp[0], vp[64]), pk2(vp[128], vp[192])});
      const char* smb = smem + SC_SM + sc * 5 * 640 + fr * 40 + fq * 8;
      const bf16x8 xnh = mk4(*(const u32x2*)(smb)), xnl = mk4(*(const u32x2*)(smb + 640));
      const bf16x8 xmak = mk4(*(const u32x2*)(smb + 2 * 640)), xmrb = mk4(*(const u32x2*)(smb + 3 * 640)), xmrk = mk4(*(const u32x2*)(smb + 4 * 640));
      wt = __builtin_amdgcn_mfma_f32_16x16x32_bf16(xmak, vmf, wt, 0, 0, 0);
      u32x2 whi, wlo;
      split4(wt, whi, wlo);
      f32x4 ut = (f32x4){0.f, 0.f, 0.f, 0.f};
      ut = __builtin_amdgcn_mfma_f32_16x16x32_bf16(xnh, mk4(whi), ut, 0, 0, 0);
      ut = __builtin_amdgcn_mfma_f32_16x16x32_bf16(xnh, mk4(wlo), ut, 0, 0, 0);
      ut = __builtin_amdgcn_mfma_f32_16x16x32_bf16(xnl, mk4(whi), ut, 0, 0, 0);
      u32x2 uhi, ulo;
      split4(ut, uhi, ulo);
      const bf16x8 uhf = mk4(uhi), ulf = mk4(ulo);
      yt = __builtin_amdgcn_mfma_f32_16x16x32_bf16(xmrb, uhf, yt, 0, 0, 0);
      yt = __builtin_amdgcn_mfma_f32_16x16x32_bf16(xmrb, ulf, yt, 0, 0, 0);
      yt = __builtin_amdgcn_mfma_f32_16x16x32_bf16(xmrk, vmf, yt, 0, 0, 0);
#pragma unroll
      for (int e = 0; e < 4; ++e) ys[(sc * 16 + fq * 4 + e) * 64 + vcol] = yt[e];
#pragma unroll
      for (int kt = 0; kt < 4; ++kt) {
        const bf16x8 xb = mk4(*(const u32x2*)(smem + SC_BTT + (kt * 16 + fr) * 72 + (sc * 16 + fq * 4) * 2));
        const bf16x8 xk = mk4(*(const u32x2*)(smem + SC_KTT + (kt * 16 + fr) * 72 + (sc * 16 + fq * 4) * 2));
        ST[kt] = __builtin_amdgcn_mfma_f32_16x16x32_bf16(xb, uhf, ST[kt], 0, 0, 0);
        ST[kt] = __builtin_amdgcn_mfma_f32_16x16x32_bf16(xb, ulf, ST[kt], 0, 0, 0);
        ST[kt] = __builtin_amdgcn_mfma_f32_16x16x32_bf16(xk, vmf, ST[kt], 0, 0, 0);
        const f32x4 pc = *(const f32x4*)(Pbuf + (sc * 16 + 15) * 64 + kt * 16 + fq * 4);
        ST[kt] = ST[kt] * pc;
      }
    }
    lds_barrier();
    {
      const size_t row = (size_t)(rowbase + sgn * tt);
      const f32x4 y0 = *(const f32x4*)(ys + tt * 64 + c8 * 8), y1 = *(const f32x4*)(ys + tt * 64 + c8 * 8 + 4);
      *(u32x4*)(Ydst + row * ldy + h * 64 + c8 * 8) = (u32x4){pk2(y0.x, y0.y), pk2(y0.z, y0.w), pk2(y1.x, y1.y), pk2(y1.z, y1.w)};
    }
    lds_barrier();
  }
  }
}

__device__ void og_phase(const Params& p, int j) {
  const int tid = otid(), lane = tid & 63;
  const int gw = blockIdx.x * 4 + (tid >> 6), nw = gridDim.x * 4;
  const bf* Vsrc = (j == 0) ? p.VF : p.V2;
  const int col = lane * 16, hh = lane >> 2;
  float lw[16], lb[16];
#pragma unroll
  for (int e = 0; e < 16; ++e) { lw[e] = p.rw_lnx_w[j * 1024 + col + e]; lb[e] = p.rw_lnx_b[j * 1024 + col + e]; }
  for (int row = gw; row < MT; row += nw) {
    const size_t off = (size_t)row * 1024 + col, offh = (size_t)row * LDH + col;
    u32x4 u0[2], u1[2], uv[2], ug[2];
#pragma unroll
    for (int q = 0; q < 2; ++q) {
      u0[q] = __builtin_nontemporal_load((const u32x4*)(p.H + offh + q * 8));
      u1[q] = __builtin_nontemporal_load((const u32x4*)(p.Y1 + off + q * 8));
      uv[q] = __builtin_nontemporal_load((const u32x4*)(Vsrc + off + q * 8));
      ug[q] = __builtin_nontemporal_load((const u32x4*)(p.G + off + q * 8));
    }
    const float bsum = p.beta[(size_t)row * 16 + hh] + p.beta[(size_t)MT * 16 + (size_t)row * 16 + hh];
    float y[16], v[16], g[16];
    float s = 0.f;
#pragma unroll
    for (int e = 0; e < 8; ++e) {
      y[2 * e] = bflo(u0[e >> 2][e & 3]) + bflo(u1[e >> 2][e & 3]); y[2 * e + 1] = bfhi(u0[e >> 2][e & 3]) + bfhi(u1[e >> 2][e & 3]);
      v[2 * e] = bflo(uv[e >> 2][e & 3]); v[2 * e + 1] = bfhi(uv[e >> 2][e & 3]);
      g[2 * e] = bflo(ug[e >> 2][e & 3]); g[2 * e + 1] = bfhi(ug[e >> 2][e & 3]);
      s += y[2 * e] + y[2 * e + 1];
    }
    s = quad_sum(s);
    const float mean = s * (1.f / 64.f);
    float q2 = 0.f;
#pragma unroll
    for (int e = 0; e < 16; ++e) { const float dd = y[e] - mean; q2 += dd * dd; }
    q2 = quad_sum(q2);
    const float rstd = rsqrtf(q2 * (1.f / 64.f) + 64e-5f);
    unsigned o[8];
#pragma unroll
    for (int e = 0; e < 8; ++e) {
      const float r0 = ((y[2 * e] - mean) * rstd * lw[2 * e] + lb[2 * e] + bsum * v[2 * e]) * g[2 * e];
      const float r1 = ((y[2 * e + 1] - mean) * rstd * lw[2 * e + 1] + lb[2 * e + 1] + bsum * v[2 * e + 1]) * g[2 * e + 1];
      o[e] = pk2(r0, r1);
    }
    *(u32x4*)(p.H + offh) = (u32x4){o[0], o[1], o[2], o[3]};
    *(u32x4*)(p.H + offh + 8) = (u32x4){o[4], o[5], o[6], o[7]};
  }
}

__device__ void attn_phase(const Params& p, int j, bool ctx_out, char* smem) {
  const int tid = otid(), lane = tid & 63, cgp = tid >> 6, fr = lane & 15, fq = lane >> 4;
  char* Ks = smem;
  bf* Vs = (bf*)smem;
  float* rpbs = (float*)(smem + 36864);
  const bf* Q = p.R; const bf* Kb = p.K; const bf* Vt = p.V2; const bf* Gb = p.G;
  const int nitems = 16384 + (ctx_out ? 512 : 0);
  for (int item = blockIdx.x; item < nitems; item += gridDim.x) {
    int b, h, r = 0, qrow0; bool haswin;
    if (item < 16384) { h = item & 15; r = (item >> 4) & 127; b = item >> 11; haswin = true; qrow0 = b * SEQ + r * 64; }
    else { const int it = item - 16384; h = it & 15; const int qb = (it >> 4) & 3; b = it >> 6; haswin = false; qrow0 = NL + b * CTXL + qb * 64; }
    const int qtok = qrow0 + cgp * 16 + fr;
    bf16x8 qf[2];
#pragma unroll
    for (int ks = 0; ks < 2; ++ks) qf[ks] = *(const bf16x8*)(Q + (size_t)qtok * 1024 + h * 64 + ks * 32 + fq * 8);
    const int rs = min(max(r - 4, 0), 120);
    const int qcol = cgp * 16 + fr;
    const int wsq = min(max(qcol - 8, 0), 48);
    const int bs = min(max(16 * cgp - 8, 0), 32);
    lds_barrier();
    if (haswin) for (int idx = tid; idx < 465; idx += 256) rpbs[idx] = p.na_rpb[((size_t)j * 16 + h) * 465 + idx];
    f32x4 sw[8][2], sc[4][4];
    bf16x8 pw[8];
    float m1 = NEGV, l1 = 0.f;
#pragma unroll
    for (int i = 0; i < 8; ++i) pw[i] = (bf16x8){0, 0, 0, 0, 0, 0, 0, 0};
#pragma unroll
    for (int i = 0; i < 8; ++i)
#pragma unroll
      for (int k2 = 0; k2 < 2; ++k2) sw[i][k2] = (f32x4){NEGV, NEGV, NEGV, NEGV};
#pragma unroll
    for (int st = 0; st < 3; ++st) {
      if (st < 2 && !haswin) continue;
      lds_barrier();
      int tq = tid; asm volatile("" : "+v"(tq));
#pragma unroll
      for (int hf = 0; hf < 2; ++hf) {
        u32x4 u[4];
#pragma unroll
        for (int i = 0; i < 4; ++i) {
          const int q = tq + (hf * 4 + i) * 256, key = q >> 3, c = q & 7, tl = key >> 6;
          const int base = (st < 2) ? b * SEQ + (rs + st * 4 + tl) * 64 : NL + b * CTXL + tl * 64;
          u[i] = *(const u32x4*)(Kb + (size_t)(base + (key & 63)) * 1024 + h * 64 + c * 8);
        }
#pragma unroll
        for (int i = 0; i < 4; ++i) {
          const int q = tq + (hf * 4 + i) * 256, key = q >> 3, c = q & 7;
          *(u32x4*)(Ks + lds_off(key, c)) = u[i];
        }
        __builtin_amdgcn_sched_barrier(0);
      }
      lds_barrier();
      if (st < 2) {
#pragma unroll
        for (int tl = 0; tl < 4; ++tl) {
          const int i = st * 4 + tl;
          const int dr = rs + i - r + 7;
#pragma unroll
          for (int k2 = 0; k2 < 2; ++k2) {
            f32x4 acc = (f32x4){0.f, 0.f, 0.f, 0.f};
#pragma unroll
            for (int ks = 0; ks < 2; ++ks) {
              const bf16x8 kf = *(const bf16x8*)(Ks + lds_off(tl * 64 + bs + k2 * 16 + fr, ks * 4 + fq));
              acc = __builtin_amdgcn_mfma_f32_16x16x32_bf16(kf, qf[ks], acc, 0, 0, 0);
            }
#pragma unroll
            for (int e = 0; e < 4; ++e) {
              const int kc = bs + k2 * 16 + fq * 4 + e;
              const bool valid = (kc >= wsq) && (kc < wsq + 16);
              const int dc = min(max(kc - qcol, -15), 15) + 15;
              sw[i][k2][e] = valid ? acc[e] + rpbs[dr * 31 + dc] : NEGV;
            }
          }
          __builtin_amdgcn_sched_barrier(0);
        }
      } else {
#pragma unroll
        for (int tl = 0; tl < 4; ++tl)
#pragma unroll
          for (int k4 = 0; k4 < 4; ++k4) {
            f32x4 acc = (f32x4){0.f, 0.f, 0.f, 0.f};
#pragma unroll
            for (int ks = 0; ks < 2; ++ks) {
              const bf16x8 kf = *(const bf16x8*)(Ks + lds_off(tl * 64 + k4 * 16 + fr, ks * 4 + fq));
              acc = __builtin_amdgcn_mfma_f32_16x16x32_bf16(kf, qf[ks], acc, 0, 0, 0);
            }
            sc[tl][k4] = acc;
            if (k4 & 1) __builtin_amdgcn_sched_barrier(0);
          }
      }
      if (st == 1) {
#pragma unroll
        for (int i = 0; i < 8; ++i)
#pragma unroll
          for (int k2 = 0; k2 < 2; ++k2)
#pragma unroll
            for (int e = 0; e < 4; ++e) m1 = fmaxf(m1, sw[i][k2][e]);
        m1 = fmaxf(m1, __shfl_xor(m1, 16));
        m1 = fmaxf(m1, __shfl_xor(m1, 32));
#pragma unroll
        for (int i = 0; i < 8; ++i) {
          float e0[4], e1[4];
#pragma unroll
          for (int e = 0; e < 4; ++e) { e0[e] = __expf(sw[i][0][e] - m1); e1[e] = __expf(sw[i][1][e] - m1); l1 += e0[e] + e1[e]; }
          u32x4 u = (u32x4){pk2(e0[0], e0[1]), pk2(e0[2], e0[3]), pk2(e1[0], e1[1]), pk2(e1[2], e1[3])};
          pw[i] = __builtin_bit_cast(bf16x8, u);
        }
        l1 += __shfl_xor(l1, 16);
        l1 += __shfl_xor(l1, 32);
      }
    }
    float m2 = NEGV;
#pragma unroll
    for (int tl = 0; tl < 4; ++tl)
#pragma unroll
      for (int k4 = 0; k4 < 4; ++k4)
#pragma unroll
        for (int e = 0; e < 4; ++e) m2 = fmaxf(m2, sc[tl][k4][e]);
    m2 = fmaxf(m2, __shfl_xor(m2, 16));
    m2 = fmaxf(m2, __shfl_xor(m2, 32));
    const float mx = fmaxf(m1, m2);
    const float alpha1 = __expf(m1 - mx);
    float l2 = 0.f;
    bf16x8 pc[4][2];
#pragma unroll
    for (int tl = 0; tl < 4; ++tl)
#pragma unroll
      for (int g2 = 0; g2 < 2; ++g2) {
        float e0[4], e1[4];
#pragma unroll
        for (int e = 0; e < 4; ++e) { e0[e] = __expf(sc[tl][2 * g2][e] - mx); e1[e] = __expf(sc[tl][2 * g2 + 1][e] - mx); l2 += e0[e] + e1[e]; }
        u32x4 u = (u32x4){pk2(e0[0], e0[1]), pk2(e0[2], e0[3]), pk2(e1[0], e1[1]), pk2(e1[2], e1[3])};
        pc[tl][g2] = __builtin_bit_cast(bf16x8, u);
      }
    l2 += __shfl_xor(l2, 16);
    l2 += __shfl_xor(l2, 32);
    const float l = alpha1 * l1 + l2;
    f32x4 o[4];
#pragma unroll
    for (int dt = 0; dt < 4; ++dt) o[dt] = (f32x4){0.f, 0.f, 0.f, 0.f};
#pragma unroll
    for (int st = 0; st < 3; ++st) {
      if (st < 2 && !haswin) continue;
      lds_barrier();
      int tq = tid; asm volatile("" : "+v"(tq));
#pragma unroll
      for (int hf = 0; hf < 2; ++hf) {
        u32x4 u[4];
#pragma unroll
        for (int i = 0; i < 4; ++i) {
          const int q = tq + (hf * 4 + i) * 256, tl = q >> 9, dd = (q >> 3) & 63, c = q & 7;
          const int base = (st < 2) ? b * SEQ + (rs + st * 4 + tl) * 64 : NL + b * CTXL + tl * 64;
          u[i] = *(const u32x4*)(Vt + (size_t)(h * 64 + dd) * MT + base + c * 8);
        }
#pragma unroll
        for (int i = 0; i < 4; ++i) {
          const int q = tq + (hf * 4 + i) * 256, tl = q >> 9, dd = (q >> 3) & 63, c = q & 7;
          *(u32x4*)(Vs + tl * 4608 + dd * 72 + c * 8) = u[i];
        }
        __builtin_amdgcn_sched_barrier(0);
      }
      lds_barrier();
      if (st < 2) {
#pragma unroll
        for (int tl = 0; tl < 4; ++tl) {
          const int i = st * 4 + tl;
#pragma unroll
          for (int dt = 0; dt < 4; ++dt) {
            const bf* vp = Vs + tl * 4608 + (dt * 16 + fr) * 72 + bs + fq * 4;
            const u32x2 lo = *(const u32x2*)vp, hi = *(const u32x2*)(vp + 16);
            u32x4 u = (u32x4){lo.x, lo.y, hi.x, hi.y};
            o[dt] = __builtin_amdgcn_mfma_f32_16x16x32_bf16(__builtin_bit_cast(bf16x8, u), pw[i], o[dt], 0, 0, 0);
          }
          __builtin_amdgcn_sched_barrier(0);
        }
      } else {
#pragma unroll
        for (int tl = 0; tl < 4; ++tl)
#pragma unroll
          for (int g2 = 0; g2 < 2; ++g2)
#pragma unroll
            for (int dt = 0; dt < 4; ++dt) {
              const bf* vp = Vs + tl * 4608 + (dt * 16 + fr) * 72 + g2 * 32 + fq * 4;
              const u32x2 lo = *(const u32x2*)vp, hi = *(const u32x2*)(vp + 16);
              u32x4 u = (u32x4){lo.x, lo.y, hi.x, hi.y};
              o[dt] = __builtin_amdgcn_mfma_f32_16x16x32_bf16(__builtin_bit_cast(bf16x8, u), pc[tl][g2], o[dt], 0, 0, 0);
              if (dt == 3) __builtin_amdgcn_sched_barrier(0);
            }
      }
      if (st == 1) {
#pragma unroll
        for (int dt = 0; dt < 4; ++dt) o[dt] *= alpha1;
      }
    }
    const float inv = 1.f / l;
#pragma unroll
    for (int dt = 0; dt < 4; ++dt) {
      const size_t off = (size_t)qtok * 1024 + h * 64 + dt * 16 + fq * 4;
      const u32x2 ug = *(const u32x2*)(Gb + off);
      const float g0 = bflo(ug.x), g1 = bfhi(ug.x), g2 = bflo(ug.y), g3 = bfhi(ug.y);
      *(u32x2*)(p.H + (size_t)qtok * LDH + h * 64 + dt * 16 + fq * 4) = (u32x2){pk2(o[dt][0] * inv * siluf(g0), o[dt][1] * inv * siluf(g1)),
                                        pk2(o[dt][2] * inv * siluf(g2), o[dt][3] * inv * siluf(g3))};
    }
  }
}


#define XB_TMO      128
#define XB_XCNT(j)  (256  + 64 * (j))
#define XB_XSUB(j)  (1280 + 64 * (j))
#define XB_XGEN(j)  (2304 + 64 * (j))
#define XB_TOP      3328
#define XB_TOPGEN   3392
#define XCD_BAR_WORDS 3456
#define XB_SPIN_CAP (1u << 18)
__device__ __forceinline__ unsigned xb_ld(unsigned* q) { return __hip_atomic_load(q, __ATOMIC_RELAXED, __HIP_MEMORY_SCOPE_AGENT); }
__device__ __forceinline__ unsigned xb_add(unsigned* q, unsigned v) { return __hip_atomic_fetch_add(q, v, __ATOMIC_RELAXED, __HIP_MEMORY_SCOPE_AGENT); }
__device__ __forceinline__ unsigned xb_xcc_id() { return (unsigned)__builtin_amdgcn_s_getreg((3 << 11) | 20) & 0xFu; }
#define XB_SPIN(cond, bar) do { unsigned _sp = 0; while (cond) { __builtin_amdgcn_s_sleep(1); \
    if ((++_sp & 255u) == 0u) { if (xb_ld(&(bar)[XB_TMO])) break; if (_sp > XB_SPIN_CAP) { atomicAdd(&(bar)[XB_TMO], 1u); break; } } } } while (0)
struct XcdBarrier { unsigned* bar; unsigned x, nloc, nx; };
__device__ __forceinline__ void xcd_barrier(const XcdBarrier& b) {
  asm volatile("s_waitcnt vmcnt(0)" ::: "memory");
  __syncthreads();
  if (threadIdx.x == 0) {
    unsigned* bar = b.bar;
    __builtin_amdgcn_s_waitcnt(0);
    const unsigned nloc = b.nloc, nx = b.nx;
    const unsigned old = xb_add(&bar[XB_XSUB(b.x)], 1u);
    const unsigned gen = old / nloc;
    if (old + 1u == (gen + 1u) * nloc) {
      __builtin_amdgcn_fence(__ATOMIC_RELEASE, "agent");
      asm volatile("s_waitcnt vmcnt(0)" ::: "memory");
      const unsigned og = xb_add(&bar[XB_TOP], 1u);
      const unsigned tg = og / nx;
      if (og + 1u == (tg + 1u) * nx) xb_add(&bar[XB_TOPGEN], 1u);
      else XB_SPIN(xb_ld(&bar[XB_TOPGEN]) == tg, bar);
      __builtin_amdgcn_fence(__ATOMIC_ACQUIRE, "agent");
      xb_add(&bar[XB_XGEN(b.x)], 1u);
      asm volatile("s_waitcnt vmcnt(0)" ::: "memory");
    } else {
      XB_SPIN(xb_ld(&bar[XB_XGEN(b.x)]) == gen, bar);
      __builtin_amdgcn_fence(__ATOMIC_ACQUIRE, "agent");
      asm volatile("s_waitcnt vmcnt(0)" ::: "memory");
    }
  }
  __syncthreads();
}

#ifndef DUP_SCAN
#define DUP_SCAN 0
#endif
#ifndef DUP_ATTN
#define DUP_ATTN 0
#endif
#ifndef DUP_GEMM
#define DUP_GEMM 0
#endif
#ifndef MULTI_LAUNCH
#define MULTI_LAUNCH 0
#endif
__device__ __forceinline__ bool step_exists(int i, int s) {
  if (s == 2) return i == 2;
  if (s == 4) return (i & 1) == 0;
  return true;
}
__device__ __forceinline__ void run_step(const Params& p, int i, int s, char* smem) {
  asm volatile("" : "+s"(i));
  const int j = i >> 1;
  if (s == 0) { transpose_phase(p, i, smem); row_phase(p, i); }
  else if (s == 1) {
    if ((i & 1) == 0) {
      EpiRwkvProj ep{p.R, p.K, (j == 0) ? p.VF : p.V2, p.G, p.HID};
#pragma unroll 1
      for (int rep = PROBE_GEMM ? 0 : 1; rep < 2; ++rep)
      gemm_phase<1>(p.H, LDH, p.Wp, LDW, 16, MT / 128, (j == 0) ? 34 : 35, p.rw_mu + (size_t)j * 6 * 1024, ep, smem, rep == 0);
    } else {
      EpiNaProj ep{p.R, p.K, p.V2, p.G, p.na_b_in + (size_t)j * 4096};
#pragma unroll 1
      for (int rep = PROBE_GEMM ? 0 : 1; rep < 2; ++rep)
      gemm_phase<0>(p.H, LDH, p.Wp, LDW, 16, MT / 128, 32, nullptr, ep, smem, rep == 0);
    }
  } else if (s == 2) {
    EpiVres ev{p.V2, p.VF, p.rw_v0};
    gemm_phase<0>(p.HID + 256, HIDW, p.v2t, 64, 1, MT / 128, 8, nullptr, ev, smem);
  } else if (s == 3) {
    if ((i & 1) == 0) scan_phase(p, j, smem);
    else attn_phase(p, j, i != 3, smem);
  } else if (s == 4) {
    og_phase(p, j);
  } else {
    EpiOut eo{p.R};
#pragma unroll 1
    for (int rep = PROBE_GEMM ? 0 : 1; rep < 2; ++rep)
    gemm_phase<0>(p.H, LDH, p.Wo, LDW, 16, (i == 3) ? NL / 128 : MT / 128, 8, nullptr, eo, smem, rep == 0);
  }
}

__global__ void __launch_bounds__(256, 2) fwd_megakernel(Params p0) {
  __shared__ __attribute__((aligned(16))) char smem[SMEM_BYTES];
  cg::grid_group grid = cg::this_grid();
  XcdBarrier xb;
  xb.bar = p0.bar; xb.x = xb_xcc_id(); xb.nloc = 0u; xb.nx = 0u;
  if (threadIdx.x == 0) (void)xb_add(&xb.bar[XB_XCNT(xb.x)], 1u);
  pre_phase(p0, smem);
  grid.sync();
  {
    unsigned cnt = 0u, mine = 0u;
#pragma unroll 1
    for (unsigned jj = 0; jj < 16; ++jj) { const unsigned c = xb_ld(&xb.bar[XB_XCNT(jj)]); cnt += (c > 0u) ? 1u : 0u; mine = (jj == xb.x) ? c : mine; }
    xb.nloc = mine > 0u ? mine : 1u; xb.nx = cnt > 0u ? cnt : 1u;
  }
  const Params& p = p0;
#pragma unroll 1
  for (int i = 0; i < 4; ++i) {
#pragma unroll 1
    for (int s = 0; s < 6; ++s) {
      if (!step_exists(i, s)) continue;
      int reps = 1;
      if (DUP_SCAN && s == 3 && (i & 1) == 0) reps = 2;
      if (DUP_ATTN && s == 3 && (i & 1) == 1) reps = 2;
      if (DUP_GEMM && (s == 1 || s == 5)) reps = 2;
#pragma unroll 1
      for (int rep = 0; rep < reps; ++rep) {
        run_step(p, i, s, smem);
        xcd_barrier(xb);
      }
    }
  }
  row_phase(p, 4);
}

#if MULTI_LAUNCH
template <int S> __global__ void __launch_bounds__(256, 2) step_kernel(Params p0, int i) {
  __shared__ __attribute__((aligned(16))) char smem[SMEM_BYTES];
  if (S == -1) { pre_phase(p0, smem); return; }
  if (S == 6) { row_phase(p0, 4); return; }
  run_step(p0, i, S, smem);
}
#endif

extern "C" void kernel_launch(void* const* d_in, const int* in_sizes, int n_in, void* d_out, int out_size, void* d_ws, size_t ws_size,
                              hipStream_t stream) {
  static int grid_blocks = 0;
  if (!grid_blocks) {
    int dev = 0, cus = 0, per_cu = 0;
    hipGetDevice(&dev);
    hipDeviceGetAttribute(&cus, hipDeviceAttributeMultiprocessorCount, dev);
    hipOccupancyMaxActiveBlocksPerMultiprocessor(&per_cu, fwd_megakernel, 256, 0);
    if (per_cu > 2) per_cu = 2;
    if (per_cu < 1) per_cu = 1;
    grid_blocks = cus * per_cu;
  }
  Params p{};
  const float** f = (const float**)&p;
  for (int i = 0; i < 29; ++i) f[i] = (const float*)d_in[i];
  p.out = (float*)d_out;
  char* w = (char*)d_ws;
  size_t off = 0;
  auto take = [&](size_t bytes) { char* r = w + off; off += (bytes + 255) & ~(size_t)255; return r; };
  p.gp = (Params*)take(sizeof(Params));
  p.bar = (unsigned*)take((size_t)XCD_BAR_WORDS * 4);
  p.mod = (float*)take((size_t)4 * 9 * 3072 * 4);
  p.ctxbuf = (float*)take((size_t)NC * 1024 * 4);
  p.beta = (float*)take((size_t)2 * MT * 16 * 4);
  p.Wp = (bf*)take((size_t)4480 * LDW * 2);
  p.Wo = (bf*)take((size_t)1024 * LDW * 2);
  p.w2t = (bf*)take((size_t)2 * 65536 * 2);
  p.a2t = (bf*)take((size_t)2 * 65536 * 2);
  p.v2t = (bf*)take((size_t)65536 * 2);
  const size_t big = (size_t)MT * 1024 * 2;
  p.H = (bf*)take((size_t)MT * LDH * 2); p.R = (bf*)take(big); p.K = (bf*)take(big); p.VF = (bf*)take(big);
  p.V2 = (bf*)take(big); p.G = (bf*)take(big); p.Y1 = (bf*)take(big);
  p.HID = (bf*)take((size_t)MT * HIDW * 2);
  if (off > ws_size) fprintf(stderr, "workspace too small: need %zu have %zu\n", off, ws_size);
#if MULTI_LAUNCH
  step_kernel<-1><<<grid_blocks, 256, 0, stream>>>(p, 0);
  for (int i = 0; i < 4; ++i) {
    step_kernel<0><<<grid_blocks, 256, 0, stream>>>(p, i);
    step_kernel<1><<<grid_blocks, 256, 0, stream>>>(p, i);
    if (i == 2) step_kernel<2><<<grid_blocks, 256, 0, stream>>>(p, i);
    step_kernel<3><<<grid_blocks, 256, 0, stream>>>(p, i);
    if ((i & 1) == 0) step_kernel<4><<<grid_blocks, 256, 0, stream>>>(p, i);
    step_kernel<5><<<grid_blocks, 256, 0, stream>>>(p, i);
  }
  step_kernel<6><<<grid_blocks, 256, 0, stream>>>(p, 0);
#else
  (void)hipMemsetAsync(p.bar, 0, (size_t)XCD_BAR_WORDS * 4, stream);
  void* args[] = {&p};
  hipError_t e = hipLaunchCooperativeKernel((void*)fwd_megakernel, dim3(grid_blocks), dim3(256), args, 0, stream);
  if (e != hipSuccess) fprintf(stderr, "cooperative launch failed: %s (grid %d)\n", hipGetErrorString(e), grid_blocks);
#endif
}
```
